# Optimizing an MI355X kernel written in HIP

```python
import math
import jax
import jax.numpy as jnp
from jax import lax
import numpy as np

D_MODEL = 1024
BATCH = 8
SEQ = 2048
DEPTH = 2

D_MIX = D_MODEL
GROUP_W = D_MIX // 4
HEAD_DIM = 64
N_HEADS = GROUP_W // HEAD_DIM
CHUNK = 64
CONV_K = 4
SSM_STATE = 128
SSM_GROUPS = 2
SSM_GROUP_W = GROUP_W // SSM_GROUPS
RWKV_DECAY_RANK = 64
RWKV_ICLR_RANK = 64
NORM_EPS = 1e-6
L2_EPS = 1e-6
RWKV_GN_EPS = 64e-5

HG_COLS = 3 * GROUP_W
GDN_QKV = 3 * GROUP_W
GDN_COLS = GDN_QKV + 2 * N_HEADS
SSM_XBC = GROUP_W + 2 * SSM_GROUPS * SSM_STATE
SSM_COLS = SSM_XBC + N_HEADS
RWKV_COLS = 3 * GROUP_W + RWKV_DECAY_RANK + RWKV_ICLR_RANK
GATE_COLS = D_MIX
IN_COLS = HG_COLS + GDN_COLS + SSM_COLS + RWKV_COLS + GATE_COLS

kernel_name = 'hybrid_hgrn2_gdn_ssd_rwkv7_block'


def _split(t, sizes):
    idx = [int(i) for i in np.cumsum(sizes)[:-1]]
    return jnp.split(t, idx, axis=-1)


def _heads(t, d):
    b, l, _ = t.shape
    return t.reshape(b, l, -1, d).transpose(0, 2, 1, 3)


def _merge(t):
    b, h, l, d = t.shape
    return t.transpose(0, 2, 1, 3).reshape(b, l, h * d)


def _chunks(t):
    b, h, l, d = t.shape
    return t.reshape(b, h, l // CHUNK, CHUNK, d).transpose(2, 0, 1, 3, 4)


def _unchunk(t):
    n, b, h, c, d = t.shape
    return t.transpose(1, 2, 0, 3, 4).reshape(b, h, n * c, d)


def rmsnorm(x, g, eps=NORM_EPS):
    xf = x.astype(jnp.float32)
    y = xf * lax.rsqrt(jnp.mean(xf * xf, axis=-1, keepdims=True) + eps)
    return (y * g.astype(jnp.float32)).astype(x.dtype)


def l2norm(x):
    return x * lax.rsqrt(jnp.sum(x * x, axis=-1, keepdims=True) + L2_EPS)


def causal_dwconv(x, w):
    k = w.shape[0]
    return lax.conv_general_dilated(
        x, w[:, None, :].astype(x.dtype), window_strides=(1,), padding=[(k - 1, 0)],
        dimension_numbers=('NWC', 'WIO', 'NWC'), feature_group_count=x.shape[-1])


def gla_chunked(q, k, v, logf):
    b, h, l, dk = q.shape
    dv = v.shape[-1]
    causal = jnp.tril(jnp.ones((CHUNK, CHUNK), bool))[:, :, None]

    def step(S, inp):
        qi, ki, vi, gi = inp
        cum = jnp.cumsum(gi, axis=-2)
        diff = cum[..., :, None, :] - cum[..., None, :, :]
        dec = jnp.exp(jnp.where(causal, diff, -jnp.inf))
        attn = jnp.einsum('bhtd,bhsd,bhtsd->bhts', qi, ki, dec)
        last = cum[..., -1:, :]
        o = (jnp.einsum('bhts,bhsv->bhtv', attn, vi)
             + jnp.einsum('bhtd,bhdv->bhtv', qi * jnp.exp(cum), S))
        S = (S * jnp.exp(last)[..., 0, :, None]
             + jnp.einsum('bhsd,bhsv->bhdv', ki * jnp.exp(last - cum), vi))
        return S, o

    S0 = jnp.zeros((b, h, dk, dv), jnp.float32)
    _, o = lax.scan(step, S0, (_chunks(q), _chunks(k), _chunks(v), _chunks(logf)))
    return _unchunk(o)


def gated_delta_chunked(q, k, v, beta, g):
    b, h, _, dk = q.shape
    dv = v.shape[-1]
    qc, kc, vc, bc, gc = map(_chunks, (q, k, v, beta, g))
    cum = jnp.cumsum(gc[..., 0], axis=-1)
    causal = jnp.tril(jnp.ones((CHUNK, CHUNK), bool))
    strict = jnp.tril(jnp.ones((CHUNK, CHUNK), bool), -1)
    gam = jnp.exp(jnp.where(causal, cum[..., :, None] - cum[..., None, :], -jnp.inf))
    kb = kc * bc
    a_strict = jnp.where(strict, jnp.einsum('nbhid,nbhjd->nbhij', kb, kc) * gam, 0.0)
    t_mat = a_strict + jnp.eye(CHUNK, dtype=jnp.float32)
    rhs = jnp.concatenate([vc * bc, kb * jnp.exp(cum)[..., None]], axis=-1)
    sol = lax.linalg.triangular_solve(t_mat, rhs, left_side=True, lower=True, unit_diagonal=True)
    u, w = sol[..., :dv], sol[..., dv:]
    qk = jnp.where(causal, jnp.einsum('nbhid,nbhjd->nbhij', qc, kc) * gam, 0.0)
    q_dec = qc * jnp.exp(cum)[..., None]
    k_dec = kc * jnp.exp(cum[..., -1:] - cum)[..., None]
    last = jnp.exp(cum[..., -1])[..., None, None]

    def step(S, inp):
        u_i, w_i, qk_i, qd_i, kd_i, last_i = inp
        v_new = u_i - jnp.einsum('bhcd,bhdv->bhcv', w_i, S)
        o = (jnp.einsum('bhcd,bhdv->bhcv', qd_i, S)
             + jnp.einsum('bhij,bhjv->bhiv', qk_i, v_new))
        S = S * last_i + jnp.einsum('bhcd,bhcv->bhdv', kd_i, v_new)
        return S, o

    S0 = jnp.zeros((b, h, dk, dv), jnp.float32)
    _, o = lax.scan(step, S0, (u, w, qk, q_dec, k_dec, last))
    return _unchunk(o)


def ssd_chunked(xv, bh, ch, ga):
    b, h, _, p = xv.shape
    n_state = bh.shape[-1]
    xc, bc, cc, gc = map(_chunks, (xv, bh, ch, ga))
    cum = jnp.cumsum(gc[..., 0], axis=-1)
    causal = jnp.tril(jnp.ones((CHUNK, CHUNK), bool))
    lmat = jnp.exp(jnp.where(causal, cum[..., :, None] - cum[..., None, :], -jnp.inf))
    scores = jnp.einsum('cbhis,cbhjs->cbhij', cc, bc) * lmat
    y_diag = jnp.einsum('cbhij,cbhjp->cbhip', scores, xc)
    states = jnp.einsum('cbhjs,cbhjp->cbhsp', bc * jnp.exp(cum[..., -1:] - cum)[..., None], xc)
    chunk_decay = jnp.exp(cum[..., -1])[..., None, None]

    def step(S, inp):
        st, dec = inp
        return S * dec + st, S

    S0 = jnp.zeros((b, h, n_state, p), jnp.float32)
    _, s_in = lax.scan(step, S0, (states, chunk_decay))
    y_off = jnp.einsum('cbhis,cbhsp->cbhip', cc * jnp.exp(cum)[..., None], s_in)
    return _unchunk(y_diag + y_off)


def rwkv7_scan(r, k, v, w, kk, a):
    b, h, _, d = r.shape
    xs = tuple(t.transpose(2, 0, 1, 3) for t in (r, k, v, w, kk, a))

    def step(S, inp):
        rt, kt, vt, wt, kkt, at = inp
        sa = jnp.einsum('bhvk,bhk->bhv', S, -kkt)
        S = (S * wt[:, :, None, :] + sa[..., None] * (kkt * at)[:, :, None, :]
             + vt[..., None] * kt[:, :, None, :])
        return S, jnp.einsum('bhvk,bhk->bhv', S, rt)

    S0 = jnp.zeros((b, h, d, d), jnp.float32)
    _, o = lax.scan(step, S0, xs)
    return o.transpose(1, 2, 0, 3)


def hgrn2_mixer(proj, lb, norm_g):
    q, f, i = _split(proj.astype(jnp.float32), [GROUP_W] * 3)
    q = jax.nn.silu(q)
    f = lb + (1.0 - lb) * jax.nn.sigmoid(f)
    k = 1.0 - f
    o = gla_chunked(_heads(q, HEAD_DIM) * HEAD_DIM ** -0.5, _heads(k, HEAD_DIM),
                    _heads(i, HEAD_DIM), _heads(jnp.log(f), HEAD_DIM))
    return _merge(rmsnorm(o, norm_g))


def gated_deltanet_mixer(proj, conv_w, a_log, dt_bias, norm_g):
    proj = proj.astype(jnp.float32)
    qkv, bt, at = _split(proj, [GDN_QKV, N_HEADS, N_HEADS])
    qkv = jax.nn.silu(causal_dwconv(qkv, conv_w))
    q, k, v = _split(qkv, [GROUP_W] * 3)
    q = l2norm(_heads(q, HEAD_DIM)) * HEAD_DIM ** -0.5
    k = l2norm(_heads(k, HEAD_DIM))
    v = _heads(v, HEAD_DIM)
    beta = jax.nn.sigmoid(bt).transpose(0, 2, 1)[..., None]
    g = (-jnp.exp(a_log.astype(jnp.float32))
         * jax.nn.softplus(at + dt_bias)).transpose(0, 2, 1)[..., None]
    o = gated_delta_chunked(q, k, v, beta, g)
    return _merge(rmsnorm(o, norm_g))


def mamba2_mixer(proj, z, conv_w, conv_b, a_log, dt_bias, d_skip, norm_g):
    proj = proj.astype(jnp.float32)
    xbc, dt = _split(proj, [SSM_XBC, N_HEADS])
    xbc = jax.nn.silu(causal_dwconv(xbc, conv_w) + conv_b)
    xs, bm, cm = _split(xbc, [GROUP_W, SSM_GROUPS * SSM_STATE, SSM_GROUPS * SSM_STATE])
    rep = N_HEADS // SSM_GROUPS
    xh = _heads(xs, HEAD_DIM)
    bh = jnp.repeat(_heads(bm, SSM_STATE), rep, axis=1)
    ch = jnp.repeat(_heads(cm, SSM_STATE), rep, axis=1)
    dt = jax.nn.softplus(dt + dt_bias).transpose(0, 2, 1)[..., None]
    a = -jnp.exp(a_log.astype(jnp.float32))[:, None, None]
    y = ssd_chunked(xh * dt, bh, ch, dt * a)
    y = y + xh * d_skip[:, None, None]
    y = _merge(y) * jax.nn.silu(z)
    b, l, _ = y.shape
    y = rmsnorm(y.reshape(b, l, SSM_GROUPS, SSM_GROUP_W), norm_g.reshape(SSM_GROUPS, SSM_GROUP_W))
    return y.reshape(b, l, GROUP_W)


def rwkv7_mixer(proj, mu, w0, w_up, a0, a_up, k_k, k_a, r_k, ln_w, ln_b):
    proj = proj.astype(jnp.float32)
    prev = jnp.pad(proj[:, :-1], ((0, 0), (1, 0), (0, 0)))
    proj = proj + (prev - proj) * mu
    r, k, v, wd, ad = _split(proj, [GROUP_W, GROUP_W, GROUP_W, RWKV_DECAY_RANK, RWKV_ICLR_RANK])
    w = -jax.nn.softplus(-(w0 + jnp.tanh(wd) @ w_up)) - 0.5
    decay = jnp.exp(-jnp.exp(w))
    a = jax.nn.sigmoid(a0 + ad @ a_up)
    kk = l2norm(_heads(k * k_k, HEAD_DIM))
    k = k * (1.0 + (a - 1.0) * k_a)
    rh, kh, vh = _heads(r, HEAD_DIM), _heads(k, HEAD_DIM), _heads(v, HEAD_DIM)
    o = rwkv7_scan(rh, kh, vh, _heads(decay, HEAD_DIM), kk, _heads(a, HEAD_DIM))
    hs = (N_HEADS, 1, HEAD_DIM)
    mean = jnp.mean(o, axis=-1, keepdims=True)
    var = jnp.mean(jnp.square(o - mean), axis=-1, keepdims=True)
    o = (o - mean) * lax.rsqrt(var + RWKV_GN_EPS) * ln_w.reshape(hs) + ln_b.reshape(hs)
    bonus = jnp.sum(rh * kh * r_k.reshape(hs), axis=-1, keepdims=True) * vh
    return _merge(o + bonus)


def setup_inputs(seed: int = 0) -> dict:
    key = jax.random.key(seed)
    ks = jax.random.split(key, 32)
    f32 = jnp.float32

    def nrm(k, shape, s):
        return s * jax.random.normal(k, shape, f32)

    def gain(k, shape):
        return 1.0 + 0.02 * jax.random.normal(k, shape, f32)

    def dt_bias(k):
        dt = jnp.exp(jax.random.uniform(k, (DEPTH, N_HEADS), f32, math.log(1e-3), math.log(1e-1)))
        return dt + jnp.log(-jnp.expm1(-dt))

    def a_log(k):
        return jnp.log(jax.random.uniform(k, (DEPTH, N_HEADS), f32, 1.0, 16.0))

    return {
        'x': jax.random.normal(ks[0], (BATCH, SEQ, D_MODEL), f32),
        'pre_norm_g': gain(ks[1], (DEPTH, D_MODEL)),
        'w_in': nrm(ks[2], (DEPTH, D_MODEL, IN_COLS), D_MODEL ** -0.5),
        'hgrn_lower_bounds': nrm(ks[3], (DEPTH, GROUP_W), 0.1),
        'hgrn_norm_g': gain(ks[4], (DEPTH, HEAD_DIM)),
        'gdn_conv_w': nrm(ks[5], (DEPTH, CONV_K, GDN_QKV), 0.5),
        'gdn_a_log': a_log(ks[6]),
        'gdn_dt_bias': dt_bias(ks[7]),
        'gdn_norm_g': gain(ks[8], (DEPTH, HEAD_DIM)),
        'ssm_conv_w': nrm(ks[9], (DEPTH, CONV_K, SSM_XBC), 0.5),
        'ssm_conv_b': nrm(ks[10], (DEPTH, SSM_XBC), 0.02),
        'ssm_a_log': a_log(ks[11]),
        'ssm_dt_bias': dt_bias(ks[12]),
        'ssm_d': gain(ks[13], (DEPTH, N_HEADS)),
        'ssm_norm_g': gain(ks[14], (DEPTH, GROUP_W)),
        'rwkv_mu': jax.random.uniform(ks[15], (DEPTH, RWKV_COLS), f32),
        'rwkv_w0': jax.random.uniform(ks[16], (DEPTH, GROUP_W), f32, -6.0, -1.0),
        'rwkv_w_up': nrm(ks[17], (DEPTH, RWKV_DECAY_RANK, GROUP_W), 0.1),
        'rwkv_a0': nrm(ks[18], (DEPTH, GROUP_W), 0.1),
        'rwkv_a_up': nrm(ks[19], (DEPTH, RWKV_ICLR_RANK, GROUP_W), 0.1),
        'rwkv_k_k': 0.85 + nrm(ks[20], (DEPTH, GROUP_W), 0.02),
        'rwkv_k_a': gain(ks[21], (DEPTH, GROUP_W)),
        'rwkv_r_k': nrm(ks[22], (DEPTH, GROUP_W), 0.1),
        'rwkv_ln_w': gain(ks[23], (DEPTH, GROUP_W)),
        'rwkv_ln_b': nrm(ks[24], (DEPTH, GROUP_W), 0.02),
        'w_out': nrm(ks[25], (DEPTH, D_MIX, D_MODEL), D_MIX ** -0.5),
        'post_norm_g': gain(ks[26], (DEPTH, D_MODEL)),
    }


def reference(x, pre_norm_g, w_in, hgrn_lower_bounds, hgrn_norm_g, gdn_conv_w, gdn_a_log,
              gdn_dt_bias, gdn_norm_g, ssm_conv_w, ssm_conv_b, ssm_a_log, ssm_dt_bias, ssm_d,
              ssm_norm_g, rwkv_mu, rwkv_w0, rwkv_w_up, rwkv_a0, rwkv_a_up, rwkv_k_k, rwkv_k_a,
              rwkv_r_k, rwkv_ln_w, rwkv_ln_b, w_out, post_norm_g):
    sm = jax.nn.softmax(hgrn_lower_bounds.astype(jnp.float32), axis=0)
    lb_table = jnp.cumsum(sm, axis=0) - sm[0]
    h = x
    for l in range(DEPTH):
        u = rmsnorm(h, pre_norm_g[l])
        proj = jnp.einsum('bld,dc->blc', u, w_in[l])
        p_a, p_b, p_c, p_d, gates = _split(proj, [HG_COLS, GDN_COLS, SSM_COLS, RWKV_COLS, GATE_COLS])
        z_a, z_b, z_c, z_d = _split(gates.astype(jnp.float32), [GROUP_W] * 4)
        y_a = hgrn2_mixer(p_a, lb_table[l], hgrn_norm_g[l]) * jax.nn.silu(z_a)
        y_b = gated_deltanet_mixer(p_b, gdn_conv_w[l], gdn_a_log[l], gdn_dt_bias[l],
                                   gdn_norm_g[l]) * jax.nn.silu(z_b)
        y_c = mamba2_mixer(p_c, z_c, ssm_conv_w[l], ssm_conv_b[l], ssm_a_log[l], ssm_dt_bias[l],
                           ssm_d[l], ssm_norm_g[l])
        y_d = rwkv7_mixer(p_d, rwkv_mu[l], rwkv_w0[l], rwkv_w_up[l], rwkv_a0[l], rwkv_a_up[l],
                          rwkv_k_k[l], rwkv_k_a[l], rwkv_r_k[l], rwkv_ln_w[l],
                          rwkv_ln_b[l]) * jax.nn.silu(z_d)
        y = jnp.concatenate([y_a, y_b, y_c, y_d], axis=-1).astype(h.dtype)
        out = jnp.einsum('blc,cd->bld', y, w_out[l])
        h = h + rmsnorm(out, post_norm_g[l])
    return h
```

```cpp
#include <hip/hip_runtime.h>
#include <cstdio>
#include <cstdint>
namespace pg8 {
#define PG8_LAS __attribute__((address_space(3)))
typedef unsigned short bf16_t;
typedef short bf16x8 __attribute__((ext_vector_type(8)));
typedef float f32x4 __attribute__((ext_vector_type(4)));
typedef unsigned u32x4 __attribute__((ext_vector_type(4)));
constexpr int BM = 256, BK = 64, HALF = 128, HTB = HALF * BK * 2  , STAGE_BYTES = 8 * HTB, NXCD = 8, WGM = 8;

__host__ __device__ __forceinline__ int lds_byte(int r, int c) { const int st = (r >> 4) * 2 + (c >> 5), rr = r & 15, cc = c & 31, ob = rr * 64 + cc * 2; return st * 1024 + (ob ^ (((ob >> 9) & 1) << 5)); }
__host__ __device__ __forceinline__ void stage_rc(int b, int& R, int& C) { const int st = b / 1024, sb = b % 1024, swz = sb ^ (((sb >> 9) & 1) << 5); R = (st >> 1) * 16 + swz / 64; C = (st & 1) * 32 + (swz % 64) / 2; }
__host__ __device__ __forceinline__ int perm32(int rho) { const int n = rho >> 4, i = rho & 15; return 8 * (i >> 2) + 4 * n + (i & 3); }

struct Unit { int pm, pn; };
struct Gemm { const bf16_t* A; const bf16_t* Bt; int M, N, K; };

struct StaticOrder {
    int nM, nN, nwg, G, c;
    __host__ __device__ void init(int M, int N, int G_, int c_) { nM = M / BM; nN = N / BM; nwg = nM * nN; G = G_; c = c_; }
    __host__ __device__ bool next(int i, Unit& u) const {
        const long L = (long)i * G + c; if (L >= nwg) return false;
        int wgid = (int)L; { const int q = nwg / NXCD, r = nwg % NXCD, xcd = wgid % NXCD, off = wgid / NXCD; wgid = (xcd < r ? xcd * (q + 1) : r * (q + 1) + (xcd - r) * q) + off; }
        const int nig = WGM * nN, gid = wgid / nig, fm = gid * WGM, gsz = (nM - fm) < WGM ? (nM - fm) : WGM;
        u.pm = fm + ((wgid % nig) % gsz); u.pn = (wgid % nig) / gsz; return true;
    }
    __device__ __forceinline__ void a_ready(const Unit&) const {}
    __device__ __forceinline__ void done(const Unit&) const {}
};
__device__ __forceinline__ unsigned cvt_pk_bf16(float lo, float hi) { unsigned r; asm volatile("v_cvt_pk_bf16_f32 %0, %1, %2" : "=v"(r) : "v"(lo), "v"(hi)); return r; }
typedef float f32x2 __attribute__((ext_vector_type(2)));
__device__ __forceinline__ f32x2 gelu_pk(f32x2 v) {
    const f32x2 av = __builtin_elementwise_abs(v), d = av * 0.2316418882f + 1.0f;
    f32x2 t; t.x = __builtin_amdgcn_rcpf(d.x); t.y = __builtin_amdgcn_rcpf(d.y);
    f32x2 q = t * 0.5307027145f + (-0.7265760135f); q = q * t + 0.7107068705f; q = q * t + (-0.142248368f); q = q * t + 0.127414796f; q = q * t;
    const f32x2 s = (v * v) * (-0.72134752044f);
    f32x2 e; e.x = __builtin_amdgcn_exp2f(s.x); e.y = __builtin_amdgcn_exp2f(s.y);
    const f32x2 m = v * (q * e), r = v - m;
    f32x2 o; o.x = v.x < 0.f ? m.x : r.x; o.y = v.y < 0.f ? m.y : r.y; return o;
}

struct EpiF32 {
    static constexpr bool PERM = false, AFTER_DRAIN = false;
    float* C; int ldc; const float* bias;
    __device__ __forceinline__ void operator()(const f32x4 (&acc)[2][2][4][2], const Unit& u, int wr, int wc, int fr, int fq) const {
        const int row0 = u.pm * BM + wr * 64 + fr, col0 = u.pn * BM + wc * 32 + 4 * fq;
        f32x4 bv[2][2];
#pragma unroll
        for (int bj = 0; bj < 2; ++bj)
#pragma unroll
            for (int n = 0; n < 2; ++n) bv[bj][n] = bias ? *(const f32x4*)(bias + col0 + bj * HALF + n * 16) : (f32x4){0.f, 0.f, 0.f, 0.f};
#pragma unroll
        for (int ai = 0; ai < 2; ++ai)
#pragma unroll
            for (int m = 0; m < 4; ++m) { float* rowp = C + (size_t)(row0 + ai * HALF + m * 16) * ldc + col0;
#pragma unroll
                for (int bj = 0; bj < 2; ++bj)
#pragma unroll
                    for (int n = 0; n < 2; ++n) *(f32x4*)(rowp + bj * HALF + n * 16) = acc[ai][bj][m][n] + bv[bj][n]; }
    }
};
template <int ACT  > struct EpiBf16 {
    static constexpr bool PERM = true, AFTER_DRAIN = false;
    bf16_t* O; int ldc; const float* bias; int split_cols; size_t split_stride;
    __device__ __forceinline__ void operator()(const f32x4 (&acc)[2][2][4][2], const Unit& u, int wr, int wc, int fr, int fq) const {
        const int row0 = u.pm * BM + wr * 64 + fr; int colt = u.pn * BM; bf16_t* base = O;
        if (split_cols) { const int t = colt / split_cols; base += (size_t)t * split_stride; colt -= t * split_cols; }
        const int col0 = colt + wc * 32 + 8 * fq, bcol0 = u.pn * BM + wc * 32 + 8 * fq;
        f32x4 bv[2][2];
#pragma unroll
        for (int bj = 0; bj < 2; ++bj)
#pragma unroll
            for (int n = 0; n < 2; ++n) bv[bj][n] = bias ? *(const f32x4*)(bias + bcol0 + bj * HALF + 4 * n) : (f32x4){0.f, 0.f, 0.f, 0.f};
#pragma unroll
        for (int ai = 0; ai < 2; ++ai)
#pragma unroll
            for (int m = 0; m < 4; ++m) { bf16_t* rowp = base + (size_t)(row0 + ai * HALF + m * 16) * ldc + col0;
#pragma unroll
                for (int bj = 0; bj < 2; ++bj) { f32x4 v0 = acc[ai][bj][m][0] + bv[bj][0], v1 = acc[ai][bj][m][1] + bv[bj][1];
                    if (ACT == 1) { f32x2 a = gelu_pk((f32x2){v0[0], v0[1]}), b = gelu_pk((f32x2){v0[2], v0[3]}), c = gelu_pk((f32x2){v1[0], v1[1]}), d = gelu_pk((f32x2){v1[2], v1[3]});
                        v0 = (f32x4){a.x, a.y, b.x, b.y}; v1 = (f32x4){c.x, c.y, d.x, d.y}; }
                    if (ACT == 2) {
#pragma unroll
                        for (int j = 0; j < 4; ++j) { v0[j] = 0.5f * v0[j] * (1.0f + erff(v0[j] * 0.70710678f)); v1[j] = 0.5f * v1[j] * (1.0f + erff(v1[j] * 0.70710678f)); } }
                    u32x4 w; w.x = cvt_pk_bf16(v0[0], v0[1]); w.y = cvt_pk_bf16(v0[2], v0[3]); w.z = cvt_pk_bf16(v1[0], v1[1]); w.w = cvt_pk_bf16(v1[2], v1[3]);
                    *(u32x4*)(rowp + bj * HALF) = w; } }
    }
};
template <class Epi, class Sched, bool STAMP = false>
__device__ __forceinline__ void gemm_phase(PG8_LAS unsigned char* lds, const Gemm g, const Sched& S, const Epi& E, unsigned long long* stamps) {
    const int tid = threadIdx.x, wid = __builtin_amdgcn_readfirstlane(tid >> 6), lane = tid & 63, wr = wid >> 2, wc = wid & 3, fr = lane & 15, fq = lane >> 4;
    const int K = g.K, nt = K / BK;
    int ts_lo = 0, ts_hi = 0, nts = 0; const unsigned long long rt_entry = STAMP ? (unsigned long long)wall_clock64() : 0ull;
#define PG8_STAMP() do { if (STAMP && wid == 0 && nts < 64) { const unsigned long long _c = (unsigned long long)clock64(); \
        ts_lo = (lane == nts) ? (int)(unsigned)_c : ts_lo; ts_hi = (lane == nts) ? (int)(unsigned)(_c >> 32) : ts_hi; ++nts; } } while (0)
    PG8_STAMP();
    unsigned voffA[2], voffB[2];
#pragma unroll
    for (int i = 0; i < 2; ++i) { int R, C; stage_rc(tid * 16 + i * 8192, R, C); const int Rb = Epi::PERM ? ((R & ~31) + perm32(R & 31)) : R;
        voffA[i] = (unsigned)(R * K + C) * 2u; voffB[i] = (unsigned)(Rb * K + C) * 2u; }
    const size_t kstep = (size_t)(BK * 2);
    const size_t hstep = (size_t)HALF * K * 2;
    const size_t tstep = 2 * hstep;
    const unsigned ldsw = (unsigned)wid * 1024u;
    const int aoff = lds_byte(wr * 64 + fr, fq * 8), boff = lds_byte(wc * 32 + fr, fq * 8);
#define PG8_SA(b, h) (((b) * 2 + (h)) * HTB)
#define PG8_SB(b, h) ((4 + (b) * 2 + (h)) * HTB)
#define PG8_STAGE(bufoff, gbase, voff) do { _Pragma("unroll") for (int _i = 0; _i < 2; ++_i) \
        __builtin_amdgcn_global_load_lds((const unsigned*)((const char*)(gbase) + (voff)[_i]), (PG8_LAS unsigned*)(lds + (bufoff) + ldsw + _i * 8192), 16, 0, 0); } while (0)
#define PG8_LDA(dst, b, h) do { _Pragma("unroll") for (int m = 0; m < 4; ++m) _Pragma("unroll") for (int k = 0; k < 2; ++k) dst[m][k] = *(const PG8_LAS bf16x8*)(lds + PG8_SA(b, h) + aoff + m * 2048 + k * 1024); } while (0)
#define PG8_LDB(dst, b, h) do { _Pragma("unroll") for (int n = 0; n < 2; ++n) _Pragma("unroll") for (int k = 0; k < 2; ++k) dst[n][k] = *(const PG8_LAS bf16x8*)(lds + PG8_SB(b, h) + boff + n * 2048 + k * 1024); } while (0)
#define PG8_MMA(ai, bj, At, Bt) do { __builtin_amdgcn_s_setprio(1); _Pragma("unroll") for (int m = 0; m < 4; ++m) _Pragma("unroll") for (int n = 0; n < 2; ++n) _Pragma("unroll") for (int k = 0; k < 2; ++k) \
        acc[ai][bj][m][n] = __builtin_amdgcn_mfma_f32_16x16x32_bf16(Bt[n][k], At[m][k], acc[ai][bj][m][n], 0, 0, 0); __builtin_amdgcn_s_setprio(0); } while (0)
#define PG8_WAIT_V(n) asm volatile("s_waitcnt vmcnt(" #n ")" ::: "memory")
#define PG8_WAIT_L(n) asm volatile("s_waitcnt lgkmcnt(" #n ")" ::: "memory")
#define PG8_BAR __builtin_amdgcn_s_barrier()
#define PG8_SCHED __builtin_amdgcn_sched_barrier(0)
    Unit cur, nxt; int ui = 0;
    if (!S.next(0, cur)) return;
    f32x4 acc[2][2][4][2];
#pragma unroll
    for (int a = 0; a < 2; ++a)
#pragma unroll
        for (int b = 0; b < 2; ++b)
#pragma unroll
            for (int m = 0; m < 4; ++m)
#pragma unroll
                for (int n = 0; n < 2; ++n) acc[a][b][m][n] = (f32x4){0.f, 0.f, 0.f, 0.f};
    bf16x8 At[4][2], B0[2][2], B1[2][2];
    const char* cA = (const char*)g.A + (size_t)cur.pm * tstep; const char* cB = (const char*)g.Bt + (size_t)cur.pn * tstep;
    S.a_ready(cur);
    PG8_STAGE(PG8_SB(0, 0), cB, voffB); PG8_STAGE(PG8_SA(0, 0), cA, voffA); PG8_STAGE(PG8_SB(0, 1), cB + hstep, voffB); PG8_STAGE(PG8_SA(0, 1), cA + hstep, voffA);
    if (wr == 1) PG8_BAR;
    PG8_WAIT_V(4); PG8_BAR;
    PG8_STAGE(PG8_SB(1, 0), cB + kstep, voffB); PG8_STAGE(PG8_SA(1, 0), cA + kstep, voffA); PG8_STAGE(PG8_SB(1, 1), cB + hstep + kstep, voffB);
    PG8_WAIT_V(6); PG8_BAR;
    PG8_STAMP();
    for (;;) {
        const bool has_next = S.next(ui + 1, nxt);
        const char* nA = has_next ? (const char*)g.A + (size_t)nxt.pm * tstep : cA; const char* nB = has_next ? (const char*)g.Bt + (size_t)nxt.pn * tstep : cB;
        for (int t = 0; t < nt; t += 2) {
            const bool last = (t == nt - 2);
            const char* a1 = cA + (size_t)(t + 1) * kstep;
            const char* a2 = last ? nA : cA + (size_t)(t + 2) * kstep; const char* b2 = last ? nB : cB + (size_t)(t + 2) * kstep;
            const char* a3 = a2 + kstep; const char* b3 = b2 + kstep;
            if (last && has_next) S.a_ready(nxt);
            PG8_LDB(B0, 0, 0); PG8_SCHED; PG8_LDA(At, 0, 0); PG8_STAGE(PG8_SA(1, 1), a1 + hstep, voffA);
            PG8_WAIT_L(8); PG8_BAR; PG8_WAIT_L(0); PG8_MMA(0, 0, At, B0); PG8_BAR; PG8_SCHED;
            PG8_LDB(B1, 0, 1); PG8_STAGE(PG8_SB(0, 0), b2, voffB);
            PG8_BAR; PG8_WAIT_L(0); PG8_MMA(0, 1, At, B1); PG8_BAR;
            PG8_LDA(At, 0, 1); PG8_STAGE(PG8_SA(0, 0), a2, voffA);
            PG8_BAR; PG8_WAIT_L(0); PG8_MMA(1, 0, At, B0); PG8_BAR; PG8_SCHED;
            PG8_STAGE(PG8_SB(0, 1), b2 + hstep, voffB);
            PG8_WAIT_V(6); PG8_BAR; PG8_MMA(1, 1, At, B1); PG8_BAR;
            PG8_LDB(B0, 1, 0); PG8_SCHED; PG8_LDA(At, 1, 0); PG8_STAGE(PG8_SA(0, 1), a2 + hstep, voffA);
            PG8_WAIT_L(8); PG8_BAR; PG8_WAIT_L(0); PG8_MMA(0, 0, At, B0); PG8_BAR; PG8_SCHED;
            PG8_LDB(B1, 1, 1); PG8_STAGE(PG8_SB(1, 0), b3, voffB);
            PG8_BAR; PG8_WAIT_L(0); PG8_MMA(0, 1, At, B1); PG8_BAR;
            PG8_LDA(At, 1, 1); PG8_STAGE(PG8_SA(1, 0), a3, voffA);
            PG8_BAR; PG8_WAIT_L(0); PG8_MMA(1, 0, At, B0); PG8_BAR; PG8_SCHED;
            PG8_STAGE(PG8_SB(1, 1), b3 + hstep, voffB);
            PG8_WAIT_V(6); PG8_BAR; PG8_MMA(1, 1, At, B1); PG8_BAR;
        }
        PG8_STAMP();
        if constexpr (!Epi::AFTER_DRAIN) { E(acc, cur, wr, wc, fr, fq); S.done(cur); }
        PG8_STAMP();
        if (!has_next) break;
#pragma unroll
        for (int a = 0; a < 2; ++a)
#pragma unroll
            for (int b = 0; b < 2; ++b)
#pragma unroll
                for (int m = 0; m < 4; ++m)
#pragma unroll
                    for (int n = 0; n < 2; ++n) acc[a][b][m][n] = (f32x4){0.f, 0.f, 0.f, 0.f};
        cur = nxt; cA = nA; cB = nB; ++ui;
    }
    PG8_WAIT_V(0);
    if (wr == 0) PG8_BAR;
    PG8_BAR;
    if constexpr (Epi::AFTER_DRAIN) { E.fused(acc, cur, wr, wc, fr, fq, lds, wid, lane); S.done(cur); }
    PG8_STAMP();
    if (STAMP && wid == 0) { stamps[lane] = lane < nts ? (((unsigned long long)(unsigned)ts_hi << 32) | (unsigned)ts_lo) : 0ull;
        if (lane == 62) stamps[62] = rt_entry; if (lane == 63) stamps[63] = (unsigned long long)wall_clock64(); }
#undef PG8_STAMP
#undef PG8_SA
#undef PG8_SB
#undef PG8_STAGE
#undef PG8_LDA
#undef PG8_LDB
#undef PG8_MMA
#undef PG8_WAIT_V
#undef PG8_WAIT_L
#undef PG8_BAR
#undef PG8_SCHED
}
}

constexpr int BATCH = 8, SEQ = 2048, DM = 1024, MTOK = BATCH * SEQ, NLAYER = 2;
constexpr int GW = 256, HD = 64, NHEAD = 4;
constexpr int IN_COLS = 4236, NP = 4352;
constexpr int C_HG_Q = 0, C_HG_F = 256, C_HG_I = 512;
constexpr int C_GD_Q = 768, C_GD_K = 1024, C_GD_V = 1280;
constexpr int C_SS_X = 1536, C_SS_B = 1792, C_SS_C = 2048;
constexpr int C_RW_R = 2304, C_RW_K = 2560, C_RW_V = 2816;
constexpr int C_Z = 3072;
constexpr int C_GD_BETA = 4096, C_GD_DEC = 4100, C_SS_DT = 4104, C_RW_WD = 4112, C_RW_AD = 4176;

typedef unsigned short bf16;
__host__ __device__ __forceinline__ int old_col(int n) {
    if (n < 1536) return n;
    if (n < 2304) return 1544 + (n - 1536);
    if (n < 3072) return 2316 + (n - 2304);
    if (n < 4096) return 3212 + (n - 3072);
    if (n < 4104) return 1536 + (n - 4096);
    if (n < 4108) return 2312 + (n - 4104);
    if (n < 4112) return -1;
    if (n < 4240) return 3084 + (n - 4112);
    return -1;
}
__device__ __forceinline__ unsigned f2bf(float f) { unsigned u = __builtin_bit_cast(unsigned, f); return (u + 0x7fffu + ((u >> 16) & 1u)) >> 16; }
__device__ __forceinline__ float bf2f(bf16 b) { return __builtin_bit_cast(float, ((unsigned)b) << 16); }
__device__ __forceinline__ float wave_sum(float v) {
#pragma unroll
    for (int o = 1; o < 64; o <<= 1) v += __shfl_xor(v, o);
    return v;
}
__device__ __forceinline__ float sigmoidf_(float x) { return 1.f / (1.f + __expf(-x)); }
__device__ __forceinline__ float siluf_(float x) { return x / (1.f + __expf(-x)); }
__device__ __forceinline__ float softplusf_(float x) { return x > 20.f ? x : log1pf(__expf(x)); }

struct Inputs {
    const float* x; const float* pre_norm_g; const float* w_in; const float* hgrn_lb; const float* hgrn_norm_g;
    const float* gdn_conv_w; const float* gdn_a_log; const float* gdn_dt_bias; const float* gdn_norm_g;
    const float* ssm_conv_w; const float* ssm_conv_b; const float* ssm_a_log; const float* ssm_dt_bias; const float* ssm_d; const float* ssm_norm_g;
    const float* rwkv_mu; const float* rwkv_w0; const float* rwkv_w_up; const float* rwkv_a0; const float* rwkv_a_up; const float* rwkv_k_k; const float* rwkv_k_a;
    const float* rwkv_r_k; const float* rwkv_ln_w; const float* rwkv_ln_b; const float* w_out; const float* post_norm_g;
};

__global__ __launch_bounds__(256) void k_wprep(const float* __restrict__ W, int K, int N, bf16* __restrict__ WT, int use_perm) {
    __shared__ float tile[64][33];
    const int n0 = blockIdx.x * 32, k0 = blockIdx.y * 64, tid = threadIdx.x;
    const int nn = tid & 31, kq = tid >> 5;
    const int oc = use_perm ? old_col(n0 + nn) : (n0 + nn);
#pragma unroll
    for (int i = 0; i < 8; ++i) { const int kk = kq + 8 * i; tile[kk][nn] = (oc >= 0) ? W[(size_t)(k0 + kk) * N + oc] : 0.f; }
    __syncthreads();
    const int n = tid >> 3, kc = (tid & 7) * 8;
    uint4 o;
    o.x = f2bf(tile[kc + 0][n]) | (f2bf(tile[kc + 1][n]) << 16);
    o.y = f2bf(tile[kc + 2][n]) | (f2bf(tile[kc + 3][n]) << 16);
    o.z = f2bf(tile[kc + 4][n]) | (f2bf(tile[kc + 5][n]) << 16);
    o.w = f2bf(tile[kc + 6][n]) | (f2bf(tile[kc + 7][n]) << 16);
    *(uint4*)(WT + (size_t)(n0 + n) * K + k0 + kc) = o;
}

__global__ __launch_bounds__(256) void k_rmsnorm_bf16(const float* __restrict__ h, const float* __restrict__ g, bf16* __restrict__ u) {
    const int row = blockIdx.x * 4 + (threadIdx.x >> 6), lane = threadIdx.x & 63;
    const float4* xr = (const float4*)(h + (size_t)row * DM) + lane;
    const float4* gr = (const float4*)g + lane;
    float4 v[4]; float s = 0.f;
#pragma unroll
    for (int j = 0; j < 4; ++j) { v[j] = xr[64 * j]; s += (v[j].x * v[j].x + v[j].y * v[j].y) + (v[j].z * v[j].z + v[j].w * v[j].w); }
    const float r = rsqrtf(wave_sum(s) * (1.f / DM) + 1e-6f);
    uint2* o8 = (uint2*)(u + (size_t)row * DM) + lane;
#pragma unroll
    for (int j = 0; j < 4; ++j) { const float4 gg = gr[64 * j]; uint2 o;
        o.x = f2bf(v[j].x * r * gg.x) | (f2bf(v[j].y * r * gg.y) << 16); o.y = f2bf(v[j].z * r * gg.z) | (f2bf(v[j].w * r * gg.w) << 16); o8[64 * j] = o; }
}

__global__ __launch_bounds__(256) void k_post(const float* h, const float* __restrict__ outp, const float* __restrict__ g, float* hnew) {
    const int row = blockIdx.x * 4 + (threadIdx.x >> 6), lane = threadIdx.x & 63;
    const float4* orow = (const float4*)(outp + (size_t)row * DM) + lane;
    const float4* hr = (const float4*)(h + (size_t)row * DM) + lane;
    const float4* gr = (const float4*)g + lane;
    float4 v[4]; float s = 0.f;
#pragma unroll
    for (int j = 0; j < 4; ++j) { v[j] = orow[64 * j]; s += (v[j].x * v[j].x + v[j].y * v[j].y) + (v[j].z * v[j].z + v[j].w * v[j].w); }
    const float r = rsqrtf(wave_sum(s) * (1.f / DM) + 1e-6f);
    float4* o = (float4*)(hnew + (size_t)row * DM) + lane;
#pragma unroll
    for (int j = 0; j < 4; ++j) { const float4 gg = gr[64 * j]; const float4 hh = hr[64 * j]; float4 w;
        w.x = hh.x + v[j].x * r * gg.x; w.y = hh.y + v[j].y * r * gg.y; w.z = hh.z + v[j].z * r * gg.z; w.w = hh.w + v[j].w * r * gg.w; o[64 * j] = w; }
}

template <int MODE> __global__ __launch_bounds__(512, 2) void k_gemm(const bf16* A, const bf16* Bt, void* out, int M, int N, int K, int ldc) {
    extern __shared__ __attribute__((aligned(16))) unsigned char shm[];
    pg8::Gemm g; g.A = A; g.Bt = Bt; g.M = M; g.N = N; g.K = K;
    pg8::StaticOrder S; S.init(M, N, (int)gridDim.x, (int)blockIdx.x);
    if constexpr (MODE == 0) { pg8::EpiBf16<0> E; E.O = (bf16*)out; E.ldc = ldc; E.bias = nullptr; E.split_cols = 0; E.split_stride = 0;
        pg8::gemm_phase<pg8::EpiBf16<0>, pg8::StaticOrder, false>((PG8_LAS unsigned char*)shm, g, S, E, nullptr); }
    else { pg8::EpiF32 E; E.C = (float*)out; E.ldc = ldc; E.bias = nullptr;
        pg8::gemm_phase<pg8::EpiF32, pg8::StaticOrder, false>((PG8_LAS unsigned char*)shm, g, S, E, nullptr); }
}

constexpr int TB = 8;
struct MixArgs { Inputs in; const bf16* proj; bf16* y; int layer; int pad; };

__device__ __forceinline__ float ldp(const bf16* P, int t, int col) { return t >= 0 ? bf2f(P[(size_t)t * NP + col]) : 0.f; }

__device__ __forceinline__ void mix_hgrn(const MixArgs& a, const bf16* P, bf16* Y, int h, int lane, float* lds) {
    const int l = a.layer, c = h * 64 + lane;
    float lbv = 0.f;
    if (l == 1) { const float x0 = a.in.hgrn_lb[c], x1 = a.in.hgrn_lb[GW + c]; const float mx = fmaxf(x0, x1); const float e0 = __expf(x0 - mx), e1 = __expf(x1 - mx); lbv = e1 / (e0 + e1); }
    const float gn = a.in.hgrn_norm_g[l * HD + lane];
    float* sq = lds; float* sf = lds + TB * 64;
    float S[64];
#pragma unroll
    for (int d = 0; d < 64; ++d) S[d] = 0.f;
    for (int tb = 0; tb < SEQ / TB; ++tb) {
        for (int i = 0; i < TB; ++i) { const int t = tb * TB + i;
            const float pq = ldp(P, t, C_HG_Q + c), pf = ldp(P, t, C_HG_F + c);
            sq[i * 64 + lane] = siluf_(pq) * 0.125f; sf[i * 64 + lane] = lbv + (1.f - lbv) * sigmoidf_(pf); }
        __syncthreads();
        for (int i = 0; i < TB; ++i) { const int t = tb * TB + i;
            const float vv = ldp(P, t, C_HG_I + c); float o = 0.f;
#pragma unroll
            for (int d = 0; d < 64; ++d) { const float f = sf[i * 64 + d]; S[d] = f * S[d] + (1.f - f) * vv; o += S[d] * sq[i * 64 + d]; }
            const float ss = wave_sum(o * o);
            float yv = o * rsqrtf(ss * (1.f / 64.f) + 1e-6f) * gn;
            yv *= siluf_(ldp(P, t, C_Z + 0 + c));
            Y[(size_t)t * DM + 0 + c] = (bf16)f2bf(yv); }
        __syncthreads();
    }
}

__device__ __forceinline__ float conv4(const bf16* P, int t, int col, const float* w4) {
    return w4[0] * ldp(P, t - 3, col) + w4[1] * ldp(P, t - 2, col) + w4[2] * ldp(P, t - 1, col) + w4[3] * ldp(P, t, col);
}

__device__ __forceinline__ void mix_gdn(const MixArgs& a, const bf16* P, bf16* Y, int h, int lane, float* lds) {
    const int l = a.layer, c = h * 64 + lane;
    const float* cw = a.in.gdn_conv_w + (size_t)l * 4 * 768;
    float wq[4], wk[4], wv[4];
#pragma unroll
    for (int j = 0; j < 4; ++j) { wq[j] = cw[j * 768 + c]; wk[j] = cw[j * 768 + 256 + c]; wv[j] = cw[j * 768 + 512 + c]; }
    const float Aneg = -__expf(a.in.gdn_a_log[l * 4 + h]), dtb = a.in.gdn_dt_bias[l * 4 + h];
    const float gn = a.in.gdn_norm_g[l * HD + lane];
    float* sq = lds; float* sk = lds + TB * 64;
    float S[64];
#pragma unroll
    for (int d = 0; d < 64; ++d) S[d] = 0.f;
    for (int tb = 0; tb < SEQ / TB; ++tb) {
        for (int i = 0; i < TB; ++i) { const int t = tb * TB + i;
            const float qc = siluf_(conv4(P, t, C_GD_Q + c, wq)), kc = siluf_(conv4(P, t, C_GD_K + c, wk));
            const float qs = wave_sum(qc * qc), ks = wave_sum(kc * kc);
            sq[i * 64 + lane] = qc * rsqrtf(qs + 1e-6f) * 0.125f; sk[i * 64 + lane] = kc * rsqrtf(ks + 1e-6f); }
        __syncthreads();
        for (int i = 0; i < TB; ++i) { const int t = tb * TB + i;
            const float vv = siluf_(conv4(P, t, C_GD_V + c, wv));
            const float beta = sigmoidf_(ldp(P, t, C_GD_BETA + h));
            const float gg = Aneg * softplusf_(ldp(P, t, C_GD_DEC + h) + dtb);
            const float al = __expf(gg);
            float dot = 0.f;
#pragma unroll
            for (int d = 0; d < 64; ++d) dot += S[d] * sk[i * 64 + d];
            const float cc = beta * (vv - al * dot); float o = 0.f;
#pragma unroll
            for (int d = 0; d < 64; ++d) { S[d] = al * S[d] + sk[i * 64 + d] * cc; o += S[d] * sq[i * 64 + d]; }
            const float ss = wave_sum(o * o);
            float yv = o * rsqrtf(ss * (1.f / 64.f) + 1e-6f) * gn;
            yv *= siluf_(ldp(P, t, C_Z + 256 + c));
            Y[(size_t)t * DM + 256 + c] = (bf16)f2bf(yv); }
        __syncthreads();
    }
}

__device__ __forceinline__ void mix_ssd(const MixArgs& a, const bf16* P, bf16* Y, int g, int wave, int lane, float* ldsw  ) {
    const int l = a.layer, h = g * 2 + wave, c = h * 64 + lane, tid = wave * 64 + lane;
    const float* cw = a.in.ssm_conv_w + (size_t)l * 4 * 768; const float* cb = a.in.ssm_conv_b + (size_t)l * 768;
    float wx[4], wB[4], wC[4];
    const int chB = 256 + g * 128 + tid, chC = 512 + g * 128 + tid;
#pragma unroll
    for (int j = 0; j < 4; ++j) { wx[j] = cw[j * 768 + c]; wB[j] = cw[j * 768 + chB]; wC[j] = cw[j * 768 + chC]; }
    const float bx = cb[c], bB = cb[chB], bC = cb[chC];
    const float Aneg = -__expf(a.in.ssm_a_log[l * 4 + h]), dtb = a.in.ssm_dt_bias[l * 4 + h], dsk = a.in.ssm_d[l * 4 + h];
    const float gn = a.in.ssm_norm_g[l * GW + c];
    float* sB = ldsw; float* sC = ldsw + TB * 128; float* sS = ldsw + 2 * TB * 128;
    float H[128];
#pragma unroll
    for (int n = 0; n < 128; ++n) H[n] = 0.f;
    for (int tb = 0; tb < SEQ / TB; ++tb) {
        for (int i = 0; i < TB; ++i) { const int t = tb * TB + i;
            sB[i * 128 + tid] = siluf_(conv4(P, t, C_SS_X + chB, wB) + bB); sC[i * 128 + tid] = siluf_(conv4(P, t, C_SS_X + chC, wC) + bC); }
        __syncthreads();
        float yv[TB];
#pragma unroll
        for (int i = 0; i < TB; ++i) { const int t = tb * TB + i;
            const float xx = siluf_(conv4(P, t, C_SS_X + c, wx) + bx);
            const float dt = softplusf_(ldp(P, t, C_SS_DT + h) + dtb);
            const float dec = __expf(dt * Aneg), xv = xx * dt;
            float y = 0.f;
#pragma unroll
            for (int n = 0; n < 128; ++n) { H[n] = dec * H[n] + sB[i * 128 + n] * xv; y += sC[i * 128 + n] * H[n]; }
            y += xx * dsk;
            y *= siluf_(ldp(P, t, C_Z + 512 + c));
            yv[i] = y;
            const float ss = wave_sum(y * y);
            if (lane == 0) sS[i * 2 + wave] = ss; }
        __syncthreads();
#pragma unroll
        for (int i = 0; i < TB; ++i) { const int t = tb * TB + i;
            const float ss = sS[i * 2] + sS[i * 2 + 1];
            Y[(size_t)t * DM + 512 + c] = (bf16)f2bf(yv[i] * rsqrtf(ss * (1.f / 128.f) + 1e-6f) * gn); }
        __syncthreads();
    }
}

__device__ __forceinline__ float rshift(const bf16* P, int t, int col, float mu) { const float x = ldp(P, t, col), xp = ldp(P, t - 1, col); return x + (xp - x) * mu; }

__device__ __forceinline__ void mix_rwkv(const MixArgs& a, const bf16* P, bf16* Y, int h, int lane, float* lds) {
    const int l = a.layer, c = h * 64 + lane;
    const float* mu = a.in.rwkv_mu + (size_t)l * 896;
    const float mu_r = mu[c], mu_k = mu[256 + c], mu_v = mu[512 + c], mu_wd = mu[768 + lane], mu_ad = mu[832 + lane];
    const float w0 = a.in.rwkv_w0[l * GW + c], a0 = a.in.rwkv_a0[l * GW + c], kkc = a.in.rwkv_k_k[l * GW + c], kac = a.in.rwkv_k_a[l * GW + c];
    const float rkc = a.in.rwkv_r_k[l * GW + c], lnw = a.in.rwkv_ln_w[l * GW + c], lnb = a.in.rwkv_ln_b[l * GW + c];
    const float* wup = a.in.rwkv_w_up + (size_t)l * 64 * GW; const float* aup = a.in.rwkv_a_up + (size_t)l * 64 * GW;
    float* swd = lds; float* sad = lds + TB * 64; float* sdec = lds + 2 * TB * 64; float* skk = lds + 3 * TB * 64; float* skka = lds + 4 * TB * 64;
    float* sk = lds + 5 * TB * 64; float* sr = lds + 6 * TB * 64; float* sbd = lds + 7 * TB * 64;
    float S[64];
#pragma unroll
    for (int d = 0; d < 64; ++d) S[d] = 0.f;
    for (int tb = 0; tb < SEQ / TB; ++tb) {
        for (int i = 0; i < TB; ++i) { const int t = tb * TB + i;
            swd[i * 64 + lane] = tanhf(rshift(P, t, C_RW_WD + lane, mu_wd)); sad[i * 64 + lane] = rshift(P, t, C_RW_AD + lane, mu_ad); }
        __syncthreads();
        for (int i = 0; i < TB; ++i) { const int t = tb * TB + i;
            const float r = rshift(P, t, C_RW_R + c, mu_r), k = rshift(P, t, C_RW_K + c, mu_k);
            float wl = w0, al = a0;
#pragma unroll 4
            for (int j = 0; j < 64; ++j) { wl += swd[i * 64 + j] * wup[j * GW + c]; al += sad[i * 64 + j] * aup[j * GW + c]; }
            const float w = -softplusf_(-wl) - 0.5f;
            const float dec = __expf(-__expf(w));
            const float av = sigmoidf_(al);
            const float kr = k * kkc;
            const float kk = kr * rsqrtf(wave_sum(kr * kr) + 1e-6f);
            const float k2 = k * (1.f + (av - 1.f) * kac);
            sdec[i * 64 + lane] = dec; skk[i * 64 + lane] = kk; skka[i * 64 + lane] = kk * av; sk[i * 64 + lane] = k2; sr[i * 64 + lane] = r;
            const float bdv = wave_sum(r * k2 * rkc); if (lane == 0) sbd[i] = bdv; }
        __syncthreads();
        for (int i = 0; i < TB; ++i) { const int t = tb * TB + i;
            const float vv = rshift(P, t, C_RW_V + c, mu_v);
            float sa = 0.f;
#pragma unroll
            for (int d = 0; d < 64; ++d) sa -= S[d] * skk[i * 64 + d];
            float o = 0.f;
#pragma unroll
            for (int d = 0; d < 64; ++d) { S[d] = S[d] * sdec[i * 64 + d] + sa * skka[i * 64 + d] + vv * sk[i * 64 + d]; o += S[d] * sr[i * 64 + d]; }
            const float mean = wave_sum(o) * (1.f / 64.f); const float dv = o - mean;
            const float var = wave_sum(dv * dv) * (1.f / 64.f);
            float yv = dv * rsqrtf(var + 64e-5f) * lnw + lnb + sbd[i] * vv;
            yv *= siluf_(ldp(P, t, C_Z + 768 + c));
            Y[(size_t)t * DM + 768 + c] = (bf16)f2bf(yv); }
        __syncthreads();
    }
}

template <int MIXER> __global__ __launch_bounds__(128) void k_mixers_simple(MixArgs a) {
    __shared__ float lds[2 * 8 * TB * 64];
    const int b = blockIdx.x >> 1, hp = blockIdx.x & 1, wave = threadIdx.x >> 6, lane = threadIdx.x & 63, h = hp * 2 + wave;
    const bf16* P = a.proj + (size_t)b * SEQ * NP; bf16* Y = a.y + (size_t)b * SEQ * DM;
    if constexpr (MIXER == 0) mix_hgrn(a, P, Y, h, lane, lds + wave * 8 * TB * 64);
    else if constexpr (MIXER == 1) mix_gdn(a, P, Y, h, lane, lds + wave * 8 * TB * 64);
    else if constexpr (MIXER == 2) mix_ssd(a, P, Y, hp, wave, lane, lds);
    else mix_rwkv(a, P, Y, h, lane, lds + wave * 8 * TB * 64);
}

constexpr size_t MiB = 1u << 20;
constexpr size_t WS_WIN = 1 * MiB;
constexpr size_t WS_WOUT = 18 * MiB;
constexpr size_t WS_U = 22 * MiB;
constexpr size_t WS_PROJ = 54 * MiB;
constexpr size_t WS_OUT = 190 * MiB;

extern "C" void kernel_launch(void* const* d_in, const int* in_sizes, int n_in, void* d_out, int out_size, void* d_ws, size_t ws_size, hipStream_t stream) {
    static int inited = 0;
    if (!inited) {
        (void)hipFuncSetAttribute((const void*)k_gemm<0>, hipFuncAttributeMaxDynamicSharedMemorySize, pg8::STAGE_BYTES);
        (void)hipFuncSetAttribute((const void*)k_gemm<1>, hipFuncAttributeMaxDynamicSharedMemorySize, pg8::STAGE_BYTES);
        inited = 1;
    }
    Inputs in{};
    const float** ip = (const float**)&in;
    for (int i = 0; i < 27; ++i) ip[i] = (const float*)d_in[i];
    unsigned char* ws = (unsigned char*)d_ws;
    bf16* Win = (bf16*)(ws + WS_WIN); bf16* Wout = (bf16*)(ws + WS_WOUT); bf16* U = (bf16*)(ws + WS_U); bf16* PROJ = (bf16*)(ws + WS_PROJ); float* OUT = (float*)(ws + WS_OUT);
    float* hout = (float*)d_out;
    for (int l = 0; l < NLAYER; ++l) {
        k_wprep<<<dim3(NP / 32, DM / 64), 256, 0, stream>>>(in.w_in + (size_t)l * DM * IN_COLS, DM, IN_COLS, Win + (size_t)l * NP * DM, 1);
        k_wprep<<<dim3(DM / 32, DM / 64), 256, 0, stream>>>(in.w_out + (size_t)l * DM * DM, DM, DM, Wout + (size_t)l * DM * DM, 0);
    }
    for (int l = 0; l < NLAYER; ++l) {
        const float* hin = (l == 0) ? in.x : hout;
        k_rmsnorm_bf16<<<MTOK / 4, 256, 0, stream>>>(hin, in.pre_norm_g + (size_t)l * DM, U);
        k_gemm<0><<<256, 512, pg8::STAGE_BYTES, stream>>>(U, Win + (size_t)l * NP * DM, (void*)PROJ, MTOK, NP, DM, NP);
        { MixArgs a{}; a.in = in; a.proj = PROJ; a.y = U; a.layer = l; a.pad = 0;
          k_mixers_simple<0><<<16, 128, 0, stream>>>(a); k_mixers_simple<1><<<16, 128, 0, stream>>>(a);
          k_mixers_simple<2><<<16, 128, 0, stream>>>(a); k_mixers_simple<3><<<16, 128, 0, stream>>>(a); }
        k_gemm<1><<<256, 512, pg8::STAGE_BYTES, stream>>>(U, Wout + (size_t)l * DM * DM, (void*)OUT, MTOK, DM, DM, DM);
        k_post<<<MTOK / 4, 256, 0, stream>>>(hin, OUT, in.post_norm_g + (size_t)l * DM, hout);
    }
}
```

```cpp
#include <hip/hip_runtime.h>
#include <cstdio>
#include <cstdint>
namespace pg8 {
#define PG8_LAS __attribute__((address_space(3)))
typedef unsigned short bf16_t;
typedef short bf16x8 __attribute__((ext_vector_type(8)));
typedef float f32x4 __attribute__((ext_vector_type(4)));
typedef unsigned u32x4 __attribute__((ext_vector_type(4)));
constexpr int BM = 256, BK = 64, HALF = 128, HTB = HALF * BK * 2  , STAGE_BYTES = 8 * HTB, NXCD = 8, WGM = 8;

__host__ __device__ __forceinline__ int lds_byte(int r, int c) { const int st = (r >> 4) * 2 + (c >> 5), rr = r & 15, cc = c & 31, ob = rr * 64 + cc * 2; return st * 1024 + (ob ^ (((ob >> 9) & 1) << 5)); }
__host__ __device__ __forceinline__ void stage_rc(int b, int& R, int& C) { const int st = b / 1024, sb = b % 1024, swz = sb ^ (((sb >> 9) & 1) << 5); R = (st >> 1) * 16 + swz / 64; C = (st & 1) * 32 + (swz % 64) / 2; }
__host__ __device__ __forceinline__ int perm32(int rho) { const int n = rho >> 4, i = rho & 15; return 8 * (i >> 2) + 4 * n + (i & 3); }

struct Unit { int pm, pn; };
struct Gemm { const bf16_t* A; const bf16_t* Bt; int M, N, K; };

struct StaticOrder {
    int nM, nN, nwg, G, c;
    __host__ __device__ void init(int M, int N, int G_, int c_) { nM = M / BM; nN = N / BM; nwg = nM * nN; G = G_; c = c_; }
    __host__ __device__ bool next(int i, Unit& u) const {
        const long L = (long)i * G + c; if (L >= nwg) return false;
        int wgid = (int)L; { const int q = nwg / NXCD, r = nwg % NXCD, xcd = wgid % NXCD, off = wgid / NXCD; wgid = (xcd < r ? xcd * (q + 1) : r * (q + 1) + (xcd - r) * q) + off; }
        const int nig = WGM * nN, gid = wgid / nig, fm = gid * WGM, gsz = (nM - fm) < WGM ? (nM - fm) : WGM;
        u.pm = fm + ((wgid % nig) % gsz); u.pn = (wgid % nig) / gsz; return true;
    }
    __device__ __forceinline__ void a_ready(const Unit&) const {}
    __device__ __forceinline__ void done(const Unit&) const {}
};
__device__ __forceinline__ unsigned cvt_pk_bf16(float lo, float hi) { unsigned r; asm volatile("v_cvt_pk_bf16_f32 %0, %1, %2" : "=v"(r) : "v"(lo), "v"(hi)); return r; }
typedef float f32x2 __attribute__((ext_vector_type(2)));
__device__ __forceinline__ f32x2 gelu_pk(f32x2 v) {
    const f32x2 av = __builtin_elementwise_abs(v), d = av * 0.2316418882f + 1.0f;
    f32x2 t; t.x = __builtin_amdgcn_rcpf(d.x); t.y = __builtin_amdgcn_rcpf(d.y);
    f32x2 q = t * 0.5307027145f + (-0.7265760135f); q = q * t + 0.7107068705f; q = q * t + (-0.142248368f); q = q * t + 0.127414796f; q = q * t;
    const f32x2 s = (v * v) * (-0.72134752044f);
    f32x2 e; e.x = __builtin_amdgcn_exp2f(s.x); e.y = __builtin_amdgcn_exp2f(s.y);
    const f32x2 m = v * (q * e), r = v - m;
    f32x2 o; o.x = v.x < 0.f ? m.x : r.x; o.y = v.y < 0.f ? m.y : r.y; return o;
}

struct EpiF32 {
    static constexpr bool PERM = false, AFTER_DRAIN = false;
    float* C; int ldc; const float* bias;
    __device__ __forceinline__ void operator()(const f32x4 (&acc)[2][2][4][2], const Unit& u, int wr, int wc, int fr, int fq) const {
        const int row0 = u.pm * BM + wr * 64 + fr, col0 = u.pn * BM + wc * 32 + 4 * fq;
        f32x4 bv[2][2];
#pragma unroll
        for (int bj = 0; bj < 2; ++bj)
#pragma unroll
            for (int n = 0; n < 2; ++n) bv[bj][n] = bias ? *(const f32x4*)(bias + col0 + bj * HALF + n * 16) : (f32x4){0.f, 0.f, 0.f, 0.f};
#pragma unroll
        for (int ai = 0; ai < 2; ++ai)
#pragma unroll
            for (int m = 0; m < 4; ++m) { float* rowp = C + (size_t)(row0 + ai * HALF + m * 16) * ldc + col0;
#pragma unroll
                for (int bj = 0; bj < 2; ++bj)
#pragma unroll
                    for (int n = 0; n < 2; ++n) *(f32x4*)(rowp + bj * HALF + n * 16) = acc[ai][bj][m][n] + bv[bj][n]; }
    }
};
template <int ACT  > struct EpiBf16 {
    static constexpr bool PERM = true, AFTER_DRAIN = false;
    bf16_t* O; int ldc; const float* bias; int split_cols; size_t split_stride;
    __device__ __forceinline__ void operator()(const f32x4 (&acc)[2][2][4][2], const Unit& u, int wr, int wc, int fr, int fq) const {
        const int row0 = u.pm * BM + wr * 64 + fr; int colt = u.pn * BM; bf16_t* base = O;
        if (split_cols) { const int t = colt / split_cols; base += (size_t)t * split_stride; colt -= t * split_cols; }
        const int col0 = colt + wc * 32 + 8 * fq, bcol0 = u.pn * BM + wc * 32 + 8 * fq;
        f32x4 bv[2][2];
#pragma unroll
        for (int bj = 0; bj < 2; ++bj)
#pragma unroll
            for (int n = 0; n < 2; ++n) bv[bj][n] = bias ? *(const f32x4*)(bias + bcol0 + bj * HALF + 4 * n) : (f32x4){0.f, 0.f, 0.f, 0.f};
#pragma unroll
        for (int ai = 0; ai < 2; ++ai)
#pragma unroll
            for (int m = 0; m < 4; ++m) { bf16_t* rowp = base + (size_t)(row0 + ai * HALF + m * 16) * ldc + col0;
#pragma unroll
                for (int bj = 0; bj < 2; ++bj) { f32x4 v0 = acc[ai][bj][m][0] + bv[bj][0], v1 = acc[ai][bj][m][1] + bv[bj][1];
                    if (ACT == 1) { f32x2 a = gelu_pk((f32x2){v0[0], v0[1]}), b = gelu_pk((f32x2){v0[2], v0[3]}), c = gelu_pk((f32x2){v1[0], v1[1]}), d = gelu_pk((f32x2){v1[2], v1[3]});
                        v0 = (f32x4){a.x, a.y, b.x, b.y}; v1 = (f32x4){c.x, c.y, d.x, d.y}; }
                    if (ACT == 2) {
#pragma unroll
                        for (int j = 0; j < 4; ++j) { v0[j] = 0.5f * v0[j] * (1.0f + erff(v0[j] * 0.70710678f)); v1[j] = 0.5f * v1[j] * (1.0f + erff(v1[j] * 0.70710678f)); } }
                    u32x4 w; w.x = cvt_pk_bf16(v0[0], v0[1]); w.y = cvt_pk_bf16(v0[2], v0[3]); w.z = cvt_pk_bf16(v1[0], v1[1]); w.w = cvt_pk_bf16(v1[2], v1[3]);
                    *(u32x4*)(rowp + bj * HALF) = w; } }
    }
};
template <class Epi, class Sched, bool STAMP = false>
__device__ __forceinline__ void gemm_phase(PG8_LAS unsigned char* lds, const Gemm g, const Sched& S, const Epi& E, unsigned long long* stamps) {
    const int tid = threadIdx.x, wid = __builtin_amdgcn_readfirstlane(tid >> 6), lane = tid & 63, wr = wid >> 2, wc = wid & 3, fr = lane & 15, fq = lane >> 4;
    const int K = g.K, nt = K / BK;
    int ts_lo = 0, ts_hi = 0, nts = 0; const unsigned long long rt_entry = STAMP ? (unsigned long long)wall_clock64() : 0ull;
#define PG8_STAMP() do { if (STAMP && wid == 0 && nts < 64) { const unsigned long long _c = (unsigned long long)clock64(); \
        ts_lo = (lane == nts) ? (int)(unsigned)_c : ts_lo; ts_hi = (lane == nts) ? (int)(unsigned)(_c >> 32) : ts_hi; ++nts; } } while (0)
    PG8_STAMP();
    unsigned voffA[2], voffB[2];
#pragma unroll
    for (int i = 0; i < 2; ++i) { int R, C; stage_rc(tid * 16 + i * 8192, R, C); const int Rb = Epi::PERM ? ((R & ~31) + perm32(R & 31)) : R;
        voffA[i] = (unsigned)(R * K + C) * 2u; voffB[i] = (unsigned)(Rb * K + C) * 2u; }
    const size_t kstep = (size_t)(BK * 2);
    const size_t hstep = (size_t)HALF * K * 2;
    const size_t tstep = 2 * hstep;
    const unsigned ldsw = (unsigned)wid * 1024u;
    const int aoff = lds_byte(wr * 64 + fr, fq * 8), boff = lds_byte(wc * 32 + fr, fq * 8);
#define PG8_SA(b, h) (((b) * 2 + (h)) * HTB)
#define PG8_SB(b, h) ((4 + (b) * 2 + (h)) * HTB)
#define PG8_STAGE(bufoff, gbase, voff) do { _Pragma("unroll") for (int _i = 0; _i < 2; ++_i) \
        __builtin_amdgcn_global_load_lds((const unsigned*)((const char*)(gbase) + (voff)[_i]), (PG8_LAS unsigned*)(lds + (bufoff) + ldsw + _i * 8192), 16, 0, 0); } while (0)
#define PG8_LDA(dst, b, h) do { _Pragma("unroll") for (int m = 0; m < 4; ++m) _Pragma("unroll") for (int k = 0; k < 2; ++k) dst[m][k] = *(const PG8_LAS bf16x8*)(lds + PG8_SA(b, h) + aoff + m * 2048 + k * 1024); } while (0)
#define PG8_LDB(dst, b, h) do { _Pragma("unroll") for (int n = 0; n < 2; ++n) _Pragma("unroll") for (int k = 0; k < 2; ++k) dst[n][k] = *(const PG8_LAS bf16x8*)(lds + PG8_SB(b, h) + boff + n * 2048 + k * 1024); } while (0)
#define PG8_MMA(ai, bj, At, Bt) do { __builtin_amdgcn_s_setprio(1); _Pragma("unroll") for (int m = 0; m < 4; ++m) _Pragma("unroll") for (int n = 0; n < 2; ++n) _Pragma("unroll") for (int k = 0; k < 2; ++k) \
        acc[ai][bj][m][n] = __builtin_amdgcn_mfma_f32_16x16x32_bf16(Bt[n][k], At[m][k], acc[ai][bj][m][n], 0, 0, 0); __builtin_amdgcn_s_setprio(0); } while (0)
#define PG8_WAIT_V(n) asm volatile("s_waitcnt vmcnt(" #n ")" ::: "memory")
#define PG8_WAIT_L(n) asm volatile("s_waitcnt lgkmcnt(" #n ")" ::: "memory")
#define PG8_BAR __builtin_amdgcn_s_barrier()
#define PG8_SCHED __builtin_amdgcn_sched_barrier(0)
    Unit cur, nxt; int ui = 0;
    if (!S.next(0, cur)) return;
    f32x4 acc[2][2][4][2];
#pragma unroll
    for (int a = 0; a < 2; ++a)
#pragma unroll
        for (int b = 0; b < 2; ++b)
#pragma unroll
            for (int m = 0; m < 4; ++m)
#pragma unroll
                for (int n = 0; n < 2; ++n) acc[a][b][m][n] = (f32x4){0.f, 0.f, 0.f, 0.f};
    bf16x8 At[4][2], B0[2][2], B1[2][2];
    const char* cA = (const char*)g.A + (size_t)cur.pm * tstep; const char* cB = (const char*)g.Bt + (size_t)cur.pn * tstep;
    S.a_ready(cur);
    PG8_STAGE(PG8_SB(0, 0), cB, voffB); PG8_STAGE(PG8_SA(0, 0), cA, voffA); PG8_STAGE(PG8_SB(0, 1), cB + hstep, voffB); PG8_STAGE(PG8_SA(0, 1), cA + hstep, voffA);
    if (wr == 1) PG8_BAR;
    PG8_WAIT_V(4); PG8_BAR;
    PG8_STAGE(PG8_SB(1, 0), cB + kstep, voffB); PG8_STAGE(PG8_SA(1, 0), cA + kstep, voffA); PG8_STAGE(PG8_SB(1, 1), cB + hstep + kstep, voffB);
    PG8_WAIT_V(6); PG8_BAR;
    PG8_STAMP();
    for (;;) {
        const bool has_next = S.next(ui + 1, nxt);
        const char* nA = has_next ? (const char*)g.A + (size_t)nxt.pm * tstep : cA; const char* nB = has_next ? (const char*)g.Bt + (size_t)nxt.pn * tstep : cB;
        for (int t = 0; t < nt; t += 2) {
            const bool last = (t == nt - 2);
            const char* a1 = cA + (size_t)(t + 1) * kstep;
            const char* a2 = last ? nA : cA + (size_t)(t + 2) * kstep; const char* b2 = last ? nB : cB + (size_t)(t + 2) * kstep;
            const char* a3 = a2 + kstep; const char* b3 = b2 + kstep;
            if (last && has_next) S.a_ready(nxt);
            PG8_LDB(B0, 0, 0); PG8_SCHED; PG8_LDA(At, 0, 0); PG8_STAGE(PG8_SA(1, 1), a1 + hstep, voffA);
            PG8_WAIT_L(8); PG8_BAR; PG8_WAIT_L(0); PG8_MMA(0, 0, At, B0); PG8_BAR; PG8_SCHED;
            PG8_LDB(B1, 0, 1); PG8_STAGE(PG8_SB(0, 0), b2, voffB);
            PG8_BAR; PG8_WAIT_L(0); PG8_MMA(0, 1, At, B1); PG8_BAR;
            PG8_LDA(At, 0, 1); PG8_STAGE(PG8_SA(0, 0), a2, voffA);
            PG8_BAR; PG8_WAIT_L(0); PG8_MMA(1, 0, At, B0); PG8_BAR; PG8_SCHED;
            PG8_STAGE(PG8_SB(0, 1), b2 + hstep, voffB);
            PG8_WAIT_V(6); PG8_BAR; PG8_MMA(1, 1, At, B1); PG8_BAR;
            PG8_LDB(B0, 1, 0); PG8_SCHED; PG8_LDA(At, 1, 0); PG8_STAGE(PG8_SA(0, 1), a2 + hstep, voffA);
            PG8_WAIT_L(8); PG8_BAR; PG8_WAIT_L(0); PG8_MMA(0, 0, At, B0); PG8_BAR; PG8_SCHED;
            PG8_LDB(B1, 1, 1); PG8_STAGE(PG8_SB(1, 0), b3, voffB);
            PG8_BAR; PG8_WAIT_L(0); PG8_MMA(0, 1, At, B1); PG8_BAR;
            PG8_LDA(At, 1, 1); PG8_STAGE(PG8_SA(1, 0), a3, voffA);
            PG8_BAR; PG8_WAIT_L(0); PG8_MMA(1, 0, At, B0); PG8_BAR; PG8_SCHED;
            PG8_STAGE(PG8_SB(1, 1), b3 + hstep, voffB);
            PG8_WAIT_V(6); PG8_BAR; PG8_MMA(1, 1, At, B1); PG8_BAR;
        }
        PG8_STAMP();
        if constexpr (!Epi::AFTER_DRAIN) { E(acc, cur, wr, wc, fr, fq); S.done(cur); }
        PG8_STAMP();
        if (!has_next) break;
#pragma unroll
        for (int a = 0; a < 2; ++a)
#pragma unroll
            for (int b = 0; b < 2; ++b)
#pragma unroll
                for (int m = 0; m < 4; ++m)
#pragma unroll
                    for (int n = 0; n < 2; ++n) acc[a][b][m][n] = (f32x4){0.f, 0.f, 0.f, 0.f};
        cur = nxt; cA = nA; cB = nB; ++ui;
    }
    PG8_WAIT_V(0);
    if (wr == 0) PG8_BAR;
    PG8_BAR;
    if constexpr (Epi::AFTER_DRAIN) { E.fused(acc, cur, wr, wc, fr, fq, lds, wid, lane); S.done(cur); }
    PG8_STAMP();
    if (STAMP && wid == 0) { stamps[lane] = lane < nts ? (((unsigned long long)(unsigned)ts_hi << 32) | (unsigned)ts_lo) : 0ull;
        if (lane == 62) stamps[62] = rt_entry; if (lane == 63) stamps[63] = (unsigned long long)wall_clock64(); }
#undef PG8_STAMP
#undef PG8_SA
#undef PG8_SB
#undef PG8_STAGE
#undef PG8_LDA
#undef PG8_LDB
#undef PG8_MMA
#undef PG8_WAIT_V
#undef PG8_WAIT_L
#undef PG8_BAR
#undef PG8_SCHED
}
}
#define GAS __attribute__((address_space(1)))
#define LAS __attribute__((address_space(3)))
typedef unsigned short bf16;
typedef unsigned v4u __attribute__((ext_vector_type(4)));
typedef float f32x4 __attribute__((ext_vector_type(4)));
typedef short bf16x8 __attribute__((ext_vector_type(8)));
typedef GAS unsigned gu32;
typedef GAS unsigned long long gu64;
#define RLX_AGENT __ATOMIC_RELAXED, __HIP_MEMORY_SCOPE_AGENT
#define LDS_WAIT() asm volatile("s_waitcnt lgkmcnt(0)" ::: "memory")
#define VM_WAIT() asm volatile("s_waitcnt vmcnt(0)" ::: "memory")
__device__ __forceinline__ unsigned long long rt() { return __builtin_amdgcn_s_memrealtime(); }
__device__ __forceinline__ unsigned f2bf(float f) { unsigned u = __builtin_bit_cast(unsigned, f); return (u + 0x7fffu + ((u >> 16) & 1u)) >> 16; }
__device__ __forceinline__ unsigned pk2(float lo, float hi) { return f2bf(lo) | (f2bf(hi) << 16); }
#define XB_TMO      128
#define XB_XCNT(j)  (256  + 64 * (j))
#define XB_XSUB(j)  (1280 + 64 * (j))
#define XB_XGEN(j)  (2304 + 64 * (j))
#define XB_TOP      3328
#define XB_TOPGEN   3392
#define XCD_BAR_WORDS 3456
#define XB_SPIN_CAP (1u << 22)

__device__ __forceinline__ unsigned xb_ld(unsigned* p)              { return __hip_atomic_load(p, __ATOMIC_RELAXED, __HIP_MEMORY_SCOPE_AGENT); }
__device__ __forceinline__ unsigned xb_add(unsigned* p, unsigned v) { return __hip_atomic_fetch_add(p, v, __ATOMIC_RELAXED, __HIP_MEMORY_SCOPE_AGENT); }
__device__ __forceinline__ unsigned xb_xcc_id() { return (unsigned)__builtin_amdgcn_s_getreg((3 << 11) | 20) & 0xFu; }
#define XB_SPIN(cond, bar) do { unsigned _sp = 0; while (cond) { __builtin_amdgcn_s_sleep(1); \
    if ((++_sp & 255u) == 0u) { if (xb_ld(&(bar)[XB_TMO])) break; if (_sp > XB_SPIN_CAP) { atomicAdd(&(bar)[XB_TMO], 1u); break; } } } } while (0)

struct XcdBarrier {
    unsigned* bar; unsigned x;
    volatile LAS unsigned* st;
};

__device__ __forceinline__ XcdBarrier xcd_barrier_post(unsigned* bar, volatile LAS unsigned* st) {
    XcdBarrier b; b.bar = bar; b.x = xb_xcc_id(); b.st = st;
    if (threadIdx.x == 0) (void)xb_add(&bar[XB_XCNT(b.x)], 1u);
    return b;
}
__device__ __forceinline__ void xcd_barrier_complete(unsigned* bar, unsigned x, unsigned& nloc, unsigned& nx) {
    const unsigned G = gridDim.x * gridDim.y * gridDim.z;
    unsigned sum, cnt, mine, sp = 0u;
    for (;;) {
        sum = 0u; cnt = 0u; mine = 0u;
#pragma unroll
        for (unsigned j = 0; j < 16; ++j) { const unsigned c = xb_ld(&bar[XB_XCNT(j)]); sum += c; cnt += (c > 0u) ? 1u : 0u; mine = (j == x) ? c : mine; }
        if (sum == G) break;
        __builtin_amdgcn_s_sleep(1);
        if ((++sp & 255u) == 0u) { if (xb_ld(&bar[XB_TMO])) break; if (sp > XB_SPIN_CAP) { atomicAdd(&bar[XB_TMO], 1u); break; } }
    }
    nloc = mine > 0u ? mine : 1u; nx = cnt > 0u ? cnt : 1u;
}

__device__ __forceinline__ void xcd_barrier(const XcdBarrier& b) {
    asm volatile("s_waitcnt vmcnt(0)" ::: "memory");
    __syncthreads();
    if (threadIdx.x == 0) {
        unsigned* bar = b.bar;
        __builtin_amdgcn_s_waitcnt(0);
        unsigned nloc = b.st[0], nx = b.st[1];
        if (nloc == 0u) { xcd_barrier_complete(bar, b.x, nloc, nx); b.st[0] = nloc; b.st[1] = nx; }
        const unsigned old = xb_add(&bar[XB_XSUB(b.x)], 1u);
        const unsigned gen = old / nloc;
        if (old + 1u == (gen + 1u) * nloc) {
            __builtin_amdgcn_fence(__ATOMIC_RELEASE, "agent");
            asm volatile("s_waitcnt vmcnt(0)" ::: "memory");
            const unsigned og = xb_add(&bar[XB_TOP], 1u);
            const unsigned tg = og / nx;
            if (og + 1u == (tg + 1u) * nx) xb_add(&bar[XB_TOPGEN], 1u);
            else XB_SPIN(xb_ld(&bar[XB_TOPGEN]) == tg, bar);
            __builtin_amdgcn_fence(__ATOMIC_ACQUIRE, "agent");
            xb_add(&bar[XB_XGEN(b.x)], 1u);
            asm volatile("s_waitcnt vmcnt(0)" ::: "memory");
        } else {
            XB_SPIN(xb_ld(&bar[XB_XGEN(b.x)]) == gen, bar);
            __builtin_amdgcn_fence(__ATOMIC_ACQUIRE, "agent");
            asm volatile("s_waitcnt vmcnt(0)" ::: "memory");
        }
    }
    __syncthreads();
}

constexpr int BATCH = 8, SEQ = 2048, DM = 1024, MTOK = BATCH * SEQ, NLAYER = 2;
constexpr int GW = 256, HD = 64, NHEAD = 4;
constexpr int IN_COLS = 4236, NP = 4352;
constexpr int C_HG_Q = 0, C_HG_F = 256, C_HG_I = 512;
constexpr int C_GD_Q = 768, C_GD_K = 1024, C_GD_V = 1280;
constexpr int C_SS_X = 1536, C_SS_B = 1792, C_SS_C = 2048;
constexpr int C_RW_R = 2304, C_RW_K = 2560, C_RW_V = 2816;
constexpr int C_Z = 3072;
constexpr int C_GD_BETA = 4096, C_GD_DEC = 4100, C_SS_DT = 4104, C_RW_WD = 4112, C_RW_AD = 4176;

__host__ __device__ __forceinline__ int old_col(int n) {
    if (n < 1536) return n;
    if (n < 2304) return 1544 + (n - 1536);
    if (n < 3072) return 2316 + (n - 2304);
    if (n < 4096) return 3212 + (n - 3072);
    if (n < 4104) return 1536 + (n - 4096);
    if (n < 4108) return 2312 + (n - 4104);
    if (n < 4112) return -1;
    if (n < 4240) return 3084 + (n - 4112);
    return -1;
}
__device__ __forceinline__ float bf2f(bf16 b) { return __builtin_bit_cast(float, ((unsigned)b) << 16); }
__device__ __forceinline__ float wave_sum(float v) {
#pragma unroll
    for (int o = 1; o < 64; o <<= 1) v += __shfl_xor(v, o);
    return v;
}
__device__ __forceinline__ float sigmoidf_(float x) { return 1.f / (1.f + __expf(-x)); }
__device__ __forceinline__ float siluf_(float x) { return x / (1.f + __expf(-x)); }
__device__ __forceinline__ float softplusf_(float x) { return x > 20.f ? x : log1pf(__expf(x)); }

struct Inputs {
    const float* x; const float* pre_norm_g; const float* w_in; const float* hgrn_lb; const float* hgrn_norm_g;
    const float* gdn_conv_w; const float* gdn_a_log; const float* gdn_dt_bias; const float* gdn_norm_g;
    const float* ssm_conv_w; const float* ssm_conv_b; const float* ssm_a_log; const float* ssm_dt_bias; const float* ssm_d; const float* ssm_norm_g;
    const float* rwkv_mu; const float* rwkv_w0; const float* rwkv_w_up; const float* rwkv_a0; const float* rwkv_a_up; const float* rwkv_k_k; const float* rwkv_k_a;
    const float* rwkv_r_k; const float* rwkv_ln_w; const float* rwkv_ln_b; const float* w_out; const float* post_norm_g;
};

constexpr int TB = 8;
struct MixRef { const Inputs& in; int layer; };

__device__ __forceinline__ float ldp(const bf16* P, int t, int col) { return t >= 0 ? bf2f(P[(size_t)t * NP + col]) : 0.f; }

__device__ __forceinline__ void mix_hgrn(const MixRef& a, const bf16* P, bf16* Y, int h, int lane, float* lds) {
    const int l = a.layer, c = h * 64 + lane;
    float lbv = 0.f;
    if (l == 1) { const float x0 = a.in.hgrn_lb[c], x1 = a.in.hgrn_lb[GW + c]; const float mx = fmaxf(x0, x1); const float e0 = __expf(x0 - mx), e1 = __expf(x1 - mx); lbv = e1 / (e0 + e1); }
    const float gn = a.in.hgrn_norm_g[l * HD + lane];
    float* sq = lds; float* sf = lds + TB * 64;
    float S[64];
#pragma unroll
    for (int d = 0; d < 64; ++d) S[d] = 0.f;
    for (int tb = 0; tb < SEQ / TB; ++tb) {
        for (int i = 0; i < TB; ++i) { const int t = tb * TB + i;
            const float pq = ldp(P, t, C_HG_Q + c), pf = ldp(P, t, C_HG_F + c);
            sq[i * 64 + lane] = siluf_(pq) * 0.125f; sf[i * 64 + lane] = lbv + (1.f - lbv) * sigmoidf_(pf); }
        __syncthreads();
        for (int i = 0; i < TB; ++i) { const int t = tb * TB + i;
            const float vv = ldp(P, t, C_HG_I + c); float o = 0.f;
#pragma unroll
            for (int d = 0; d < 64; ++d) { const float f = sf[i * 64 + d]; S[d] = f * S[d] + (1.f - f) * vv; o += S[d] * sq[i * 64 + d]; }
            const float ss = wave_sum(o * o);
            float yv = o * rsqrtf(ss * (1.f / 64.f) + 1e-6f) * gn;
            yv *= siluf_(ldp(P, t, C_Z + 0 + c));
            Y[(size_t)t * DM + 0 + c] = (bf16)f2bf(yv); }
        __syncthreads();
    }
}

__device__ __forceinline__ float conv4(const bf16* P, int t, int col, const float* w4) {
    return w4[0] * ldp(P, t - 3, col) + w4[1] * ldp(P, t - 2, col) + w4[2] * ldp(P, t - 1, col) + w4[3] * ldp(P, t, col);
}

__device__ __forceinline__ void mix_gdn(const MixRef& a, const bf16* P, bf16* Y, int h, int lane, float* lds) {
    const int l = a.layer, c = h * 64 + lane;
    const float* cw = a.in.gdn_conv_w + (size_t)l * 4 * 768;
    float wq[4], wk[4], wv[4];
#pragma unroll
    for (int j = 0; j < 4; ++j) { wq[j] = cw[j * 768 + c]; wk[j] = cw[j * 768 + 256 + c]; wv[j] = cw[j * 768 + 512 + c]; }
    const float Aneg = -__expf(a.in.gdn_a_log[l * 4 + h]), dtb = a.in.gdn_dt_bias[l * 4 + h];
    const float gn = a.in.gdn_norm_g[l * HD + lane];
    float* sq = lds; float* sk = lds + TB * 64;
    float S[64];
#pragma unroll
    for (int d = 0; d < 64; ++d) S[d] = 0.f;
    for (int tb = 0; tb < SEQ / TB; ++tb) {
        for (int i = 0; i < TB; ++i) { const int t = tb * TB + i;
            const float qc = siluf_(conv4(P, t, C_GD_Q + c, wq)), kc = siluf_(conv4(P, t, C_GD_K + c, wk));
            const float qs = wave_sum(qc * qc), ks = wave_sum(kc * kc);
            sq[i * 64 + lane] = qc * rsqrtf(qs + 1e-6f) * 0.125f; sk[i * 64 + lane] = kc * rsqrtf(ks + 1e-6f); }
        __syncthreads();
        for (int i = 0; i < TB; ++i) { const int t = tb * TB + i;
            const float vv = siluf_(conv4(P, t, C_GD_V + c, wv));
            const float beta = sigmoidf_(ldp(P, t, C_GD_BETA + h));
            const float gg = Aneg * softplusf_(ldp(P, t, C_GD_DEC + h) + dtb);
            const float al = __expf(gg);
            float dot = 0.f;
#pragma unroll
            for (int d0 = 0; d0 < 64; d0 += 16) {
#pragma unroll
                for (int d = d0; d < d0 + 16; ++d) dot += S[d] * sk[i * 64 + d];
                asm volatile("" ::: "memory"); }
            const float cc = beta * (vv - al * dot); float o = 0.f;
#pragma unroll
            for (int d0 = 0; d0 < 64; d0 += 16) {
#pragma unroll
                for (int d = d0; d < d0 + 16; ++d) { S[d] = al * S[d] + sk[i * 64 + d] * cc; o += S[d] * sq[i * 64 + d]; }
                asm volatile("" ::: "memory"); }
            const float ss = wave_sum(o * o);
            float yv = o * rsqrtf(ss * (1.f / 64.f) + 1e-6f) * gn;
            yv *= siluf_(ldp(P, t, C_Z + 256 + c));
            Y[(size_t)t * DM + 256 + c] = (bf16)f2bf(yv); }
        __syncthreads();
    }
}

__device__ __forceinline__ void mix_ssd(const MixRef& a, const bf16* P, bf16* Y, int wave, int lane, float* lds) {
    const int l = a.layer, h = wave >> 1, nh = wave & 1, g = h >> 1, c = h * 64 + lane, tid = wave * 64 + lane;
    const float* cw = a.in.ssm_conv_w + (size_t)l * 4 * 768; const float* cb = a.in.ssm_conv_b + (size_t)l * 768;
    float wx[4], wBC[4];
    const int chBC = 256 + tid;
#pragma unroll
    for (int j = 0; j < 4; ++j) { wx[j] = cw[j * 768 + c]; wBC[j] = cw[j * 768 + chBC]; }
    const float bx = cb[c], bBC = cb[chBC];
    const float Aneg = -__expf(a.in.ssm_a_log[l * 4 + h]), dtb = a.in.ssm_dt_bias[l * 4 + h];
    float* sBC = lds;
    float* sY = lds + TB * 512;
    float* sX = lds + TB * 512 + TB * 512;
    float H[64];
#pragma unroll
    for (int n = 0; n < 64; ++n) H[n] = 0.f;
    for (int tb = 0; tb < SEQ / TB; ++tb) {
        for (int i = 0; i < TB; ++i) { const int t = tb * TB + i; sBC[i * 512 + tid] = siluf_(conv4(P, t, C_SS_X + chBC, wBC) + bBC); }
        __syncthreads();
        for (int i = 0; i < TB; ++i) { const int t = tb * TB + i;
            const float xx = siluf_(conv4(P, t, C_SS_X + c, wx) + bx);
            const float dt = softplusf_(ldp(P, t, C_SS_DT + h) + dtb);
            const float dec = __expf(dt * Aneg), xv = xx * dt;
            const float* pB = sBC + i * 512 + g * 128 + nh * 64; const float* pC = sBC + i * 512 + 256 + g * 128 + nh * 64;
            float y = 0.f;
#pragma unroll
            for (int n0 = 0; n0 < 64; n0 += 16) {
#pragma unroll
                for (int n = n0; n < n0 + 16; ++n) { H[n] = dec * H[n] + pB[n] * xv; y += pC[n] * H[n]; }
                asm volatile("" ::: "memory"); }
            sY[(i * 8 + wave) * 64 + lane] = y;
            if (nh == 0) sX[i * 256 + c] = xx; }
        __syncthreads();
        { const int i = wave, t = tb * TB + i;
            float yv[4];
#pragma unroll
            for (int j = 0; j < 4; ++j) { const int cc = j * 64 + lane;
                float y = sY[(i * 8 + 2 * j) * 64 + lane] + sY[(i * 8 + 2 * j + 1) * 64 + lane] + sX[i * 256 + cc] * a.in.ssm_d[l * 4 + j];
                yv[j] = y * siluf_(ldp(P, t, C_Z + 512 + cc)); }
            const float s0 = wave_sum(yv[0] * yv[0] + yv[1] * yv[1]), s1 = wave_sum(yv[2] * yv[2] + yv[3] * yv[3]);
            const float r0 = rsqrtf(s0 * (1.f / 128.f) + 1e-6f), r1 = rsqrtf(s1 * (1.f / 128.f) + 1e-6f);
#pragma unroll
            for (int j = 0; j < 4; ++j) { const int cc = j * 64 + lane;
                Y[(size_t)t * DM + 512 + cc] = (bf16)f2bf(yv[j] * (j < 2 ? r0 : r1) * a.in.ssm_norm_g[l * GW + cc]); } }
        __syncthreads();
    }
}

__device__ __forceinline__ float rshift(const bf16* P, int t, int col, float mu) { const float x = ldp(P, t, col), xp = ldp(P, t - 1, col); return x + (xp - x) * mu; }

__device__ __forceinline__ void mix_rwkv(const MixRef& a, const bf16* P, bf16* Y, int h, int lane, float* lds) {
    const int l = a.layer, c = h * 64 + lane;
    const float* mu = a.in.rwkv_mu + (size_t)l * 896;
    const float mu_r = mu[c], mu_k = mu[256 + c], mu_v = mu[512 + c], mu_wd = mu[768 + lane], mu_ad = mu[832 + lane];
    const float w0 = a.in.rwkv_w0[l * GW + c], a0 = a.in.rwkv_a0[l * GW + c], kkc = a.in.rwkv_k_k[l * GW + c], kac = a.in.rwkv_k_a[l * GW + c];
    const float rkc = a.in.rwkv_r_k[l * GW + c], lnw = a.in.rwkv_ln_w[l * GW + c], lnb = a.in.rwkv_ln_b[l * GW + c];
    const float* wup = a.in.rwkv_w_up + (size_t)l * 64 * GW; const float* aup = a.in.rwkv_a_up + (size_t)l * 64 * GW;
    float* swd = lds; float* sad = lds + TB * 64; float* sdec = lds + 2 * TB * 64; float* skk = lds + 3 * TB * 64; float* skka = lds + 4 * TB * 64;
    float* sk = lds + 5 * TB * 64; float* sr = lds + 6 * TB * 64; float* sbd = lds + 7 * TB * 64;
    float S[64];
#pragma unroll
    for (int d = 0; d < 64; ++d) S[d] = 0.f;
    for (int tb = 0; tb < SEQ / TB; ++tb) {
        for (int i = 0; i < TB; ++i) { const int t = tb * TB + i;
            swd[i * 64 + lane] = tanhf(rshift(P, t, C_RW_WD + lane, mu_wd)); sad[i * 64 + lane] = rshift(P, t, C_RW_AD + lane, mu_ad); }
        __syncthreads();
        for (int i = 0; i < TB; ++i) { const int t = tb * TB + i;
            const float r = rshift(P, t, C_RW_R + c, mu_r), k = rshift(P, t, C_RW_K + c, mu_k);
            float wl = w0, al = a0;
#pragma unroll 4
            for (int j = 0; j < 64; ++j) { wl += swd[i * 64 + j] * wup[j * GW + c]; al += sad[i * 64 + j] * aup[j * GW + c]; }
            const float w = -softplusf_(-wl) - 0.5f;
            const float dec = __expf(-__expf(w));
            const float av = sigmoidf_(al);
            const float kr = k * kkc;
            const float kk = kr * rsqrtf(wave_sum(kr * kr) + 1e-6f);
            const float k2 = k * (1.f + (av - 1.f) * kac);
            sdec[i * 64 + lane] = dec; skk[i * 64 + lane] = kk; skka[i * 64 + lane] = kk * av; sk[i * 64 + lane] = k2; sr[i * 64 + lane] = r;
            const float bdv = wave_sum(r * k2 * rkc); if (lane == 0) sbd[i] = bdv; }
        __syncthreads();
        for (int i = 0; i < TB; ++i) { const int t = tb * TB + i;
            const float vv = rshift(P, t, C_RW_V + c, mu_v);
            float sa = 0.f;
#pragma unroll
            for (int d0 = 0; d0 < 64; d0 += 16) {
#pragma unroll
                for (int d = d0; d < d0 + 16; ++d) sa -= S[d] * skk[i * 64 + d];
                asm volatile("" ::: "memory"); }
            float o = 0.f;
#pragma unroll
            for (int d0 = 0; d0 < 64; d0 += 8) {
#pragma unroll
                for (int d = d0; d < d0 + 8; ++d) { S[d] = S[d] * sdec[i * 64 + d] + sa * skka[i * 64 + d] + vv * sk[i * 64 + d]; o += S[d] * sr[i * 64 + d]; }
                asm volatile("" ::: "memory"); }
            const float mean = wave_sum(o) * (1.f / 64.f); const float dv = o - mean;
            const float var = wave_sum(dv * dv) * (1.f / 64.f);
            float yv = dv * rsqrtf(var + 64e-5f) * lnw + lnb + sbd[i] * vv;
            yv *= siluf_(ldp(P, t, C_Z + 768 + c));
            Y[(size_t)t * DM + 768 + c] = (bf16)f2bf(yv); }
        __syncthreads();
    }
}


constexpr int NWAVES = 8;
constexpr size_t MiB = 1u << 20;
constexpr size_t WS_CTL = 0, CTL_ZERO_BYTES = 64 * 1024;
constexpr size_t WS_WIN = 1 * MiB;
constexpr size_t WS_WOUT = 18 * MiB;
constexpr size_t WS_U = 22 * MiB;
constexpr size_t WS_PROJ = 54 * MiB;
constexpr size_t WS_OUT = 190 * MiB;
constexpr int CW_BAR = 4096;
constexpr int RING_BYTES = 131072, LDSCTL_OFF = RING_BYTES, MISC_OFF = LDSCTL_OFF + 320, LDS_BYTES = 147456;

struct Args { Inputs in; float* out; unsigned char* ws; };
__device__ __forceinline__ int opaque_v(int v) { asm volatile("" : "+v"(v)); return v; }

__device__ __forceinline__ void wprep_load(const float* __restrict__ W, int N, int use_perm, int n0, int k0, int tid, LAS float* tile) {
    const int nn = tid & 31, kq = tid >> 5;
    const int oc = use_perm ? old_col(n0 + nn) : (n0 + nn);
#pragma unroll
    for (int i = 0; i < 8; ++i) { const int kk = kq + 8 * i; tile[kk * 33 + nn] = (oc >= 0) ? W[(size_t)(k0 + kk) * N + oc] : 0.f; }
}
__device__ __forceinline__ void wprep_store(bf16* __restrict__ WT, int K, int n0, int k0, int tid, const LAS float* tile) {
    const int n = tid >> 3, kc = (tid & 7) * 8;
    uint4 o;
    o.x = f2bf(tile[(kc + 0) * 33 + n]) | (f2bf(tile[(kc + 1) * 33 + n]) << 16);
    o.y = f2bf(tile[(kc + 2) * 33 + n]) | (f2bf(tile[(kc + 3) * 33 + n]) << 16);
    o.z = f2bf(tile[(kc + 4) * 33 + n]) | (f2bf(tile[(kc + 5) * 33 + n]) << 16);
    o.w = f2bf(tile[(kc + 6) * 33 + n]) | (f2bf(tile[(kc + 7) * 33 + n]) << 16);
    *(uint4*)(WT + (size_t)(n0 + n) * K + k0 + kc) = o;
}

__device__ __forceinline__ void rmsnorm_row_bf16(const float* __restrict__ hrow, const float* __restrict__ g, bf16* __restrict__ urow, int lane) {
    const float4* xr = (const float4*)hrow + lane; const float4* gr = (const float4*)g + lane;
    float4 v[4]; float s = 0.f;
#pragma unroll
    for (int j = 0; j < 4; ++j) { v[j] = xr[64 * j]; s += (v[j].x * v[j].x + v[j].y * v[j].y) + (v[j].z * v[j].z + v[j].w * v[j].w); }
    const float r = rsqrtf(wave_sum(s) * (1.f / DM) + 1e-6f);
    uint2* o8 = (uint2*)urow + lane;
#pragma unroll
    for (int j = 0; j < 4; ++j) { const float4 gg = gr[64 * j]; uint2 o;
        o.x = f2bf(v[j].x * r * gg.x) | (f2bf(v[j].y * r * gg.y) << 16); o.y = f2bf(v[j].z * r * gg.z) | (f2bf(v[j].w * r * gg.w) << 16); o8[64 * j] = o; }
}

__device__ __forceinline__ void post_row(const float* hrow, const float* __restrict__ orow_, const float* __restrict__ g, float* hnew, const float* __restrict__ g2, bf16* __restrict__ urow, int lane) {
    const float4* orow = (const float4*)orow_ + lane; const float4* hr = (const float4*)hrow + lane; const float4* gr = (const float4*)g + lane;
    float4 v[4]; float s = 0.f;
#pragma unroll
    for (int j = 0; j < 4; ++j) { v[j] = orow[64 * j]; s += (v[j].x * v[j].x + v[j].y * v[j].y) + (v[j].z * v[j].z + v[j].w * v[j].w); }
    const float r = rsqrtf(wave_sum(s) * (1.f / DM) + 1e-6f);
    float4* o = (float4*)hnew + lane; float s2 = 0.f;
#pragma unroll
    for (int j = 0; j < 4; ++j) { const float4 gg = gr[64 * j]; const float4 hh = hr[64 * j]; float4 w;
        w.x = hh.x + v[j].x * r * gg.x; w.y = hh.y + v[j].y * r * gg.y; w.z = hh.z + v[j].z * r * gg.z; w.w = hh.w + v[j].w * r * gg.w; o[64 * j] = w; v[j] = w;
        s2 += (w.x * w.x + w.y * w.y) + (w.z * w.z + w.w * w.w); }
    if (g2) {
        const float r2 = rsqrtf(wave_sum(s2) * (1.f / DM) + 1e-6f);
        const float4* g2r = (const float4*)g2 + lane; uint2* o8 = (uint2*)urow + lane;
#pragma unroll
        for (int j = 0; j < 4; ++j) { const float4 gg = g2r[64 * j]; uint2 q;
            q.x = f2bf(v[j].x * r2 * gg.x) | (f2bf(v[j].y * r2 * gg.y) << 16); q.y = f2bf(v[j].z * r2 * gg.z) | (f2bf(v[j].w * r2 * gg.w) << 16); o8[64 * j] = q; }
    }
}

#define PHASE_LOCALS() \
    unsigned char* ws = args.ws; asm volatile("" : "+s"(ws)); float* hout = args.out; asm volatile("" : "+s"(hout)); \
    int bx = blockIdx.x; asm volatile("" : "+s"(bx)); int G = gridDim.x; asm volatile("" : "+s"(G)); \
    const int tid = opaque_v(threadIdx.x); const int lane = tid & 63; int wave = __builtin_amdgcn_readfirstlane(tid >> 6); \
    bf16* Win = (bf16*)(ws + WS_WIN); bf16* Wout = (bf16*)(ws + WS_WOUT); bf16* U = (bf16*)(ws + WS_U); bf16* PROJ = (bf16*)(ws + WS_PROJ); float* OUT = (float*)(ws + WS_OUT); \
    (void)Win; (void)Wout; (void)U; (void)PROJ; (void)OUT; (void)hout; (void)bx; (void)G; (void)lane; (void)wave;

__global__ void __launch_bounds__(NWAVES * 64, 2) mk_fwd(Args args) {
    extern __shared__ __attribute__((aligned(16))) unsigned char lds_raw[];
    LAS unsigned char* lds = (LAS unsigned char*)lds_raw;
    volatile LAS unsigned* MISC = (volatile LAS unsigned*)(lds + MISC_OFF);
    const Inputs& in = args.in;
    for (int u = threadIdx.x; u < (LDS_BYTES - LDSCTL_OFF) / 4; u += NWAVES * 64) ((LAS unsigned*)(lds + LDSCTL_OFF))[u] = 0u;
    __syncthreads();
    XcdBarrier bar = xcd_barrier_post((unsigned*)((gu32*)(args.ws + WS_CTL) + CW_BAR), MISC + 8);

    {
        PHASE_LOCALS();
        const int half = tid >> 8, t256 = tid & 255;
        LAS float* tile = (LAS float*)(lds + half * 16384);
        constexpr int IT_IN = (NP / 32) * (DM / 64), IT_OUT = (DM / 32) * (DM / 64), IT_ALL = NLAYER * (IT_IN + IT_OUT);
        for (int it0 = bx * 2; it0 < IT_ALL; it0 += G * 2) {
            const int it = it0 + half; const bool act = it < IT_ALL;
            const float* W = nullptr; bf16* WT = nullptr; int N = 0, perm = 0, n0 = 0, k0 = 0;
            if (act) { int r = it; const int l = r / (IT_IN + IT_OUT); r -= l * (IT_IN + IT_OUT);
                if (r < IT_IN) { W = in.w_in + (size_t)l * DM * IN_COLS; N = IN_COLS; perm = 1; WT = Win + (size_t)l * NP * DM; n0 = (r % (NP / 32)) * 32; k0 = (r / (NP / 32)) * 64; }
                else { r -= IT_IN; W = in.w_out + (size_t)l * DM * DM; N = DM; perm = 0; WT = Wout + (size_t)l * DM * DM; n0 = (r % (DM / 32)) * 32; k0 = (r / (DM / 32)) * 64; }
                wprep_load(W, N, perm, n0, k0, t256, tile); }
            __syncthreads();
            if (act) wprep_store(WT, DM, n0, k0, t256, tile);
            __syncthreads();
        }
        for (int m = bx * NWAVES + wave; m < MTOK; m += G * NWAVES) rmsnorm_row_bf16(in.x + (size_t)m * DM, in.pre_norm_g, U + (size_t)m * DM, lane);
    }
    xcd_barrier(bar);

#pragma unroll
    for (int l = 0; l < NLAYER; ++l) {
        { PHASE_LOCALS();
          pg8::Gemm g; g.A = U; g.Bt = Win + (size_t)l * NP * DM; g.M = MTOK; g.N = NP; g.K = DM;
          pg8::StaticOrder S; S.init(MTOK, NP, G, bx);
          pg8::EpiBf16<0> E; E.O = PROJ; E.ldc = NP; E.bias = nullptr; E.split_cols = 0; E.split_stride = 0;
          pg8::gemm_phase<pg8::EpiBf16<0>, pg8::StaticOrder, false>(lds, g, S, E, nullptr); }
        xcd_barrier(bar);
        { PHASE_LOCALS();
          if (bx < 20) {
            static_assert(TB == 8, "ssd finalize maps wave -> token");
            const MixRef a{in, l};
#ifndef MIXMASK
#define MIXMASK 15
#endif
            if (bx >= 12) { const int b = bx - 12; if (MIXMASK & 4) mix_ssd(a, PROJ + (size_t)b * SEQ * NP, U + (size_t)b * SEQ * DM, wave, lane, (float*)lds_raw); }
            else {
                const int mixer = bx >> 2, idx = (bx & 3) * 8 + wave, b = idx >> 2, h = idx & 3;
                const bf16* P = PROJ + (size_t)b * SEQ * NP; bf16* Y = U + (size_t)b * SEQ * DM;
                float* lw = (float*)lds_raw + wave * 8 * TB * 64;
                if (mixer == 0) { if (MIXMASK & 1) mix_hgrn(a, P, Y, h, lane, lw); }
                else if (mixer == 1) { if (MIXMASK & 2) mix_gdn(a, P, Y, h, lane, lw); }
                else { if (MIXMASK & 8) mix_rwkv(a, P, Y, h, lane, lw); }
            }
          } }
        xcd_barrier(bar);
        { PHASE_LOCALS();
          pg8::Gemm g; g.A = U; g.Bt = Wout + (size_t)l * DM * DM; g.M = MTOK; g.N = DM; g.K = DM;
          pg8::StaticOrder S; S.init(MTOK, DM, G, bx);
          pg8::EpiF32 E; E.C = OUT; E.ldc = DM; E.bias = nullptr;
          pg8::gemm_phase<pg8::EpiF32, pg8::StaticOrder, false>(lds, g, S, E, nullptr); }
        xcd_barrier(bar);
        { PHASE_LOCALS();
          const float* hin = (l == 0) ? in.x : hout;
          for (int m = bx * NWAVES + wave; m < MTOK; m += G * NWAVES)
            post_row(hin + (size_t)m * DM, OUT + (size_t)m * DM, in.post_norm_g + (size_t)l * DM, hout + (size_t)m * DM,
                     (l + 1 < NLAYER) ? in.pre_norm_g + (size_t)(l + 1) * DM : nullptr, U + (size_t)m * DM, lane); }
        if (l + 1 < NLAYER) xcd_barrier(bar);
    }
}

extern "C" void kernel_launch(void* const* d_in, const int* in_sizes, int n_in, void* d_out, int out_size, void* d_ws, size_t ws_size, hipStream_t stream) {
    static int grid = 0;
    if (grid == 0) {
        int dev = 0, cus = 0, per_cu = 0;
        if (hipGetDevice(&dev) != hipSuccess || hipDeviceGetAttribute(&cus, hipDeviceAttributeMultiprocessorCount, dev) != hipSuccess) { fprintf(stderr, "kernel_launch: device query failed\n"); grid = -1; return; }
        if (hipFuncSetAttribute((const void*)mk_fwd, hipFuncAttributeMaxDynamicSharedMemorySize, LDS_BYTES) != hipSuccess) { fprintf(stderr, "kernel_launch: hipFuncSetAttribute failed\n"); grid = -1; return; }
        if (hipOccupancyMaxActiveBlocksPerMultiprocessor(&per_cu, (const void*)mk_fwd, NWAVES * 64, LDS_BYTES) != hipSuccess || per_cu < 1)
            fprintf(stderr, "kernel_launch: note: occupancy query reports %d workgroups per CU\n", per_cu);
        (void)hipGetLastError();
        grid = cus;
    }
    if (grid < 0) return;
    if (hipMemsetAsync((char*)d_ws + WS_CTL, 0, CTL_ZERO_BYTES, stream) != hipSuccess) { fprintf(stderr, "kernel_launch: memset failed\n"); return; }
    Args a{};
    { const float** ip = (const float**)&a.in; for (int i = 0; i < 27; ++i) ip[i] = (const float*)d_in[i]; }
    a.out = (float*)d_out; a.ws = (unsigned char*)d_ws;
    hipLaunchKernelGGL(mk_fwd, dim3(grid), dim3(NWAVES * 64), LDS_BYTES, stream, a);
}
```

```cpp
#include <hip/hip_runtime.h>
#include <cstdio>
#include <cstdint>
namespace pg8 {
#define PG8_LAS __attribute__((address_space(3)))
typedef unsigned short bf16_t;
typedef short bf16x8 __attribute__((ext_vector_type(8)));
typedef float f32x4 __attribute__((ext_vector_type(4)));
typedef unsigned u32x4 __attribute__((ext_vector_type(4)));
constexpr int BM = 256, BK = 64, HALF = 128, HTB = HALF * BK * 2  , STAGE_BYTES = 8 * HTB, NXCD = 8, WGM = 8;

__host__ __device__ __forceinline__ int lds_byte(int r, int c) { const int st = (r >> 4) * 2 + (c >> 5), rr = r & 15, cc = c & 31, ob = rr * 64 + cc * 2; return st * 1024 + (ob ^ (((ob >> 9) & 1) << 5)); }
__host__ __device__ __forceinline__ void stage_rc(int b, int& R, int& C) { const int st = b / 1024, sb = b % 1024, swz = sb ^ (((sb >> 9) & 1) << 5); R = (st >> 1) * 16 + swz / 64; C = (st & 1) * 32 + (swz % 64) / 2; }
__host__ __device__ __forceinline__ int perm32(int rho) { const int n = rho >> 4, i = rho & 15; return 8 * (i >> 2) + 4 * n + (i & 3); }

struct Unit { int pm, pn; };
struct Gemm { const bf16_t* A; const bf16_t* Bt; int M, N, K; };

struct StaticOrder {
    int nM, nN, nwg, G, c, wave_id;
    __host__ __device__ void init(int M, int N, int G_, int c_) { nM = M / BM; nN = N / BM; nwg = nM * nN; G = G_; c = c_; }
    __host__ __device__ bool next(int i, Unit& u) const {
        const long L = (long)i * G + c; if (L >= nwg) return false;
        int wgid = (int)L; { const int q = nwg / NXCD, r = nwg % NXCD, xcd = wgid % NXCD, off = wgid / NXCD; wgid = (xcd < r ? xcd * (q + 1) : r * (q + 1) + (xcd - r) * q) + off; }
        const int nig = WGM * nN, gid = wgid / nig, fm = gid * WGM, gsz = (nM - fm) < WGM ? (nM - fm) : WGM;
        u.pm = fm + ((wgid % nig) % gsz); u.pn = (wgid % nig) / gsz; return true;
    }
    __device__ __forceinline__ void a_ready(const Unit&) const {}
    __device__ __forceinline__ void done(const Unit&) const {}
};
__device__ __forceinline__ unsigned cvt_pk_bf16(float lo, float hi) { unsigned r; asm volatile("v_cvt_pk_bf16_f32 %0, %1, %2" : "=v"(r) : "v"(lo), "v"(hi)); return r; }
typedef float f32x2 __attribute__((ext_vector_type(2)));
__device__ __forceinline__ f32x2 gelu_pk(f32x2 v) {
    const f32x2 av = __builtin_elementwise_abs(v), d = av * 0.2316418882f + 1.0f;
    f32x2 t; t.x = __builtin_amdgcn_rcpf(d.x); t.y = __builtin_amdgcn_rcpf(d.y);
    f32x2 q = t * 0.5307027145f + (-0.7265760135f); q = q * t + 0.7107068705f; q = q * t + (-0.142248368f); q = q * t + 0.127414796f; q = q * t;
    const f32x2 s = (v * v) * (-0.72134752044f);
    f32x2 e; e.x = __builtin_amdgcn_exp2f(s.x); e.y = __builtin_amdgcn_exp2f(s.y);
    const f32x2 m = v * (q * e), r = v - m;
    f32x2 o; o.x = v.x < 0.f ? m.x : r.x; o.y = v.y < 0.f ? m.y : r.y; return o;
}

struct EpiF32 {
    static constexpr bool PERM = false, AFTER_DRAIN = false;
    float* C; int ldc; const float* bias;
    __device__ __forceinline__ void operator()(const f32x4 (&acc)[2][2][4][2], const Unit& u, int wr, int wc, int fr, int fq) const {
        const int row0 = u.pm * BM + wr * 64 + fr, col0 = u.pn * BM + wc * 32 + 4 * fq;
        f32x4 bv[2][2];
#pragma unroll
        for (int bj = 0; bj < 2; ++bj)
#pragma unroll
            for (int n = 0; n < 2; ++n) bv[bj][n] = bias ? *(const f32x4*)(bias + col0 + bj * HALF + n * 16) : (f32x4){0.f, 0.f, 0.f, 0.f};
#pragma unroll
        for (int ai = 0; ai < 2; ++ai)
#pragma unroll
            for (int m = 0; m < 4; ++m) { float* rowp = C + (size_t)(row0 + ai * HALF + m * 16) * ldc + col0;
#pragma unroll
                for (int bj = 0; bj < 2; ++bj)
#pragma unroll
                    for (int n = 0; n < 2; ++n) *(f32x4*)(rowp + bj * HALF + n * 16) = acc[ai][bj][m][n] + bv[bj][n]; }
    }
};
template <int ACT  > struct EpiBf16 {
    static constexpr bool PERM = true, AFTER_DRAIN = false;
    bf16_t* O; int ldc; const float* bias; int split_cols; size_t split_stride;
    __device__ __forceinline__ void operator()(const f32x4 (&acc)[2][2][4][2], const Unit& u, int wr, int wc, int fr, int fq) const {
        const int row0 = u.pm * BM + wr * 64 + fr; int colt = u.pn * BM; bf16_t* base = O;
        if (split_cols) { const int t = colt / split_cols; base += (size_t)t * split_stride; colt -= t * split_cols; }
        const int col0 = colt + wc * 32 + 8 * fq, bcol0 = u.pn * BM + wc * 32 + 8 * fq;
        f32x4 bv[2][2];
#pragma unroll
        for (int bj = 0; bj < 2; ++bj)
#pragma unroll
            for (int n = 0; n < 2; ++n) bv[bj][n] = bias ? *(const f32x4*)(bias + bcol0 + bj * HALF + 4 * n) : (f32x4){0.f, 0.f, 0.f, 0.f};
#pragma unroll
        for (int ai = 0; ai < 2; ++ai)
#pragma unroll
            for (int m = 0; m < 4; ++m) { bf16_t* rowp = base + (size_t)(row0 + ai * HALF + m * 16) * ldc + col0;
#pragma unroll
                for (int bj = 0; bj < 2; ++bj) { f32x4 v0 = acc[ai][bj][m][0] + bv[bj][0], v1 = acc[ai][bj][m][1] + bv[bj][1];
                    if (ACT == 1) { f32x2 a = gelu_pk((f32x2){v0[0], v0[1]}), b = gelu_pk((f32x2){v0[2], v0[3]}), c = gelu_pk((f32x2){v1[0], v1[1]}), d = gelu_pk((f32x2){v1[2], v1[3]});
                        v0 = (f32x4){a.x, a.y, b.x, b.y}; v1 = (f32x4){c.x, c.y, d.x, d.y}; }
                    if (ACT == 2) {
#pragma unroll
                        for (int j = 0; j < 4; ++j) { v0[j] = 0.5f * v0[j] * (1.0f + erff(v0[j] * 0.70710678f)); v1[j] = 0.5f * v1[j] * (1.0f + erff(v1[j] * 0.70710678f)); } }
                    u32x4 w; w.x = cvt_pk_bf16(v0[0], v0[1]); w.y = cvt_pk_bf16(v0[2], v0[3]); w.z = cvt_pk_bf16(v1[0], v1[1]); w.w = cvt_pk_bf16(v1[2], v1[3]);
                    *(u32x4*)(rowp + bj * HALF) = w; } }
    }
};
__device__ __forceinline__ int fresh_lane_pg8() { unsigned m_ = ~0u; asm volatile("" : "+s"(m_)); return (int)__builtin_amdgcn_mbcnt_hi(m_, __builtin_amdgcn_mbcnt_lo(m_, 0u)); }
template <class Epi, class Sched, bool STAMP = false>
__device__ __forceinline__ void gemm_phase(PG8_LAS unsigned char* lds, const Gemm g, const Sched& S, const Epi& E, unsigned long long* stamps) {
    int tid_op_ = (S.wave_id << 6) | fresh_lane_pg8(); const int tid = tid_op_, wid = __builtin_amdgcn_readfirstlane(tid >> 6), lane = tid & 63, wr = wid >> 2, wc = wid & 3, fr = lane & 15, fq = lane >> 4;
    const int K = g.K, nt = K / BK;
    int ts_lo = 0, ts_hi = 0, nts = 0; const unsigned long long rt_entry = STAMP ? (unsigned long long)wall_clock64() : 0ull;
#define PG8_STAMP() do { if (STAMP && wid == 0 && nts < 64) { const unsigned long long _c = (unsigned long long)clock64(); \
        ts_lo = (lane == nts) ? (int)(unsigned)_c : ts_lo; ts_hi = (lane == nts) ? (int)(unsigned)(_c >> 32) : ts_hi; ++nts; } } while (0)
    PG8_STAMP();
    unsigned voffA[2], voffB[2];
#pragma unroll
    for (int i = 0; i < 2; ++i) { int R, C; stage_rc(tid * 16 + i * 8192, R, C); const int Rb = Epi::PERM ? ((R & ~31) + perm32(R & 31)) : R;
        voffA[i] = (unsigned)(R * K + C) * 2u; voffB[i] = (unsigned)(Rb * K + C) * 2u; }
    const size_t kstep = (size_t)(BK * 2);
    const size_t hstep = (size_t)HALF * K * 2;
    const size_t tstep = 2 * hstep;
    const unsigned ldsw = (unsigned)wid * 1024u;
    const int aoff = lds_byte(wr * 64 + fr, fq * 8), boff = lds_byte(wc * 32 + fr, fq * 8);
#define PG8_SA(b, h) (((b) * 2 + (h)) * HTB)
#define PG8_SB(b, h) ((4 + (b) * 2 + (h)) * HTB)
#define PG8_STAGE(bufoff, gbase, voff) do { _Pragma("unroll") for (int _i = 0; _i < 2; ++_i) \
        __builtin_amdgcn_global_load_lds((const unsigned*)((const char*)(gbase) + (voff)[_i]), (PG8_LAS unsigned*)(lds + (bufoff) + ldsw + _i * 8192), 16, 0, 0); } while (0)
#define PG8_LDA(dst, b, h) do { _Pragma("unroll") for (int m = 0; m < 4; ++m) _Pragma("unroll") for (int k = 0; k < 2; ++k) dst[m][k] = *(const PG8_LAS bf16x8*)(lds + PG8_SA(b, h) + aoff + m * 2048 + k * 1024); } while (0)
#define PG8_LDB(dst, b, h) do { _Pragma("unroll") for (int n = 0; n < 2; ++n) _Pragma("unroll") for (int k = 0; k < 2; ++k) dst[n][k] = *(const PG8_LAS bf16x8*)(lds + PG8_SB(b, h) + boff + n * 2048 + k * 1024); } while (0)
#define PG8_MMA(ai, bj, At, Bt) do { __builtin_amdgcn_s_setprio(1); _Pragma("unroll") for (int m = 0; m < 4; ++m) _Pragma("unroll") for (int n = 0; n < 2; ++n) _Pragma("unroll") for (int k = 0; k < 2; ++k) \
        acc[ai][bj][m][n] = __builtin_amdgcn_mfma_f32_16x16x32_bf16(Bt[n][k], At[m][k], acc[ai][bj][m][n], 0, 0, 0); __builtin_amdgcn_s_setprio(0); } while (0)
#define PG8_WAIT_V(n) asm volatile("s_waitcnt vmcnt(" #n ")" ::: "memory")
#define PG8_WAIT_L(n) asm volatile("s_waitcnt lgkmcnt(" #n ")" ::: "memory")
#define PG8_BAR __builtin_amdgcn_s_barrier()
#define PG8_SCHED __builtin_amdgcn_sched_barrier(0)
    Unit cur, nxt; int ui = 0;
    if (!S.next(0, cur)) return;
    f32x4 acc[2][2][4][2];
#pragma unroll
    for (int a = 0; a < 2; ++a)
#pragma unroll
        for (int b = 0; b < 2; ++b)
#pragma unroll
            for (int m = 0; m < 4; ++m)
#pragma unroll
                for (int n = 0; n < 2; ++n) acc[a][b][m][n] = (f32x4){0.f, 0.f, 0.f, 0.f};
    bf16x8 At[4][2], B0[2][2], B1[2][2];
    const char* cA = (const char*)g.A + (size_t)cur.pm * tstep; const char* cB = (const char*)g.Bt + (size_t)cur.pn * tstep;
    S.a_ready(cur);
    PG8_STAGE(PG8_SB(0, 0), cB, voffB); PG8_STAGE(PG8_SA(0, 0), cA, voffA); PG8_STAGE(PG8_SB(0, 1), cB + hstep, voffB); PG8_STAGE(PG8_SA(0, 1), cA + hstep, voffA);
    if (wr == 1) PG8_BAR;
    PG8_WAIT_V(4); PG8_BAR;
    PG8_STAGE(PG8_SB(1, 0), cB + kstep, voffB); PG8_STAGE(PG8_SA(1, 0), cA + kstep, voffA); PG8_STAGE(PG8_SB(1, 1), cB + hstep + kstep, voffB);
    PG8_WAIT_V(6); PG8_BAR;
    PG8_STAMP();
    for (;;) {
        const bool has_next = S.next(ui + 1, nxt);
        const char* nA = has_next ? (const char*)g.A + (size_t)nxt.pm * tstep : cA; const char* nB = has_next ? (const char*)g.Bt + (size_t)nxt.pn * tstep : cB;
        for (int t = 0; t < nt; t += 2) {
            const bool last = (t == nt - 2);
            const char* a1 = cA + (size_t)(t + 1) * kstep;
            const char* a2 = last ? nA : cA + (size_t)(t + 2) * kstep; const char* b2 = last ? nB : cB + (size_t)(t + 2) * kstep;
            const char* a3 = a2 + kstep; const char* b3 = b2 + kstep;
            if (last && has_next) S.a_ready(nxt);
            PG8_LDB(B0, 0, 0); PG8_SCHED; PG8_LDA(At, 0, 0); PG8_STAGE(PG8_SA(1, 1), a1 + hstep, voffA);
            PG8_WAIT_L(8); PG8_BAR; PG8_WAIT_L(0); PG8_MMA(0, 0, At, B0); PG8_BAR; PG8_SCHED;
            PG8_LDB(B1, 0, 1); PG8_STAGE(PG8_SB(0, 0), b2, voffB);
            PG8_BAR; PG8_WAIT_L(0); PG8_MMA(0, 1, At, B1); PG8_BAR;
            PG8_LDA(At, 0, 1); PG8_STAGE(PG8_SA(0, 0), a2, voffA);
            PG8_BAR; PG8_WAIT_L(0); PG8_MMA(1, 0, At, B0); PG8_BAR; PG8_SCHED;
            PG8_STAGE(PG8_SB(0, 1), b2 + hstep, voffB);
            PG8_WAIT_V(6); PG8_BAR; PG8_MMA(1, 1, At, B1); PG8_BAR;
            PG8_LDB(B0, 1, 0); PG8_SCHED; PG8_LDA(At, 1, 0); PG8_STAGE(PG8_SA(0, 1), a2 + hstep, voffA);
            PG8_WAIT_L(8); PG8_BAR; PG8_WAIT_L(0); PG8_MMA(0, 0, At, B0); PG8_BAR; PG8_SCHED;
            PG8_LDB(B1, 1, 1); PG8_STAGE(PG8_SB(1, 0), b3, voffB);
            PG8_BAR; PG8_WAIT_L(0); PG8_MMA(0, 1, At, B1); PG8_BAR;
            PG8_LDA(At, 1, 1); PG8_STAGE(PG8_SA(1, 0), a3, voffA);
            PG8_BAR; PG8_WAIT_L(0); PG8_MMA(1, 0, At, B0); PG8_BAR; PG8_SCHED;
            PG8_STAGE(PG8_SB(1, 1), b3 + hstep, voffB);
            PG8_WAIT_V(6); PG8_BAR; PG8_MMA(1, 1, At, B1); PG8_BAR;
        }
        PG8_STAMP();
        if constexpr (!Epi::AFTER_DRAIN) { E(acc, cur, wr, wc, fr, fq); S.done(cur); }
        PG8_STAMP();
        if (!has_next) break;
#pragma unroll
        for (int a = 0; a < 2; ++a)
#pragma unroll
            for (int b = 0; b < 2; ++b)
#pragma unroll
                for (int m = 0; m < 4; ++m)
#pragma unroll
                    for (int n = 0; n < 2; ++n) acc[a][b][m][n] = (f32x4){0.f, 0.f, 0.f, 0.f};
        cur = nxt; cA = nA; cB = nB; ++ui;
    }
    PG8_WAIT_V(0);
    if (wr == 0) PG8_BAR;
    PG8_BAR;
    if constexpr (Epi::AFTER_DRAIN) { E.fused(acc, cur, wr, wc, fr, fq, lds, wid, lane); S.done(cur); }
    PG8_STAMP();
    if (STAMP && wid == 0) { stamps[lane] = lane < nts ? (((unsigned long long)(unsigned)ts_hi << 32) | (unsigned)ts_lo) : 0ull;
        if (lane == 62) stamps[62] = rt_entry; if (lane == 63) stamps[63] = (unsigned long long)wall_clock64(); }
#undef PG8_STAMP
#undef PG8_SA
#undef PG8_SB
#undef PG8_STAGE
#undef PG8_LDA
#undef PG8_LDB
#undef PG8_MMA
#undef PG8_WAIT_V
#undef PG8_WAIT_L
#undef PG8_BAR
#undef PG8_SCHED
}
}
#define GAS __attribute__((address_space(1)))
#define LAS __attribute__((address_space(3)))
typedef unsigned short bf16;
typedef unsigned v4u __attribute__((ext_vector_type(4)));
typedef float f32x4 __attribute__((ext_vector_type(4)));
typedef short bf16x8 __attribute__((ext_vector_type(8)));
typedef GAS unsigned gu32;
typedef GAS unsigned long long gu64;
__device__ __forceinline__ int fresh_lane() { unsigned m_ = ~0u; asm volatile("" : "+s"(m_)); return (int)__builtin_amdgcn_mbcnt_hi(m_, __builtin_amdgcn_mbcnt_lo(m_, 0u)); }
#define RLX_AGENT __ATOMIC_RELAXED, __HIP_MEMORY_SCOPE_AGENT
#define LDS_WAIT() asm volatile("s_waitcnt lgkmcnt(0)" ::: "memory")
#define VM_WAIT() asm volatile("s_waitcnt vmcnt(0)" ::: "memory")
__device__ __forceinline__ unsigned long long rt() { return __builtin_amdgcn_s_memrealtime(); }
__device__ __forceinline__ unsigned f2bf(float f) { unsigned u = __builtin_bit_cast(unsigned, f); return (u + 0x7fffu + ((u >> 16) & 1u)) >> 16; }
__device__ __forceinline__ unsigned pk2(float lo, float hi) { return f2bf(lo) | (f2bf(hi) << 16); }
#define XB_TMO      128
#define XB_XCNT(j)  (256  + 64 * (j))
#define XB_XSUB(j)  (1280 + 64 * (j))
#define XB_XGEN(j)  (2304 + 64 * (j))
#define XB_TOP      3328
#define XB_TOPGEN   3392
#define XCD_BAR_WORDS 3456
#define XB_SPIN_CAP (1u << 22)

__device__ __forceinline__ unsigned xb_ld(unsigned* p)              { return __hip_atomic_load(p, __ATOMIC_RELAXED, __HIP_MEMORY_SCOPE_AGENT); }
__device__ __forceinline__ unsigned xb_add(unsigned* p, unsigned v) { return __hip_atomic_fetch_add(p, v, __ATOMIC_RELAXED, __HIP_MEMORY_SCOPE_AGENT); }
__device__ __forceinline__ unsigned xb_xcc_id() { return (unsigned)__builtin_amdgcn_s_getreg((3 << 11) | 20) & 0xFu; }
#define XB_SPIN(cond, bar) do { unsigned _sp = 0; while (cond) { __builtin_amdgcn_s_sleep(1); \
    if ((++_sp & 255u) == 0u) { if (xb_ld(&(bar)[XB_TMO])) break; if (_sp > XB_SPIN_CAP) { atomicAdd(&(bar)[XB_TMO], 1u); break; } } } } while (0)

struct XcdBarrier {
    unsigned* bar; unsigned x;
    volatile LAS unsigned* st;
};

__device__ __forceinline__ XcdBarrier xcd_barrier_post(unsigned* bar, volatile LAS unsigned* st, const int tid_) {
    XcdBarrier b; b.bar = bar; b.x = xb_xcc_id(); b.st = st;
    if (tid_ == 0) (void)xb_add(&bar[XB_XCNT(b.x)], 1u);
    return b;
}
__device__ __forceinline__ void xcd_barrier_complete(unsigned* bar, unsigned x, unsigned& nloc, unsigned& nx) {
    const unsigned G = gridDim.x * gridDim.y * gridDim.z;
    unsigned sum, cnt, mine, sp = 0u;
    for (;;) {
        sum = 0u; cnt = 0u; mine = 0u;
#pragma unroll
        for (unsigned j = 0; j < 16; ++j) { const unsigned c = xb_ld(&bar[XB_XCNT(j)]); sum += c; cnt += (c > 0u) ? 1u : 0u; mine = (j == x) ? c : mine; }
        if (sum == G) break;
        __builtin_amdgcn_s_sleep(1);
        if ((++sp & 255u) == 0u) { if (xb_ld(&bar[XB_TMO])) break; if (sp > XB_SPIN_CAP) { atomicAdd(&bar[XB_TMO], 1u); break; } }
    }
    nloc = mine > 0u ? mine : 1u; nx = cnt > 0u ? cnt : 1u;
}

__device__ __forceinline__ void xcd_barrier(const XcdBarrier& b, const int tid_) {
    asm volatile("s_waitcnt vmcnt(0)" ::: "memory");
    __syncthreads();
    if (tid_ == 0) {
        unsigned* bar = b.bar;
        __builtin_amdgcn_s_waitcnt(0);
        unsigned nloc = b.st[0], nx = b.st[1];
        if (nloc == 0u) { xcd_barrier_complete(bar, b.x, nloc, nx); b.st[0] = nloc; b.st[1] = nx; }
        const unsigned old = xb_add(&bar[XB_XSUB(b.x)], 1u);
        const unsigned gen = old / nloc;
        if (old + 1u == (gen + 1u) * nloc) {
            __builtin_amdgcn_fence(__ATOMIC_RELEASE, "agent");
            asm volatile("s_waitcnt vmcnt(0)" ::: "memory");
            const unsigned og = xb_add(&bar[XB_TOP], 1u);
            const unsigned tg = og / nx;
            if (og + 1u == (tg + 1u) * nx) xb_add(&bar[XB_TOPGEN], 1u);
            else XB_SPIN(xb_ld(&bar[XB_TOPGEN]) == tg, bar);
            __builtin_amdgcn_fence(__ATOMIC_ACQUIRE, "agent");
            xb_add(&bar[XB_XGEN(b.x)], 1u);
            asm volatile("s_waitcnt vmcnt(0)" ::: "memory");
        } else {
            XB_SPIN(xb_ld(&bar[XB_XGEN(b.x)]) == gen, bar);
            __builtin_amdgcn_fence(__ATOMIC_ACQUIRE, "agent");
            asm volatile("s_waitcnt vmcnt(0)" ::: "memory");
        }
    }
    __syncthreads();
}

constexpr int BATCH = 8, SEQ = 2048, DM = 1024, MTOK = BATCH * SEQ, NLAYER = 2;
constexpr int GW = 256, HD = 64, NHEAD = 4;
constexpr int IN_COLS = 4236, NP = 4352;
constexpr int C_HG_Q = 0, C_HG_F = 256, C_HG_I = 512;
constexpr int C_GD_Q = 768, C_GD_K = 1024, C_GD_V = 1280;
constexpr int C_SS_X = 1536, C_SS_B = 1792, C_SS_C = 2048;
constexpr int C_RW_R = 2304, C_RW_K = 2560, C_RW_V = 2816;
constexpr int C_Z = 3072;
constexpr int C_GD_BETA = 4096, C_GD_DEC = 4100, C_SS_DT = 4104, C_RW_WD = 4112, C_RW_AD = 4176;

__host__ __device__ __forceinline__ int old_col(int n) {
    if (n < 1536) return n;
    if (n < 2304) return 1544 + (n - 1536);
    if (n < 3072) return 2316 + (n - 2304);
    if (n < 4096) return 3212 + (n - 3072);
    if (n < 4104) return 1536 + (n - 4096);
    if (n < 4108) return 2312 + (n - 4104);
    if (n < 4112) return -1;
    if (n < 4240) return 3084 + (n - 4112);
    return -1;
}
__device__ __forceinline__ float bf2f(bf16 b) { return __builtin_bit_cast(float, ((unsigned)b) << 16); }
__device__ __forceinline__ float wave_sum(float v) {
#pragma unroll
    for (int o = 1; o < 64; o <<= 1) v += __shfl_xor(v, o);
    return v;
}
__device__ __forceinline__ float sigmoidf_(float x) { return 1.f / (1.f + __expf(-x)); }
__device__ __forceinline__ float siluf_(float x) { return x / (1.f + __expf(-x)); }
__device__ __forceinline__ float softplusf_(float x) { return x > 20.f ? x : log1pf(__expf(x)); }

struct Inputs {
    const float* x; const float* pre_norm_g; const float* w_in; const float* hgrn_lb; const float* hgrn_norm_g;
    const float* gdn_conv_w; const float* gdn_a_log; const float* gdn_dt_bias; const float* gdn_norm_g;
    const float* ssm_conv_w; const float* ssm_conv_b; const float* ssm_a_log; const float* ssm_dt_bias; const float* ssm_d; const float* ssm_norm_g;
    const float* rwkv_mu; const float* rwkv_w0; const float* rwkv_w_up; const float* rwkv_a0; const float* rwkv_a_up; const float* rwkv_k_k; const float* rwkv_k_a;
    const float* rwkv_r_k; const float* rwkv_ln_w; const float* rwkv_ln_b; const float* w_out; const float* post_norm_g;
};


typedef short bf16x4 __attribute__((ext_vector_type(4)));
typedef unsigned v2u __attribute__((ext_vector_type(2)));
#define MFMA16(a, b, c) __builtin_amdgcn_mfma_f32_16x16x32_bf16((a), (b), (c), 0, 0, 0)
constexpr int LS = 72;
constexpr int MAT_B = 64 * LS * 2;
constexpr int LS2 = 136;
constexpr int HEAD_LDS = 73728;

__device__ __forceinline__ unsigned pk_bf16(float lo, float hi) { return f2bf(lo) | (f2bf(hi) << 16); }
__device__ __forceinline__ bf16x8 ld_frag(const LAS bf16* base, int stride, int row, int kofs, int q) {
    return *(const LAS bf16x8*)(base + row * stride + kofs + 8 * q);
}
__device__ __forceinline__ bf16x8 ld_frag_perm(const LAS bf16* base, int stride, int row, int kofs, int q) {
    const bf16x4 lo = *(const LAS bf16x4*)(base + row * stride + kofs + 4 * q);
    const bf16x4 hi = *(const LAS bf16x4*)(base + row * stride + kofs + 16 + 4 * q);
    bf16x8 v; v[0] = lo[0]; v[1] = lo[1]; v[2] = lo[2]; v[3] = lo[3]; v[4] = hi[0]; v[5] = hi[1]; v[6] = hi[2]; v[7] = hi[3]; return v;
}
__device__ __forceinline__ bf16x8 pack_frag(const f32x4& a, const f32x4& b) {
    union { unsigned u[4]; bf16x8 v; } x;
    x.u[0] = pk_bf16(a[0], a[1]); x.u[1] = pk_bf16(a[2], a[3]); x.u[2] = pk_bf16(b[0], b[1]); x.u[3] = pk_bf16(b[2], b[3]); return x.v;
}
__device__ __forceinline__ void st4(LAS bf16* base, int stride, int row, int col, const f32x4& v) {
    v2u o; o.x = pk_bf16(v[0], v[1]); o.y = pk_bf16(v[2], v[3]); *(LAS v2u*)(base + row * stride + col) = o;
}
__device__ __forceinline__ f32x4 zero4() { return (f32x4){0.f, 0.f, 0.f, 0.f}; }
#define WG_BAR() __syncthreads()

__device__ __forceinline__ void ssd_pack16(LAS bf16* dst, const float* v) {
    v4u w0, w1;
    w0.x = pk_bf16(v[0], v[1]); w0.y = pk_bf16(v[2], v[3]); w0.z = pk_bf16(v[4], v[5]); w0.w = pk_bf16(v[6], v[7]);
    w1.x = pk_bf16(v[8], v[9]); w1.y = pk_bf16(v[10], v[11]); w1.z = pk_bf16(v[12], v[13]); w1.w = pk_bf16(v[14], v[15]);
    *(LAS v4u*)dst = w0; *(LAS v4u*)(dst + 8) = w1;
}
#define RAWF(arr, j) bf2f((arr)[(j) >> 1][(j) & 1])
__device__ __forceinline__ int opaque_i(int v) { asm volatile("" : "+v"(v)); return v; }

__device__ __forceinline__ void mixopt_hgrn(const Inputs& in, const int layer, const bf16* __restrict__ PROJ, bf16* __restrict__ Yg, LAS unsigned char* ldsw, const int b, const int hp, const int tid) {
    const int lane = tid & 63, wave = __builtin_amdgcn_readfirstlane(tid >> 6), hh = wave >> 2, w4 = wave & 3, h = hp * 2 + hh, r = lane & 15, q = lane >> 4;
    LAS unsigned char* L = ldsw + hh * HEAD_LDS;
    LAS bf16* QT = (LAS bf16*)L; LAS bf16* KA = (LAS bf16*)(L + MAT_B); LAS bf16* KB = (LAS bf16*)(L + 2 * MAT_B); LAS bf16* R2 = (LAS bf16*)(L + 3 * MAT_B);
    LAS bf16* KDT = (LAS bf16*)(L + 4 * MAT_B); LAS bf16* VT = (LAS bf16*)(L + 5 * MAT_B); LAS bf16* ZT = (LAS bf16*)(L + 6 * MAT_B);
    LAS float* QTOT = (LAS float*)(L + 7 * MAT_B); LAS float* ELAST = QTOT + 256;
    const bf16* P = PROJ + (size_t)b * SEQ * NP; bf16* Yb = Yg + (size_t)b * SEQ * DM;
    const int c = h * 64 + lane;
    float lbv = 0.f;
    if (layer == 1) { const float x0 = in.hgrn_lb[c], x1 = in.hgrn_lb[GW + c]; const float mx = fmaxf(x0, x1); const float e0 = __expf(x0 - mx), e1 = __expf(x1 - mx); lbv = e1 / (e0 + e1); }
    f32x4 gn[4];
#pragma unroll
    for (int nv = 0; nv < 4; ++nv) gn[nv] = *(const f32x4*)(in.hgrn_norm_g + layer * HD + 16 * nv + 4 * q);
    f32x4 zs[4];
#pragma unroll
    for (int n = 0; n < 4; ++n) zs[n] = zero4();
    bf16 rq[16], rf[16], rv[16];
    { const bf16* p0 = P + (size_t)(16 * w4) * NP;
#pragma unroll
      for (int i = 0; i < 16; ++i) { rq[i] = p0[(size_t)i * NP + C_HG_Q + c]; rf[i] = p0[(size_t)i * NP + C_HG_F + c]; rv[i] = p0[(size_t)i * NP + C_HG_I + c]; } }
    for (int ch = 0; ch < SEQ / 64; ++ch) {
        float qv[16], kv[16], cl[16], vv[16]; float run = 0.f;
#pragma unroll
        for (int i = 0; i < 16; ++i) { const float x = bf2f(rq[i]); qv[i] = siluf_(x) * 0.125f; const float f = lbv + (1.f - lbv) * sigmoidf_(bf2f(rf[i])); kv[i] = 1.f - f; run += __logf(f); cl[i] = run; vv[i] = bf2f(rv[i]); }
        QTOT[w4 * 64 + lane] = run;
        if (ch + 1 < SEQ / 64) { const bf16* p0 = P + (size_t)((ch + 1) * 64 + 16 * w4) * NP;
#pragma unroll
            for (int i = 0; i < 16; ++i) { rq[i] = p0[(size_t)i * NP + C_HG_Q + c]; rf[i] = p0[(size_t)i * NP + C_HG_F + c]; rv[i] = p0[(size_t)i * NP + C_HG_I + c]; } }
        WG_BAR();
        {
            const float o0 = QTOT[lane], o1 = QTOT[64 + lane], o2 = QTOT[128 + lane], o3 = QTOT[192 + lane];
            const float base = (w4 > 0 ? o0 : 0.f) + (w4 > 1 ? o1 : 0.f) + (w4 > 2 ? o2 : 0.f);
            const float c31 = o0 + o1, c63 = c31 + o2 + o3, cI = (w4 >= 2) ? c31 : 0.f;
            float kd[16];
#pragma unroll
            for (int i = 0; i < 16; ++i) { const float cum = cl[i] + base; const int t = 16 * w4 + i;
                QT[t * LS + lane] = (bf16)f2bf(qv[i] * __expf(cum - cI));
                KA[t * LS + lane] = (bf16)f2bf(kv[i] * __expf(fminf(cI - cum, 80.f)));
                if (w4 < 2) KB[t * LS + lane] = (bf16)f2bf(kv[i] * __expf(c31 - cum));
                R2[t * LS + lane] = (bf16)f2bf(qv[i] * __expf(cum));
                kd[i] = kv[i] * __expf(c63 - cum); }
            v4u w0, w1;
            w0.x = pk_bf16(kd[0], kd[1]); w0.y = pk_bf16(kd[2], kd[3]); w0.z = pk_bf16(kd[4], kd[5]); w0.w = pk_bf16(kd[6], kd[7]);
            w1.x = pk_bf16(kd[8], kd[9]); w1.y = pk_bf16(kd[10], kd[11]); w1.z = pk_bf16(kd[12], kd[13]); w1.w = pk_bf16(kd[14], kd[15]);
            *(LAS v4u*)(KDT + lane * LS + 16 * w4) = w0; *(LAS v4u*)(KDT + lane * LS + 16 * w4 + 8) = w1;
            w0.x = pk_bf16(vv[0], vv[1]); w0.y = pk_bf16(vv[2], vv[3]); w0.z = pk_bf16(vv[4], vv[5]); w0.w = pk_bf16(vv[6], vv[7]);
            w1.x = pk_bf16(vv[8], vv[9]); w1.y = pk_bf16(vv[10], vv[11]); w1.z = pk_bf16(vv[12], vv[13]); w1.w = pk_bf16(vv[14], vv[15]);
            *(LAS v4u*)(VT + lane * LS + 16 * w4) = w0; *(LAS v4u*)(VT + lane * LS + 16 * w4 + 8) = w1;
            if (w4 == 0) ELAST[lane] = __expf(c63);
#pragma unroll
            for (int n = 0; n < 4; ++n) st4(ZT, LS, 16 * n + r, 16 * w4 + 4 * q, zs[n]);
        }
        WG_BAR();
        {
            const int m = w4;
            f32x4 Pt[4];
#pragma unroll
            for (int n = 0; n < 4; ++n) Pt[n] = zero4();
            bf16x8 aq[2];
#pragma unroll
            for (int k = 0; k < 2; ++k) aq[k] = ld_frag(QT, LS, 16 * m + r, 32 * k, q);
#pragma unroll
            for (int n = 0; n < 4; ++n) if (n <= m) {
                const LAS bf16* Bs = ((n >> 1) == (m >> 1)) ? KA : KB;
#pragma unroll
                for (int k = 0; k < 2; ++k) Pt[n] = MFMA16(ld_frag(Bs, LS, 16 * n + r, 32 * k, q), aq[k], Pt[n]);
                if (n == m) {
#pragma unroll
                    for (int i = 0; i < 4; ++i) if (4 * q + i > r) Pt[n][i] = 0.f; }
            }
            f32x4 O[4];
#pragma unroll
            for (int nv = 0; nv < 4; ++nv) O[nv] = zero4();
#pragma unroll
            for (int k = 0; k < 2; ++k) if (2 * k <= m) { const bf16x8 pf = pack_frag(Pt[2 * k], Pt[2 * k + 1]);
#pragma unroll
                for (int nv = 0; nv < 4; ++nv) O[nv] = MFMA16(ld_frag_perm(VT, LS, 16 * nv + r, 32 * k, q), pf, O[nv]); }
#pragma unroll
            for (int k = 0; k < 2; ++k) { const bf16x8 ar = ld_frag(R2, LS, 16 * m + r, 32 * k, q);
#pragma unroll
                for (int nv = 0; nv < 4; ++nv) O[nv] = MFMA16(ld_frag(ZT, LS, 16 * nv + r, 32 * k, q), ar, O[nv]); }
            float ss = 0.f;
#pragma unroll
            for (int nv = 0; nv < 4; ++nv) ss += (O[nv][0] * O[nv][0] + O[nv][1] * O[nv][1]) + (O[nv][2] * O[nv][2] + O[nv][3] * O[nv][3]);
            ss += __shfl_xor(ss, 16); ss += __shfl_xor(ss, 32);
            const float rs = rsqrtf(ss * (1.f / 64.f) + 1e-6f);
            const int t = ch * 64 + 16 * m + r;
#pragma unroll
            for (int nv = 0; nv < 4; ++nv) { const int dv0 = h * 64 + 16 * nv + 4 * q;
                const v2u zr = *(const v2u*)(P + (size_t)t * NP + C_Z + 0 + dv0);
                const float z0 = __builtin_bit_cast(float, zr.x << 16), z1 = __builtin_bit_cast(float, zr.x & 0xffff0000u), z2 = __builtin_bit_cast(float, zr.y << 16), z3 = __builtin_bit_cast(float, zr.y & 0xffff0000u);
                v2u o; o.x = pk_bf16(O[nv][0] * rs * gn[nv][0] * siluf_(z0), O[nv][1] * rs * gn[nv][1] * siluf_(z1));
                o.y = pk_bf16(O[nv][2] * rs * gn[nv][2] * siluf_(z2), O[nv][3] * rs * gn[nv][3] * siluf_(z3));
                *(v2u*)(Yb + (size_t)t * DM + 0 + dv0) = o; }
            const f32x4 el = *(const LAS f32x4*)(ELAST + 16 * w4 + 4 * q);
            bf16x8 ak[2];
#pragma unroll
            for (int k = 0; k < 2; ++k) ak[k] = ld_frag(KDT, LS, 16 * w4 + r, 32 * k, q);
#pragma unroll
            for (int n = 0; n < 4; ++n) { zs[n] = zs[n] * el;
#pragma unroll
                for (int k = 0; k < 2; ++k) zs[n] = MFMA16(ak[k], ld_frag(VT, LS, 16 * n + r, 32 * k, q), zs[n]); }
        }
        WG_BAR();
    }
}

__device__ __forceinline__ float tr_reduce16(const float* v, int lane) {
    float a[8], b[4], c[2], d;
    const bool b5 = lane & 32, b4 = lane & 16, b3 = lane & 8, b2 = lane & 4;
#pragma unroll
    for (int j = 0; j < 8; ++j) { const float snd = b5 ? v[j] : v[8 + j]; const float got = __shfl_xor(snd, 32); a[j] = (b5 ? v[8 + j] : v[j]) + got; }
#pragma unroll
    for (int j = 0; j < 4; ++j) { const float snd = b4 ? a[j] : a[4 + j]; const float got = __shfl_xor(snd, 16); b[j] = (b4 ? a[4 + j] : a[j]) + got; }
#pragma unroll
    for (int j = 0; j < 2; ++j) { const float snd = b3 ? b[j] : b[2 + j]; const float got = __shfl_xor(snd, 8); c[j] = (b3 ? b[2 + j] : b[j]) + got; }
    { const float snd = b2 ? c[0] : c[1]; const float got = __shfl_xor(snd, 4); d = (b2 ? c[1] : c[0]) + got; }
    d += __shfl_xor(d, 2); d += __shfl_xor(d, 1);
    return d;
}
__device__ __forceinline__ float rdlane(float x, int l) { return __builtin_bit_cast(float, __builtin_amdgcn_readlane(__builtin_bit_cast(int, x), l)); }

__device__ __forceinline__ void diag_inverse(const LAS float* AD, LAS bf16* DT, int lane) {
    const int j = lane >> 4, c = lane & 15;
    const LAS float* A = AD + j * 256;
    float x[16];
#pragma unroll
    for (int i = 0; i < 16; ++i) {
        float s = (i == c) ? 1.f : 0.f;
#pragma unroll
        for (int k4 = 0; k4 < i; k4 += 4) { const f32x4 a = *(const LAS f32x4*)(A + i * 16 + k4);
#pragma unroll
            for (int kk = 0; kk < 4; ++kk) if (k4 + kk < i) s -= a[kk] * x[k4 + kk]; }
        x[i] = s;
    }
    v4u w0, w1;
    w0.x = pk_bf16(x[0], x[1]); w0.y = pk_bf16(x[2], x[3]); w0.z = pk_bf16(x[4], x[5]); w0.w = pk_bf16(x[6], x[7]);
    w1.x = pk_bf16(x[8], x[9]); w1.y = pk_bf16(x[10], x[11]); w1.z = pk_bf16(x[12], x[13]); w1.w = pk_bf16(x[14], x[15]);
    *(LAS v4u*)(DT + (j * 16 + c) * 16) = w0; *(LAS v4u*)(DT + (j * 16 + c) * 16 + 8) = w1;
}
__device__ __forceinline__ bf16x8 half_frag_lds(const LAS bf16* p) { const bf16x4 lo = *(const LAS bf16x4*)p; bf16x8 v; v[0] = lo[0]; v[1] = lo[1]; v[2] = lo[2]; v[3] = lo[3]; v[4] = 0; v[5] = 0; v[6] = 0; v[7] = 0; return v; }
__device__ __forceinline__ bf16x8 two_frag_lds(const LAS bf16* p0, const LAS bf16* p1) { const bf16x4 lo = *(const LAS bf16x4*)p0; const bf16x4 hi = *(const LAS bf16x4*)p1; bf16x8 v; v[0] = lo[0]; v[1] = lo[1]; v[2] = lo[2]; v[3] = lo[3]; v[4] = hi[0]; v[5] = hi[1]; v[6] = hi[2]; v[7] = hi[3]; return v; }
__device__ __forceinline__ void tri_inverse_row(const LAS bf16* AMT, const LAS bf16* DT, int m, int r, int q, f32x4* Tm) {
    const f32x4 z4 = zero4();
    f32x4 dm;
#pragma unroll
    for (int i = 0; i < 4; ++i) dm[i] = bf2f(DT[(m * 16 + 4 * q + i) * 16 + r]);
#pragma unroll
    for (int n = 0; n < 4; ++n) Tm[n] = (n == m) ? dm : z4;
#pragma unroll
    for (int j = 2; j >= 0; --j) if (j < m) {
        f32x4 X = z4;
#pragma unroll
        for (int k = j + 1; k <= 3; k += 2) if (k <= m) {
            const LAS bf16* p0 = AMT + (16 * j + r) * LS + 16 * k + 4 * q;
            if (k + 1 <= 3) { const bf16x8 af = pack_frag(Tm[k], Tm[k + 1]); const bf16x8 bfr = two_frag_lds(p0, p0 + 16); X = MFMA16(bfr, af, X); }
            else { const bf16x8 af = pack_frag(Tm[k], z4); const bf16x8 bfr = half_frag_lds(p0); X = MFMA16(bfr, af, X); }
        }
        const bf16x8 xf = pack_frag(X, z4);
        const bf16x8 df = half_frag_lds(DT + (j * 16 + r) * 16 + 4 * q);
        const f32x4 Tj = MFMA16(df, xf, z4);
        Tm[j] = -Tj;
    }
}

__device__ __forceinline__ void mixopt_gdn(const Inputs& in, const int layer, const bf16* __restrict__ PROJ, bf16* __restrict__ Yg, LAS unsigned char* ldsw, const int b, const int hp, const int tid) {
    const int lane0 = tid & 63, wave = __builtin_amdgcn_readfirstlane(tid >> 6), hh = wave >> 2, w4 = wave & 3, h = hp * 2 + hh;
    LAS unsigned char* L = ldsw + hh * HEAD_LDS;
    LAS bf16* Qm = (LAS bf16*)L; LAS bf16* Km = (LAS bf16*)(L + 9216); LAS bf16* KT = (LAS bf16*)(L + 18432); LAS bf16* VT = (LAS bf16*)(L + 27648); LAS bf16* ZT = (LAS bf16*)(L + 36864);
    LAS bf16* AMT = (LAS bf16*)(L + 46080); LAS bf16* RHST = (LAS bf16*)(L + 55296); LAS float* AD = (LAS float*)(L + 64512); LAS bf16* DT = (LAS bf16*)(L + 68608);
    LAS float* CUM = (LAS float*)(L + 70656); LAS float* ECUM = CUM + 64; LAS float* BETA = CUM + 128; LAS float* WSC = CUM + 192;
    LAS bf16* VNWT = Km; LAS bf16* VNT = VT;
    const bf16* P = PROJ + (size_t)b * SEQ * NP; bf16* Yb = Yg + (size_t)b * SEQ * DM;
    const float* cw = in.gdn_conv_w + (size_t)layer * 4 * 768 + h * 64;
    const float Aneg = -__expf(in.gdn_a_log[layer * 4 + h]), dtb = in.gdn_dt_bias[layer * 4 + h];
    f32x4 zs[4];
#pragma unroll
    for (int n = 0; n < 4; ++n) zs[n] = zero4();
    typedef unsigned short us2 __attribute__((ext_vector_type(2)));
    us2 rq[10], rk[10], rv[10]; bf16 rbt, rat;
    auto load_raw = [&](int ch, int lane) {
        const int c = h * 64 + lane;
        const int tb = ch * 64 + 16 * w4 - 3;
#pragma unroll
        for (int j = 0; j < 20; ++j) { const int t = tb + j; const bool ok = (t >= 0) && (j < 19); const bf16* p0 = P + (size_t)(ok ? t : 0) * NP;
            const bf16 a = p0[C_GD_Q + c], bb = p0[C_GD_K + c], cc = p0[C_GD_V + c];
            rq[j >> 1][j & 1] = ok ? a : (bf16)0; rk[j >> 1][j & 1] = ok ? bb : (bf16)0; rv[j >> 1][j & 1] = ok ? cc : (bf16)0; }
        rbt = P[(size_t)(ch * 64 + lane) * NP + C_GD_BETA + h]; rat = P[(size_t)(ch * 64 + lane) * NP + C_GD_DEC + h];
    };
    load_raw(0, lane0);
    for (int ch = 0; ch < SEQ / 64; ++ch) {
        const int lane = opaque_i(lane0), r = lane & 15, q = lane >> 4;
        {
            float tv[16];
            float wq[4], wk[4], wv[4];
#pragma unroll
            for (int j = 0; j < 4; ++j) { wq[j] = cw[j * 768 + lane]; wk[j] = cw[j * 768 + 256 + lane]; wv[j] = cw[j * 768 + 512 + lane]; }
#pragma unroll
            for (int i = 0; i < 16; ++i) tv[i] = siluf_(wk[0] * RAWF(rk, i) + wk[1] * RAWF(rk, i + 1) + wk[2] * RAWF(rk, i + 2) + wk[3] * RAWF(rk, i + 3));
            { float sq[16];
#pragma unroll
              for (int i = 0; i < 16; ++i) sq[i] = tv[i] * tv[i];
              const float sred = tr_reduce16(sq, lane);
#pragma unroll
              for (int i = 0; i < 16; ++i) { tv[i] *= rsqrtf(rdlane(sred, 4 * i) + 1e-6f); Km[(16 * w4 + i) * LS + lane] = (bf16)f2bf(tv[i]); } }
            ssd_pack16(KT + lane * LS + 16 * w4, tv);
            asm volatile("" ::: "memory");
#pragma unroll
            for (int i = 0; i < 16; ++i) tv[i] = siluf_(wq[0] * RAWF(rq, i) + wq[1] * RAWF(rq, i + 1) + wq[2] * RAWF(rq, i + 2) + wq[3] * RAWF(rq, i + 3));
            { float sq[16];
#pragma unroll
              for (int i = 0; i < 16; ++i) sq[i] = tv[i] * tv[i];
              const float sred = tr_reduce16(sq, lane);
#pragma unroll
              for (int i = 0; i < 16; ++i) Qm[(16 * w4 + i) * LS + lane] = (bf16)f2bf(tv[i] * rsqrtf(rdlane(sred, 4 * i) + 1e-6f) * 0.125f); }
            asm volatile("" ::: "memory");
#pragma unroll
            for (int i = 0; i < 16; ++i) tv[i] = siluf_(wv[0] * RAWF(rv, i) + wv[1] * RAWF(rv, i + 1) + wv[2] * RAWF(rv, i + 2) + wv[3] * RAWF(rv, i + 3));
            ssd_pack16(VT + lane * LS + 16 * w4, tv);
            if (w4 == 0) {
                const float beta = sigmoidf_(bf2f(rbt)); float cs = Aneg * softplusf_(bf2f(rat) + dtb);
#pragma unroll
                for (int o = 1; o < 64; o <<= 1) { const float u = __shfl_up(cs, o); if (lane >= o) cs += u; }
                const float c63 = __shfl(cs, 63);
                CUM[lane] = cs; ECUM[lane] = __expf(cs); BETA[lane] = beta; WSC[lane] = __expf(c63 - cs);
            }
#pragma unroll
            for (int n = 0; n < 4; ++n) st4(ZT, LS, 16 * n + r, 16 * w4 + 4 * q, zs[n]);
        }
        WG_BAR();
        if (ch + 1 < SEQ / 64) load_raw(ch + 1, lane);
        const int m = w4;
        f32x4 QK[4];
        { const int lane = opaque_i(lane0), r = lane & 15, q = lane >> 4;
        {
            bf16x8 ak[2], aq[2];
#pragma unroll
            for (int k = 0; k < 2; ++k) { ak[k] = ld_frag(Km, LS, 16 * m + r, 32 * k, q); aq[k] = ld_frag(Qm, LS, 16 * m + r, 32 * k, q); }
            const f32x4 cumt4 = *(const LAS f32x4*)(CUM + 16 * m + 4 * q);
            const f32x4 bet4 = *(const LAS f32x4*)(BETA + 16 * m + 4 * q);
            const f32x4 ecum4 = *(const LAS f32x4*)(ECUM + 16 * m + 4 * q);
            const float cumr = CUM[16 * m + r];
#pragma unroll
            for (int n = 0; n < 4; ++n) { QK[n] = zero4(); if (n <= m) {
                f32x4 kk = zero4();
#pragma unroll
                for (int k = 0; k < 2; ++k) { const bf16x8 bk = ld_frag(Km, LS, 16 * n + r, 32 * k, q);
                    kk = MFMA16(ak[k], bk, kk);
                    QK[n] = MFMA16(bk, aq[k], QK[n]); }
                const float cums = CUM[16 * n + r];
                f32x4 av;
#pragma unroll
                for (int i = 0; i < 4; ++i) { const bool keep = (n < m) || (r < 4 * q + i); av[i] = keep ? bet4[i] * kk[i] * __expf(cumt4[i] - cums) : 0.f; }
                st4(AMT, LS, 16 * n + r, 16 * m + 4 * q, av);
                if (n == m) {
#pragma unroll
                    for (int i = 0; i < 4; ++i) AD[m * 256 + (4 * q + i) * 16 + r] = av[i]; }
                const f32x4 cs4 = *(const LAS f32x4*)(CUM + 16 * n + 4 * q);
#pragma unroll
                for (int i = 0; i < 4; ++i) { const bool keep = (n < m) || (4 * q + i <= r); QK[n][i] = keep ? QK[n][i] * __expf(cumr - cs4[i]) : 0.f; }
            } }
#pragma unroll
            for (int nv = 0; nv < 4; ++nv) { f32x4 kz = zero4();
#pragma unroll
                for (int k = 0; k < 2; ++k) kz = MFMA16(ak[k], ld_frag(ZT, LS, 16 * nv + r, 32 * k, q), kz);
                const v2u vr = *(const LAS v2u*)(VT + (16 * nv + r) * LS + 16 * m + 4 * q);
                f32x4 rh;
                rh[0] = bet4[0] * (__builtin_bit_cast(float, vr.x << 16) - ecum4[0] * kz[0]); rh[1] = bet4[1] * (__builtin_bit_cast(float, vr.x & 0xffff0000u) - ecum4[1] * kz[1]);
                rh[2] = bet4[2] * (__builtin_bit_cast(float, vr.y << 16) - ecum4[2] * kz[2]); rh[3] = bet4[3] * (__builtin_bit_cast(float, vr.y & 0xffff0000u) - ecum4[3] * kz[3]);
                st4(RHST, LS, 16 * nv + r, 16 * m + 4 * q, rh); }
        }
        }
        WG_BAR();
        { const int lane = opaque_i(lane0), r = lane & 15, q = lane >> 4;
        {
            diag_inverse(AD, DT, lane);
            asm volatile("s_waitcnt lgkmcnt(0)" ::: "memory");
            f32x4 Tm[4];
            tri_inverse_row(AMT, DT, m, r, q, Tm);
            const f32x4 w4v = *(const LAS f32x4*)(WSC + 16 * m + 4 * q);
            const bf16x8 t0 = pack_frag(Tm[0], Tm[1]), t1 = pack_frag(Tm[2], Tm[3]);
#pragma unroll
            for (int nv = 0; nv < 4; ++nv) { f32x4 vn = zero4();
                vn = MFMA16(t0, ld_frag_perm(RHST, LS, 16 * nv + r, 0, q), vn);
                if (m >= 2) vn = MFMA16(t1, ld_frag_perm(RHST, LS, 16 * nv + r, 32, q), vn);
                st4(VNT, LS, 16 * nv + r, 16 * m + 4 * q, vn);
                st4(VNWT, LS, 16 * nv + r, 16 * m + 4 * q, vn * w4v); }
        }
        }
        WG_BAR();
        { const int lane = opaque_i(lane0), r = lane & 15, q = lane >> 4; const float* gnp = in.gdn_norm_g + layer * HD + 4 * q;
        {
            f32x4 O[4];
            bf16x8 aq[2];
#pragma unroll
            for (int k = 0; k < 2; ++k) aq[k] = ld_frag(Qm, LS, 16 * m + r, 32 * k, q);
            const float ect = ECUM[16 * m + r];
            const bf16x8 p0 = pack_frag(QK[0], QK[1]), p1 = pack_frag(QK[2], QK[3]);
            float ss = 0.f;
#pragma unroll
            for (int nv = 0; nv < 4; ++nv) { O[nv] = zero4();
#pragma unroll
                for (int k = 0; k < 2; ++k) O[nv] = MFMA16(ld_frag(ZT, LS, 16 * nv + r, 32 * k, q), aq[k], O[nv]);
                O[nv] = O[nv] * ect;
                O[nv] = MFMA16(ld_frag_perm(VNT, LS, 16 * nv + r, 0, q), p0, O[nv]);
                if (m >= 2) O[nv] = MFMA16(ld_frag_perm(VNT, LS, 16 * nv + r, 32, q), p1, O[nv]);
                ss += (O[nv][0] * O[nv][0] + O[nv][1] * O[nv][1]) + (O[nv][2] * O[nv][2] + O[nv][3] * O[nv][3]); }
            ss += __shfl_xor(ss, 16); ss += __shfl_xor(ss, 32);
            const float rs = rsqrtf(ss * (1.f / 64.f) + 1e-6f);
            const int t = ch * 64 + 16 * m + r;
#pragma unroll
            for (int nv = 0; nv < 4; ++nv) { const int dv0 = h * 64 + 16 * nv + 4 * q;
                const f32x4 gg = *(const f32x4*)(gnp + 16 * nv);
                const v2u zr = *(const v2u*)(P + (size_t)t * NP + C_Z + 256 + dv0);
                const float z0 = __builtin_bit_cast(float, zr.x << 16), z1 = __builtin_bit_cast(float, zr.x & 0xffff0000u), z2 = __builtin_bit_cast(float, zr.y << 16), z3 = __builtin_bit_cast(float, zr.y & 0xffff0000u);
                v2u o; o.x = pk_bf16(O[nv][0] * rs * gg[0] * siluf_(z0), O[nv][1] * rs * gg[1] * siluf_(z1)); o.y = pk_bf16(O[nv][2] * rs * gg[2] * siluf_(z2), O[nv][3] * rs * gg[3] * siluf_(z3));
                *(v2u*)(Yb + (size_t)t * DM + 256 + dv0) = o; }
            const float last = ECUM[63];
            bf16x8 akt[2];
#pragma unroll
            for (int k = 0; k < 2; ++k) akt[k] = ld_frag(KT, LS, 16 * w4 + r, 32 * k, q);
#pragma unroll
            for (int n = 0; n < 4; ++n) { zs[n] = zs[n] * last;
#pragma unroll
                for (int k = 0; k < 2; ++k) zs[n] = MFMA16(akt[k], ld_frag(VNWT, LS, 16 * n + r, 32 * k, q), zs[n]); }
        }
        }
        WG_BAR();
    }
}

__device__ __forceinline__ void mixopt_ssd(const Inputs& in, const int layer, const bf16* __restrict__ PROJ, bf16* __restrict__ Yg, LAS unsigned char* ldsw, const int b, const int g, const int tid) {
    const int lane = tid & 63, wave = __builtin_amdgcn_readfirstlane(tid >> 6), hh = wave >> 2, w4 = wave & 3, h = g * 2 + hh, r = lane & 15, q = lane >> 4;
    LAS bf16* CM = (LAS bf16*)ldsw; LAS bf16* BM = (LAS bf16*)(ldsw + 17408); LAS bf16* BT = (LAS bf16*)(ldsw + 34816);
    LAS unsigned char* L = ldsw + 53248 + hh * 45056;
    LAS bf16* XVT = (LAS bf16*)L; LAS bf16* XVWT = (LAS bf16*)(L + MAT_B); LAS bf16* XR = (LAS bf16*)(L + 2 * MAT_B); LAS bf16* ZT = (LAS bf16*)(L + 3 * MAT_B);
    LAS float* CUM = (LAS float*)(ldsw + 143360 + hh * 1024); LAS float* ECUM = CUM + 64;
    LAS float* SS = (LAS float*)(ldsw + 145408);
    const bf16* P = PROJ + (size_t)b * SEQ * NP; bf16* Yb = Yg + (size_t)b * SEQ * DM;
    const int cx = h * 64 + lane, cbc = g * 128 + 64 * hh + lane;
    const float* cw = in.ssm_conv_w + (size_t)layer * 4 * 768; const float* cb = in.ssm_conv_b + (size_t)layer * 768;
    float wx[4], wB[4], wC[4];
#pragma unroll
    for (int j = 0; j < 4; ++j) { wx[j] = cw[j * 768 + cx]; wB[j] = cw[j * 768 + 256 + cbc]; wC[j] = cw[j * 768 + 512 + cbc]; }
    const float bx = cb[cx], bB = cb[256 + cbc], bC = cb[512 + cbc];
    const float Aneg = -__expf(in.ssm_a_log[layer * 4 + h]), dtb = in.ssm_dt_bias[layer * 4 + h], dsk = in.ssm_d[layer * 4 + h];
    const float* gnp = in.ssm_norm_g + layer * GW + h * 64 + 4 * q;
    f32x4 zs[2][4];
#pragma unroll
    for (int a = 0; a < 2; ++a)
#pragma unroll
        for (int n = 0; n < 4; ++n) zs[a][n] = zero4();
    typedef unsigned short us2 __attribute__((ext_vector_type(2)));
    us2 rx[10], rB[10], rC[10]; bf16 rdt;
    auto load_raw = [&](int ch) {
        const int tb = ch * 64 + 16 * w4 - 3;
#pragma unroll
        for (int j = 0; j < 20; ++j) { const int t = tb + j; const bool ok = (t >= 0) && (j < 19); const bf16* p0 = P + (size_t)(ok ? t : 0) * NP;
            const bf16 a = p0[C_SS_X + cx], bb = p0[C_SS_B + cbc], cc = p0[C_SS_C + cbc];
            rx[j >> 1][j & 1] = ok ? a : (bf16)0; rB[j >> 1][j & 1] = ok ? bb : (bf16)0; rC[j >> 1][j & 1] = ok ? cc : (bf16)0; }
        rdt = P[(size_t)(ch * 64 + lane) * NP + C_SS_DT + h];
    };
    load_raw(0);
    for (int ch = 0; ch < SEQ / 64; ++ch) {
        {
            float tv[16];
#pragma unroll
            for (int i = 0; i < 16; ++i) { tv[i] = siluf_(wC[0] * RAWF(rC, i) + wC[1] * RAWF(rC, i + 1) + wC[2] * RAWF(rC, i + 2) + wC[3] * RAWF(rC, i + 3) + bC);
                CM[(16 * w4 + i) * LS2 + 64 * hh + lane] = (bf16)f2bf(tv[i]); }
            asm volatile("" ::: "memory");
#pragma unroll
            for (int i = 0; i < 16; ++i) { tv[i] = siluf_(wB[0] * RAWF(rB, i) + wB[1] * RAWF(rB, i + 1) + wB[2] * RAWF(rB, i + 2) + wB[3] * RAWF(rB, i + 3) + bB);
                BM[(16 * w4 + i) * LS2 + 64 * hh + lane] = (bf16)f2bf(tv[i]); }
            ssd_pack16(BT + (64 * hh + lane) * LS + 16 * w4, tv);
            asm volatile("" ::: "memory");
            const float dt = softplusf_(bf2f(rdt) + dtb); float cs = dt * Aneg;
#pragma unroll
            for (int o = 1; o < 64; o <<= 1) { const float u = __shfl_up(cs, o); if (lane >= o) cs += u; }
            const float c63 = __shfl(cs, 63);
            const float wsc = __expf(c63 - cs);
            if (w4 == 0) { CUM[lane] = cs; ECUM[lane] = __expf(cs); }
            float xw[16];
#pragma unroll
            for (int i = 0; i < 16; ++i) { const int t = 16 * w4 + i;
                const float xs = siluf_(wx[0] * RAWF(rx, i) + wx[1] * RAWF(rx, i + 1) + wx[2] * RAWF(rx, i + 2) + wx[3] * RAWF(rx, i + 3) + bx);
                XR[t * LS + lane] = (bf16)f2bf(xs); tv[i] = xs * __shfl(dt, t); xw[i] = tv[i] * __shfl(wsc, t); }
            ssd_pack16(XVT + lane * LS + 16 * w4, tv);
            ssd_pack16(XVWT + lane * LS + 16 * w4, xw);
#pragma unroll
            for (int a = 0; a < 2; ++a)
#pragma unroll
                for (int nv = 0; nv < 4; ++nv) st4(ZT, LS2, 16 * nv + r, 16 * (2 * w4 + a) + 4 * q, zs[a][nv]);
        }
        WG_BAR();
        if (ch + 1 < SEQ / 64) load_raw(ch + 1);
        f32x4 yv[4];
        {
            const int m = w4;
            f32x4 Pt[4];
#pragma unroll
            for (int n = 0; n < 4; ++n) Pt[n] = zero4();
            bf16x8 ac[4];
#pragma unroll
            for (int k = 0; k < 4; ++k) ac[k] = ld_frag(CM, LS2, 16 * m + r, 32 * k, q);
            const float cumt = CUM[16 * m + r];
#pragma unroll
            for (int n = 0; n < 4; ++n) if (n <= m) {
#pragma unroll
                for (int k = 0; k < 4; ++k) Pt[n] = MFMA16(ld_frag(BM, LS2, 16 * n + r, 32 * k, q), ac[k], Pt[n]);
                const f32x4 cs = *(const LAS f32x4*)(CUM + 16 * n + 4 * q);
#pragma unroll
                for (int i = 0; i < 4; ++i) { const bool keep = (n < m) || (4 * q + i <= r); Pt[n][i] = keep ? Pt[n][i] * __expf(cumt - cs[i]) : 0.f; }
            }
            f32x4 O[4];
            const float ect = ECUM[16 * m + r];
#pragma unroll
            for (int nv = 0; nv < 4; ++nv) O[nv] = zero4();
#pragma unroll
            for (int k = 0; k < 4; ++k)
#pragma unroll
                for (int nv = 0; nv < 4; ++nv) O[nv] = MFMA16(ld_frag(ZT, LS2, 16 * nv + r, 32 * k, q), ac[k], O[nv]);
#pragma unroll
            for (int nv = 0; nv < 4; ++nv) O[nv] = O[nv] * ect;
#pragma unroll
            for (int k = 0; k < 2; ++k) if (2 * k <= m) { const bf16x8 pf = pack_frag(Pt[2 * k], Pt[2 * k + 1]);
#pragma unroll
                for (int nv = 0; nv < 4; ++nv) O[nv] = MFMA16(ld_frag_perm(XVT, LS, 16 * nv + r, 32 * k, q), pf, O[nv]); }
            const int t = ch * 64 + 16 * m + r;
            float ss = 0.f;
#pragma unroll
            for (int nv = 0; nv < 4; ++nv) { const int p0 = 16 * nv + 4 * q;
                const v2u xr = *(const LAS v2u*)(XR + (16 * m + r) * LS + p0);
                const v2u zr = *(const v2u*)(P + (size_t)t * NP + C_Z + 512 + h * 64 + p0);
                const float x0 = __builtin_bit_cast(float, xr.x << 16), x1 = __builtin_bit_cast(float, xr.x & 0xffff0000u), x2 = __builtin_bit_cast(float, xr.y << 16), x3 = __builtin_bit_cast(float, xr.y & 0xffff0000u);
                const float z0 = __builtin_bit_cast(float, zr.x << 16), z1 = __builtin_bit_cast(float, zr.x & 0xffff0000u), z2 = __builtin_bit_cast(float, zr.y << 16), z3 = __builtin_bit_cast(float, zr.y & 0xffff0000u);
                yv[nv][0] = (O[nv][0] + x0 * dsk) * siluf_(z0); yv[nv][1] = (O[nv][1] + x1 * dsk) * siluf_(z1);
                yv[nv][2] = (O[nv][2] + x2 * dsk) * siluf_(z2); yv[nv][3] = (O[nv][3] + x3 * dsk) * siluf_(z3);
                ss += (yv[nv][0] * yv[nv][0] + yv[nv][1] * yv[nv][1]) + (yv[nv][2] * yv[nv][2] + yv[nv][3] * yv[nv][3]); }
            ss += __shfl_xor(ss, 16); ss += __shfl_xor(ss, 32);
            if (q == 0) SS[hh * 64 + 16 * m + r] = ss;
            const float el = ECUM[63];
#pragma unroll
            for (int a = 0; a < 2; ++a) { bf16x8 ab[2];
#pragma unroll
                for (int k = 0; k < 2; ++k) ab[k] = ld_frag(BT, LS, 16 * (2 * w4 + a) + r, 32 * k, q);
#pragma unroll
                for (int nv = 0; nv < 4; ++nv) { zs[a][nv] = zs[a][nv] * el;
#pragma unroll
                    for (int k = 0; k < 2; ++k) zs[a][nv] = MFMA16(ab[k], ld_frag(XVWT, LS, 16 * nv + r, 32 * k, q), zs[a][nv]); } }
        }
        WG_BAR();
        {
            const int m = w4, t = ch * 64 + 16 * m + r;
            const float tot = SS[16 * m + r] + SS[64 + 16 * m + r];
            const float rs = rsqrtf(tot * (1.f / 128.f) + 1e-6f);
#pragma unroll
            for (int nv = 0; nv < 4; ++nv) { const f32x4 gg = *(const f32x4*)(gnp + 16 * nv); v2u o; o.x = pk_bf16(yv[nv][0] * rs * gg[0], yv[nv][1] * rs * gg[1]); o.y = pk_bf16(yv[nv][2] * rs * gg[2], yv[nv][3] * rs * gg[3]);
                *(v2u*)(Yb + (size_t)t * DM + 512 + h * 64 + 16 * nv + 4 * q) = o; }
        }
    }
}

__device__ __forceinline__ void rwkv_pre_block(const Inputs& in, const int layer, const bf16* __restrict__ PROJ, float* __restrict__ CUMo, float* __restrict__ CUMPo, float* __restrict__ AV, LAS float* lds, const int m0, const int tid) {
    LAS float* SW = lds; LAS float* SA = lds + 4096; LAS float* HT = lds + 8192;
    const float* mu = in.rwkv_mu + (size_t)layer * 896;
    { const int j = tid & 63, tg = tid >> 6; const float muw = mu[768 + j], mua = mu[832 + j];
#pragma unroll
      for (int tt = 0; tt < 8; ++tt) { const int t = tg * 8 + tt, m = m0 + t; const bool first = ((m & (SEQ - 1)) == 0);
          const float xw = bf2f(PROJ[(size_t)m * NP + C_RW_WD + j]), xa = bf2f(PROJ[(size_t)m * NP + C_RW_AD + j]);
          const float pw = first ? 0.f : bf2f(PROJ[(size_t)(m - 1) * NP + C_RW_WD + j]), pa = first ? 0.f : bf2f(PROJ[(size_t)(m - 1) * NP + C_RW_AD + j]);
          SW[t * 64 + j] = tanhf(xw + (pw - xw) * muw); SA[t * 64 + j] = xa + (pa - xa) * mua; } }
    __syncthreads();
    { const int c = tid & 255, th = tid >> 8;
      float run = 0.f;
      { const float* wup = in.rwkv_w_up + (size_t)layer * 64 * GW + c;
        float wu[64];
#pragma unroll
        for (int j = 0; j < 64; ++j) wu[j] = wup[j * GW];
        const float w0 = in.rwkv_w0[layer * GW + c];
        for (int tt = 0; tt < 32; ++tt) { const int t = th * 32 + tt; float wl = w0;
#pragma unroll
            for (int j4 = 0; j4 < 16; ++j4) { const f32x4 sw = *(const LAS f32x4*)(SW + t * 64 + 4 * j4);
#pragma unroll
                for (int e = 0; e < 4; ++e) wl += sw[e] * wu[4 * j4 + e]; }
            const float w = -softplusf_(-wl) - 0.5f;
            const float lw = -__expf(w); run += lw;
            CUMo[(size_t)(m0 + t) * GW + c] = lw; } }
      asm volatile("" ::: "memory");
      { const float* aup = in.rwkv_a_up + (size_t)layer * 64 * GW + c;
        float au[64];
#pragma unroll
        for (int j = 0; j < 64; ++j) au[j] = aup[j * GW];
        const float a0 = in.rwkv_a0[layer * GW + c];
        for (int tt = 0; tt < 32; ++tt) { const int t = th * 32 + tt; float al = a0;
#pragma unroll
            for (int j4 = 0; j4 < 16; ++j4) { const f32x4 sa = *(const LAS f32x4*)(SA + t * 64 + 4 * j4);
#pragma unroll
                for (int e = 0; e < 4; ++e) al += sa[e] * au[4 * j4 + e]; }
            AV[(size_t)(m0 + t) * GW + c] = sigmoidf_(al); } }
      if (th == 0) HT[c] = run;
      __syncthreads();
      float acc = (th == 1) ? HT[c] : 0.f;
      for (int tt = 0; tt < 32; ++tt) { const int t = th * 32 + tt; const float lw = CUMo[(size_t)(m0 + t) * GW + c]; CUMPo[(size_t)(m0 + t) * GW + c] = acc; acc += lw; CUMo[(size_t)(m0 + t) * GW + c] = acc; } }
    __syncthreads();
}

__device__ __forceinline__ void mixopt_rwkv(const Inputs& in, const int layer, const bf16* __restrict__ PROJ, const float* __restrict__ CUMg, const float* __restrict__ CUMPg, const float* __restrict__ AV, bf16* __restrict__ Yg,
                                            LAS unsigned char* L, const int b, const int h, const int tid) {
    const int lane0 = tid & 63, wave = __builtin_amdgcn_readfirstlane(tid >> 6), w4 = wave & 3;
    const bool act = wave < 4;
    LAS bf16* AT = (LAS bf16*)L; LAS bf16* RT = (LAS bf16*)(L + 9216); LAS bf16* BL = (LAS bf16*)(L + 18432); LAS bf16* KL = (LAS bf16*)(L + 27648);
    LAS bf16* BTT = (LAS bf16*)(L + 36864); LAS bf16* KTT = (LAS bf16*)(L + 46080); LAS bf16* VT = (LAS bf16*)(L + 55296); LAS bf16* ZT = (LAS bf16*)(L + 64512);
    LAS bf16* AMT = (LAS bf16*)(L + 73728); LAS bf16* RHST = (LAS bf16*)(L + 82944); LAS float* AD = (LAS float*)(L + 92160); LAS bf16* DT = (LAS bf16*)(L + 96256);
    LAS float* QTOT = (LAS float*)(L + 98304); LAS float* ELAST = (LAS float*)(L + 99328); LAS float* BON = (LAS float*)(L + 99584);
    LAS bf16* SAT = AT;
    const bf16* P = PROJ + (size_t)b * SEQ * NP; bf16* Yb = Yg + (size_t)b * SEQ * DM;
    const float* CUMb = CUMg + (size_t)b * SEQ * GW; const float* CUMPb = CUMPg + (size_t)b * SEQ * GW; const float* AVb = AV + (size_t)b * SEQ * GW;
    const int c0 = h * 64 + lane0;
    const float* mu = in.rwkv_mu + (size_t)layer * 896;
    const float mu_r = mu[c0], mu_k = mu[256 + c0], mu_v = mu[512 + c0];
    const float kkc = in.rwkv_k_k[layer * GW + c0], kac = in.rwkv_k_a[layer * GW + c0], rkc = in.rwkv_r_k[layer * GW + c0];
    f32x4 zs[4];
#pragma unroll
    for (int n = 0; n < 4; ++n) zs[n] = zero4();
    typedef unsigned short us2 __attribute__((ext_vector_type(2)));
    us2 rr[9], rk[9], rv[9]; float cmv[17], avv[16];
    auto load_raw = [&](int ch, int lane) {
        const int c = h * 64 + lane;
        const int tb = ch * 64 + 16 * w4 - 1;
#pragma unroll
        for (int j = 0; j < 18; ++j) { const int t = tb + j; const bool ok = (t >= 0) && (j < 17); const bf16* p0 = P + (size_t)(ok ? t : 0) * NP;
            const bf16 a = p0[C_RW_R + c], bb = p0[C_RW_K + c], cc = p0[C_RW_V + c];
            rr[j >> 1][j & 1] = ok ? a : (bf16)0; rk[j >> 1][j & 1] = ok ? bb : (bf16)0; rv[j >> 1][j & 1] = ok ? cc : (bf16)0; }
    };
    auto load_raw2 = [&](int ch, int lane) {
        const int c = h * 64 + lane;
        const int tb = ch * 64 + 16 * w4 - 1;
#pragma unroll
        for (int j = 0; j < 17; ++j) { const int t = tb + j; cmv[j] = CUMb[(size_t)(t >= 0 ? t : 0) * GW + c]; }
#pragma unroll
        for (int i = 0; i < 16; ++i) avv[i] = AVb[(size_t)(tb + 1 + i) * GW + c];
    };
    if (act) { load_raw(0, lane0); load_raw2(0, lane0); }
    for (int ch = 0; ch < SEQ / 64; ++ch) {
        if (act) { const int lane = opaque_i(lane0), r = lane & 15, q = lane >> 4;
            float rs[16], k2[16], kkv[16], tv[16];
#pragma unroll
            for (int i = 0; i < 16; ++i) { const float xr = RAWF(rr, i + 1), xk = RAWF(rk, i + 1), xv = RAWF(rv, i + 1);
                rs[i] = xr + (RAWF(rr, i) - xr) * mu_r; const float ks = xk + (RAWF(rk, i) - xk) * mu_k; tv[i] = xv + (RAWF(rv, i) - xv) * mu_v;
                kkv[i] = ks * kkc; k2[i] = ks * (1.f + (avv[i] - 1.f) * kac); }
            ssd_pack16(VT + lane * LS + 16 * w4, tv);
            { float sq[16];
#pragma unroll
              for (int i = 0; i < 16; ++i) sq[i] = kkv[i] * kkv[i];
              const float sred = tr_reduce16(sq, lane);
#pragma unroll
              for (int i = 0; i < 16; ++i) kkv[i] *= rsqrtf(rdlane(sred, 4 * i) + 1e-6f);
#pragma unroll
              for (int i = 0; i < 16; ++i) sq[i] = rs[i] * k2[i] * rkc;
              const float bred = tr_reduce16(sq, lane);
              if ((lane & 3) == 0) BON[16 * w4 + (lane >> 2)] = bred; }
#pragma unroll
            for (int i = 0; i < 16; ++i) { const float cum = cmv[i + 1]; const int t = 16 * w4 + i;
                const float en = __expf(-cum); const float cump = (i == 0 && w4 == 0) ? 0.f : cmv[i];
                AT[t * LS + lane] = (bf16)f2bf(-kkv[i] * __expf(cump));
                RT[t * LS + lane] = (bf16)f2bf(rs[i] * __expf(cum));
                kkv[i] = kkv[i] * avv[i] * en; k2[i] = k2[i] * en;
                BL[t * LS + lane] = (bf16)f2bf(kkv[i]); KL[t * LS + lane] = (bf16)f2bf(k2[i]); }
            ssd_pack16(BTT + lane * LS + 16 * w4, kkv);
            ssd_pack16(KTT + lane * LS + 16 * w4, k2);
            if (w4 == 3) ELAST[lane] = __expf(cmv[16]);
#pragma unroll
            for (int n = 0; n < 4; ++n) st4(ZT, LS, 16 * n + r, 16 * w4 + 4 * q, zs[n]);
        }
        WG_BAR();
        if (act && ch + 1 < SEQ / 64) load_raw(ch + 1, opaque_i(lane0));
        const int m = w4;
        if (act) { const int lane = opaque_i(lane0), r = lane & 15, q = lane >> 4;
            f32x4 Aak[4];
            bf16x8 aa[2];
#pragma unroll
            for (int k = 0; k < 2; ++k) aa[k] = ld_frag(AT, LS, 16 * m + r, 32 * k, q);
#pragma unroll
            for (int n = 0; n < 4; ++n) { Aak[n] = zero4(); if (n <= m) {
                f32x4 ab = zero4();
#pragma unroll
                for (int k = 0; k < 2; ++k) { const bf16x8 fb = ld_frag(BL, LS, 16 * n + r, 32 * k, q), fk = ld_frag(KL, LS, 16 * n + r, 32 * k, q);
                    ab = MFMA16(aa[k], fb, ab);
                    Aak[n] = MFMA16(fk, aa[k], Aak[n]); }
                f32x4 av;
#pragma unroll
                for (int i = 0; i < 4; ++i) { const bool keep = (n < m) || (r < 4 * q + i); av[i] = keep ? -ab[i] : 0.f; }
                st4(AMT, LS, 16 * n + r, 16 * m + 4 * q, av);
                if (n == m) {
#pragma unroll
                    for (int i = 0; i < 4; ++i) AD[m * 256 + (4 * q + i) * 16 + r] = av[i];
#pragma unroll
                    for (int i = 0; i < 4; ++i) { const bool strict = (4 * q + i < r); Aak[n][i] = strict ? Aak[n][i] : 0.f; } }
            } }
            const bf16x8 p0 = pack_frag(Aak[0], Aak[1]), p1 = pack_frag(Aak[2], Aak[3]);
#pragma unroll
            for (int nv = 0; nv < 4; ++nv) { f32x4 rh = zero4();
#pragma unroll
                for (int k = 0; k < 2; ++k) rh = MFMA16(aa[k], ld_frag(ZT, LS, 16 * nv + r, 32 * k, q), rh);
                rh = MFMA16(p0, ld_frag_perm(VT, LS, 16 * nv + r, 0, q), rh);
                if (m >= 2) rh = MFMA16(p1, ld_frag_perm(VT, LS, 16 * nv + r, 32, q), rh);
                st4(RHST, LS, 16 * nv + r, 16 * m + 4 * q, rh); }
        }
        WG_BAR();
        if (act) { const int lane = opaque_i(lane0), r = lane & 15, q = lane >> 4;
            if (ch + 1 < SEQ / 64) load_raw2(ch + 1, lane);
            diag_inverse(AD, DT, lane);
            asm volatile("s_waitcnt lgkmcnt(0)" ::: "memory");
            f32x4 Tm[4];
            tri_inverse_row(AMT, DT, m, r, q, Tm);
            const bf16x8 t0 = pack_frag(Tm[0], Tm[1]), t1 = pack_frag(Tm[2], Tm[3]);
#pragma unroll
            for (int nv = 0; nv < 4; ++nv) { f32x4 sa = zero4();
                sa = MFMA16(t0, ld_frag_perm(RHST, LS, 16 * nv + r, 0, q), sa);
                if (m >= 2) sa = MFMA16(t1, ld_frag_perm(RHST, LS, 16 * nv + r, 32, q), sa);
                st4(SAT, LS, 16 * nv + r, 16 * m + 4 * q, sa); }
        }
        WG_BAR();
        if (act) { const int lane = opaque_i(lane0), r = lane & 15, q = lane >> 4;
            f32x4 O[4];
            bf16x8 ar[2];
#pragma unroll
            for (int k = 0; k < 2; ++k) ar[k] = ld_frag(RT, LS, 16 * m + r, 32 * k, q);
            f32x4 Arb[4], Ark[4];
#pragma unroll
            for (int n = 0; n < 4; ++n) { Arb[n] = zero4(); Ark[n] = zero4(); if (n <= m) {
#pragma unroll
                for (int k = 0; k < 2; ++k) { Arb[n] = MFMA16(ld_frag(BL, LS, 16 * n + r, 32 * k, q), ar[k], Arb[n]); Ark[n] = MFMA16(ld_frag(KL, LS, 16 * n + r, 32 * k, q), ar[k], Ark[n]); }
                if (n == m) {
#pragma unroll
                    for (int i = 0; i < 4; ++i) { const bool incl = (4 * q + i <= r); Arb[n][i] = incl ? Arb[n][i] : 0.f; Ark[n][i] = incl ? Ark[n][i] : 0.f; } } } }
            const bf16x8 b0 = pack_frag(Arb[0], Arb[1]), b1 = pack_frag(Arb[2], Arb[3]), k0 = pack_frag(Ark[0], Ark[1]), k1 = pack_frag(Ark[2], Ark[3]);
            float s1 = 0.f;
#pragma unroll
            for (int nv = 0; nv < 4; ++nv) { O[nv] = zero4();
#pragma unroll
                for (int k = 0; k < 2; ++k) O[nv] = MFMA16(ld_frag(ZT, LS, 16 * nv + r, 32 * k, q), ar[k], O[nv]);
                O[nv] = MFMA16(ld_frag_perm(SAT, LS, 16 * nv + r, 0, q), b0, O[nv]);
                O[nv] = MFMA16(ld_frag_perm(VT, LS, 16 * nv + r, 0, q), k0, O[nv]);
                if (m >= 2) { O[nv] = MFMA16(ld_frag_perm(SAT, LS, 16 * nv + r, 32, q), b1, O[nv]); O[nv] = MFMA16(ld_frag_perm(VT, LS, 16 * nv + r, 32, q), k1, O[nv]); }
                s1 += (O[nv][0] + O[nv][1]) + (O[nv][2] + O[nv][3]); }
            s1 += __shfl_xor(s1, 16); s1 += __shfl_xor(s1, 32);
            const float mean = s1 * (1.f / 64.f); float s2 = 0.f;
#pragma unroll
            for (int nv = 0; nv < 4; ++nv) { O[nv] = O[nv] - mean; s2 += (O[nv][0] * O[nv][0] + O[nv][1] * O[nv][1]) + (O[nv][2] * O[nv][2] + O[nv][3] * O[nv][3]); }
            s2 += __shfl_xor(s2, 16); s2 += __shfl_xor(s2, 32);
            const float rstd = rsqrtf(s2 * (1.f / 64.f) + 64e-5f);
            const int t = ch * 64 + 16 * m + r; const float bon = BON[16 * m + r];
#pragma unroll
            for (int nv = 0; nv < 4; ++nv) { const int dv0 = 16 * nv + 4 * q, cc = h * 64 + dv0;
                const f32x4 lw4 = *(const f32x4*)(in.rwkv_ln_w + layer * GW + cc); const f32x4 lb4 = *(const f32x4*)(in.rwkv_ln_b + layer * GW + cc);
                const v2u zr = *(const v2u*)(P + (size_t)t * NP + C_Z + 768 + cc);
                const float z0 = __builtin_bit_cast(float, zr.x << 16), z1 = __builtin_bit_cast(float, zr.x & 0xffff0000u), z2 = __builtin_bit_cast(float, zr.y << 16), z3 = __builtin_bit_cast(float, zr.y & 0xffff0000u);
                const float v0 = bf2f(VT[(dv0 + 0) * LS + 16 * m + r]), v1 = bf2f(VT[(dv0 + 1) * LS + 16 * m + r]), v2 = bf2f(VT[(dv0 + 2) * LS + 16 * m + r]), v3 = bf2f(VT[(dv0 + 3) * LS + 16 * m + r]);
                v2u o; o.x = pk_bf16((O[nv][0] * rstd * lw4[0] + lb4[0] + bon * v0) * siluf_(z0), (O[nv][1] * rstd * lw4[1] + lb4[1] + bon * v1) * siluf_(z1));
                o.y = pk_bf16((O[nv][2] * rstd * lw4[2] + lb4[2] + bon * v2) * siluf_(z2), (O[nv][3] * rstd * lw4[3] + lb4[3] + bon * v3) * siluf_(z3));
                *(v2u*)(Yb + (size_t)t * DM + 768 + cc) = o; }
            const f32x4 el = *(const LAS f32x4*)(ELAST + 16 * w4 + 4 * q);
            bf16x8 ab2[2], ak2[2];
#pragma unroll
            for (int k = 0; k < 2; ++k) { ab2[k] = ld_frag(BTT, LS, 16 * w4 + r, 32 * k, q); ak2[k] = ld_frag(KTT, LS, 16 * w4 + r, 32 * k, q); }
#pragma unroll
            for (int n = 0; n < 4; ++n) {
#pragma unroll
                for (int k = 0; k < 2; ++k) { zs[n] = MFMA16(ab2[k], ld_frag(SAT, LS, 16 * n + r, 32 * k, q), zs[n]); zs[n] = MFMA16(ak2[k], ld_frag(VT, LS, 16 * n + r, 32 * k, q), zs[n]); }
                zs[n] = zs[n] * el; }
        }
        WG_BAR();
    }
}

#ifndef MK_MASK
#define MK_MASK 31
#endif

constexpr int NWAVES = 8;
constexpr size_t MiB = 1u << 20;
constexpr size_t WS_CTL = 0, CTL_ZERO_BYTES = 64 * 1024;
constexpr size_t WS_WIN = 1 * MiB;
constexpr size_t WS_WOUT = 18 * MiB;
constexpr size_t WS_U = 22 * MiB;
constexpr size_t WS_PROJ = 54 * MiB;
constexpr size_t WS_OUT = 190 * MiB;
constexpr int CW_BAR = 4096;
constexpr int LDSCTL_OFF = 147456, MISC_OFF = LDSCTL_OFF + 320, LDS_BYTES = 148480;

struct Args { Inputs in; float* out; unsigned char* ws; };
__device__ __forceinline__ int opaque_v(int v) { asm volatile("" : "+v"(v)); return v; }

__device__ __forceinline__ void wprep_load(const float* __restrict__ W, int N, int use_perm, int n0, int k0, int tid, LAS float* tile) {
    const int nn = tid & 31, kq = tid >> 5;
    const int oc = use_perm ? old_col(n0 + nn) : (n0 + nn);
#pragma unroll
    for (int i = 0; i < 8; ++i) { const int kk = kq + 8 * i; tile[kk * 33 + nn] = (oc >= 0) ? W[(size_t)(k0 + kk) * N + oc] : 0.f; }
}
__device__ __forceinline__ void wprep_store(bf16* __restrict__ WT, int K, int n0, int k0, int tid, const LAS float* tile) {
    const int n = tid >> 3, kc = (tid & 7) * 8;
    uint4 o;
    o.x = f2bf(tile[(kc + 0) * 33 + n]) | (f2bf(tile[(kc + 1) * 33 + n]) << 16);
    o.y = f2bf(tile[(kc + 2) * 33 + n]) | (f2bf(tile[(kc + 3) * 33 + n]) << 16);
    o.z = f2bf(tile[(kc + 4) * 33 + n]) | (f2bf(tile[(kc + 5) * 33 + n]) << 16);
    o.w = f2bf(tile[(kc + 6) * 33 + n]) | (f2bf(tile[(kc + 7) * 33 + n]) << 16);
    *(uint4*)(WT + (size_t)(n0 + n) * K + k0 + kc) = o;
}

__device__ __forceinline__ void rmsnorm_row_bf16(const float* __restrict__ hrow, const float* __restrict__ g, bf16* __restrict__ urow, int lane) {
    const float4* xr = (const float4*)hrow + lane; const float4* gr = (const float4*)g + lane;
    float4 v[4]; float s = 0.f;
#pragma unroll
    for (int j = 0; j < 4; ++j) { v[j] = xr[64 * j]; s += (v[j].x * v[j].x + v[j].y * v[j].y) + (v[j].z * v[j].z + v[j].w * v[j].w); }
    const float r = rsqrtf(wave_sum(s) * (1.f / DM) + 1e-6f);
    uint2* o8 = (uint2*)urow + lane;
#pragma unroll
    for (int j = 0; j < 4; ++j) { const float4 gg = gr[64 * j]; uint2 o;
        o.x = f2bf(v[j].x * r * gg.x) | (f2bf(v[j].y * r * gg.y) << 16); o.y = f2bf(v[j].z * r * gg.z) | (f2bf(v[j].w * r * gg.w) << 16); o8[64 * j] = o; }
}

__device__ __forceinline__ void post_row(const float* hrow, const float* __restrict__ orow_, const float* __restrict__ g, float* hnew, const float* __restrict__ g2, bf16* __restrict__ urow, int lane) {
    const float4* orow = (const float4*)orow_ + lane; const float4* hr = (const float4*)hrow + lane; const float4* gr = (const float4*)g + lane;
    float4 v[4]; float s = 0.f;
#pragma unroll
    for (int j = 0; j < 4; ++j) { v[j] = orow[64 * j]; s += (v[j].x * v[j].x + v[j].y * v[j].y) + (v[j].z * v[j].z + v[j].w * v[j].w); }
    const float r = rsqrtf(wave_sum(s) * (1.f / DM) + 1e-6f);
    float4* o = (float4*)hnew + lane; float s2 = 0.f;
#pragma unroll
    for (int j = 0; j < 4; ++j) { const float4 gg = gr[64 * j]; const float4 hh = hr[64 * j]; float4 w;
        w.x = hh.x + v[j].x * r * gg.x; w.y = hh.y + v[j].y * r * gg.y; w.z = hh.z + v[j].z * r * gg.z; w.w = hh.w + v[j].w * r * gg.w; o[64 * j] = w; v[j] = w;
        s2 += (w.x * w.x + w.y * w.y) + (w.z * w.z + w.w * w.w); }
    if (g2) {
        const float r2 = rsqrtf(wave_sum(s2) * (1.f / DM) + 1e-6f);
        const float4* g2r = (const float4*)g2 + lane; uint2* o8 = (uint2*)urow + lane;
#pragma unroll
        for (int j = 0; j < 4; ++j) { const float4 gg = g2r[64 * j]; uint2 q;
            q.x = f2bf(v[j].x * r2 * gg.x) | (f2bf(v[j].y * r2 * gg.y) << 16); q.y = f2bf(v[j].z * r2 * gg.z) | (f2bf(v[j].w * r2 * gg.w) << 16); o8[64 * j] = q; }
    }
}

#define CAS __attribute__((address_space(4)))
#define PHASE_LOCALS() \
    const CAS Args* ap = (const CAS Args*)__builtin_amdgcn_kernarg_segment_ptr(); asm volatile("" : "+s"(ap)); \
    Inputs in; in.x = ap->in.x; in.pre_norm_g = ap->in.pre_norm_g; in.w_in = ap->in.w_in; in.hgrn_lb = ap->in.hgrn_lb; in.hgrn_norm_g = ap->in.hgrn_norm_g; in.gdn_conv_w = ap->in.gdn_conv_w; in.gdn_a_log = ap->in.gdn_a_log; in.gdn_dt_bias = ap->in.gdn_dt_bias; in.gdn_norm_g = ap->in.gdn_norm_g; in.ssm_conv_w = ap->in.ssm_conv_w; in.ssm_conv_b = ap->in.ssm_conv_b; in.ssm_a_log = ap->in.ssm_a_log; in.ssm_dt_bias = ap->in.ssm_dt_bias; in.ssm_d = ap->in.ssm_d; in.ssm_norm_g = ap->in.ssm_norm_g; in.rwkv_mu = ap->in.rwkv_mu; in.rwkv_w0 = ap->in.rwkv_w0; in.rwkv_w_up = ap->in.rwkv_w_up; in.rwkv_a0 = ap->in.rwkv_a0; in.rwkv_a_up = ap->in.rwkv_a_up; in.rwkv_k_k = ap->in.rwkv_k_k; in.rwkv_k_a = ap->in.rwkv_k_a; in.rwkv_r_k = ap->in.rwkv_r_k; in.rwkv_ln_w = ap->in.rwkv_ln_w; in.rwkv_ln_b = ap->in.rwkv_ln_b; in.w_out = ap->in.w_out; in.post_norm_g = ap->in.post_norm_g; \
    unsigned char* ws = ap->ws; float* hout = ap->out; \
    int bx = blockIdx.x; asm volatile("" : "+s"(bx)); int G = gridDim.x; asm volatile("" : "+s"(G)); \
    const int lane = fresh_lane(); int wave = wave_k; asm volatile("" : "+s"(wave)); const int tid = (wave << 6) | lane; \
    bf16* Win = (bf16*)(ws + WS_WIN); bf16* Wout = (bf16*)(ws + WS_WOUT); bf16* U = (bf16*)(ws + WS_U); bf16* PROJ = (bf16*)(ws + WS_PROJ); float* OUT = (float*)(ws + WS_OUT); \
    (void)Win; (void)Wout; (void)U; (void)PROJ; (void)OUT; (void)hout; (void)bx; (void)G; (void)lane; (void)wave;

__global__ void __launch_bounds__(NWAVES * 64, 2) mk_fwd(Args args) {
    extern __shared__ __attribute__((aligned(16))) unsigned char lds_raw[];
    LAS unsigned char* lds = (LAS unsigned char*)lds_raw;
    volatile LAS unsigned* MISC = (volatile LAS unsigned*)(lds + MISC_OFF);
    const int wave_k = __builtin_amdgcn_readfirstlane((int)threadIdx.x >> 6);
    for (int u = threadIdx.x; u < (LDS_BYTES - LDSCTL_OFF) / 4; u += NWAVES * 64) ((LAS unsigned*)(lds + LDSCTL_OFF))[u] = 0u;
    __syncthreads();
    XcdBarrier bar = xcd_barrier_post((unsigned*)((gu32*)(args.ws + WS_CTL) + CW_BAR), MISC + 8, (int)threadIdx.x);

    {
        PHASE_LOCALS();
        const int half = tid >> 8, t256 = tid & 255;
        LAS float* tile = (LAS float*)(lds + half * 16384);
        constexpr int IT_IN = (NP / 32) * (DM / 64), IT_OUT = (DM / 32) * (DM / 64), IT_ALL = NLAYER * (IT_IN + IT_OUT);
        for (int it0 = bx * 2; it0 < IT_ALL; it0 += G * 2) {
            const int it = it0 + half; const bool act = it < IT_ALL;
            const float* W = nullptr; bf16* WT = nullptr; int N = 0, perm = 0, n0 = 0, k0 = 0;
            if (act) { int r = it; const int l = r / (IT_IN + IT_OUT); r -= l * (IT_IN + IT_OUT);
                if (r < IT_IN) { W = in.w_in + (size_t)l * DM * IN_COLS; N = IN_COLS; perm = 1; WT = Win + (size_t)l * NP * DM; n0 = (r % (NP / 32)) * 32; k0 = (r / (NP / 32)) * 64; }
                else { r -= IT_IN; W = in.w_out + (size_t)l * DM * DM; N = DM; perm = 0; WT = Wout + (size_t)l * DM * DM; n0 = (r % (DM / 32)) * 32; k0 = (r / (DM / 32)) * 64; }
                wprep_load(W, N, perm, n0, k0, t256, tile); }
            __syncthreads();
            if (act) wprep_store(WT, DM, n0, k0, t256, tile);
            __syncthreads();
        }
        for (int m = bx * NWAVES + wave; m < MTOK; m += G * NWAVES) rmsnorm_row_bf16(in.x + (size_t)m * DM, in.pre_norm_g, U + (size_t)m * DM, lane);
    }
    { int wv_ = wave_k; asm volatile("" : "+s"(wv_)); xcd_barrier(bar, (wv_ << 6) | fresh_lane()); }

#pragma unroll
    for (int l = 0; l < NLAYER; ++l) {
        { PHASE_LOCALS();
          pg8::Gemm g; g.A = U; g.Bt = Win + (size_t)l * NP * DM; g.M = MTOK; g.N = NP; g.K = DM;
          pg8::StaticOrder S; S.init(MTOK, NP, G, bx); S.wave_id = wave;
          pg8::EpiBf16<0> E; E.O = PROJ; E.ldc = NP; E.bias = nullptr; E.split_cols = 0; E.split_stride = 0;
          pg8::gemm_phase<pg8::EpiBf16<0>, pg8::StaticOrder, false>(lds, g, S, E, nullptr); }
        { int wv_ = wave_k; asm volatile("" : "+s"(wv_)); xcd_barrier(bar, (wv_ << 6) | fresh_lane()); }
        { PHASE_LOCALS();
          float* CUMW = OUT; float* CUMPW = OUT + (size_t)MTOK * GW; float* AVW = OUT + (size_t)2 * MTOK * GW;
          if (MK_MASK & 16) for (int blk = bx; blk < MTOK / 64; blk += G) { const int tid_l = opaque_v(tid); rwkv_pre_block(in, l, PROJ, CUMW, CUMPW, AVW, (LAS float*)lds, blk * 64, tid_l); } }
        { int wv_ = wave_k; asm volatile("" : "+s"(wv_)); xcd_barrier(bar, (wv_ << 6) | fresh_lane()); }
        { PHASE_LOCALS();
          const float* CUMW = OUT; const float* CUMPW = OUT + (size_t)MTOK * GW; const float* AVW = OUT + (size_t)2 * MTOK * GW;
          if (bx < 16) { if (MK_MASK & 1) mixopt_hgrn(in, l, PROJ, U, lds, (bx >> 1) & 7, bx & 1, (wave << 6) | fresh_lane()); }
          else if (bx < 32) { if (MK_MASK & 2) mixopt_gdn(in, l, PROJ, U, lds, (bx >> 1) & 7, bx & 1, (wave << 6) | fresh_lane()); }
          else if (bx < 48) { if (MK_MASK & 4) mixopt_ssd(in, l, PROJ, U, lds, (bx >> 1) & 7, bx & 1, (wave << 6) | fresh_lane()); }
          else if (bx < 80) { if (MK_MASK & 8) mixopt_rwkv(in, l, PROJ, CUMW, CUMPW, AVW, U, lds, (bx - 48) >> 2, (bx - 48) & 3, (wave << 6) | fresh_lane()); } }
        { int wv_ = wave_k; asm volatile("" : "+s"(wv_)); xcd_barrier(bar, (wv_ << 6) | fresh_lane()); }
        { PHASE_LOCALS();
          pg8::Gemm g; g.A = U; g.Bt = Wout + (size_t)l * DM * DM; g.M = MTOK; g.N = DM; g.K = DM;
          pg8::StaticOrder S; S.init(MTOK, DM, G, bx); S.wave_id = wave;
          pg8::EpiF32 E; E.C = OUT; E.ldc = DM; E.bias = nullptr;
          pg8::gemm_phase<pg8::EpiF32, pg8::StaticOrder, false>(lds, g, S, E, nullptr); }
        { int wv_ = wave_k; asm volatile("" : "+s"(wv_)); xcd_barrier(bar, (wv_ << 6) | fresh_lane()); }
        { PHASE_LOCALS();
          const float* hin = (l == 0) ? in.x : hout;
          for (int m = bx * NWAVES + wave; m < MTOK; m += G * NWAVES)
            post_row(hin + (size_t)m * DM, OUT + (size_t)m * DM, in.post_norm_g + (size_t)l * DM, hout + (size_t)m * DM,
                     (l + 1 < NLAYER) ? in.pre_norm_g + (size_t)(l + 1) * DM : nullptr, U + (size_t)m * DM, lane); }
        if (l + 1 < NLAYER) { int wv_ = wave_k; asm volatile("" : "+s"(wv_)); xcd_barrier(bar, (wv_ << 6) | fresh_lane()); }
    }
}

extern "C" void kernel_launch(void* const* d_in, const int* in_sizes, int n_in, void* d_out, int out_size, void* d_ws, size_t ws_size, hipStream_t stream) {
    static int grid = 0;
    if (grid == 0) {
        int dev = 0, cus = 0, per_cu = 0;
        if (hipGetDevice(&dev) != hipSuccess || hipDeviceGetAttribute(&cus, hipDeviceAttributeMultiprocessorCount, dev) != hipSuccess) { fprintf(stderr, "kernel_launch: device query failed\n"); grid = -1; return; }
        if (hipFuncSetAttribute((const void*)mk_fwd, hipFuncAttributeMaxDynamicSharedMemorySize, LDS_BYTES) != hipSuccess) { fprintf(stderr, "kernel_launch: hipFuncSetAttribute failed\n"); grid = -1; return; }
        if (hipOccupancyMaxActiveBlocksPerMultiprocessor(&per_cu, (const void*)mk_fwd, NWAVES * 64, LDS_BYTES) != hipSuccess || per_cu < 1)
            fprintf(stderr, "kernel_launch: note: occupancy query reports %d workgroups per CU\n", per_cu);
        (void)hipGetLastError();
        grid = cus;
    }
    if (grid < 0) return;
    if (hipMemsetAsync((char*)d_ws + WS_CTL, 0, CTL_ZERO_BYTES, stream) != hipSuccess) { fprintf(stderr, "kernel_launch: memset failed\n"); return; }
    Args a{};
    { const float** ip = (const float**)&a.in; for (int i = 0; i < 27; ++i) ip[i] = (const float*)d_in[i]; }
    a.out = (float*)d_out; a.ws = (unsigned char*)d_ws;
    hipLaunchKernelGGL(mk_fwd, dim3(grid), dim3(NWAVES * 64), LDS_BYTES, stream, a);
}
```

```cpp
#include <hip/hip_runtime.h>
#include <cstdio>
#include <cstdint>
#define REP_MASK 0
namespace pg8 {
#define PG8_LAS __attribute__((address_space(3)))
typedef unsigned short bf16_t;
typedef short bf16x8 __attribute__((ext_vector_type(8)));
typedef float f32x4 __attribute__((ext_vector_type(4)));
typedef unsigned u32x4 __attribute__((ext_vector_type(4)));
constexpr int BM = 256, BK = 64, HALF = 128, HTB = HALF * BK * 2  , STAGE_BYTES = 8 * HTB, NXCD = 8, WGM = 8;

__host__ __device__ __forceinline__ int lds_byte(int r, int c) { const int st = (r >> 4) * 2 + (c >> 5), rr = r & 15, cc = c & 31, ob = rr * 64 + cc * 2; return st * 1024 + (ob ^ (((ob >> 9) & 1) << 5)); }
__host__ __device__ __forceinline__ void stage_rc(int b, int& R, int& C) { const int st = b / 1024, sb = b % 1024, swz = sb ^ (((sb >> 9) & 1) << 5); R = (st >> 1) * 16 + swz / 64; C = (st & 1) * 32 + (swz % 64) / 2; }
__host__ __device__ __forceinline__ int perm32(int rho) { const int n = rho >> 4, i = rho & 15; return 8 * (i >> 2) + 4 * n + (i & 3); }

struct Unit { int pm, pn; };
struct Gemm { const bf16_t* A; const bf16_t* Bt; int M, N, K; };

struct StaticOrder {
    int nM, nN, nwg, G, c, wave_id;
    __host__ __device__ void init(int M, int N, int G_, int c_) { nM = M / BM; nN = N / BM; nwg = nM * nN; G = G_; c = c_; }
    __host__ __device__ bool next(int i, Unit& u) const {
        const long L = (long)i * G + c; if (L >= nwg) return false;
        int wgid = (int)L; { const int q = nwg / NXCD, r = nwg % NXCD, xcd = wgid % NXCD, off = wgid / NXCD; wgid = (xcd < r ? xcd * (q + 1) : r * (q + 1) + (xcd - r) * q) + off; }
        const int nig = WGM * nN, gid = wgid / nig, fm = gid * WGM, gsz = (nM - fm) < WGM ? (nM - fm) : WGM;
        u.pm = fm + ((wgid % nig) % gsz); u.pn = (wgid % nig) / gsz; return true;
    }
    __device__ __forceinline__ void a_ready(const Unit&) const {}
    __device__ __forceinline__ void done(const Unit&) const {}
};
__device__ __forceinline__ unsigned cvt_pk_bf16(float lo, float hi) { unsigned r; asm volatile("v_cvt_pk_bf16_f32 %0, %1, %2" : "=v"(r) : "v"(lo), "v"(hi)); return r; }
typedef float f32x2 __attribute__((ext_vector_type(2)));
__device__ __forceinline__ f32x2 gelu_pk(f32x2 v) {
    const f32x2 av = __builtin_elementwise_abs(v), d = av * 0.2316418882f + 1.0f;
    f32x2 t; t.x = __builtin_amdgcn_rcpf(d.x); t.y = __builtin_amdgcn_rcpf(d.y);
    f32x2 q = t * 0.5307027145f + (-0.7265760135f); q = q * t + 0.7107068705f; q = q * t + (-0.142248368f); q = q * t + 0.127414796f; q = q * t;
    const f32x2 s = (v * v) * (-0.72134752044f);
    f32x2 e; e.x = __builtin_amdgcn_exp2f(s.x); e.y = __builtin_amdgcn_exp2f(s.y);
    const f32x2 m = v * (q * e), r = v - m;
    f32x2 o; o.x = v.x < 0.f ? m.x : r.x; o.y = v.y < 0.f ? m.y : r.y; return o;
}

struct EpiF32 {
    static constexpr bool PERM = false, AFTER_DRAIN = false;
    float* C; int ldc; const float* bias;
    __device__ __forceinline__ void operator()(const f32x4 (&acc)[2][2][4][2], const Unit& u, int wr, int wc, int fr, int fq) const {
        const int row0 = u.pm * BM + wr * 64 + fr, col0 = u.pn * BM + wc * 32 + 4 * fq;
        f32x4 bv[2][2];
#pragma unroll
        for (int bj = 0; bj < 2; ++bj)
#pragma unroll
            for (int n = 0; n < 2; ++n) bv[bj][n] = bias ? *(const f32x4*)(bias + col0 + bj * HALF + n * 16) : (f32x4){0.f, 0.f, 0.f, 0.f};
#pragma unroll
        for (int ai = 0; ai < 2; ++ai)
#pragma unroll
            for (int m = 0; m < 4; ++m) { float* rowp = C + (size_t)(row0 + ai * HALF + m * 16) * ldc + col0;
#pragma unroll
                for (int bj = 0; bj < 2; ++bj)
#pragma unroll
                    for (int n = 0; n < 2; ++n) *(f32x4*)(rowp + bj * HALF + n * 16) = acc[ai][bj][m][n] + bv[bj][n]; }
    }
};
template <int ACT  > struct EpiBf16 {
    static constexpr bool PERM = true, AFTER_DRAIN = false;
    bf16_t* O; int ldc; const float* bias; int split_cols; size_t split_stride;
    __device__ __forceinline__ void operator()(const f32x4 (&acc)[2][2][4][2], const Unit& u, int wr, int wc, int fr, int fq) const {
        const int row0 = u.pm * BM + wr * 64 + fr; int colt = u.pn * BM; bf16_t* base = O;
        if (split_cols) { const int t = colt / split_cols; base += (size_t)t * split_stride; colt -= t * split_cols; }
        const int col0 = colt + wc * 32 + 8 * fq, bcol0 = u.pn * BM + wc * 32 + 8 * fq;
        f32x4 bv[2][2];
#pragma unroll
        for (int bj = 0; bj < 2; ++bj)
#pragma unroll
            for (int n = 0; n < 2; ++n) bv[bj][n] = bias ? *(const f32x4*)(bias + bcol0 + bj * HALF + 4 * n) : (f32x4){0.f, 0.f, 0.f, 0.f};
#pragma unroll
        for (int ai = 0; ai < 2; ++ai)
#pragma unroll
            for (int m = 0; m < 4; ++m) { bf16_t* rowp = base + (size_t)(row0 + ai * HALF + m * 16) * ldc + col0;
#pragma unroll
                for (int bj = 0; bj < 2; ++bj) { f32x4 v0 = acc[ai][bj][m][0] + bv[bj][0], v1 = acc[ai][bj][m][1] + bv[bj][1];
                    if (ACT == 1) { f32x2 a = gelu_pk((f32x2){v0[0], v0[1]}), b = gelu_pk((f32x2){v0[2], v0[3]}), c = gelu_pk((f32x2){v1[0], v1[1]}), d = gelu_pk((f32x2){v1[2], v1[3]});
                        v0 = (f32x4){a.x, a.y, b.x, b.y}; v1 = (f32x4){c.x, c.y, d.x, d.y}; }
                    if (ACT == 2) {
#pragma unroll
                        for (int j = 0; j < 4; ++j) { v0[j] = 0.5f * v0[j] * (1.0f + erff(v0[j] * 0.70710678f)); v1[j] = 0.5f * v1[j] * (1.0f + erff(v1[j] * 0.70710678f)); } }
                    u32x4 w; w.x = cvt_pk_bf16(v0[0], v0[1]); w.y = cvt_pk_bf16(v0[2], v0[3]); w.z = cvt_pk_bf16(v1[0], v1[1]); w.w = cvt_pk_bf16(v1[2], v1[3]);
                    *(u32x4*)(rowp + bj * HALF) = w; } }
    }
};
__device__ __forceinline__ int fresh_lane_pg8() { unsigned m_ = ~0u; asm volatile("" : "+s"(m_)); return (int)__builtin_amdgcn_mbcnt_hi(m_, __builtin_amdgcn_mbcnt_lo(m_, 0u)); }
template <class Epi, class Sched, bool STAMP = false>
__device__ __forceinline__ void gemm_phase(PG8_LAS unsigned char* lds, const Gemm g, const Sched& S, const Epi& E, unsigned long long* stamps) {
    int tid_op_ = (S.wave_id << 6) | fresh_lane_pg8(); const int tid = tid_op_, wid = __builtin_amdgcn_readfirstlane(tid >> 6), lane = tid & 63, wr = wid >> 2, wc = wid & 3, fr = lane & 15, fq = lane >> 4;
    const int K = g.K, nt = K / BK;
    int ts_lo = 0, ts_hi = 0, nts = 0; const unsigned long long rt_entry = STAMP ? (unsigned long long)wall_clock64() : 0ull;
#define PG8_STAMP() do { if (STAMP && wid == 0 && nts < 64) { const unsigned long long _c = (unsigned long long)clock64(); \
        ts_lo = (lane == nts) ? (int)(unsigned)_c : ts_lo; ts_hi = (lane == nts) ? (int)(unsigned)(_c >> 32) : ts_hi; ++nts; } } while (0)
    PG8_STAMP();
    unsigned voffA[2], voffB[2];
#pragma unroll
    for (int i = 0; i < 2; ++i) { int R, C; stage_rc(tid * 16 + i * 8192, R, C); const int Rb = Epi::PERM ? ((R & ~31) + perm32(R & 31)) : R;
        voffA[i] = (unsigned)(R * K + C) * 2u; voffB[i] = (unsigned)(Rb * K + C) * 2u; }
    const size_t kstep = (size_t)(BK * 2);
    const size_t hstep = (size_t)HALF * K * 2;
    const size_t tstep = 2 * hstep;
    const unsigned ldsw = (unsigned)wid * 1024u;
    const int aoff = lds_byte(wr * 64 + fr, fq * 8), boff = lds_byte(wc * 32 + fr, fq * 8);
#define PG8_SA(b, h) (((b) * 2 + (h)) * HTB)
#define PG8_SB(b, h) ((4 + (b) * 2 + (h)) * HTB)
#define PG8_STAGE(bufoff, gbase, voff) do { _Pragma("unroll") for (int _i = 0; _i < 2; ++_i) \
        __builtin_amdgcn_global_load_lds((const unsigned*)((const char*)(gbase) + (voff)[_i]), (PG8_LAS unsigned*)(lds + (bufoff) + ldsw + _i * 8192), 16, 0, 0); } while (0)
#define PG8_LDA(dst, b, h) do { _Pragma("unroll") for (int m = 0; m < 4; ++m) _Pragma("unroll") for (int k = 0; k < 2; ++k) dst[m][k] = *(const PG8_LAS bf16x8*)(lds + PG8_SA(b, h) + aoff + m * 2048 + k * 1024); } while (0)
#define PG8_LDB(dst, b, h) do { _Pragma("unroll") for (int n = 0; n < 2; ++n) _Pragma("unroll") for (int k = 0; k < 2; ++k) dst[n][k] = *(const PG8_LAS bf16x8*)(lds + PG8_SB(b, h) + boff + n * 2048 + k * 1024); } while (0)
#define PG8_MMA(ai, bj, At, Bt) do { __builtin_amdgcn_s_setprio(1); _Pragma("unroll") for (int m = 0; m < 4; ++m) _Pragma("unroll") for (int n = 0; n < 2; ++n) _Pragma("unroll") for (int k = 0; k < 2; ++k) \
        acc[ai][bj][m][n] = __builtin_amdgcn_mfma_f32_16x16x32_bf16(Bt[n][k], At[m][k], acc[ai][bj][m][n], 0, 0, 0); __builtin_amdgcn_s_setprio(0); } while (0)
#define PG8_WAIT_V(n) asm volatile("s_waitcnt vmcnt(" #n ")" ::: "memory")
#define PG8_WAIT_L(n) asm volatile("s_waitcnt lgkmcnt(" #n ")" ::: "memory")
#define PG8_BAR __builtin_amdgcn_s_barrier()
#define PG8_SCHED __builtin_amdgcn_sched_barrier(0)
    Unit cur, nxt; int ui = 0;
    if (!S.next(0, cur)) return;
    f32x4 acc[2][2][4][2];
#pragma unroll
    for (int a = 0; a < 2; ++a)
#pragma unroll
        for (int b = 0; b < 2; ++b)
#pragma unroll
            for (int m = 0; m < 4; ++m)
#pragma unroll
                for (int n = 0; n < 2; ++n) acc[a][b][m][n] = (f32x4){0.f, 0.f, 0.f, 0.f};
    bf16x8 At[4][2], B0[2][2], B1[2][2];
    const char* cA = (const char*)g.A + (size_t)cur.pm * tstep; const char* cB = (const char*)g.Bt + (size_t)cur.pn * tstep;
    S.a_ready(cur);
    PG8_STAGE(PG8_SB(0, 0), cB, voffB); PG8_STAGE(PG8_SA(0, 0), cA, voffA); PG8_STAGE(PG8_SB(0, 1), cB + hstep, voffB); PG8_STAGE(PG8_SA(0, 1), cA + hstep, voffA);
    if (wr == 1) PG8_BAR;
    PG8_WAIT_V(4); PG8_BAR;
    PG8_STAGE(PG8_SB(1, 0), cB + kstep, voffB); PG8_STAGE(PG8_SA(1, 0), cA + kstep, voffA); PG8_STAGE(PG8_SB(1, 1), cB + hstep + kstep, voffB);
    PG8_WAIT_V(6); PG8_BAR;
    PG8_STAMP();
    for (;;) {
        const bool has_next = S.next(ui + 1, nxt);
        const char* nA = has_next ? (const char*)g.A + (size_t)nxt.pm * tstep : cA; const char* nB = has_next ? (const char*)g.Bt + (size_t)nxt.pn * tstep : cB;
        for (int t = 0; t < nt; t += 2) {
            const bool last = (t == nt - 2);
            const char* a1 = cA + (size_t)(t + 1) * kstep;
            const char* a2 = last ? nA : cA + (size_t)(t + 2) * kstep; const char* b2 = last ? nB : cB + (size_t)(t + 2) * kstep;
            const char* a3 = a2 + kstep; const char* b3 = b2 + kstep;
            if (last && has_next) S.a_ready(nxt);
            PG8_LDB(B0, 0, 0); PG8_SCHED; PG8_LDA(At, 0, 0); PG8_STAGE(PG8_SA(1, 1), a1 + hstep, voffA);
            PG8_WAIT_L(8); PG8_BAR; PG8_WAIT_L(0); PG8_MMA(0, 0, At, B0); PG8_BAR; PG8_SCHED;
            PG8_LDB(B1, 0, 1); PG8_STAGE(PG8_SB(0, 0), b2, voffB);
            PG8_BAR; PG8_WAIT_L(0); PG8_MMA(0, 1, At, B1); PG8_BAR;
            PG8_LDA(At, 0, 1); PG8_STAGE(PG8_SA(0, 0), a2, voffA);
            PG8_BAR; PG8_WAIT_L(0); PG8_MMA(1, 0, At, B0); PG8_BAR; PG8_SCHED;
            PG8_STAGE(PG8_SB(0, 1), b2 + hstep, voffB);
            PG8_WAIT_V(6); PG8_BAR; PG8_MMA(1, 1, At, B1); PG8_BAR;
            PG8_LDB(B0, 1, 0); PG8_SCHED; PG8_LDA(At, 1, 0); PG8_STAGE(PG8_SA(0, 1), a2 + hstep, voffA);
            PG8_WAIT_L(8); PG8_BAR; PG8_WAIT_L(0); PG8_MMA(0, 0, At, B0); PG8_BAR; PG8_SCHED;
            PG8_LDB(B1, 1, 1); PG8_STAGE(PG8_SB(1, 0), b3, voffB);
            PG8_BAR; PG8_WAIT_L(0); PG8_MMA(0, 1, At, B1); PG8_BAR;
            PG8_LDA(At, 1, 1); PG8_STAGE(PG8_SA(1, 0), a3, voffA);
            PG8_BAR; PG8_WAIT_L(0); PG8_MMA(1, 0, At, B0); PG8_BAR; PG8_SCHED;
            PG8_STAGE(PG8_SB(1, 1), b3 + hstep, voffB);
            PG8_WAIT_V(6); PG8_BAR; PG8_MMA(1, 1, At, B1); PG8_BAR;
        }
        PG8_STAMP();
        if constexpr (!Epi::AFTER_DRAIN) { E(acc, cur, wr, wc, fr, fq); S.done(cur); }
        PG8_STAMP();
        if (!has_next) break;
#pragma unroll
        for (int a = 0; a < 2; ++a)
#pragma unroll
            for (int b = 0; b < 2; ++b)
#pragma unroll
                for (int m = 0; m < 4; ++m)
#pragma unroll
                    for (int n = 0; n < 2; ++n) acc[a][b][m][n] = (f32x4){0.f, 0.f, 0.f, 0.f};
        cur = nxt; cA = nA; cB = nB; ++ui;
    }
    PG8_WAIT_V(0);
    if (wr == 0) PG8_BAR;
    PG8_BAR;
    if constexpr (Epi::AFTER_DRAIN) { E.fused(acc, cur, wr, wc, fr, fq, lds, wid, lane); S.done(cur); }
    PG8_STAMP();
    if (STAMP && wid == 0) { stamps[lane] = lane < nts ? (((unsigned long long)(unsigned)ts_hi << 32) | (unsigned)ts_lo) : 0ull;
        if (lane == 62) stamps[62] = rt_entry; if (lane == 63) stamps[63] = (unsigned long long)wall_clock64(); }
#undef PG8_STAMP
#undef PG8_SA
#undef PG8_SB
#undef PG8_STAGE
#undef PG8_LDA
#undef PG8_LDB
#undef PG8_MMA
#undef PG8_WAIT_V
#undef PG8_WAIT_L
#undef PG8_BAR
#undef PG8_SCHED
}
}
#define GAS __attribute__((address_space(1)))
#define LAS __attribute__((address_space(3)))
typedef unsigned short bf16;
typedef unsigned v4u __attribute__((ext_vector_type(4)));
typedef float f32x4 __attribute__((ext_vector_type(4)));
typedef short bf16x8 __attribute__((ext_vector_type(8)));
typedef GAS unsigned gu32;
typedef GAS unsigned long long gu64;
__device__ __forceinline__ int fresh_lane() { unsigned m_ = ~0u; asm volatile("" : "+s"(m_)); return (int)__builtin_amdgcn_mbcnt_hi(m_, __builtin_amdgcn_mbcnt_lo(m_, 0u)); }
#define RLX_AGENT __ATOMIC_RELAXED, __HIP_MEMORY_SCOPE_AGENT
#define LDS_WAIT() asm volatile("s_waitcnt lgkmcnt(0)" ::: "memory")
#define VM_WAIT() asm volatile("s_waitcnt vmcnt(0)" ::: "memory")
__device__ __forceinline__ unsigned long long rt() { return __builtin_amdgcn_s_memrealtime(); }
__device__ __forceinline__ unsigned f2bf(float f) { unsigned u = __builtin_bit_cast(unsigned, f); return (u + 0x7fffu + ((u >> 16) & 1u)) >> 16; }
__device__ __forceinline__ unsigned pk2(float lo, float hi) { return f2bf(lo) | (f2bf(hi) << 16); }
#define XB_TMO      128
#define XB_XCNT(j)  (256  + 64 * (j))
#define XB_XSUB(j)  (1280 + 64 * (j))
#define XB_XGEN(j)  (2304 + 64 * (j))
#define XB_TOP      3328
#define XB_TOPGEN   3392
#define XCD_BAR_WORDS 3456
#define XB_SPIN_CAP (1u << 22)

__device__ __forceinline__ unsigned xb_ld(unsigned* p)              { return __hip_atomic_load(p, __ATOMIC_RELAXED, __HIP_MEMORY_SCOPE_AGENT); }
__device__ __forceinline__ unsigned xb_add(unsigned* p, unsigned v) { return __hip_atomic_fetch_add(p, v, __ATOMIC_RELAXED, __HIP_MEMORY_SCOPE_AGENT); }
__device__ __forceinline__ unsigned xb_xcc_id() { return (unsigned)__builtin_amdgcn_s_getreg((3 << 11) | 20) & 0xFu; }
#define XB_SPIN(cond, bar) do { unsigned _sp = 0; while (cond) { __builtin_amdgcn_s_sleep(1); \
    if ((++_sp & 255u) == 0u) { if (xb_ld(&(bar)[XB_TMO])) break; if (_sp > XB_SPIN_CAP) { atomicAdd(&(bar)[XB_TMO], 1u); break; } } } } while (0)

struct XcdBarrier {
    unsigned* bar; unsigned x;
    volatile LAS unsigned* st;
};

__device__ __forceinline__ XcdBarrier xcd_barrier_post(unsigned* bar, volatile LAS unsigned* st, const int tid_) {
    XcdBarrier b; b.bar = bar; b.x = xb_xcc_id(); b.st = st;
    if (tid_ == 0) (void)xb_add(&bar[XB_XCNT(b.x)], 1u);
    return b;
}
__device__ __forceinline__ void xcd_barrier_complete(unsigned* bar, unsigned x, unsigned& nloc, unsigned& nx) {
    const unsigned G = gridDim.x * gridDim.y * gridDim.z;
    unsigned sum, cnt, mine, sp = 0u;
    for (;;) {
        sum = 0u; cnt = 0u; mine = 0u;
#pragma unroll
        for (unsigned j = 0; j < 16; ++j) { const unsigned c = xb_ld(&bar[XB_XCNT(j)]); sum += c; cnt += (c > 0u) ? 1u : 0u; mine = (j == x) ? c : mine; }
        if (sum == G) break;
        __builtin_amdgcn_s_sleep(1);
        if ((++sp & 255u) == 0u) { if (xb_ld(&bar[XB_TMO])) break; if (sp > XB_SPIN_CAP) { atomicAdd(&bar[XB_TMO], 1u); break; } }
    }
    nloc = mine > 0u ? mine : 1u; nx = cnt > 0u ? cnt : 1u;
}

__device__ __forceinline__ void xcd_barrier(const XcdBarrier& b, const int tid_) {
    asm volatile("s_waitcnt vmcnt(0)" ::: "memory");
    __syncthreads();
    if (tid_ == 0) {
        unsigned* bar = b.bar;
        __builtin_amdgcn_s_waitcnt(0);
        unsigned nloc = b.st[0], nx = b.st[1];
        if (nloc == 0u) { xcd_barrier_complete(bar, b.x, nloc, nx); b.st[0] = nloc; b.st[1] = nx; }
        const unsigned old = xb_add(&bar[XB_XSUB(b.x)], 1u);
        const unsigned gen = old / nloc;
        if (old + 1u == (gen + 1u) * nloc) {
            __builtin_amdgcn_fence(__ATOMIC_RELEASE, "agent");
            asm volatile("s_waitcnt vmcnt(0)" ::: "memory");
            const unsigned og = xb_add(&bar[XB_TOP], 1u);
            const unsigned tg = og / nx;
            if (og + 1u == (tg + 1u) * nx) xb_add(&bar[XB_TOPGEN], 1u);
            else XB_SPIN(xb_ld(&bar[XB_TOPGEN]) == tg, bar);
            __builtin_amdgcn_fence(__ATOMIC_ACQUIRE, "agent");
            xb_add(&bar[XB_XGEN(b.x)], 1u);
            asm volatile("s_waitcnt vmcnt(0)" ::: "memory");
        } else {
            XB_SPIN(xb_ld(&bar[XB_XGEN(b.x)]) == gen, bar);
            __builtin_amdgcn_fence(__ATOMIC_ACQUIRE, "agent");
            asm volatile("s_waitcnt vmcnt(0)" ::: "memory");
        }
    }
    __syncthreads();
}

constexpr int BATCH = 8, SEQ = 2048, DM = 1024, MTOK = BATCH * SEQ, NLAYER = 2;
constexpr int GW = 256, HD = 64, NHEAD = 4;
constexpr int IN_COLS = 4236, NP = 4352;
constexpr int C_HG_Q = 0, C_HG_F = 256, C_HG_I = 512;
constexpr int C_GD_Q = 768, C_GD_K = 1024, C_GD_V = 1280;
constexpr int C_SS_X = 1536, C_SS_B = 1792, C_SS_C = 2048;
constexpr int C_RW_R = 2304, C_RW_K = 2560, C_RW_V = 2816;
constexpr int C_Z = 3072;
constexpr int C_GD_BETA = 4096, C_GD_DEC = 4100, C_SS_DT = 4104, C_RW_WD = 4112, C_RW_AD = 4176;

__host__ __device__ __forceinline__ int old_col(int n) {
    if (n < 1536) return n;
    if (n < 2304) return 1544 + (n - 1536);
    if (n < 3072) return 2316 + (n - 2304);
    if (n < 4096) return 3212 + (n - 3072);
    if (n < 4104) return 1536 + (n - 4096);
    if (n < 4108) return 2312 + (n - 4104);
    if (n < 4112) return -1;
    if (n < 4240) return 3084 + (n - 4112);
    return -1;
}
__device__ __forceinline__ float bf2f(bf16 b) { return __builtin_bit_cast(float, ((unsigned)b) << 16); }
__device__ __forceinline__ float wave_sum(float v) {
#pragma unroll
    for (int o = 1; o < 64; o <<= 1) v += __shfl_xor(v, o);
    return v;
}
__device__ __forceinline__ float sigmoidf_(float x) { return 1.f / (1.f + __expf(-x)); }
__device__ __forceinline__ float siluf_(float x) { return x / (1.f + __expf(-x)); }
__device__ __forceinline__ float softplusf_(float x) { return x > 20.f ? x : log1pf(__expf(x)); }

struct Inputs {
    const float* x; const float* pre_norm_g; const float* w_in; const float* hgrn_lb; const float* hgrn_norm_g;
    const float* gdn_conv_w; const float* gdn_a_log; const float* gdn_dt_bias; const float* gdn_norm_g;
    const float* ssm_conv_w; const float* ssm_conv_b; const float* ssm_a_log; const float* ssm_dt_bias; const float* ssm_d; const float* ssm_norm_g;
    const float* rwkv_mu; const float* rwkv_w0; const float* rwkv_w_up; const float* rwkv_a0; const float* rwkv_a_up; const float* rwkv_k_k; const float* rwkv_k_a;
    const float* rwkv_r_k; const float* rwkv_ln_w; const float* rwkv_ln_b; const float* w_out; const float* post_norm_g;
};


typedef short bf16x4 __attribute__((ext_vector_type(4)));
typedef unsigned v2u __attribute__((ext_vector_type(2)));
#define MFMA16(a, b, c) __builtin_amdgcn_mfma_f32_16x16x32_bf16((a), (b), (c), 0, 0, 0)
constexpr int LS = 72;
constexpr int MAT_B = 64 * LS * 2;
constexpr int LS2 = 136;
constexpr int HEAD_LDS = 73728;

typedef float f32x2_ __attribute__((ext_vector_type(2)));
typedef __bf16 bf2_ __attribute__((ext_vector_type(2)));
#ifndef HWCVT
#define HWCVT 0
#endif
__device__ __forceinline__ unsigned pk_bf16(float lo, float hi) {
#if (HWCVT & 1)
    const f32x2_ v_ = {lo, hi}; const bf2_ r_ = __builtin_convertvector(v_, bf2_); return __builtin_bit_cast(unsigned, r_);
#else
    return f2bf(lo) | (f2bf(hi) << 16);
#endif
}
__device__ __forceinline__ bf16 cvt_bf16(float x) {
#if (HWCVT & 2)
    return (bf16)(pk_bf16(x, x) & 0xffffu);
#else
    return (bf16)f2bf(x);
#endif
}
__device__ __forceinline__ bf16x8 ld_frag(const LAS bf16* base, int stride, int row, int kofs, int q) {
    return *(const LAS bf16x8*)(base + row * stride + kofs + 8 * q);
}
__device__ __forceinline__ bf16x8 ld_frag_perm(const LAS bf16* base, int stride, int row, int kofs, int q) {
    const bf16x4 lo = *(const LAS bf16x4*)(base + row * stride + kofs + 4 * q);
    const bf16x4 hi = *(const LAS bf16x4*)(base + row * stride + kofs + 16 + 4 * q);
    bf16x8 v; v[0] = lo[0]; v[1] = lo[1]; v[2] = lo[2]; v[3] = lo[3]; v[4] = hi[0]; v[5] = hi[1]; v[6] = hi[2]; v[7] = hi[3]; return v;
}
__device__ __forceinline__ bf16x8 pack_frag(const f32x4& a, const f32x4& b) {
    union { unsigned u[4]; bf16x8 v; } x;
    x.u[0] = pk_bf16(a[0], a[1]); x.u[1] = pk_bf16(a[2], a[3]); x.u[2] = pk_bf16(b[0], b[1]); x.u[3] = pk_bf16(b[2], b[3]); return x.v;
}
__device__ __forceinline__ void st4(LAS bf16* base, int stride, int row, int col, const f32x4& v) {
    v2u o; o.x = pk_bf16(v[0], v[1]); o.y = pk_bf16(v[2], v[3]); *(LAS v2u*)(base + row * stride + col) = o;
}
__device__ __forceinline__ f32x4 zero4() { return (f32x4){0.f, 0.f, 0.f, 0.f}; }
#define WG_BAR() __syncthreads()

__device__ __forceinline__ void ssd_pack16(LAS bf16* dst, const float* v) {
    v4u w0, w1;
    w0.x = pk_bf16(v[0], v[1]); w0.y = pk_bf16(v[2], v[3]); w0.z = pk_bf16(v[4], v[5]); w0.w = pk_bf16(v[6], v[7]);
    w1.x = pk_bf16(v[8], v[9]); w1.y = pk_bf16(v[10], v[11]); w1.z = pk_bf16(v[12], v[13]); w1.w = pk_bf16(v[14], v[15]);
    *(LAS v4u*)dst = w0; *(LAS v4u*)(dst + 8) = w1;
}
#define RAWF(arr, j) bf2f((arr)[(j) >> 1][(j) & 1])
__device__ __forceinline__ int opaque_i(int v) { asm volatile("" : "+v"(v)); return v; }
#define RAWG(arr, j) bf2f((arr)[(j)])

__device__ __forceinline__ unsigned pk_sw(float lo, float hi) { return f2bf(lo) | (f2bf(hi) << 16); }
template <bool SW> __device__ __forceinline__ unsigned pkx(float lo, float hi) { if constexpr (SW) return pk_sw(lo, hi); else return pk_bf16(lo, hi); }
template <bool SW> __device__ __forceinline__ bf16x8 pack_frag_x(const f32x4& a, const f32x4& b) {
    union { unsigned u[4]; bf16x8 v; } x;
    x.u[0] = pkx<SW>(a[0], a[1]); x.u[1] = pkx<SW>(a[2], a[3]); x.u[2] = pkx<SW>(b[0], b[1]); x.u[3] = pkx<SW>(b[2], b[3]); return x.v; }
template <bool SW> __device__ __forceinline__ void st4_x(LAS bf16* base, int stride, int row, int col, const f32x4& v) {
    v2u o; o.x = pkx<SW>(v[0], v[1]); o.y = pkx<SW>(v[2], v[3]); *(LAS v2u*)(base + row * stride + col) = o; }
template <bool SW> __device__ __forceinline__ void pack16_x(LAS bf16* dst, const float* v) {
    v4u w0, w1;
    w0.x = pkx<SW>(v[0], v[1]); w0.y = pkx<SW>(v[2], v[3]); w0.z = pkx<SW>(v[4], v[5]); w0.w = pkx<SW>(v[6], v[7]);
    w1.x = pkx<SW>(v[8], v[9]); w1.y = pkx<SW>(v[10], v[11]); w1.z = pkx<SW>(v[12], v[13]); w1.w = pkx<SW>(v[14], v[15]);
    *(LAS v4u*)dst = w0; *(LAS v4u*)(dst + 8) = w1; }
#ifndef SWSITE
#define SWSITE 0
#endif
#define SITE(k) (((SWSITE) >> (k)) & 1)

__device__ __forceinline__ void mixopt_hgrn(const Inputs& in, const int layer, const bf16* __restrict__ PROJ, bf16* __restrict__ Yg, LAS unsigned char* ldsw, const int b, const int hp, const int tid) {
    const int lane = tid & 63, wave = __builtin_amdgcn_readfirstlane(tid >> 6), hh = wave >> 2, w4 = wave & 3, h = hp * 2 + hh, r = lane & 15, q = lane >> 4;
    LAS unsigned char* L = ldsw + hh * HEAD_LDS;
    LAS bf16* QT = (LAS bf16*)L; LAS bf16* KA = (LAS bf16*)(L + MAT_B); LAS bf16* KB = (LAS bf16*)(L + 2 * MAT_B); LAS bf16* R2 = (LAS bf16*)(L + 3 * MAT_B);
    LAS bf16* KDT = (LAS bf16*)(L + 4 * MAT_B); LAS bf16* VT = (LAS bf16*)(L + 5 * MAT_B); LAS bf16* ZT = (LAS bf16*)(L + 6 * MAT_B);
    LAS float* QTOT = (LAS float*)(L + 7 * MAT_B); LAS float* ELAST = QTOT + 256;
    const bf16* P = PROJ + (size_t)b * SEQ * NP; bf16* Yb = Yg + (size_t)b * SEQ * DM;
    const int c = h * 64 + lane;
    float lbv = 0.f;
    if (layer == 1) { const float x0 = in.hgrn_lb[c], x1 = in.hgrn_lb[GW + c]; const float mx = fmaxf(x0, x1); const float e0 = __expf(x0 - mx), e1 = __expf(x1 - mx); lbv = e1 / (e0 + e1); }
    f32x4 gn[4];
#pragma unroll
    for (int nv = 0; nv < 4; ++nv) gn[nv] = *(const f32x4*)(in.hgrn_norm_g + layer * HD + 16 * nv + 4 * q);
    f32x4 zs[4];
#pragma unroll
    for (int n = 0; n < 4; ++n) zs[n] = zero4();
    bf16 rq[16], rf[16], rv[16];
    { const bf16* p0 = P + (size_t)(16 * w4) * NP;
#pragma unroll
      for (int i = 0; i < 16; ++i) { rq[i] = p0[(size_t)i * NP + C_HG_Q + c]; rf[i] = p0[(size_t)i * NP + C_HG_F + c]; rv[i] = p0[(size_t)i * NP + C_HG_I + c]; } }
    for (int ch = 0; ch < SEQ / 64; ++ch) {
        float qv[16], kv[16], cl[16], vv[16]; float run = 0.f;
#pragma unroll
        for (int i = 0; i < 16; ++i) { const float x = bf2f(rq[i]); qv[i] = siluf_(x) * 0.125f; const float f = lbv + (1.f - lbv) * sigmoidf_(bf2f(rf[i])); kv[i] = 1.f - f; run += __logf(f); cl[i] = run; vv[i] = bf2f(rv[i]); }
        QTOT[w4 * 64 + lane] = run;
        if (ch + 1 < SEQ / 64) { const bf16* p0 = P + (size_t)((ch + 1) * 64 + 16 * w4) * NP;
#pragma unroll
            for (int i = 0; i < 16; ++i) { rq[i] = p0[(size_t)i * NP + C_HG_Q + c]; rf[i] = p0[(size_t)i * NP + C_HG_F + c]; rv[i] = p0[(size_t)i * NP + C_HG_I + c]; } }
        WG_BAR();
        {
            const float o0 = QTOT[lane], o1 = QTOT[64 + lane], o2 = QTOT[128 + lane], o3 = QTOT[192 + lane];
            const float base = (w4 > 0 ? o0 : 0.f) + (w4 > 1 ? o1 : 0.f) + (w4 > 2 ? o2 : 0.f);
            const float c31 = o0 + o1, c63 = c31 + o2 + o3, cI = (w4 >= 2) ? c31 : 0.f;
            float kd[16];
#pragma unroll
            for (int i = 0; i < 16; ++i) { const float cum = cl[i] + base; const int t = 16 * w4 + i;
                QT[t * LS + lane] = cvt_bf16(qv[i] * __expf(cum - cI));
                KA[t * LS + lane] = cvt_bf16(kv[i] * __expf(fminf(cI - cum, 80.f)));
                if (w4 < 2) KB[t * LS + lane] = cvt_bf16(kv[i] * __expf(c31 - cum));
                R2[t * LS + lane] = cvt_bf16(qv[i] * __expf(cum));
                kd[i] = kv[i] * __expf(c63 - cum); }
            v4u w0, w1;
            w0.x = pk_bf16(kd[0], kd[1]); w0.y = pk_bf16(kd[2], kd[3]); w0.z = pk_bf16(kd[4], kd[5]); w0.w = pk_bf16(kd[6], kd[7]);
            w1.x = pk_bf16(kd[8], kd[9]); w1.y = pk_bf16(kd[10], kd[11]); w1.z = pk_bf16(kd[12], kd[13]); w1.w = pk_bf16(kd[14], kd[15]);
            *(LAS v4u*)(KDT + lane * LS + 16 * w4) = w0; *(LAS v4u*)(KDT + lane * LS + 16 * w4 + 8) = w1;
            w0.x = pk_bf16(vv[0], vv[1]); w0.y = pk_bf16(vv[2], vv[3]); w0.z = pk_bf16(vv[4], vv[5]); w0.w = pk_bf16(vv[6], vv[7]);
            w1.x = pk_bf16(vv[8], vv[9]); w1.y = pk_bf16(vv[10], vv[11]); w1.z = pk_bf16(vv[12], vv[13]); w1.w = pk_bf16(vv[14], vv[15]);
            *(LAS v4u*)(VT + lane * LS + 16 * w4) = w0; *(LAS v4u*)(VT + lane * LS + 16 * w4 + 8) = w1;
            if (w4 == 0) ELAST[lane] = __expf(c63);
#pragma unroll
            for (int n = 0; n < 4; ++n) st4(ZT, LS, 16 * n + r, 16 * w4 + 4 * q, zs[n]);
        }
        WG_BAR();
        {
            const int m = w4;
            f32x4 Pt[4];
#pragma unroll
            for (int n = 0; n < 4; ++n) Pt[n] = zero4();
            bf16x8 aq[2];
#pragma unroll
            for (int k = 0; k < 2; ++k) aq[k] = ld_frag(QT, LS, 16 * m + r, 32 * k, q);
#pragma unroll
            for (int n = 0; n < 4; ++n) if (n <= m) {
                const LAS bf16* Bs = ((n >> 1) == (m >> 1)) ? KA : KB;
#pragma unroll
                for (int k = 0; k < 2; ++k) Pt[n] = MFMA16(ld_frag(Bs, LS, 16 * n + r, 32 * k, q), aq[k], Pt[n]);
                if (n == m) {
#pragma unroll
                    for (int i = 0; i < 4; ++i) if (4 * q + i > r) Pt[n][i] = 0.f; }
            }
            f32x4 O[4];
#pragma unroll
            for (int nv = 0; nv < 4; ++nv) O[nv] = zero4();
#pragma unroll
            for (int k = 0; k < 2; ++k) if (2 * k <= m) { const bf16x8 pf = pack_frag(Pt[2 * k], Pt[2 * k + 1]);
#pragma unroll
                for (int nv = 0; nv < 4; ++nv) O[nv] = MFMA16(ld_frag_perm(VT, LS, 16 * nv + r, 32 * k, q), pf, O[nv]); }
#pragma unroll
            for (int k = 0; k < 2; ++k) { const bf16x8 ar = ld_frag(R2, LS, 16 * m + r, 32 * k, q);
#pragma unroll
                for (int nv = 0; nv < 4; ++nv) O[nv] = MFMA16(ld_frag(ZT, LS, 16 * nv + r, 32 * k, q), ar, O[nv]); }
            float ss = 0.f;
#pragma unroll
            for (int nv = 0; nv < 4; ++nv) ss += (O[nv][0] * O[nv][0] + O[nv][1] * O[nv][1]) + (O[nv][2] * O[nv][2] + O[nv][3] * O[nv][3]);
            ss += __shfl_xor(ss, 16); ss += __shfl_xor(ss, 32);
            const float rs = rsqrtf(ss * (1.f / 64.f) + 1e-6f);
            const int t = ch * 64 + 16 * m + r;
#pragma unroll
            for (int nv = 0; nv < 4; ++nv) { const int dv0 = h * 64 + 16 * nv + 4 * q;
                const v2u zr = *(const v2u*)(P + (size_t)t * NP + C_Z + 0 + dv0);
                const float z0 = __builtin_bit_cast(float, zr.x << 16), z1 = __builtin_bit_cast(float, zr.x & 0xffff0000u), z2 = __builtin_bit_cast(float, zr.y << 16), z3 = __builtin_bit_cast(float, zr.y & 0xffff0000u);
                v2u o; o.x = pk_bf16(O[nv][0] * rs * gn[nv][0] * siluf_(z0), O[nv][1] * rs * gn[nv][1] * siluf_(z1));
                o.y = pk_bf16(O[nv][2] * rs * gn[nv][2] * siluf_(z2), O[nv][3] * rs * gn[nv][3] * siluf_(z3));
                *(v2u*)(Yb + (size_t)t * DM + 0 + dv0) = o; }
            const f32x4 el = *(const LAS f32x4*)(ELAST + 16 * w4 + 4 * q);
            bf16x8 ak[2];
#pragma unroll
            for (int k = 0; k < 2; ++k) ak[k] = ld_frag(KDT, LS, 16 * w4 + r, 32 * k, q);
#pragma unroll
            for (int n = 0; n < 4; ++n) { zs[n] = zs[n] * el;
#pragma unroll
                for (int k = 0; k < 2; ++k) zs[n] = MFMA16(ak[k], ld_frag(VT, LS, 16 * n + r, 32 * k, q), zs[n]); }
        }
        WG_BAR();
    }
}

__device__ __forceinline__ float tr_reduce16(const float* v, int lane) {
    float a[8], b[4], c[2], d;
    const bool b5 = lane & 32, b4 = lane & 16, b3 = lane & 8, b2 = lane & 4;
#pragma unroll
    for (int j = 0; j < 8; ++j) { const float snd = b5 ? v[j] : v[8 + j]; const float got = __shfl_xor(snd, 32); a[j] = (b5 ? v[8 + j] : v[j]) + got; }
#pragma unroll
    for (int j = 0; j < 4; ++j) { const float snd = b4 ? a[j] : a[4 + j]; const float got = __shfl_xor(snd, 16); b[j] = (b4 ? a[4 + j] : a[j]) + got; }
#pragma unroll
    for (int j = 0; j < 2; ++j) { const float snd = b3 ? b[j] : b[2 + j]; const float got = __shfl_xor(snd, 8); c[j] = (b3 ? b[2 + j] : b[j]) + got; }
    { const float snd = b2 ? c[0] : c[1]; const float got = __shfl_xor(snd, 4); d = (b2 ? c[1] : c[0]) + got; }
    d += __shfl_xor(d, 2); d += __shfl_xor(d, 1);
    return d;
}
__device__ __forceinline__ float rdlane(float x, int l) { return __builtin_bit_cast(float, __builtin_amdgcn_readlane(__builtin_bit_cast(int, x), l)); }

template <bool SW = false> __device__ __forceinline__ void diag_inverse(const LAS float* AD, LAS bf16* DT, int lane) {
    const int j = lane >> 4, c = lane & 15;
    const LAS float* A = AD + j * 256;
    float x[16];
#pragma unroll
    for (int i = 0; i < 16; ++i) {
        float s = (i == c) ? 1.f : 0.f;
#pragma unroll
        for (int k4 = 0; k4 < i; k4 += 4) { const f32x4 a = *(const LAS f32x4*)(A + i * 16 + k4);
#pragma unroll
            for (int kk = 0; kk < 4; ++kk) if (k4 + kk < i) s -= a[kk] * x[k4 + kk]; }
        x[i] = s;
    }
    v4u w0, w1;
    w0.x = pkx<SW>(x[0], x[1]); w0.y = pkx<SW>(x[2], x[3]); w0.z = pkx<SW>(x[4], x[5]); w0.w = pkx<SW>(x[6], x[7]);
    w1.x = pkx<SW>(x[8], x[9]); w1.y = pkx<SW>(x[10], x[11]); w1.z = pkx<SW>(x[12], x[13]); w1.w = pkx<SW>(x[14], x[15]);
    *(LAS v4u*)(DT + (j * 16 + c) * 16) = w0; *(LAS v4u*)(DT + (j * 16 + c) * 16 + 8) = w1;
}
__device__ __forceinline__ bf16x8 half_frag_lds(const LAS bf16* p) { const bf16x4 lo = *(const LAS bf16x4*)p; bf16x8 v; v[0] = lo[0]; v[1] = lo[1]; v[2] = lo[2]; v[3] = lo[3]; v[4] = 0; v[5] = 0; v[6] = 0; v[7] = 0; return v; }
__device__ __forceinline__ bf16x8 two_frag_lds(const LAS bf16* p0, const LAS bf16* p1) { const bf16x4 lo = *(const LAS bf16x4*)p0; const bf16x4 hi = *(const LAS bf16x4*)p1; bf16x8 v; v[0] = lo[0]; v[1] = lo[1]; v[2] = lo[2]; v[3] = lo[3]; v[4] = hi[0]; v[5] = hi[1]; v[6] = hi[2]; v[7] = hi[3]; return v; }
template <bool SW = false> __device__ __forceinline__ void tri_inverse_row(const LAS bf16* AMT, const LAS bf16* DT, int m, int r, int q, f32x4* Tm) {
    const f32x4 z4 = zero4();
    f32x4 dm;
#pragma unroll
    for (int i = 0; i < 4; ++i) dm[i] = bf2f(DT[(m * 16 + 4 * q + i) * 16 + r]);
#pragma unroll
    for (int n = 0; n < 4; ++n) Tm[n] = (n == m) ? dm : z4;
#pragma unroll
    for (int j = 2; j >= 0; --j) if (j < m) {
        f32x4 X = z4;
#pragma unroll
        for (int k = j + 1; k <= 3; k += 2) if (k <= m) {
            const LAS bf16* p0 = AMT + (16 * j + r) * LS + 16 * k + 4 * q;
            if (k + 1 <= 3) { const bf16x8 af = pack_frag_x<SW>(Tm[k], Tm[k + 1]); const bf16x8 bfr = two_frag_lds(p0, p0 + 16); X = MFMA16(bfr, af, X); }
            else { const bf16x8 af = pack_frag_x<SW>(Tm[k], z4); const bf16x8 bfr = half_frag_lds(p0); X = MFMA16(bfr, af, X); }
        }
        const bf16x8 xf = pack_frag_x<SW>(X, z4);
        const bf16x8 df = half_frag_lds(DT + (j * 16 + r) * 16 + 4 * q);
        const f32x4 Tj = MFMA16(df, xf, z4);
        Tm[j] = -Tj;
    }
}

__device__ __forceinline__ void mixopt_gdn(const Inputs& in, const int layer, const bf16* __restrict__ PROJ, bf16* __restrict__ Yg, LAS unsigned char* ldsw, const int b, const int hp, const int tid) {
    const int lane0 = tid & 63, wave = __builtin_amdgcn_readfirstlane(tid >> 6), hh = wave >> 2, w4 = wave & 3, h = hp * 2 + hh;
    LAS unsigned char* L = ldsw + hh * HEAD_LDS;
    LAS bf16* Qm = (LAS bf16*)L; LAS bf16* Km = (LAS bf16*)(L + 9216); LAS bf16* KT = (LAS bf16*)(L + 18432); LAS bf16* VT = (LAS bf16*)(L + 27648); LAS bf16* ZT = (LAS bf16*)(L + 36864);
    LAS bf16* AMT = (LAS bf16*)(L + 46080); LAS bf16* RHST = (LAS bf16*)(L + 55296); LAS float* AD = (LAS float*)(L + 64512); LAS bf16* DT = (LAS bf16*)(L + 68608);
    LAS float* CUM = (LAS float*)(L + 70656); LAS float* ECUM = CUM + 64; LAS float* BETA = CUM + 128; LAS float* WSC = CUM + 192;
    LAS bf16* VNWT = Km; LAS bf16* VNT = VT;
    const bf16* P = PROJ + (size_t)b * SEQ * NP; bf16* Yb = Yg + (size_t)b * SEQ * DM;
    const float* cw = in.gdn_conv_w + (size_t)layer * 4 * 768 + h * 64;
    const float Aneg = -__expf(in.gdn_a_log[layer * 4 + h]), dtb = in.gdn_dt_bias[layer * 4 + h];
    f32x4 zs[4];
#pragma unroll
    for (int n = 0; n < 4; ++n) zs[n] = zero4();
    typedef unsigned short us2 __attribute__((ext_vector_type(2)));
    bf16 rq[19], rk[19], rv[19]; bf16 rbt, rat;
    auto load_raw = [&](int ch, int lane) {
        const int c = h * 64 + lane;
        const int tb = ch * 64 + 16 * w4 - 3;
#pragma unroll
        for (int j = 0; j < 19; ++j) { const int t = tb + j; const bool ok = (t >= 0); const bf16* p0 = P + (size_t)(ok ? t : 0) * NP;
            const bf16 a = p0[C_GD_Q + c], bb = p0[C_GD_K + c], cc = p0[C_GD_V + c];
            rq[j] = ok ? a : (bf16)0; rk[j] = ok ? bb : (bf16)0; rv[j] = ok ? cc : (bf16)0; }
        rbt = P[(size_t)(ch * 64 + lane) * NP + C_GD_BETA + h]; rat = P[(size_t)(ch * 64 + lane) * NP + C_GD_DEC + h];
    };
    load_raw(0, lane0);
    for (int ch = 0; ch < SEQ / 64; ++ch) {
        const int lane = opaque_i(lane0), r = lane & 15, q = lane >> 4;
        {
            float tv[16];
            float wq[4], wk[4], wv[4];
#pragma unroll
            for (int j = 0; j < 4; ++j) { wq[j] = cw[j * 768 + lane]; wk[j] = cw[j * 768 + 256 + lane]; wv[j] = cw[j * 768 + 512 + lane]; }
#pragma unroll
            for (int i = 0; i < 16; ++i) tv[i] = siluf_(wk[0] * RAWG(rk, i) + wk[1] * RAWG(rk, i + 1) + wk[2] * RAWG(rk, i + 2) + wk[3] * RAWG(rk, i + 3));
            { float sq[16];
#pragma unroll
              for (int i = 0; i < 16; ++i) sq[i] = tv[i] * tv[i];
              const float sred = tr_reduce16(sq, lane);
#pragma unroll
              for (int i = 0; i < 16; ++i) { tv[i] *= rsqrtf(rdlane(sred, 4 * i) + 1e-6f); Km[(16 * w4 + i) * LS + lane] = cvt_bf16(tv[i]); } }
            pack16_x<SITE(0)>(KT + lane * LS + 16 * w4, tv);
            asm volatile("" ::: "memory");
#pragma unroll
            for (int i = 0; i < 16; ++i) tv[i] = siluf_(wq[0] * RAWG(rq, i) + wq[1] * RAWG(rq, i + 1) + wq[2] * RAWG(rq, i + 2) + wq[3] * RAWG(rq, i + 3));
            { float sq[16];
#pragma unroll
              for (int i = 0; i < 16; ++i) sq[i] = tv[i] * tv[i];
              const float sred = tr_reduce16(sq, lane);
#pragma unroll
              for (int i = 0; i < 16; ++i) Qm[(16 * w4 + i) * LS + lane] = cvt_bf16(tv[i] * rsqrtf(rdlane(sred, 4 * i) + 1e-6f) * 0.125f); }
            asm volatile("" ::: "memory");
#pragma unroll
            for (int i = 0; i < 16; ++i) tv[i] = siluf_(wv[0] * RAWG(rv, i) + wv[1] * RAWG(rv, i + 1) + wv[2] * RAWG(rv, i + 2) + wv[3] * RAWG(rv, i + 3));
            pack16_x<SITE(0)>(VT + lane * LS + 16 * w4, tv);
            if (w4 == 0) {
                const float beta = sigmoidf_(bf2f(rbt)); float cs = Aneg * softplusf_(bf2f(rat) + dtb);
#pragma unroll
                for (int o = 1; o < 64; o <<= 1) { const float u = __shfl_up(cs, o); if (lane >= o) cs += u; }
                const float c63 = __shfl(cs, 63);
                CUM[lane] = cs; ECUM[lane] = __expf(cs); BETA[lane] = beta; WSC[lane] = __expf(c63 - cs);
            }
#pragma unroll
            for (int n = 0; n < 4; ++n) st4_x<SITE(1)>(ZT, LS, 16 * n + r, 16 * w4 + 4 * q, zs[n]);
        }
        WG_BAR();
        const int m = w4;
        f32x4 QK[4];
        { const int lane = opaque_i(lane0), r = lane & 15, q = lane >> 4;
        {
            bf16x8 ak[2], aq[2];
#pragma unroll
            for (int k = 0; k < 2; ++k) { ak[k] = ld_frag(Km, LS, 16 * m + r, 32 * k, q); aq[k] = ld_frag(Qm, LS, 16 * m + r, 32 * k, q); }
            const f32x4 cumt4 = *(const LAS f32x4*)(CUM + 16 * m + 4 * q);
            const f32x4 bet4 = *(const LAS f32x4*)(BETA + 16 * m + 4 * q);
            const f32x4 ecum4 = *(const LAS f32x4*)(ECUM + 16 * m + 4 * q);
            const float cumr = CUM[16 * m + r];
#pragma unroll
            for (int n = 0; n < 4; ++n) { QK[n] = zero4(); if (n <= m) {
                f32x4 kk = zero4();
#pragma unroll
                for (int k = 0; k < 2; ++k) { const bf16x8 bk = ld_frag(Km, LS, 16 * n + r, 32 * k, q);
                    kk = MFMA16(ak[k], bk, kk);
                    QK[n] = MFMA16(bk, aq[k], QK[n]); }
                const float cums = CUM[16 * n + r];
                f32x4 av;
#pragma unroll
                for (int i = 0; i < 4; ++i) { const bool keep = (n < m) || (r < 4 * q + i); av[i] = keep ? bet4[i] * kk[i] * __expf(cumt4[i] - cums) : 0.f; }
                st4_x<SITE(2)>(AMT, LS, 16 * n + r, 16 * m + 4 * q, av);
                if (n == m) {
#pragma unroll
                    for (int i = 0; i < 4; ++i) AD[m * 256 + (4 * q + i) * 16 + r] = av[i]; }
                const f32x4 cs4 = *(const LAS f32x4*)(CUM + 16 * n + 4 * q);
#pragma unroll
                for (int i = 0; i < 4; ++i) { const bool keep = (n < m) || (4 * q + i <= r); QK[n][i] = keep ? QK[n][i] * __expf(cumr - cs4[i]) : 0.f; }
            } }
#pragma unroll
            for (int nv = 0; nv < 4; ++nv) { f32x4 kz = zero4();
#pragma unroll
                for (int k = 0; k < 2; ++k) kz = MFMA16(ak[k], ld_frag(ZT, LS, 16 * nv + r, 32 * k, q), kz);
                const v2u vr = *(const LAS v2u*)(VT + (16 * nv + r) * LS + 16 * m + 4 * q);
                f32x4 rh;
                rh[0] = bet4[0] * (__builtin_bit_cast(float, vr.x << 16) - ecum4[0] * kz[0]); rh[1] = bet4[1] * (__builtin_bit_cast(float, vr.x & 0xffff0000u) - ecum4[1] * kz[1]);
                rh[2] = bet4[2] * (__builtin_bit_cast(float, vr.y << 16) - ecum4[2] * kz[2]); rh[3] = bet4[3] * (__builtin_bit_cast(float, vr.y & 0xffff0000u) - ecum4[3] * kz[3]);
                st4_x<SITE(2)>(RHST, LS, 16 * nv + r, 16 * m + 4 * q, rh); }
        }
        }
        WG_BAR();
        { const int lane = opaque_i(lane0), r = lane & 15, q = lane >> 4;
        if (ch + 1 < SEQ / 64) load_raw(ch + 1, lane);
        {
            diag_inverse<SITE(5)>(AD, DT, lane);
            asm volatile("s_waitcnt lgkmcnt(0)" ::: "memory");
            f32x4 Tm[4];
            tri_inverse_row<SITE(6)>(AMT, DT, m, r, q, Tm);
            const f32x4 w4v = *(const LAS f32x4*)(WSC + 16 * m + 4 * q);
            const bf16x8 t0 = pack_frag_x<SITE(3)>(Tm[0], Tm[1]), t1 = pack_frag_x<SITE(3)>(Tm[2], Tm[3]);
#pragma unroll
            for (int nv = 0; nv < 4; ++nv) { f32x4 vn = zero4();
                vn = MFMA16(t0, ld_frag_perm(RHST, LS, 16 * nv + r, 0, q), vn);
                if (m >= 2) vn = MFMA16(t1, ld_frag_perm(RHST, LS, 16 * nv + r, 32, q), vn);
                st4_x<SITE(3)>(VNT, LS, 16 * nv + r, 16 * m + 4 * q, vn);
                st4_x<SITE(3)>(VNWT, LS, 16 * nv + r, 16 * m + 4 * q, vn * w4v); }
        }
        }
        WG_BAR();
        { const int lane = opaque_i(lane0), r = lane & 15, q = lane >> 4; const float* gnp = in.gdn_norm_g + layer * HD + 4 * q;
        {
            f32x4 O[4];
            bf16x8 aq[2];
#pragma unroll
            for (int k = 0; k < 2; ++k) aq[k] = ld_frag(Qm, LS, 16 * m + r, 32 * k, q);
            const float ect = ECUM[16 * m + r];
            const bf16x8 p0 = pack_frag_x<SITE(4)>(QK[0], QK[1]), p1 = pack_frag_x<SITE(4)>(QK[2], QK[3]);
            float ss = 0.f;
#pragma unroll
            for (int nv = 0; nv < 4; ++nv) { O[nv] = zero4();
#pragma unroll
                for (int k = 0; k < 2; ++k) O[nv] = MFMA16(ld_frag(ZT, LS, 16 * nv + r, 32 * k, q), aq[k], O[nv]);
                O[nv] = O[nv] * ect;
                O[nv] = MFMA16(ld_frag_perm(VNT, LS, 16 * nv + r, 0, q), p0, O[nv]);
                if (m >= 2) O[nv] = MFMA16(ld_frag_perm(VNT, LS, 16 * nv + r, 32, q), p1, O[nv]);
                ss += (O[nv][0] * O[nv][0] + O[nv][1] * O[nv][1]) + (O[nv][2] * O[nv][2] + O[nv][3] * O[nv][3]); }
            ss += __shfl_xor(ss, 16); ss += __shfl_xor(ss, 32);
            const float rs = rsqrtf(ss * (1.f / 64.f) + 1e-6f);
            const int t = ch * 64 + 16 * m + r;
#pragma unroll
            for (int nv = 0; nv < 4; ++nv) { const int dv0 = h * 64 + 16 * nv + 4 * q;
                const f32x4 gg = *(const f32x4*)(gnp + 16 * nv);
                const v2u zr = *(const v2u*)(P + (size_t)t * NP + C_Z + 256 + dv0);
                const float z0 = __builtin_bit_cast(float, zr.x << 16), z1 = __builtin_bit_cast(float, zr.x & 0xffff0000u), z2 = __builtin_bit_cast(float, zr.y << 16), z3 = __builtin_bit_cast(float, zr.y & 0xffff0000u);
                v2u o; o.x = pkx<SITE(4)>(O[nv][0] * rs * gg[0] * siluf_(z0), O[nv][1] * rs * gg[1] * siluf_(z1)); o.y = pkx<SITE(4)>(O[nv][2] * rs * gg[2] * siluf_(z2), O[nv][3] * rs * gg[3] * siluf_(z3));
                *(v2u*)(Yb + (size_t)t * DM + 256 + dv0) = o; }
            const float last = ECUM[63];
            bf16x8 akt[2];
#pragma unroll
            for (int k = 0; k < 2; ++k) akt[k] = ld_frag(KT, LS, 16 * w4 + r, 32 * k, q);
#pragma unroll
            for (int n = 0; n < 4; ++n) { zs[n] = zs[n] * last;
#pragma unroll
                for (int k = 0; k < 2; ++k) zs[n] = MFMA16(akt[k], ld_frag(VNWT, LS, 16 * n + r, 32 * k, q), zs[n]); }
        }
        }
        WG_BAR();
    }
}

__device__ __forceinline__ void mixopt_ssd(const Inputs& in, const int layer, const bf16* __restrict__ PROJ, bf16* __restrict__ Yg, LAS unsigned char* ldsw, const int b, const int g, const int tid) {
    const int lane = tid & 63, wave = __builtin_amdgcn_readfirstlane(tid >> 6), hh = wave >> 2, w4 = wave & 3, h = g * 2 + hh, r = lane & 15, q = lane >> 4;
    LAS bf16* CM = (LAS bf16*)ldsw; LAS bf16* BM = (LAS bf16*)(ldsw + 17408); LAS bf16* BT = (LAS bf16*)(ldsw + 34816);
    LAS unsigned char* L = ldsw + 53248 + hh * 45056;
    LAS bf16* XVT = (LAS bf16*)L; LAS bf16* XVWT = (LAS bf16*)(L + MAT_B); LAS bf16* XR = (LAS bf16*)(L + 2 * MAT_B); LAS bf16* ZT = (LAS bf16*)(L + 3 * MAT_B);
    LAS float* CUM = (LAS float*)(ldsw + 143360 + hh * 1024); LAS float* ECUM = CUM + 64;
    LAS float* SS = (LAS float*)(ldsw + 145408);
    const bf16* P = PROJ + (size_t)b * SEQ * NP; bf16* Yb = Yg + (size_t)b * SEQ * DM;
    const int cx = h * 64 + lane, cbc = g * 128 + 64 * hh + lane;
    const float* cw = in.ssm_conv_w + (size_t)layer * 4 * 768; const float* cb = in.ssm_conv_b + (size_t)layer * 768;
    float wx[4], wB[4], wC[4];
#pragma unroll
    for (int j = 0; j < 4; ++j) { wx[j] = cw[j * 768 + cx]; wB[j] = cw[j * 768 + 256 + cbc]; wC[j] = cw[j * 768 + 512 + cbc]; }
    const float bx = cb[cx], bB = cb[256 + cbc], bC = cb[512 + cbc];
    const float Aneg = -__expf(in.ssm_a_log[layer * 4 + h]), dtb = in.ssm_dt_bias[layer * 4 + h], dsk = in.ssm_d[layer * 4 + h];
    const float* gnp = in.ssm_norm_g + layer * GW + h * 64 + 4 * q;
    f32x4 zs[2][4];
#pragma unroll
    for (int a = 0; a < 2; ++a)
#pragma unroll
        for (int n = 0; n < 4; ++n) zs[a][n] = zero4();
    typedef unsigned short us2 __attribute__((ext_vector_type(2)));
    bf16 rx[19], rB[19], rC[19]; bf16 rdt;
    auto load_raw = [&](int ch) {
        const int tb = ch * 64 + 16 * w4 - 3;
#pragma unroll
        for (int j = 0; j < 19; ++j) { const int t = tb + j; const bool ok = (t >= 0); const bf16* p0 = P + (size_t)(ok ? t : 0) * NP;
            const bf16 a = p0[C_SS_X + cx], bb = p0[C_SS_B + cbc], cc = p0[C_SS_C + cbc];
            rx[j] = ok ? a : (bf16)0; rB[j] = ok ? bb : (bf16)0; rC[j] = ok ? cc : (bf16)0; }
        rdt = P[(size_t)(ch * 64 + lane) * NP + C_SS_DT + h];
    };
    load_raw(0);
    for (int ch = 0; ch < SEQ / 64; ++ch) {
        {
            float tv[16];
#pragma unroll
            for (int i = 0; i < 16; ++i) { tv[i] = siluf_(wC[0] * RAWG(rC, i) + wC[1] * RAWG(rC, i + 1) + wC[2] * RAWG(rC, i + 2) + wC[3] * RAWG(rC, i + 3) + bC);
                CM[(16 * w4 + i) * LS2 + 64 * hh + lane] = cvt_bf16(tv[i]); }
            asm volatile("" ::: "memory");
#pragma unroll
            for (int i = 0; i < 16; ++i) { tv[i] = siluf_(wB[0] * RAWG(rB, i) + wB[1] * RAWG(rB, i + 1) + wB[2] * RAWG(rB, i + 2) + wB[3] * RAWG(rB, i + 3) + bB);
                BM[(16 * w4 + i) * LS2 + 64 * hh + lane] = cvt_bf16(tv[i]); }
            ssd_pack16(BT + (64 * hh + lane) * LS + 16 * w4, tv);
            asm volatile("" ::: "memory");
            const float dt = softplusf_(bf2f(rdt) + dtb); float cs = dt * Aneg;
#pragma unroll
            for (int o = 1; o < 64; o <<= 1) { const float u = __shfl_up(cs, o); if (lane >= o) cs += u; }
            const float c63 = __shfl(cs, 63);
            const float wsc = __expf(c63 - cs);
            if (w4 == 0) { CUM[lane] = cs; ECUM[lane] = __expf(cs); }
            float xw[16];
#pragma unroll
            for (int i = 0; i < 16; ++i) { const int t = 16 * w4 + i;
                const float xs = siluf_(wx[0] * RAWG(rx, i) + wx[1] * RAWG(rx, i + 1) + wx[2] * RAWG(rx, i + 2) + wx[3] * RAWG(rx, i + 3) + bx);
                XR[t * LS + lane] = cvt_bf16(xs); tv[i] = xs * __shfl(dt, t); xw[i] = tv[i] * __shfl(wsc, t); }
            ssd_pack16(XVT + lane * LS + 16 * w4, tv);
            ssd_pack16(XVWT + lane * LS + 16 * w4, xw);
#pragma unroll
            for (int a = 0; a < 2; ++a)
#pragma unroll
                for (int nv = 0; nv < 4; ++nv) st4(ZT, LS2, 16 * nv + r, 16 * (2 * w4 + a) + 4 * q, zs[a][nv]);
        }
        WG_BAR();
        if (ch + 1 < SEQ / 64) load_raw(ch + 1);
        f32x4 yv[4];
        {
            const int m = w4;
            f32x4 Pt[4];
#pragma unroll
            for (int n = 0; n < 4; ++n) Pt[n] = zero4();
            bf16x8 ac[4];
#pragma unroll
            for (int k = 0; k < 4; ++k) ac[k] = ld_frag(CM, LS2, 16 * m + r, 32 * k, q);
            const float cumt = CUM[16 * m + r];
#pragma unroll
            for (int n = 0; n < 4; ++n) if (n <= m) {
#pragma unroll
                for (int k = 0; k < 4; ++k) Pt[n] = MFMA16(ld_frag(BM, LS2, 16 * n + r, 32 * k, q), ac[k], Pt[n]);
                const f32x4 cs = *(const LAS f32x4*)(CUM + 16 * n + 4 * q);
#pragma unroll
                for (int i = 0; i < 4; ++i) { const bool keep = (n < m) || (4 * q + i <= r); Pt[n][i] = keep ? Pt[n][i] * __expf(cumt - cs[i]) : 0.f; }
            }
            f32x4 O[4];
            const float ect = ECUM[16 * m + r];
#pragma unroll
            for (int nv = 0; nv < 4; ++nv) O[nv] = zero4();
#pragma unroll
            for (int k = 0; k < 4; ++k)
#pragma unroll
                for (int nv = 0; nv < 4; ++nv) O[nv] = MFMA16(ld_frag(ZT, LS2, 16 * nv + r, 32 * k, q), ac[k], O[nv]);
#pragma unroll
            for (int nv = 0; nv < 4; ++nv) O[nv] = O[nv] * ect;
#pragma unroll
            for (int k = 0; k < 2; ++k) if (2 * k <= m) { const bf16x8 pf = pack_frag(Pt[2 * k], Pt[2 * k + 1]);
#pragma unroll
                for (int nv = 0; nv < 4; ++nv) O[nv] = MFMA16(ld_frag_perm(XVT, LS, 16 * nv + r, 32 * k, q), pf, O[nv]); }
            const int t = ch * 64 + 16 * m + r;
            float ss = 0.f;
#pragma unroll
            for (int nv = 0; nv < 4; ++nv) { const int p0 = 16 * nv + 4 * q;
                const v2u xr = *(const LAS v2u*)(XR + (16 * m + r) * LS + p0);
                const v2u zr = *(const v2u*)(P + (size_t)t * NP + C_Z + 512 + h * 64 + p0);
                const float x0 = __builtin_bit_cast(float, xr.x << 16), x1 = __builtin_bit_cast(float, xr.x & 0xffff0000u), x2 = __builtin_bit_cast(float, xr.y << 16), x3 = __builtin_bit_cast(float, xr.y & 0xffff0000u);
                const float z0 = __builtin_bit_cast(float, zr.x << 16), z1 = __builtin_bit_cast(float, zr.x & 0xffff0000u), z2 = __builtin_bit_cast(float, zr.y << 16), z3 = __builtin_bit_cast(float, zr.y & 0xffff0000u);
                yv[nv][0] = (O[nv][0] + x0 * dsk) * siluf_(z0); yv[nv][1] = (O[nv][1] + x1 * dsk) * siluf_(z1);
                yv[nv][2] = (O[nv][2] + x2 * dsk) * siluf_(z2); yv[nv][3] = (O[nv][3] + x3 * dsk) * siluf_(z3);
                ss += (yv[nv][0] * yv[nv][0] + yv[nv][1] * yv[nv][1]) + (yv[nv][2] * yv[nv][2] + yv[nv][3] * yv[nv][3]); }
            ss += __shfl_xor(ss, 16); ss += __shfl_xor(ss, 32);
            if (q == 0) SS[hh * 64 + 16 * m + r] = ss;
            const float el = ECUM[63];
#pragma unroll
            for (int a = 0; a < 2; ++a) { bf16x8 ab[2];
#pragma unroll
                for (int k = 0; k < 2; ++k) ab[k] = ld_frag(BT, LS, 16 * (2 * w4 + a) + r, 32 * k, q);
#pragma unroll
                for (int nv = 0; nv < 4; ++nv) { zs[a][nv] = zs[a][nv] * el;
#pragma unroll
                    for (int k = 0; k < 2; ++k) zs[a][nv] = MFMA16(ab[k], ld_frag(XVWT, LS, 16 * nv + r, 32 * k, q), zs[a][nv]); } }
        }
        WG_BAR();
        {
            const int m = w4, t = ch * 64 + 16 * m + r;
            const float tot = SS[16 * m + r] + SS[64 + 16 * m + r];
            const float rs = rsqrtf(tot * (1.f / 128.f) + 1e-6f);
#pragma unroll
            for (int nv = 0; nv < 4; ++nv) { const f32x4 gg = *(const f32x4*)(gnp + 16 * nv); v2u o; o.x = pk_bf16(yv[nv][0] * rs * gg[0], yv[nv][1] * rs * gg[1]); o.y = pk_bf16(yv[nv][2] * rs * gg[2], yv[nv][3] * rs * gg[3]);
                *(v2u*)(Yb + (size_t)t * DM + 512 + h * 64 + 16 * nv + 4 * q) = o; }
        }
    }
}

__device__ __forceinline__ void rwkv_pre_block(const Inputs& in, const int layer, const bf16* __restrict__ PROJ, float* __restrict__ CUMo, float* __restrict__ CUMPo, float* __restrict__ AV, LAS float* lds, const int m0, const int tid) {
    LAS float* SW = lds; LAS float* SA = lds + 4096; LAS float* HT = lds + 8192;
    const float* mu = in.rwkv_mu + (size_t)layer * 896;
    { const int j = tid & 63, tg = tid >> 6; const float muw = mu[768 + j], mua = mu[832 + j];
#pragma unroll
      for (int tt = 0; tt < 8; ++tt) { const int t = tg * 8 + tt, m = m0 + t; const bool first = ((m & (SEQ - 1)) == 0);
          const float xw = bf2f(PROJ[(size_t)m * NP + C_RW_WD + j]), xa = bf2f(PROJ[(size_t)m * NP + C_RW_AD + j]);
          const float pw = first ? 0.f : bf2f(PROJ[(size_t)(m - 1) * NP + C_RW_WD + j]), pa = first ? 0.f : bf2f(PROJ[(size_t)(m - 1) * NP + C_RW_AD + j]);
          SW[t * 64 + j] = tanhf(xw + (pw - xw) * muw); SA[t * 64 + j] = xa + (pa - xa) * mua; } }
    __syncthreads();
    { const int c = tid & 255, th = tid >> 8;
      float run = 0.f;
      { const float* wup = in.rwkv_w_up + (size_t)layer * 64 * GW + c;
        float wu[64];
#pragma unroll
        for (int j = 0; j < 64; ++j) wu[j] = wup[j * GW];
        const float w0 = in.rwkv_w0[layer * GW + c];
        for (int tt = 0; tt < 32; ++tt) { const int t = th * 32 + tt; float wl = w0;
#pragma unroll
            for (int j4 = 0; j4 < 16; ++j4) { const f32x4 sw = *(const LAS f32x4*)(SW + t * 64 + 4 * j4);
#pragma unroll
                for (int e = 0; e < 4; ++e) wl += sw[e] * wu[4 * j4 + e]; }
            const float w = -softplusf_(-wl) - 0.5f;
            const float lw = -__expf(w); run += lw;
            CUMo[(size_t)(m0 + t) * GW + c] = lw; } }
      asm volatile("" ::: "memory");
      { const float* aup = in.rwkv_a_up + (size_t)layer * 64 * GW + c;
        float au[64];
#pragma unroll
        for (int j = 0; j < 64; ++j) au[j] = aup[j * GW];
        const float a0 = in.rwkv_a0[layer * GW + c];
        for (int tt = 0; tt < 32; ++tt) { const int t = th * 32 + tt; float al = a0;
#pragma unroll
            for (int j4 = 0; j4 < 16; ++j4) { const f32x4 sa = *(const LAS f32x4*)(SA + t * 64 + 4 * j4);
#pragma unroll
                for (int e = 0; e < 4; ++e) al += sa[e] * au[4 * j4 + e]; }
            AV[(size_t)(m0 + t) * GW + c] = sigmoidf_(al); } }
      if (th == 0) HT[c] = run;
      __syncthreads();
      float acc = (th == 1) ? HT[c] : 0.f;
      for (int tt = 0; tt < 32; ++tt) { const int t = th * 32 + tt; const float lw = CUMo[(size_t)(m0 + t) * GW + c]; CUMPo[(size_t)(m0 + t) * GW + c] = acc; acc += lw; CUMo[(size_t)(m0 + t) * GW + c] = acc; } }
    __syncthreads();
}

__device__ __forceinline__ void mixopt_rwkv(const Inputs& in, const int layer, const bf16* __restrict__ PROJ, const float* __restrict__ CUMg, const float* __restrict__ CUMPg, const float* __restrict__ AV, bf16* __restrict__ Yg,
                                            LAS unsigned char* L, const int b, const int h, const int tid) {
    const int lane0 = tid & 63, wave = __builtin_amdgcn_readfirstlane(tid >> 6), w4 = wave & 3;
    const bool act = wave < 4;
    LAS bf16* AT = (LAS bf16*)L; LAS bf16* RT = (LAS bf16*)(L + 9216); LAS bf16* BL = (LAS bf16*)(L + 18432); LAS bf16* KL = (LAS bf16*)(L + 27648);
    LAS bf16* BTT = (LAS bf16*)(L + 36864); LAS bf16* KTT = (LAS bf16*)(L + 46080); LAS bf16* VT = (LAS bf16*)(L + 55296); LAS bf16* ZT = (LAS bf16*)(L + 64512);
    LAS bf16* AMT = (LAS bf16*)(L + 73728); LAS bf16* RHST = (LAS bf16*)(L + 82944); LAS float* AD = (LAS float*)(L + 92160); LAS bf16* DT = (LAS bf16*)(L + 96256);
    LAS float* QTOT = (LAS float*)(L + 98304); LAS float* ELAST = (LAS float*)(L + 99328); LAS float* BON = (LAS float*)(L + 99584);
    LAS bf16* SAT = AT;
    const bf16* P = PROJ + (size_t)b * SEQ * NP; bf16* Yb = Yg + (size_t)b * SEQ * DM;
    const float* CUMb = CUMg + (size_t)b * SEQ * GW; const float* CUMPb = CUMPg + (size_t)b * SEQ * GW; const float* AVb = AV + (size_t)b * SEQ * GW;
    const int c0 = h * 64 + lane0;
    const float* mu = in.rwkv_mu + (size_t)layer * 896;
    const float mu_r = mu[c0], mu_k = mu[256 + c0], mu_v = mu[512 + c0];
    const float kkc = in.rwkv_k_k[layer * GW + c0], kac = in.rwkv_k_a[layer * GW + c0], rkc = in.rwkv_r_k[layer * GW + c0];
    f32x4 zs[4];
#pragma unroll
    for (int n = 0; n < 4; ++n) zs[n] = zero4();
    LAS unsigned char* RAWT = L + 73728; LAS float* CMT = (LAS float*)(L + 99840); LAS float* AVT = (LAS float*)(L + 116480);
    v4u st[16];
    auto stage_load = [&](int ch, int ht) {
#pragma unroll
        for (int i = 0; i < 7; ++i) { const int u = ht + 256 * i; const int row = u / 24, rem = u - row * 24, seg = rem >> 3, part = rem & 7; const int t = ch * 64 - 1 + row;
            st[i] = (u < 1560 && t >= 0) ? *(const v4u*)(P + (size_t)t * NP + C_RW_R + seg * 256 + h * 64 + part * 8) : (v4u){0u, 0u, 0u, 0u}; }
#pragma unroll
        for (int i = 0; i < 5; ++i) { const int u = ht + 256 * i; const int row = u >> 4, part = u & 15; const int t = ch * 64 - 1 + row;
            st[7 + i] = (u < 1040 && t >= 0) ? *(const v4u*)(CUMb + (size_t)t * GW + h * 64 + part * 4) : (v4u){0u, 0u, 0u, 0u}; }
#pragma unroll
        for (int i = 0; i < 4; ++i) { const int u = ht + 256 * i; const int row = u >> 4, part = u & 15; const int t = ch * 64 + row;
            st[12 + i] = *(const v4u*)(AVb + (size_t)t * GW + h * 64 + part * 4); }
    };
    auto stage_store = [&](int ht) {
#pragma unroll
        for (int i = 0; i < 7; ++i) { const int u = ht + 256 * i; const int row = u / 24, rem = u - row * 24; if (u < 1560) *(LAS v4u*)(RAWT + row * 384 + rem * 16) = st[i]; }
#pragma unroll
        for (int i = 0; i < 5; ++i) { const int u = ht + 256 * i; if (u < 1040) *(LAS v4u*)((LAS unsigned char*)CMT + u * 16) = st[7 + i]; }
#pragma unroll
        for (int i = 0; i < 4; ++i) { const int u = ht + 256 * i; *(LAS v4u*)((LAS unsigned char*)AVT + u * 16) = st[12 + i]; }
    };
    if (!act) { const int ht = opaque_i(tid - 256); stage_load(0, ht); stage_store(ht); }
    WG_BAR();
    for (int ch = 0; ch < SEQ / 64; ++ch) {
        if (act) { const int lane = opaque_i(lane0), r = lane & 15, q = lane >> 4;
            float rs[16], k2[16], kkv[16], tv[16];
            { const LAS bf16* rw = (const LAS bf16*)RAWT + (16 * w4) * 192 + lane;
              float pr = bf2f(rw[0]), pk = bf2f(rw[64]), pv = bf2f(rw[128]);
#pragma unroll
              for (int i = 0; i < 16; ++i) { const float xr = bf2f(rw[(i + 1) * 192]), xk = bf2f(rw[(i + 1) * 192 + 64]), xv = bf2f(rw[(i + 1) * 192 + 128]);
                  const float av = AVT[(16 * w4 + i) * 64 + lane];
                  rs[i] = xr + (pr - xr) * mu_r; const float ks = xk + (pk - xk) * mu_k; tv[i] = xv + (pv - xv) * mu_v;
                  kkv[i] = ks * kkc; k2[i] = ks * (1.f + (av - 1.f) * kac); pr = xr; pk = xk; pv = xv; } }
            ssd_pack16(VT + lane * LS + 16 * w4, tv);
            { float sq[16];
#pragma unroll
              for (int i = 0; i < 16; ++i) sq[i] = kkv[i] * kkv[i];
              const float sred = tr_reduce16(sq, lane);
#pragma unroll
              for (int i = 0; i < 16; ++i) kkv[i] *= rsqrtf(rdlane(sred, 4 * i) + 1e-6f);
#pragma unroll
              for (int i = 0; i < 16; ++i) sq[i] = rs[i] * k2[i] * rkc;
              const float bred = tr_reduce16(sq, lane);
              if ((lane & 3) == 0) BON[16 * w4 + (lane >> 2)] = bred; }
#pragma unroll
            for (int i = 0; i < 16; ++i) { const float cum = CMT[(16 * w4 + i + 1) * 64 + lane]; const int t = 16 * w4 + i;
                const float en = __expf(-cum); const float cump = (i == 0 && w4 == 0) ? 0.f : CMT[(16 * w4 + i) * 64 + lane];
                AT[t * LS + lane] = cvt_bf16(-kkv[i] * __expf(cump));
                RT[t * LS + lane] = cvt_bf16(rs[i] * __expf(cum));
                kkv[i] = kkv[i] * AVT[(16 * w4 + i) * 64 + lane] * en; k2[i] = k2[i] * en;
                BL[t * LS + lane] = cvt_bf16(kkv[i]); KL[t * LS + lane] = cvt_bf16(k2[i]); }
            ssd_pack16(BTT + lane * LS + 16 * w4, kkv);
            ssd_pack16(KTT + lane * LS + 16 * w4, k2);
            if (w4 == 3) ELAST[lane] = __expf(CMT[64 * 64 + lane]);
#pragma unroll
            for (int n = 0; n < 4; ++n) st4(ZT, LS, 16 * n + r, 16 * w4 + 4 * q, zs[n]);
        }
        WG_BAR();
        if (!act && ch + 1 < SEQ / 64) stage_load(ch + 1, opaque_i(tid - 256));
        const int m = w4;
        if (act) { const int lane = opaque_i(lane0), r = lane & 15, q = lane >> 4;
            f32x4 Aak[4];
            bf16x8 aa[2];
#pragma unroll
            for (int k = 0; k < 2; ++k) aa[k] = ld_frag(AT, LS, 16 * m + r, 32 * k, q);
#pragma unroll
            for (int n = 0; n < 4; ++n) { Aak[n] = zero4(); if (n <= m) {
                f32x4 ab = zero4();
#pragma unroll
                for (int k = 0; k < 2; ++k) { const bf16x8 fb = ld_frag(BL, LS, 16 * n + r, 32 * k, q), fk = ld_frag(KL, LS, 16 * n + r, 32 * k, q);
                    ab = MFMA16(aa[k], fb, ab);
                    Aak[n] = MFMA16(fk, aa[k], Aak[n]); }
                f32x4 av;
#pragma unroll
                for (int i = 0; i < 4; ++i) { const bool keep = (n < m) || (r < 4 * q + i); av[i] = keep ? -ab[i] : 0.f; }
                st4(AMT, LS, 16 * n + r, 16 * m + 4 * q, av);
                if (n == m) {
#pragma unroll
                    for (int i = 0; i < 4; ++i) AD[m * 256 + (4 * q + i) * 16 + r] = av[i];
#pragma unroll
                    for (int i = 0; i < 4; ++i) { const bool strict = (4 * q + i < r); Aak[n][i] = strict ? Aak[n][i] : 0.f; } }
            } }
            const bf16x8 p0 = pack_frag(Aak[0], Aak[1]), p1 = pack_frag(Aak[2], Aak[3]);
#pragma unroll
            for (int nv = 0; nv < 4; ++nv) { f32x4 rh = zero4();
#pragma unroll
                for (int k = 0; k < 2; ++k) rh = MFMA16(aa[k], ld_frag(ZT, LS, 16 * nv + r, 32 * k, q), rh);
                rh = MFMA16(p0, ld_frag_perm(VT, LS, 16 * nv + r, 0, q), rh);
                if (m >= 2) rh = MFMA16(p1, ld_frag_perm(VT, LS, 16 * nv + r, 32, q), rh);
                st4(RHST, LS, 16 * nv + r, 16 * m + 4 * q, rh); }
        }
        WG_BAR();
        if (act) { const int lane = opaque_i(lane0), r = lane & 15, q = lane >> 4;
            diag_inverse(AD, DT, lane);
            asm volatile("s_waitcnt lgkmcnt(0)" ::: "memory");
            f32x4 Tm[4];
            tri_inverse_row(AMT, DT, m, r, q, Tm);
            const bf16x8 t0 = pack_frag(Tm[0], Tm[1]), t1 = pack_frag(Tm[2], Tm[3]);
#pragma unroll
            for (int nv = 0; nv < 4; ++nv) { f32x4 sa = zero4();
                sa = MFMA16(t0, ld_frag_perm(RHST, LS, 16 * nv + r, 0, q), sa);
                if (m >= 2) sa = MFMA16(t1, ld_frag_perm(RHST, LS, 16 * nv + r, 32, q), sa);
                st4(SAT, LS, 16 * nv + r, 16 * m + 4 * q, sa); }
        }
        WG_BAR();
        if (!act && ch + 1 < SEQ / 64) stage_store(opaque_i(tid - 256));
        if (act) { const int lane = opaque_i(lane0), r = lane & 15, q = lane >> 4;
            f32x4 O[4];
            bf16x8 ar[2];
#pragma unroll
            for (int k = 0; k < 2; ++k) ar[k] = ld_frag(RT, LS, 16 * m + r, 32 * k, q);
            f32x4 Arb[4], Ark[4];
#pragma unroll
            for (int n = 0; n < 4; ++n) { Arb[n] = zero4(); Ark[n] = zero4(); if (n <= m) {
#pragma unroll
                for (int k = 0; k < 2; ++k) { Arb[n] = MFMA16(ld_frag(BL, LS, 16 * n + r, 32 * k, q), ar[k], Arb[n]); Ark[n] = MFMA16(ld_frag(KL, LS, 16 * n + r, 32 * k, q), ar[k], Ark[n]); }
                if (n == m) {
#pragma unroll
                    for (int i = 0; i < 4; ++i) { const bool incl = (4 * q + i <= r); Arb[n][i] = incl ? Arb[n][i] : 0.f; Ark[n][i] = incl ? Ark[n][i] : 0.f; } } } }
            const bf16x8 b0 = pack_frag(Arb[0], Arb[1]), b1 = pack_frag(Arb[2], Arb[3]), k0 = pack_frag(Ark[0], Ark[1]), k1 = pack_frag(Ark[2], Ark[3]);
            float s1 = 0.f;
#pragma unroll
            for (int nv = 0; nv < 4; ++nv) { O[nv] = zero4();
#pragma unroll
                for (int k = 0; k < 2; ++k) O[nv] = MFMA16(ld_frag(ZT, LS, 16 * nv + r, 32 * k, q), ar[k], O[nv]);
                O[nv] = MFMA16(ld_frag_perm(SAT, LS, 16 * nv + r, 0, q), b0, O[nv]);
                O[nv] = MFMA16(ld_frag_perm(VT, LS, 16 * nv + r, 0, q), k0, O[nv]);
                if (m >= 2) { O[nv] = MFMA16(ld_frag_perm(SAT, LS, 16 * nv + r, 32, q), b1, O[nv]); O[nv] = MFMA16(ld_frag_perm(VT, LS, 16 * nv + r, 32, q), k1, O[nv]); }
                s1 += (O[nv][0] + O[nv][1]) + (O[nv][2] + O[nv][3]); }
            s1 += __shfl_xor(s1, 16); s1 += __shfl_xor(s1, 32);
            const float mean = s1 * (1.f / 64.f); float s2 = 0.f;
#pragma unroll
            for (int nv = 0; nv < 4; ++nv) { O[nv] = O[nv] - mean; s2 += (O[nv][0] * O[nv][0] + O[nv][1] * O[nv][1]) + (O[nv][2] * O[nv][2] + O[nv][3] * O[nv][3]); }
            s2 += __shfl_xor(s2, 16); s2 += __shfl_xor(s2, 32);
            const float rstd = rsqrtf(s2 * (1.f / 64.f) + 64e-5f);
            const int t = ch * 64 + 16 * m + r; const float bon = BON[16 * m + r];
#pragma unroll
            for (int nv = 0; nv < 4; ++nv) { const int dv0 = 16 * nv + 4 * q, cc = h * 64 + dv0;
                const f32x4 lw4 = *(const f32x4*)(in.rwkv_ln_w + layer * GW + cc); const f32x4 lb4 = *(const f32x4*)(in.rwkv_ln_b + layer * GW + cc);
                const v2u zr = *(const v2u*)(P + (size_t)t * NP + C_Z + 768 + cc);
                const float z0 = __builtin_bit_cast(float, zr.x << 16), z1 = __builtin_bit_cast(float, zr.x & 0xffff0000u), z2 = __builtin_bit_cast(float, zr.y << 16), z3 = __builtin_bit_cast(float, zr.y & 0xffff0000u);
                const float v0 = bf2f(VT[(dv0 + 0) * LS + 16 * m + r]), v1 = bf2f(VT[(dv0 + 1) * LS + 16 * m + r]), v2 = bf2f(VT[(dv0 + 2) * LS + 16 * m + r]), v3 = bf2f(VT[(dv0 + 3) * LS + 16 * m + r]);
                v2u o; o.x = pk_bf16((O[nv][0] * rstd * lw4[0] + lb4[0] + bon * v0) * siluf_(z0), (O[nv][1] * rstd * lw4[1] + lb4[1] + bon * v1) * siluf_(z1));
                o.y = pk_bf16((O[nv][2] * rstd * lw4[2] + lb4[2] + bon * v2) * siluf_(z2), (O[nv][3] * rstd * lw4[3] + lb4[3] + bon * v3) * siluf_(z3));
                *(v2u*)(Yb + (size_t)t * DM + 768 + cc) = o; }
            const f32x4 el = *(const LAS f32x4*)(ELAST + 16 * w4 + 4 * q);
            bf16x8 ab2[2], ak2[2];
#pragma unroll
            for (int k = 0; k < 2; ++k) { ab2[k] = ld_frag(BTT, LS, 16 * w4 + r, 32 * k, q); ak2[k] = ld_frag(KTT, LS, 16 * w4 + r, 32 * k, q); }
#pragma unroll
            for (int n = 0; n < 4; ++n) {
#pragma unroll
                for (int k = 0; k < 2; ++k) { zs[n] = MFMA16(ab2[k], ld_frag(SAT, LS, 16 * n + r, 32 * k, q), zs[n]); zs[n] = MFMA16(ak2[k], ld_frag(VT, LS, 16 * n + r, 32 * k, q), zs[n]); }
                zs[n] = zs[n] * el; }
        }
        WG_BAR();
    }
}

#ifndef MK_MASK
#define MK_MASK 31
#endif
#ifndef REP_MASK
#define REP_MASK 0
#endif

constexpr int NWAVES = 8;
constexpr size_t MiB = 1u << 20;
constexpr size_t WS_CTL = 0, CTL_ZERO_BYTES = 64 * 1024;
constexpr size_t WS_WIN = 1 * MiB;
constexpr size_t WS_WOUT = 18 * MiB;
constexpr size_t WS_U = 22 * MiB;
constexpr size_t WS_PROJ = 54 * MiB;
constexpr size_t WS_OUT = 190 * MiB;
constexpr int CW_BAR = 4096;
constexpr int LDSCTL_OFF = 147456, MISC_OFF = LDSCTL_OFF + 320, LDS_BYTES = 148480;

struct Args { Inputs in; float* out; unsigned char* ws; };
__device__ __forceinline__ int opaque_v(int v) { asm volatile("" : "+v"(v)); return v; }

__device__ __forceinline__ void wprep_load(const float* __restrict__ W, int N, int use_perm, int n0, int k0, int tid, LAS float* tile) {
    const int nn = tid & 31, kq = tid >> 5;
    const int oc = use_perm ? old_col(n0 + nn) : (n0 + nn);
#pragma unroll
    for (int i = 0; i < 8; ++i) { const int kk = kq + 8 * i; tile[kk * 33 + nn] = (oc >= 0) ? W[(size_t)(k0 + kk) * N + oc] : 0.f; }
}
__device__ __forceinline__ void wprep_store(bf16* __restrict__ WT, int K, int n0, int k0, int tid, const LAS float* tile) {
    const int n = tid >> 3, kc = (tid & 7) * 8;
    uint4 o;
    o.x = f2bf(tile[(kc + 0) * 33 + n]) | (f2bf(tile[(kc + 1) * 33 + n]) << 16);
    o.y = f2bf(tile[(kc + 2) * 33 + n]) | (f2bf(tile[(kc + 3) * 33 + n]) << 16);
    o.z = f2bf(tile[(kc + 4) * 33 + n]) | (f2bf(tile[(kc + 5) * 33 + n]) << 16);
    o.w = f2bf(tile[(kc + 6) * 33 + n]) | (f2bf(tile[(kc + 7) * 33 + n]) << 16);
    *(uint4*)(WT + (size_t)(n0 + n) * K + k0 + kc) = o;
}

__device__ __forceinline__ void rmsnorm_row_bf16(const float* __restrict__ hrow, const float* __restrict__ g, bf16* __restrict__ urow, int lane) {
    const float4* xr = (const float4*)hrow + lane; const float4* gr = (const float4*)g + lane;
    float4 v[4]; float s = 0.f;
#pragma unroll
    for (int j = 0; j < 4; ++j) { v[j] = xr[64 * j]; s += (v[j].x * v[j].x + v[j].y * v[j].y) + (v[j].z * v[j].z + v[j].w * v[j].w); }
    const float r = rsqrtf(wave_sum(s) * (1.f / DM) + 1e-6f);
    uint2* o8 = (uint2*)urow + lane;
#pragma unroll
    for (int j = 0; j < 4; ++j) { const float4 gg = gr[64 * j]; uint2 o;
        o.x = f2bf(v[j].x * r * gg.x) | (f2bf(v[j].y * r * gg.y) << 16); o.y = f2bf(v[j].z * r * gg.z) | (f2bf(v[j].w * r * gg.w) << 16); o8[64 * j] = o; }
}

__device__ __forceinline__ void post_row(const float* hrow, const float* __restrict__ orow_, const float* __restrict__ g, float* hnew, const float* __restrict__ g2, bf16* __restrict__ urow, int lane) {
    const float4* orow = (const float4*)orow_ + lane; const float4* hr = (const float4*)hrow + lane; const float4* gr = (const float4*)g + lane;
    float4 v[4]; float s = 0.f;
#pragma unroll
    for (int j = 0; j < 4; ++j) { v[j] = orow[64 * j]; s += (v[j].x * v[j].x + v[j].y * v[j].y) + (v[j].z * v[j].z + v[j].w * v[j].w); }
    const float r = rsqrtf(wave_sum(s) * (1.f / DM) + 1e-6f);
    float4* o = (float4*)hnew + lane; float s2 = 0.f;
#pragma unroll
    for (int j = 0; j < 4; ++j) { const float4 gg = gr[64 * j]; const float4 hh = hr[64 * j]; float4 w;
        w.x = hh.x + v[j].x * r * gg.x; w.y = hh.y + v[j].y * r * gg.y; w.z = hh.z + v[j].z * r * gg.z; w.w = hh.w + v[j].w * r * gg.w; o[64 * j] = w; v[j] = w;
        s2 += (w.x * w.x + w.y * w.y) + (w.z * w.z + w.w * w.w); }
    if (g2) {
        const float r2 = rsqrtf(wave_sum(s2) * (1.f / DM) + 1e-6f);
        const float4* g2r = (const float4*)g2 + lane; uint2* o8 = (uint2*)urow + lane;
#pragma unroll
        for (int j = 0; j < 4; ++j) { const float4 gg = g2r[64 * j]; uint2 q;
            q.x = f2bf(v[j].x * r2 * gg.x) | (f2bf(v[j].y * r2 * gg.y) << 16); q.y = f2bf(v[j].z * r2 * gg.z) | (f2bf(v[j].w * r2 * gg.w) << 16); o8[64 * j] = q; }
    }
}

#define CAS __attribute__((address_space(4)))
#define GRID_BAR() do { const CAS Args* apb = (const CAS Args*)__builtin_amdgcn_kernarg_segment_ptr(); asm volatile("" : "+s"(apb)); \
    XcdBarrier bq; bq.bar = (unsigned*)((gu32*)(apb->ws + WS_CTL) + CW_BAR); bq.x = xb_xcc_id(); bq.st = (volatile LAS unsigned*)(lds + MISC_OFF) + 8; \
    int wv_ = wave_k; asm volatile("" : "+s"(wv_)); xcd_barrier(bq, (wv_ << 6) | fresh_lane()); } while (0)
#define PHASE_LOCALS() \
    const CAS Args* ap = (const CAS Args*)__builtin_amdgcn_kernarg_segment_ptr(); asm volatile("" : "+s"(ap)); \
    Inputs in; in.x = ap->in.x; in.pre_norm_g = ap->in.pre_norm_g; in.w_in = ap->in.w_in; in.hgrn_lb = ap->in.hgrn_lb; in.hgrn_norm_g = ap->in.hgrn_norm_g; in.gdn_conv_w = ap->in.gdn_conv_w; in.gdn_a_log = ap->in.gdn_a_log; in.gdn_dt_bias = ap->in.gdn_dt_bias; in.gdn_norm_g = ap->in.gdn_norm_g; in.ssm_conv_w = ap->in.ssm_conv_w; in.ssm_conv_b = ap->in.ssm_conv_b; in.ssm_a_log = ap->in.ssm_a_log; in.ssm_dt_bias = ap->in.ssm_dt_bias; in.ssm_d = ap->in.ssm_d; in.ssm_norm_g = ap->in.ssm_norm_g; in.rwkv_mu = ap->in.rwkv_mu; in.rwkv_w0 = ap->in.rwkv_w0; in.rwkv_w_up = ap->in.rwkv_w_up; in.rwkv_a0 = ap->in.rwkv_a0; in.rwkv_a_up = ap->in.rwkv_a_up; in.rwkv_k_k = ap->in.rwkv_k_k; in.rwkv_k_a = ap->in.rwkv_k_a; in.rwkv_r_k = ap->in.rwkv_r_k; in.rwkv_ln_w = ap->in.rwkv_ln_w; in.rwkv_ln_b = ap->in.rwkv_ln_b; in.w_out = ap->in.w_out; in.post_norm_g = ap->in.post_norm_g; \
    unsigned char* ws = ap->ws; float* hout = ap->out; \
    int bx = blockIdx.x; asm volatile("" : "+s"(bx)); int G = gridDim.x; asm volatile("" : "+s"(G)); \
    const int lane = fresh_lane(); int wave = wave_k; asm volatile("" : "+s"(wave)); const int tid = (wave << 6) | lane; \
    bf16* Win = (bf16*)(ws + WS_WIN); bf16* Wout = (bf16*)(ws + WS_WOUT); bf16* U = (bf16*)(ws + WS_U); bf16* PROJ = (bf16*)(ws + WS_PROJ); float* OUT = (float*)(ws + WS_OUT); \
    (void)Win; (void)Wout; (void)U; (void)PROJ; (void)OUT; (void)hout; (void)bx; (void)G; (void)lane; (void)wave;

__global__ void __launch_bounds__(NWAVES * 64, 2) mk_fwd(Args args) {
    extern __shared__ __attribute__((aligned(16))) unsigned char lds_raw[];
    LAS unsigned char* lds = (LAS unsigned char*)lds_raw;
    volatile LAS unsigned* MISC = (volatile LAS unsigned*)(lds + MISC_OFF);
    const int wave_k = __builtin_amdgcn_readfirstlane((int)threadIdx.x >> 6);
    for (int u = threadIdx.x; u < (LDS_BYTES - LDSCTL_OFF) / 4; u += NWAVES * 64) ((LAS unsigned*)(lds + LDSCTL_OFF))[u] = 0u;
    __syncthreads();
    (void)xcd_barrier_post((unsigned*)((gu32*)(args.ws + WS_CTL) + CW_BAR), MISC + 8, (int)threadIdx.x);

    {
        PHASE_LOCALS();
        const int half = tid >> 8, t256 = tid & 255;
        LAS float* tile = (LAS float*)(lds + half * 16384);
        constexpr int IT_IN = (NP / 32) * (DM / 64), IT_OUT = (DM / 32) * (DM / 64), IT_ALL = NLAYER * (IT_IN + IT_OUT);
        for (int it0 = bx * 2; it0 < IT_ALL; it0 += G * 2) {
            const int it = it0 + half; const bool act = it < IT_ALL;
            const float* W = nullptr; bf16* WT = nullptr; int N = 0, perm = 0, n0 = 0, k0 = 0;
            if (act) { int r = it; const int l = r / (IT_IN + IT_OUT); r -= l * (IT_IN + IT_OUT);
                if (r < IT_IN) { W = in.w_in + (size_t)l * DM * IN_COLS; N = IN_COLS; perm = 1; WT = Win + (size_t)l * NP * DM; n0 = (r % (NP / 32)) * 32; k0 = (r / (NP / 32)) * 64; }
                else { r -= IT_IN; W = in.w_out + (size_t)l * DM * DM; N = DM; perm = 0; WT = Wout + (size_t)l * DM * DM; n0 = (r % (DM / 32)) * 32; k0 = (r / (DM / 32)) * 64; }
                wprep_load(W, N, perm, n0, k0, t256, tile); }
            __syncthreads();
            if (act) wprep_store(WT, DM, n0, k0, t256, tile);
            __syncthreads();
        }
        for (int m = bx * NWAVES + wave; m < MTOK; m += G * NWAVES) rmsnorm_row_bf16(in.x + (size_t)m * DM, in.pre_norm_g, U + (size_t)m * DM, lane);
    }
    GRID_BAR();

#pragma unroll
    for (int l = 0; l < NLAYER; ++l) {
        { PHASE_LOCALS();
          pg8::Gemm g; g.A = U; g.Bt = Win + (size_t)l * NP * DM; g.M = MTOK; g.N = NP; g.K = DM;
          pg8::StaticOrder S; S.init(MTOK, NP, G, bx); S.wave_id = wave;
          pg8::EpiBf16<0> E; E.O = PROJ; E.ldc = NP; E.bias = nullptr; E.split_cols = 0; E.split_stride = 0;
          pg8::gemm_phase<pg8::EpiBf16<0>, pg8::StaticOrder, false>(lds, g, S, E, nullptr); }
        GRID_BAR();
        { PHASE_LOCALS();
          float* CUMW = OUT; float* CUMPW = OUT + (size_t)MTOK * GW; float* AVW = OUT + (size_t)2 * MTOK * GW;
          for (int rep = 0; rep < ((REP_MASK & 16) ? 2 : 1); ++rep) for (int blk = bx; blk < MTOK / 64; blk += G) { const int tid_l = opaque_v(tid); rwkv_pre_block(in, l, PROJ, CUMW, CUMPW, AVW, (LAS float*)lds, blk * 64, tid_l); } }
        GRID_BAR();
        { PHASE_LOCALS();
          const float* CUMW = OUT; const float* CUMPW = OUT + (size_t)MTOK * GW; const float* AVW = OUT + (size_t)2 * MTOK * GW;
          if (bx < 16) { int nrep = (REP_MASK & 1) ? 2 : 1; asm volatile("" : "+s"(nrep)); for (int rep = 0; rep < nrep; ++rep) mixopt_hgrn(in, l, PROJ, U, lds, (bx >> 1) & 7, bx & 1, (wave << 6) | fresh_lane()); }
          else if (bx < 32) { int nrep = (REP_MASK & 2) ? 2 : 1; asm volatile("" : "+s"(nrep)); for (int rep = 0; rep < nrep; ++rep) mixopt_gdn(in, l, PROJ, U, lds, (bx >> 1) & 7, bx & 1, (wave << 6) | fresh_lane()); }
          else if (bx < 48) { int nrep = (REP_MASK & 4) ? 2 : 1; asm volatile("" : "+s"(nrep)); for (int rep = 0; rep < nrep; ++rep) mixopt_ssd(in, l, PROJ, U, lds, (bx >> 1) & 7, bx & 1, (wave << 6) | fresh_lane()); }
          else if (bx < 80) { int nrep = (REP_MASK & 8) ? 2 : 1; asm volatile("" : "+s"(nrep)); for (int rep = 0; rep < nrep; ++rep) mixopt_rwkv(in, l, PROJ, CUMW, CUMPW, AVW, U, lds, (bx - 48) >> 2, (bx - 48) & 3, (wave << 6) | fresh_lane()); } }
        GRID_BAR();
        { PHASE_LOCALS();
          pg8::Gemm g; g.A = U; g.Bt = Wout + (size_t)l * DM * DM; g.M = MTOK; g.N = DM; g.K = DM;
          pg8::StaticOrder S; S.init(MTOK, DM, G, bx); S.wave_id = wave;
          pg8::EpiF32 E; E.C = OUT; E.ldc = DM; E.bias = nullptr;
          pg8::gemm_phase<pg8::EpiF32, pg8::StaticOrder, false>(lds, g, S, E, nullptr); }
        GRID_BAR();
        { PHASE_LOCALS();
          const float* hin = (l == 0) ? in.x : hout;
          for (int m = bx * NWAVES + wave; m < MTOK; m += G * NWAVES)
            post_row(hin + (size_t)m * DM, OUT + (size_t)m * DM, in.post_norm_g + (size_t)l * DM, hout + (size_t)m * DM,
                     (l + 1 < NLAYER) ? in.pre_norm_g + (size_t)(l + 1) * DM : nullptr, U + (size_t)m * DM, lane); }
        if (l + 1 < NLAYER) GRID_BAR();
    }
}

extern "C" void kernel_launch(void* const* d_in, const int* in_sizes, int n_in, void* d_out, int out_size, void* d_ws, size_t ws_size, hipStream_t stream) {
    static int grid = 0;
    if (grid == 0) {
        int dev = 0, cus = 0, per_cu = 0;
        if (hipGetDevice(&dev) != hipSuccess || hipDeviceGetAttribute(&cus, hipDeviceAttributeMultiprocessorCount, dev) != hipSuccess) { fprintf(stderr, "kernel_launch: device query failed\n"); grid = -1; return; }
        if (hipFuncSetAttribute((const void*)mk_fwd, hipFuncAttributeMaxDynamicSharedMemorySize, LDS_BYTES) != hipSuccess) { fprintf(stderr, "kernel_launch: hipFuncSetAttribute failed\n"); grid = -1; return; }
        if (hipOccupancyMaxActiveBlocksPerMultiprocessor(&per_cu, (const void*)mk_fwd, NWAVES * 64, LDS_BYTES) != hipSuccess || per_cu < 1)
            fprintf(stderr, "kernel_launch: note: occupancy query reports %d workgroups per CU\n", per_cu);
        (void)hipGetLastError();
        grid = cus;
    }
    if (grid < 0) return;
    if (hipMemsetAsync((char*)d_ws + WS_CTL, 0, CTL_ZERO_BYTES, stream) != hipSuccess) { fprintf(stderr, "kernel_launch: memset failed\n"); return; }
    Args a{};
    { const float** ip = (const float**)&a.in; for (int i = 0; i < 27; ++i) ip[i] = (const float*)d_in[i]; }
    a.out = (float*)d_out; a.ws = (unsigned char*)d_ws;
    hipLaunchKernelGGL(mk_fwd, dim3(grid), dim3(NWAVES * 64), LDS_BYTES, stream, a);
}
```

```cpp
#include <hip/hip_runtime.h>
#include <cstdio>
#include <cstdint>
#define REP_MASK 0
#define HWCVT 0
#define HWSITES 0
namespace pg8 {
#define PG8_LAS __attribute__((address_space(3)))
typedef unsigned short bf16_t;
typedef short bf16x8 __attribute__((ext_vector_type(8)));
typedef float f32x4 __attribute__((ext_vector_type(4)));
typedef unsigned u32x4 __attribute__((ext_vector_type(4)));
constexpr int BM = 256, BK = 64, HALF = 128, HTB = HALF * BK * 2  , STAGE_BYTES = 8 * HTB, NXCD = 8, WGM = 8;

__host__ __device__ __forceinline__ int lds_byte(int r, int c) { const int st = (r >> 4) * 2 + (c >> 5), rr = r & 15, cc = c & 31, ob = rr * 64 + cc * 2; return st * 1024 + (ob ^ (((ob >> 9) & 1) << 5)); }
__host__ __device__ __forceinline__ void stage_rc(int b, int& R, int& C) { const int st = b / 1024, sb = b % 1024, swz = sb ^ (((sb >> 9) & 1) << 5); R = (st >> 1) * 16 + swz / 64; C = (st & 1) * 32 + (swz % 64) / 2; }
__host__ __device__ __forceinline__ int perm32(int rho) { const int n = rho >> 4, i = rho & 15; return 8 * (i >> 2) + 4 * n + (i & 3); }

struct Unit { int pm, pn; };
struct Gemm { const bf16_t* A; const bf16_t* Bt; int M, N, K; };

struct StaticOrder {
    int nM, nN, nwg, G, c, wave_id;
    __host__ __device__ void init(int M, int N, int G_, int c_) { nM = M / BM; nN = N / BM; nwg = nM * nN; G = G_; c = c_; }
    __host__ __device__ bool next(int i, Unit& u) const {
        const long L = (long)i * G + c; if (L >= nwg) return false;
        int wgid = (int)L; { const int q = nwg / NXCD, r = nwg % NXCD, xcd = wgid % NXCD, off = wgid / NXCD; wgid = (xcd < r ? xcd * (q + 1) : r * (q + 1) + (xcd - r) * q) + off; }
        const int nig = WGM * nN, gid = wgid / nig, fm = gid * WGM, gsz = (nM - fm) < WGM ? (nM - fm) : WGM;
        u.pm = fm + ((wgid % nig) % gsz); u.pn = (wgid % nig) / gsz; return true;
    }
    __device__ __forceinline__ void a_ready(const Unit&) const {}
    __device__ __forceinline__ void done(const Unit&) const {}
};
__device__ __forceinline__ unsigned cvt_pk_bf16(float lo, float hi) { unsigned r; asm volatile("v_cvt_pk_bf16_f32 %0, %1, %2" : "=v"(r) : "v"(lo), "v"(hi)); return r; }
typedef float f32x2 __attribute__((ext_vector_type(2)));
__device__ __forceinline__ f32x2 gelu_pk(f32x2 v) {
    const f32x2 av = __builtin_elementwise_abs(v), d = av * 0.2316418882f + 1.0f;
    f32x2 t; t.x = __builtin_amdgcn_rcpf(d.x); t.y = __builtin_amdgcn_rcpf(d.y);
    f32x2 q = t * 0.5307027145f + (-0.7265760135f); q = q * t + 0.7107068705f; q = q * t + (-0.142248368f); q = q * t + 0.127414796f; q = q * t;
    const f32x2 s = (v * v) * (-0.72134752044f);
    f32x2 e; e.x = __builtin_amdgcn_exp2f(s.x); e.y = __builtin_amdgcn_exp2f(s.y);
    const f32x2 m = v * (q * e), r = v - m;
    f32x2 o; o.x = v.x < 0.f ? m.x : r.x; o.y = v.y < 0.f ? m.y : r.y; return o;
}

struct EpiF32 {
    static constexpr bool PERM = false, AFTER_DRAIN = false;
    float* C; int ldc; const float* bias;
    __device__ __forceinline__ void operator()(const f32x4 (&acc)[2][2][4][2], const Unit& u, int wr, int wc, int fr, int fq) const {
        const int row0 = u.pm * BM + wr * 64 + fr, col0 = u.pn * BM + wc * 32 + 4 * fq;
        f32x4 bv[2][2];
#pragma unroll
        for (int bj = 0; bj < 2; ++bj)
#pragma unroll
            for (int n = 0; n < 2; ++n) bv[bj][n] = bias ? *(const f32x4*)(bias + col0 + bj * HALF + n * 16) : (f32x4){0.f, 0.f, 0.f, 0.f};
#pragma unroll
        for (int ai = 0; ai < 2; ++ai)
#pragma unroll
            for (int m = 0; m < 4; ++m) { float* rowp = C + (size_t)(row0 + ai * HALF + m * 16) * ldc + col0;
#pragma unroll
                for (int bj = 0; bj < 2; ++bj)
#pragma unroll
                    for (int n = 0; n < 2; ++n) *(f32x4*)(rowp + bj * HALF + n * 16) = acc[ai][bj][m][n] + bv[bj][n]; }
    }
};
template <int ACT  > struct EpiBf16 {
    static constexpr bool PERM = true, AFTER_DRAIN = false;
    bf16_t* O; int ldc; const float* bias; int split_cols; size_t split_stride;
    __device__ __forceinline__ void operator()(const f32x4 (&acc)[2][2][4][2], const Unit& u, int wr, int wc, int fr, int fq) const {
        const int row0 = u.pm * BM + wr * 64 + fr; int colt = u.pn * BM; bf16_t* base = O;
        if (split_cols) { const int t = colt / split_cols; base += (size_t)t * split_stride; colt -= t * split_cols; }
        const int col0 = colt + wc * 32 + 8 * fq, bcol0 = u.pn * BM + wc * 32 + 8 * fq;
        f32x4 bv[2][2];
#pragma unroll
        for (int bj = 0; bj < 2; ++bj)
#pragma unroll
            for (int n = 0; n < 2; ++n) bv[bj][n] = bias ? *(const f32x4*)(bias + bcol0 + bj * HALF + 4 * n) : (f32x4){0.f, 0.f, 0.f, 0.f};
#pragma unroll
        for (int ai = 0; ai < 2; ++ai)
#pragma unroll
            for (int m = 0; m < 4; ++m) { bf16_t* rowp = base + (size_t)(row0 + ai * HALF + m * 16) * ldc + col0;
#pragma unroll
                for (int bj = 0; bj < 2; ++bj) { f32x4 v0 = acc[ai][bj][m][0] + bv[bj][0], v1 = acc[ai][bj][m][1] + bv[bj][1];
                    if (ACT == 1) { f32x2 a = gelu_pk((f32x2){v0[0], v0[1]}), b = gelu_pk((f32x2){v0[2], v0[3]}), c = gelu_pk((f32x2){v1[0], v1[1]}), d = gelu_pk((f32x2){v1[2], v1[3]});
                        v0 = (f32x4){a.x, a.y, b.x, b.y}; v1 = (f32x4){c.x, c.y, d.x, d.y}; }
                    if (ACT == 2) {
#pragma unroll
                        for (int j = 0; j < 4; ++j) { v0[j] = 0.5f * v0[j] * (1.0f + erff(v0[j] * 0.70710678f)); v1[j] = 0.5f * v1[j] * (1.0f + erff(v1[j] * 0.70710678f)); } }
                    u32x4 w; w.x = cvt_pk_bf16(v0[0], v0[1]); w.y = cvt_pk_bf16(v0[2], v0[3]); w.z = cvt_pk_bf16(v1[0], v1[1]); w.w = cvt_pk_bf16(v1[2], v1[3]);
                    *(u32x4*)(rowp + bj * HALF) = w; } }
    }
};
__device__ __forceinline__ int fresh_lane_pg8() { unsigned m_ = ~0u; asm volatile("" : "+s"(m_)); return (int)__builtin_amdgcn_mbcnt_hi(m_, __builtin_amdgcn_mbcnt_lo(m_, 0u)); }
template <class Epi, class Sched, bool STAMP = false>
__device__ __forceinline__ void gemm_phase(PG8_LAS unsigned char* lds, const Gemm g, const Sched& S, const Epi& E, unsigned long long* stamps) {
    int tid_op_ = (S.wave_id << 6) | fresh_lane_pg8(); const int tid = tid_op_, wid = __builtin_amdgcn_readfirstlane(tid >> 6), lane = tid & 63, wr = wid >> 2, wc = wid & 3, fr = lane & 15, fq = lane >> 4;
    const int K = g.K, nt = K / BK;
    int ts_lo = 0, ts_hi = 0, nts = 0; const unsigned long long rt_entry = STAMP ? (unsigned long long)wall_clock64() : 0ull;
#define PG8_STAMP() do { if (STAMP && wid == 0 && nts < 64) { const unsigned long long _c = (unsigned long long)clock64(); \
        ts_lo = (lane == nts) ? (int)(unsigned)_c : ts_lo; ts_hi = (lane == nts) ? (int)(unsigned)(_c >> 32) : ts_hi; ++nts; } } while (0)
    PG8_STAMP();
    unsigned voffA[2], voffB[2];
#pragma unroll
    for (int i = 0; i < 2; ++i) { int R, C; stage_rc(tid * 16 + i * 8192, R, C); const int Rb = Epi::PERM ? ((R & ~31) + perm32(R & 31)) : R;
        voffA[i] = (unsigned)(R * K + C) * 2u; voffB[i] = (unsigned)(Rb * K + C) * 2u; }
    const size_t kstep = (size_t)(BK * 2);
    const size_t hstep = (size_t)HALF * K * 2;
    const size_t tstep = 2 * hstep;
    const unsigned ldsw = (unsigned)wid * 1024u;
    const int aoff = lds_byte(wr * 64 + fr, fq * 8), boff = lds_byte(wc * 32 + fr, fq * 8);
#define PG8_SA(b, h) (((b) * 2 + (h)) * HTB)
#define PG8_SB(b, h) ((4 + (b) * 2 + (h)) * HTB)
#define PG8_STAGE(bufoff, gbase, voff) do { _Pragma("unroll") for (int _i = 0; _i < 2; ++_i) \
        __builtin_amdgcn_global_load_lds((const unsigned*)((const char*)(gbase) + (voff)[_i]), (PG8_LAS unsigned*)(lds + (bufoff) + ldsw + _i * 8192), 16, 0, 0); } while (0)
#define PG8_LDA(dst, b, h) do { _Pragma("unroll") for (int m = 0; m < 4; ++m) _Pragma("unroll") for (int k = 0; k < 2; ++k) dst[m][k] = *(const PG8_LAS bf16x8*)(lds + PG8_SA(b, h) + aoff + m * 2048 + k * 1024); } while (0)
#define PG8_LDB(dst, b, h) do { _Pragma("unroll") for (int n = 0; n < 2; ++n) _Pragma("unroll") for (int k = 0; k < 2; ++k) dst[n][k] = *(const PG8_LAS bf16x8*)(lds + PG8_SB(b, h) + boff + n * 2048 + k * 1024); } while (0)
#define PG8_MMA(ai, bj, At, Bt) do { __builtin_amdgcn_s_setprio(1); _Pragma("unroll") for (int m = 0; m < 4; ++m) _Pragma("unroll") for (int n = 0; n < 2; ++n) _Pragma("unroll") for (int k = 0; k < 2; ++k) \
        acc[ai][bj][m][n] = __builtin_amdgcn_mfma_f32_16x16x32_bf16(Bt[n][k], At[m][k], acc[ai][bj][m][n], 0, 0, 0); __builtin_amdgcn_s_setprio(0); } while (0)
#define PG8_WAIT_V(n) asm volatile("s_waitcnt vmcnt(" #n ")" ::: "memory")
#define PG8_WAIT_L(n) asm volatile("s_waitcnt lgkmcnt(" #n ")" ::: "memory")
#define PG8_BAR __builtin_amdgcn_s_barrier()
#define PG8_SCHED __builtin_amdgcn_sched_barrier(0)
    Unit cur, nxt; int ui = 0;
    if (!S.next(0, cur)) return;
    f32x4 acc[2][2][4][2];
#pragma unroll
    for (int a = 0; a < 2; ++a)
#pragma unroll
        for (int b = 0; b < 2; ++b)
#pragma unroll
            for (int m = 0; m < 4; ++m)
#pragma unroll
                for (int n = 0; n < 2; ++n) acc[a][b][m][n] = (f32x4){0.f, 0.f, 0.f, 0.f};
    bf16x8 At[4][2], B0[2][2], B1[2][2];
    const char* cA = (const char*)g.A + (size_t)cur.pm * tstep; const char* cB = (const char*)g.Bt + (size_t)cur.pn * tstep;
    S.a_ready(cur);
    PG8_STAGE(PG8_SB(0, 0), cB, voffB); PG8_STAGE(PG8_SA(0, 0), cA, voffA); PG8_STAGE(PG8_SB(0, 1), cB + hstep, voffB); PG8_STAGE(PG8_SA(0, 1), cA + hstep, voffA);
    if (wr == 1) PG8_BAR;
    PG8_WAIT_V(4); PG8_BAR;
    PG8_STAGE(PG8_SB(1, 0), cB + kstep, voffB); PG8_STAGE(PG8_SA(1, 0), cA + kstep, voffA); PG8_STAGE(PG8_SB(1, 1), cB + hstep + kstep, voffB);
    PG8_WAIT_V(6); PG8_BAR;
    PG8_STAMP();
    for (;;) {
        const bool has_next = S.next(ui + 1, nxt);
        const char* nA = has_next ? (const char*)g.A + (size_t)nxt.pm * tstep : cA; const char* nB = has_next ? (const char*)g.Bt + (size_t)nxt.pn * tstep : cB;
        for (int t = 0; t < nt; t += 2) {
            const bool last = (t == nt - 2);
            const char* a1 = cA + (size_t)(t + 1) * kstep;
            const char* a2 = last ? nA : cA + (size_t)(t + 2) * kstep; const char* b2 = last ? nB : cB + (size_t)(t + 2) * kstep;
            const char* a3 = a2 + kstep; const char* b3 = b2 + kstep;
            if (last && has_next) S.a_ready(nxt);
            PG8_LDB(B0, 0, 0); PG8_SCHED; PG8_LDA(At, 0, 0); PG8_STAGE(PG8_SA(1, 1), a1 + hstep, voffA);
            PG8_WAIT_L(8); PG8_BAR; PG8_WAIT_L(0); PG8_MMA(0, 0, At, B0); PG8_BAR; PG8_SCHED;
            PG8_LDB(B1, 0, 1); PG8_STAGE(PG8_SB(0, 0), b2, voffB);
            PG8_BAR; PG8_WAIT_L(0); PG8_MMA(0, 1, At, B1); PG8_BAR;
            PG8_LDA(At, 0, 1); PG8_STAGE(PG8_SA(0, 0), a2, voffA);
            PG8_BAR; PG8_WAIT_L(0); PG8_MMA(1, 0, At, B0); PG8_BAR; PG8_SCHED;
            PG8_STAGE(PG8_SB(0, 1), b2 + hstep, voffB);
            PG8_WAIT_V(6); PG8_BAR; PG8_MMA(1, 1, At, B1); PG8_BAR;
            PG8_LDB(B0, 1, 0); PG8_SCHED; PG8_LDA(At, 1, 0); PG8_STAGE(PG8_SA(0, 1), a2 + hstep, voffA);
            PG8_WAIT_L(8); PG8_BAR; PG8_WAIT_L(0); PG8_MMA(0, 0, At, B0); PG8_BAR; PG8_SCHED;
            PG8_LDB(B1, 1, 1); PG8_STAGE(PG8_SB(1, 0), b3, voffB);
            PG8_BAR; PG8_WAIT_L(0); PG8_MMA(0, 1, At, B1); PG8_BAR;
            PG8_LDA(At, 1, 1); PG8_STAGE(PG8_SA(1, 0), a3, voffA);
            PG8_BAR; PG8_WAIT_L(0); PG8_MMA(1, 0, At, B0); PG8_BAR; PG8_SCHED;
            PG8_STAGE(PG8_SB(1, 1), b3 + hstep, voffB);
            PG8_WAIT_V(6); PG8_BAR; PG8_MMA(1, 1, At, B1); PG8_BAR;
        }
        PG8_STAMP();
        if constexpr (!Epi::AFTER_DRAIN) { E(acc, cur, wr, wc, fr, fq); S.done(cur); }
        PG8_STAMP();
        if (!has_next) break;
#pragma unroll
        for (int a = 0; a < 2; ++a)
#pragma unroll
            for (int b = 0; b < 2; ++b)
#pragma unroll
                for (int m = 0; m < 4; ++m)
#pragma unroll
                    for (int n = 0; n < 2; ++n) acc[a][b][m][n] = (f32x4){0.f, 0.f, 0.f, 0.f};
        cur = nxt; cA = nA; cB = nB; ++ui;
    }
    PG8_WAIT_V(0);
    if (wr == 0) PG8_BAR;
    PG8_BAR;
    if constexpr (Epi::AFTER_DRAIN) { E.fused(acc, cur, wr, wc, fr, fq, lds, wid, lane); S.done(cur); }
    PG8_STAMP();
    if (STAMP && wid == 0) { stamps[lane] = lane < nts ? (((unsigned long long)(unsigned)ts_hi << 32) | (unsigned)ts_lo) : 0ull;
        if (lane == 62) stamps[62] = rt_entry; if (lane == 63) stamps[63] = (unsigned long long)wall_clock64(); }
#undef PG8_STAMP
#undef PG8_SA
#undef PG8_SB
#undef PG8_STAGE
#undef PG8_LDA
#undef PG8_LDB
#undef PG8_MMA
#undef PG8_WAIT_V
#undef PG8_WAIT_L
#undef PG8_BAR
#undef PG8_SCHED
}
}
#define GAS __attribute__((address_space(1)))
#define LAS __attribute__((address_space(3)))
typedef unsigned short bf16;
typedef unsigned v4u __attribute__((ext_vector_type(4)));
typedef float f32x4 __attribute__((ext_vector_type(4)));
typedef short bf16x8 __attribute__((ext_vector_type(8)));
typedef GAS unsigned gu32;
typedef GAS unsigned long long gu64;
__device__ __forceinline__ int fresh_lane() { unsigned m_ = ~0u; asm volatile("" : "+s"(m_)); return (int)__builtin_amdgcn_mbcnt_hi(m_, __builtin_amdgcn_mbcnt_lo(m_, 0u)); }
#define RLX_AGENT __ATOMIC_RELAXED, __HIP_MEMORY_SCOPE_AGENT
#define LDS_WAIT() asm volatile("s_waitcnt lgkmcnt(0)" ::: "memory")
#define VM_WAIT() asm volatile("s_waitcnt vmcnt(0)" ::: "memory")
__device__ __forceinline__ unsigned long long rt() { return __builtin_amdgcn_s_memrealtime(); }
__device__ __forceinline__ unsigned f2bf(float f) { unsigned u = __builtin_bit_cast(unsigned, f); return (u + 0x7fffu + ((u >> 16) & 1u)) >> 16; }
__device__ __forceinline__ unsigned pk2(float lo, float hi) { return f2bf(lo) | (f2bf(hi) << 16); }
#define XB_TMO      128
#define XB_XCNT(j)  (256  + 64 * (j))
#define XB_XSUB(j)  (1280 + 64 * (j))
#define XB_XGEN(j)  (2304 + 64 * (j))
#define XB_TOP      3328
#define XB_TOPGEN   3392
#define XCD_BAR_WORDS 3456
#define XB_SPIN_CAP (1u << 22)

__device__ __forceinline__ unsigned xb_ld(unsigned* p)              { return __hip_atomic_load(p, __ATOMIC_RELAXED, __HIP_MEMORY_SCOPE_AGENT); }
__device__ __forceinline__ unsigned xb_add(unsigned* p, unsigned v) { return __hip_atomic_fetch_add(p, v, __ATOMIC_RELAXED, __HIP_MEMORY_SCOPE_AGENT); }
__device__ __forceinline__ unsigned xb_xcc_id() { return (unsigned)__builtin_amdgcn_s_getreg((3 << 11) | 20) & 0xFu; }
#define XB_SPIN(cond, bar) do { unsigned _sp = 0; while (cond) { __builtin_amdgcn_s_sleep(1); \
    if ((++_sp & 255u) == 0u) { if (xb_ld(&(bar)[XB_TMO])) break; if (_sp > XB_SPIN_CAP) { atomicAdd(&(bar)[XB_TMO], 1u); break; } } } } while (0)

struct XcdBarrier {
    unsigned* bar; unsigned x;
    volatile LAS unsigned* st;
};

__device__ __forceinline__ XcdBarrier xcd_barrier_post(unsigned* bar, volatile LAS unsigned* st, const int tid_) {
    XcdBarrier b; b.bar = bar; b.x = xb_xcc_id(); b.st = st;
    if (tid_ == 0) (void)xb_add(&bar[XB_XCNT(b.x)], 1u);
    return b;
}
__device__ __forceinline__ void xcd_barrier_complete(unsigned* bar, unsigned x, unsigned& nloc, unsigned& nx) {
    const unsigned G = gridDim.x * gridDim.y * gridDim.z;
    unsigned sum, cnt, mine, sp = 0u;
    for (;;) {
        sum = 0u; cnt = 0u; mine = 0u;
#pragma unroll
        for (unsigned j = 0; j < 16; ++j) { const unsigned c = xb_ld(&bar[XB_XCNT(j)]); sum += c; cnt += (c > 0u) ? 1u : 0u; mine = (j == x) ? c : mine; }
        if (sum == G) break;
        __builtin_amdgcn_s_sleep(1);
        if ((++sp & 255u) == 0u) { if (xb_ld(&bar[XB_TMO])) break; if (sp > XB_SPIN_CAP) { atomicAdd(&bar[XB_TMO], 1u); break; } }
    }
    nloc = mine > 0u ? mine : 1u; nx = cnt > 0u ? cnt : 1u;
}

__device__ __forceinline__ void xcd_barrier(const XcdBarrier& b, const int tid_) {
    asm volatile("s_waitcnt vmcnt(0)" ::: "memory");
    __syncthreads();
    if (tid_ == 0) {
        unsigned* bar = b.bar;
        __builtin_amdgcn_s_waitcnt(0);
        unsigned nloc = b.st[0], nx = b.st[1];
        if (nloc == 0u) { xcd_barrier_complete(bar, b.x, nloc, nx); b.st[0] = nloc; b.st[1] = nx; }
        const unsigned old = xb_add(&bar[XB_XSUB(b.x)], 1u);
        const unsigned gen = old / nloc;
        if (old + 1u == (gen + 1u) * nloc) {
            __builtin_amdgcn_fence(__ATOMIC_RELEASE, "agent");
            asm volatile("s_waitcnt vmcnt(0)" ::: "memory");
            const unsigned og = xb_add(&bar[XB_TOP], 1u);
            const unsigned tg = og / nx;
            if (og + 1u == (tg + 1u) * nx) xb_add(&bar[XB_TOPGEN], 1u);
            else XB_SPIN(xb_ld(&bar[XB_TOPGEN]) == tg, bar);
            __builtin_amdgcn_fence(__ATOMIC_ACQUIRE, "agent");
            xb_add(&bar[XB_XGEN(b.x)], 1u);
            asm volatile("s_waitcnt vmcnt(0)" ::: "memory");
        } else {
            XB_SPIN(xb_ld(&bar[XB_XGEN(b.x)]) == gen, bar);
            __builtin_amdgcn_fence(__ATOMIC_ACQUIRE, "agent");
            asm volatile("s_waitcnt vmcnt(0)" ::: "memory");
        }
    }
    __syncthreads();
}

constexpr int BATCH = 8, SEQ = 2048, DM = 1024, MTOK = BATCH * SEQ, NLAYER = 2;
constexpr int GW = 256, HD = 64, NHEAD = 4;
constexpr int IN_COLS = 4236, NP = 4352;
constexpr int C_HG_Q = 0, C_HG_F = 256, C_HG_I = 512;
constexpr int C_GD_Q = 768, C_GD_K = 1024, C_GD_V = 1280;
constexpr int C_SS_X = 1536, C_SS_B = 1792, C_SS_C = 2048;
constexpr int C_RW_R = 2304, C_RW_K = 2560, C_RW_V = 2816;
constexpr int C_Z = 3072;
constexpr int C_GD_BETA = 4096, C_GD_DEC = 4100, C_SS_DT = 4104, C_RW_WD = 4112, C_RW_AD = 4176;

__host__ __device__ __forceinline__ int old_col(int n) {
    if (n < 1536) return n;
    if (n < 2304) return 1544 + (n - 1536);
    if (n < 3072) return 2316 + (n - 2304);
    if (n < 4096) return 3212 + (n - 3072);
    if (n < 4104) return 1536 + (n - 4096);
    if (n < 4108) return 2312 + (n - 4104);
    if (n < 4112) return -1;
    if (n < 4240) return 3084 + (n - 4112);
    return -1;
}
__device__ __forceinline__ float bf2f(bf16 b) { return __builtin_bit_cast(float, ((unsigned)b) << 16); }
__device__ __forceinline__ float wave_sum(float v) {
#pragma unroll
    for (int o = 1; o < 64; o <<= 1) v += __shfl_xor(v, o);
    return v;
}
__device__ __forceinline__ float sigmoidf_(float x) { return __builtin_amdgcn_rcpf(1.f + __expf(-x)); }
__device__ __forceinline__ float siluf_(float x) { return x * __builtin_amdgcn_rcpf(1.f + __expf(-x)); }
__device__ __forceinline__ float softplusf_(float x) { return x > 20.f ? x : log1pf(__expf(x)); }

struct Inputs {
    const float* x; const float* pre_norm_g; const float* w_in; const float* hgrn_lb; const float* hgrn_norm_g;
    const float* gdn_conv_w; const float* gdn_a_log; const float* gdn_dt_bias; const float* gdn_norm_g;
    const float* ssm_conv_w; const float* ssm_conv_b; const float* ssm_a_log; const float* ssm_dt_bias; const float* ssm_d; const float* ssm_norm_g;
    const float* rwkv_mu; const float* rwkv_w0; const float* rwkv_w_up; const float* rwkv_a0; const float* rwkv_a_up; const float* rwkv_k_k; const float* rwkv_k_a;
    const float* rwkv_r_k; const float* rwkv_ln_w; const float* rwkv_ln_b; const float* w_out; const float* post_norm_g;
};


typedef short bf16x4 __attribute__((ext_vector_type(4)));
typedef unsigned v2u __attribute__((ext_vector_type(2)));
#define MFMA16(a, b, c) __builtin_amdgcn_mfma_f32_16x16x32_bf16((a), (b), (c), 0, 0, 0)
constexpr int LS = 72;
constexpr int MAT_B = 64 * LS * 2;
constexpr int LS2 = 136;
constexpr int HEAD_LDS = 73728;

typedef float f32x2_ __attribute__((ext_vector_type(2)));
typedef __bf16 bf2_ __attribute__((ext_vector_type(2)));
#ifndef HWCVT
#define HWCVT 0
#endif
__device__ __forceinline__ unsigned pk_hw(float lo, float hi) { const f32x2_ v_ = {lo, hi}; const bf2_ r_ = __builtin_convertvector(v_, bf2_); return __builtin_bit_cast(unsigned, r_); }
__device__ __forceinline__ unsigned pk_sw(float lo, float hi) { return f2bf(lo) | (f2bf(hi) << 16); }
__device__ __forceinline__ unsigned pk_bf16(float lo, float hi) { return (HWCVT & 1) ? pk_hw(lo, hi) : pk_sw(lo, hi); }
__device__ __forceinline__ bf16 cvt_bf16(float x) { return (HWCVT & 2) ? (bf16)(pk_hw(x, x) & 0xffffu) : (bf16)f2bf(x); }
__device__ __forceinline__ bf16x8 ld_frag(const LAS bf16* base, int stride, int row, int kofs, int q) {
    return *(const LAS bf16x8*)(base + row * stride + kofs + 8 * q);
}
__device__ __forceinline__ bf16x8 ld_frag_perm(const LAS bf16* base, int stride, int row, int kofs, int q) {
    const bf16x4 lo = *(const LAS bf16x4*)(base + row * stride + kofs + 4 * q);
    const bf16x4 hi = *(const LAS bf16x4*)(base + row * stride + kofs + 16 + 4 * q);
    bf16x8 v; v[0] = lo[0]; v[1] = lo[1]; v[2] = lo[2]; v[3] = lo[3]; v[4] = hi[0]; v[5] = hi[1]; v[6] = hi[2]; v[7] = hi[3]; return v;
}
__device__ __forceinline__ bf16x8 pack_frag(const f32x4& a, const f32x4& b) {
    union { unsigned u[4]; bf16x8 v; } x;
    x.u[0] = pk_bf16(a[0], a[1]); x.u[1] = pk_bf16(a[2], a[3]); x.u[2] = pk_bf16(b[0], b[1]); x.u[3] = pk_bf16(b[2], b[3]); return x.v;
}
__device__ __forceinline__ void st4(LAS bf16* base, int stride, int row, int col, const f32x4& v) {
    v2u o; o.x = pk_bf16(v[0], v[1]); o.y = pk_bf16(v[2], v[3]); *(LAS v2u*)(base + row * stride + col) = o;
}
__device__ __forceinline__ f32x4 zero4() { return (f32x4){0.f, 0.f, 0.f, 0.f}; }
#define WG_BAR() __syncthreads()

__device__ __forceinline__ void ssd_pack16(LAS bf16* dst, const float* v) {
    v4u w0, w1;
    w0.x = pk_bf16(v[0], v[1]); w0.y = pk_bf16(v[2], v[3]); w0.z = pk_bf16(v[4], v[5]); w0.w = pk_bf16(v[6], v[7]);
    w1.x = pk_bf16(v[8], v[9]); w1.y = pk_bf16(v[10], v[11]); w1.z = pk_bf16(v[12], v[13]); w1.w = pk_bf16(v[14], v[15]);
    *(LAS v4u*)dst = w0; *(LAS v4u*)(dst + 8) = w1;
}
#define RAWF(arr, j) bf2f((arr)[(j) >> 1][(j) & 1])
__device__ __forceinline__ int opaque_i(int v) { asm volatile("" : "+v"(v)); return v; }
#define RAWG(arr, j) bf2f((arr)[(j)])

template <bool HW> __device__ __forceinline__ unsigned pkx(float lo, float hi) { if constexpr (HW) return pk_hw(lo, hi); else return pk_bf16(lo, hi); }
template <bool HW> __device__ __forceinline__ bf16x8 pack_frag_x(const f32x4& a, const f32x4& b) {
    union { unsigned u[4]; bf16x8 v; } x;
    x.u[0] = pkx<HW>(a[0], a[1]); x.u[1] = pkx<HW>(a[2], a[3]); x.u[2] = pkx<HW>(b[0], b[1]); x.u[3] = pkx<HW>(b[2], b[3]); return x.v; }
template <bool HW> __device__ __forceinline__ void st4_x(LAS bf16* base, int stride, int row, int col, const f32x4& v) {
    v2u o; o.x = pkx<HW>(v[0], v[1]); o.y = pkx<HW>(v[2], v[3]); *(LAS v2u*)(base + row * stride + col) = o; }
template <bool HW> __device__ __forceinline__ void pack16_x(LAS bf16* dst, const float* v) {
    v4u w0, w1;
    w0.x = pkx<HW>(v[0], v[1]); w0.y = pkx<HW>(v[2], v[3]); w0.z = pkx<HW>(v[4], v[5]); w0.w = pkx<HW>(v[6], v[7]);
    w1.x = pkx<HW>(v[8], v[9]); w1.y = pkx<HW>(v[10], v[11]); w1.z = pkx<HW>(v[12], v[13]); w1.w = pkx<HW>(v[14], v[15]);
    *(LAS v4u*)dst = w0; *(LAS v4u*)(dst + 8) = w1; }
#ifndef HWSITES
#define HWSITES 0
#endif
#define SITE(k) (((HWSITES) >> (k)) & 1)

__device__ __forceinline__ void mixopt_hgrn(const Inputs& in, const int layer, const bf16* __restrict__ PROJ, bf16* __restrict__ Yg, LAS unsigned char* ldsw, const int b, const int hp, const int tid) {
    const int lane = tid & 63, wave = __builtin_amdgcn_readfirstlane(tid >> 6), hh = wave >> 2, w4 = wave & 3, h = hp * 2 + hh, r = lane & 15, q = lane >> 4;
    LAS unsigned char* L = ldsw + hh * HEAD_LDS;
    LAS bf16* QT = (LAS bf16*)L; LAS bf16* KA = (LAS bf16*)(L + MAT_B); LAS bf16* KB = (LAS bf16*)(L + 2 * MAT_B); LAS bf16* R2 = (LAS bf16*)(L + 3 * MAT_B);
    LAS bf16* KDT = (LAS bf16*)(L + 4 * MAT_B); LAS bf16* VT = (LAS bf16*)(L + 5 * MAT_B); LAS bf16* ZT = (LAS bf16*)(L + 6 * MAT_B);
    LAS float* QTOT = (LAS float*)(L + 7 * MAT_B); LAS float* ELAST = QTOT + 256;
    const bf16* P = PROJ + (size_t)b * SEQ * NP; bf16* Yb = Yg + (size_t)b * SEQ * DM;
    const int c = h * 64 + lane;
    float lbv = 0.f;
    if (layer == 1) { const float x0 = in.hgrn_lb[c], x1 = in.hgrn_lb[GW + c]; const float mx = fmaxf(x0, x1); const float e0 = __expf(x0 - mx), e1 = __expf(x1 - mx); lbv = e1 / (e0 + e1); }
    f32x4 gn[4];
#pragma unroll
    for (int nv = 0; nv < 4; ++nv) gn[nv] = *(const f32x4*)(in.hgrn_norm_g + layer * HD + 16 * nv + 4 * q);
    f32x4 zs[4];
#pragma unroll
    for (int n = 0; n < 4; ++n) zs[n] = zero4();
    bf16 rq[16], rf[16], rv[16];
    { const bf16* p0 = P + (size_t)(16 * w4) * NP;
#pragma unroll
      for (int i = 0; i < 16; ++i) { rq[i] = p0[(size_t)i * NP + C_HG_Q + c]; rf[i] = p0[(size_t)i * NP + C_HG_F + c]; rv[i] = p0[(size_t)i * NP + C_HG_I + c]; } }
    for (int ch = 0; ch < SEQ / 64; ++ch) {
        float qv[16], kv[16], cl[16], vv[16]; float run = 0.f;
#pragma unroll
        for (int i = 0; i < 16; ++i) { const float x = bf2f(rq[i]); qv[i] = siluf_(x) * 0.125f; const float f = lbv + (1.f - lbv) * sigmoidf_(bf2f(rf[i])); kv[i] = 1.f - f; run += __logf(f); cl[i] = run; vv[i] = bf2f(rv[i]); }
        QTOT[w4 * 64 + lane] = run;
        if (ch + 1 < SEQ / 64) { const bf16* p0 = P + (size_t)((ch + 1) * 64 + 16 * w4) * NP;
#pragma unroll
            for (int i = 0; i < 16; ++i) { rq[i] = p0[(size_t)i * NP + C_HG_Q + c]; rf[i] = p0[(size_t)i * NP + C_HG_F + c]; rv[i] = p0[(size_t)i * NP + C_HG_I + c]; } }
        WG_BAR();
        {
            const float o0 = QTOT[lane], o1 = QTOT[64 + lane], o2 = QTOT[128 + lane], o3 = QTOT[192 + lane];
            const float base = (w4 > 0 ? o0 : 0.f) + (w4 > 1 ? o1 : 0.f) + (w4 > 2 ? o2 : 0.f);
            const float c31 = o0 + o1, c63 = c31 + o2 + o3, cI = (w4 >= 2) ? c31 : 0.f;
            float kd[16];
#pragma unroll
            for (int i = 0; i < 16; ++i) { const float cum = cl[i] + base; const int t = 16 * w4 + i;
                QT[t * LS + lane] = cvt_bf16(qv[i] * __expf(cum - cI));
                KA[t * LS + lane] = cvt_bf16(kv[i] * __expf(fminf(cI - cum, 80.f)));
                if (w4 < 2) KB[t * LS + lane] = cvt_bf16(kv[i] * __expf(c31 - cum));
                R2[t * LS + lane] = cvt_bf16(qv[i] * __expf(cum));
                kd[i] = kv[i] * __expf(c63 - cum); }
            v4u w0, w1;
            w0.x = pk_bf16(kd[0], kd[1]); w0.y = pk_bf16(kd[2], kd[3]); w0.z = pk_bf16(kd[4], kd[5]); w0.w = pk_bf16(kd[6], kd[7]);
            w1.x = pk_bf16(kd[8], kd[9]); w1.y = pk_bf16(kd[10], kd[11]); w1.z = pk_bf16(kd[12], kd[13]); w1.w = pk_bf16(kd[14], kd[15]);
            *(LAS v4u*)(KDT + lane * LS + 16 * w4) = w0; *(LAS v4u*)(KDT + lane * LS + 16 * w4 + 8) = w1;
            w0.x = pk_bf16(vv[0], vv[1]); w0.y = pk_bf16(vv[2], vv[3]); w0.z = pk_bf16(vv[4], vv[5]); w0.w = pk_bf16(vv[6], vv[7]);
            w1.x = pk_bf16(vv[8], vv[9]); w1.y = pk_bf16(vv[10], vv[11]); w1.z = pk_bf16(vv[12], vv[13]); w1.w = pk_bf16(vv[14], vv[15]);
            *(LAS v4u*)(VT + lane * LS + 16 * w4) = w0; *(LAS v4u*)(VT + lane * LS + 16 * w4 + 8) = w1;
            if (w4 == 0) ELAST[lane] = __expf(c63);
#pragma unroll
            for (int n = 0; n < 4; ++n) st4(ZT, LS, 16 * n + r, 16 * w4 + 4 * q, zs[n]);
        }
        WG_BAR();
        {
            const int m = w4;
            f32x4 Pt[4];
#pragma unroll
            for (int n = 0; n < 4; ++n) Pt[n] = zero4();
            bf16x8 aq[2];
#pragma unroll
            for (int k = 0; k < 2; ++k) aq[k] = ld_frag(QT, LS, 16 * m + r, 32 * k, q);
#pragma unroll
            for (int n = 0; n < 4; ++n) if (n <= m) {
                const LAS bf16* Bs = ((n >> 1) == (m >> 1)) ? KA : KB;
#pragma unroll
                for (int k = 0; k < 2; ++k) Pt[n] = MFMA16(ld_frag(Bs, LS, 16 * n + r, 32 * k, q), aq[k], Pt[n]);
                if (n == m) {
#pragma unroll
                    for (int i = 0; i < 4; ++i) if (4 * q + i > r) Pt[n][i] = 0.f; }
            }
            f32x4 O[4];
#pragma unroll
            for (int nv = 0; nv < 4; ++nv) O[nv] = zero4();
#pragma unroll
            for (int k = 0; k < 2; ++k) if (2 * k <= m) { const bf16x8 pf = pack_frag(Pt[2 * k], Pt[2 * k + 1]);
#pragma unroll
                for (int nv = 0; nv < 4; ++nv) O[nv] = MFMA16(ld_frag_perm(VT, LS, 16 * nv + r, 32 * k, q), pf, O[nv]); }
#pragma unroll
            for (int k = 0; k < 2; ++k) { const bf16x8 ar = ld_frag(R2, LS, 16 * m + r, 32 * k, q);
#pragma unroll
                for (int nv = 0; nv < 4; ++nv) O[nv] = MFMA16(ld_frag(ZT, LS, 16 * nv + r, 32 * k, q), ar, O[nv]); }
            float ss = 0.f;
#pragma unroll
            for (int nv = 0; nv < 4; ++nv) ss += (O[nv][0] * O[nv][0] + O[nv][1] * O[nv][1]) + (O[nv][2] * O[nv][2] + O[nv][3] * O[nv][3]);
            ss += __shfl_xor(ss, 16); ss += __shfl_xor(ss, 32);
            const float rs = rsqrtf(ss * (1.f / 64.f) + 1e-6f);
            const int t = ch * 64 + 16 * m + r;
#pragma unroll
            for (int nv = 0; nv < 4; ++nv) { const int dv0 = h * 64 + 16 * nv + 4 * q;
                const v2u zr = *(const v2u*)(P + (size_t)t * NP + C_Z + 0 + dv0);
                const float z0 = __builtin_bit_cast(float, zr.x << 16), z1 = __builtin_bit_cast(float, zr.x & 0xffff0000u), z2 = __builtin_bit_cast(float, zr.y << 16), z3 = __builtin_bit_cast(float, zr.y & 0xffff0000u);
                v2u o; o.x = pk_bf16(O[nv][0] * rs * gn[nv][0] * siluf_(z0), O[nv][1] * rs * gn[nv][1] * siluf_(z1));
                o.y = pk_bf16(O[nv][2] * rs * gn[nv][2] * siluf_(z2), O[nv][3] * rs * gn[nv][3] * siluf_(z3));
                *(v2u*)(Yb + (size_t)t * DM + 0 + dv0) = o; }
            const f32x4 el = *(const LAS f32x4*)(ELAST + 16 * w4 + 4 * q);
            bf16x8 ak[2];
#pragma unroll
            for (int k = 0; k < 2; ++k) ak[k] = ld_frag(KDT, LS, 16 * w4 + r, 32 * k, q);
#pragma unroll
            for (int n = 0; n < 4; ++n) { zs[n] = zs[n] * el;
#pragma unroll
                for (int k = 0; k < 2; ++k) zs[n] = MFMA16(ak[k], ld_frag(VT, LS, 16 * n + r, 32 * k, q), zs[n]); }
        }
        WG_BAR();
    }
}

__device__ __forceinline__ float tr_reduce16(const float* v, int lane) {
    float a[8], b[4], c[2], d;
    const bool b5 = lane & 32, b4 = lane & 16, b3 = lane & 8, b2 = lane & 4;
#pragma unroll
    for (int j = 0; j < 8; ++j) { const float snd = b5 ? v[j] : v[8 + j]; const float got = __shfl_xor(snd, 32); a[j] = (b5 ? v[8 + j] : v[j]) + got; }
#pragma unroll
    for (int j = 0; j < 4; ++j) { const float snd = b4 ? a[j] : a[4 + j]; const float got = __shfl_xor(snd, 16); b[j] = (b4 ? a[4 + j] : a[j]) + got; }
#pragma unroll
    for (int j = 0; j < 2; ++j) { const float snd = b3 ? b[j] : b[2 + j]; const float got = __shfl_xor(snd, 8); c[j] = (b3 ? b[2 + j] : b[j]) + got; }
    { const float snd = b2 ? c[0] : c[1]; const float got = __shfl_xor(snd, 4); d = (b2 ? c[1] : c[0]) + got; }
    d += __shfl_xor(d, 2); d += __shfl_xor(d, 1);
    return d;
}
__device__ __forceinline__ float rdlane(float x, int l) { return __builtin_bit_cast(float, __builtin_amdgcn_readlane(__builtin_bit_cast(int, x), l)); }

template <bool SW = false> __device__ __forceinline__ void diag_inverse(const LAS float* AD, LAS bf16* DT, int lane) {
    const int j = lane >> 4, c = lane & 15;
    const LAS float* A = AD + j * 256;
    float x[16];
#pragma unroll
    for (int i = 0; i < 16; ++i) {
        float s = (i == c) ? 1.f : 0.f;
#pragma unroll
        for (int k4 = 0; k4 < i; k4 += 4) { const f32x4 a = *(const LAS f32x4*)(A + i * 16 + k4);
#pragma unroll
            for (int kk = 0; kk < 4; ++kk) if (k4 + kk < i) s -= a[kk] * x[k4 + kk]; }
        x[i] = s;
    }
    v4u w0, w1;
    w0.x = pkx<SW>(x[0], x[1]); w0.y = pkx<SW>(x[2], x[3]); w0.z = pkx<SW>(x[4], x[5]); w0.w = pkx<SW>(x[6], x[7]);
    w1.x = pkx<SW>(x[8], x[9]); w1.y = pkx<SW>(x[10], x[11]); w1.z = pkx<SW>(x[12], x[13]); w1.w = pkx<SW>(x[14], x[15]);
    *(LAS v4u*)(DT + (j * 16 + c) * 16) = w0; *(LAS v4u*)(DT + (j * 16 + c) * 16 + 8) = w1;
}
__device__ __forceinline__ bf16x8 half_frag_lds(const LAS bf16* p) { const bf16x4 lo = *(const LAS bf16x4*)p; bf16x8 v; v[0] = lo[0]; v[1] = lo[1]; v[2] = lo[2]; v[3] = lo[3]; v[4] = 0; v[5] = 0; v[6] = 0; v[7] = 0; return v; }
__device__ __forceinline__ bf16x8 two_frag_lds(const LAS bf16* p0, const LAS bf16* p1) { const bf16x4 lo = *(const LAS bf16x4*)p0; const bf16x4 hi = *(const LAS bf16x4*)p1; bf16x8 v; v[0] = lo[0]; v[1] = lo[1]; v[2] = lo[2]; v[3] = lo[3]; v[4] = hi[0]; v[5] = hi[1]; v[6] = hi[2]; v[7] = hi[3]; return v; }
template <bool SW = false> __device__ __forceinline__ void tri_inverse_row(const LAS bf16* AMT, const LAS bf16* DT, int m, int r, int q, f32x4* Tm) {
    const f32x4 z4 = zero4();
    f32x4 dm;
#pragma unroll
    for (int i = 0; i < 4; ++i) dm[i] = bf2f(DT[(m * 16 + 4 * q + i) * 16 + r]);
#pragma unroll
    for (int n = 0; n < 4; ++n) Tm[n] = (n == m) ? dm : z4;
#pragma unroll
    for (int j = 2; j >= 0; --j) if (j < m) {
        f32x4 X = z4;
#pragma unroll
        for (int k = j + 1; k <= 3; k += 2) if (k <= m) {
            const LAS bf16* p0 = AMT + (16 * j + r) * LS + 16 * k + 4 * q;
            if (k + 1 <= 3) { const bf16x8 af = pack_frag_x<SW>(Tm[k], Tm[k + 1]); const bf16x8 bfr = two_frag_lds(p0, p0 + 16); X = MFMA16(bfr, af, X); }
            else { const bf16x8 af = pack_frag_x<SW>(Tm[k], z4); const bf16x8 bfr = half_frag_lds(p0); X = MFMA16(bfr, af, X); }
        }
        const bf16x8 xf = pack_frag_x<SW>(X, z4);
        const bf16x8 df = half_frag_lds(DT + (j * 16 + r) * 16 + 4 * q);
        const f32x4 Tj = MFMA16(df, xf, z4);
        Tm[j] = -Tj;
    }
}

__device__ __forceinline__ void mixopt_gdn(const Inputs& in, const int layer, const bf16* __restrict__ PROJ, bf16* __restrict__ Yg, LAS unsigned char* ldsw, const int b, const int hp, const int tid) {
    const int lane0 = tid & 63, wave = __builtin_amdgcn_readfirstlane(tid >> 6), hh = wave >> 2, w4 = wave & 3, h = hp * 2 + hh;
    LAS unsigned char* L = ldsw + hh * HEAD_LDS;
    LAS bf16* Qm = (LAS bf16*)L; LAS bf16* Km = (LAS bf16*)(L + 9216); LAS bf16* KT = (LAS bf16*)(L + 18432); LAS bf16* VT = (LAS bf16*)(L + 27648); LAS bf16* ZT = (LAS bf16*)(L + 36864);
    LAS bf16* AMT = (LAS bf16*)(L + 46080); LAS bf16* RHST = (LAS bf16*)(L + 55296); LAS float* AD = (LAS float*)(L + 64512); LAS bf16* DT = (LAS bf16*)(L + 68608);
    LAS float* CUM = (LAS float*)(L + 70656); LAS float* ECUM = CUM + 64; LAS float* BETA = CUM + 128; LAS float* WSC = CUM + 192;
    LAS bf16* VNWT = Km; LAS bf16* VNT = VT;
    const bf16* P = PROJ + (size_t)b * SEQ * NP; bf16* Yb = Yg + (size_t)b * SEQ * DM;
    const float* cw = in.gdn_conv_w + (size_t)layer * 4 * 768 + h * 64;
    const float Aneg = -__expf(in.gdn_a_log[layer * 4 + h]), dtb = in.gdn_dt_bias[layer * 4 + h];
    f32x4 zs[4];
#pragma unroll
    for (int n = 0; n < 4; ++n) zs[n] = zero4();
    typedef unsigned short us2 __attribute__((ext_vector_type(2)));
    bf16 rq[19], rk[19], rv[19]; bf16 rbt, rat;
    auto load_raw = [&](int ch, int lane) {
        const int c = h * 64 + lane;
        const int tb = ch * 64 + 16 * w4 - 3;
#pragma unroll
        for (int j = 0; j < 19; ++j) { const int t = tb + j; const bool ok = (t >= 0); const bf16* p0 = P + (size_t)(ok ? t : 0) * NP;
            const bf16 a = p0[C_GD_Q + c], bb = p0[C_GD_K + c], cc = p0[C_GD_V + c];
            rq[j] = ok ? a : (bf16)0; rk[j] = ok ? bb : (bf16)0; rv[j] = ok ? cc : (bf16)0; }
        rbt = P[(size_t)(ch * 64 + lane) * NP + C_GD_BETA + h]; rat = P[(size_t)(ch * 64 + lane) * NP + C_GD_DEC + h];
    };
    load_raw(0, lane0);
    for (int ch = 0; ch < SEQ / 64; ++ch) {
        const int lane = opaque_i(lane0), r = lane & 15, q = lane >> 4;
#ifndef GDN_REP
#define GDN_REP 0
#endif
        {
            float tv[16];
            float wq[4], wk[4], wv[4];
#pragma unroll
            for (int j = 0; j < 4; ++j) { wq[j] = cw[j * 768 + lane]; wk[j] = cw[j * 768 + 256 + lane]; wv[j] = cw[j * 768 + 512 + lane]; }
#pragma unroll
            for (int i = 0; i < 16; ++i) tv[i] = siluf_(wk[0] * RAWG(rk, i) + wk[1] * RAWG(rk, i + 1) + wk[2] * RAWG(rk, i + 2) + wk[3] * RAWG(rk, i + 3));
            { float sq[16];
#pragma unroll
              for (int i = 0; i < 16; ++i) sq[i] = tv[i] * tv[i];
              const float sred = tr_reduce16(sq, lane);
#pragma unroll
              for (int i = 0; i < 16; ++i) { tv[i] *= rsqrtf(rdlane(sred, 4 * i) + 1e-6f); Km[(16 * w4 + i) * LS + lane] = cvt_bf16(tv[i]); } }
            pack16_x<SITE(0)>(KT + lane * LS + 16 * w4, tv);
            asm volatile("" ::: "memory");
#pragma unroll
            for (int i = 0; i < 16; ++i) tv[i] = siluf_(wq[0] * RAWG(rq, i) + wq[1] * RAWG(rq, i + 1) + wq[2] * RAWG(rq, i + 2) + wq[3] * RAWG(rq, i + 3));
            { float sq[16];
#pragma unroll
              for (int i = 0; i < 16; ++i) sq[i] = tv[i] * tv[i];
              const float sred = tr_reduce16(sq, lane);
#pragma unroll
              for (int i = 0; i < 16; ++i) Qm[(16 * w4 + i) * LS + lane] = cvt_bf16(tv[i] * rsqrtf(rdlane(sred, 4 * i) + 1e-6f) * 0.125f); }
            asm volatile("" ::: "memory");
#pragma unroll
            for (int i = 0; i < 16; ++i) tv[i] = siluf_(wv[0] * RAWG(rv, i) + wv[1] * RAWG(rv, i + 1) + wv[2] * RAWG(rv, i + 2) + wv[3] * RAWG(rv, i + 3));
            pack16_x<SITE(0)>(VT + lane * LS + 16 * w4, tv);
            if (w4 == 0) {
                const float beta = sigmoidf_(bf2f(rbt)); float cs = Aneg * softplusf_(bf2f(rat) + dtb);
#pragma unroll
                for (int o = 1; o < 64; o <<= 1) { const float u = __shfl_up(cs, o); if (lane >= o) cs += u; }
                const float c63 = __shfl(cs, 63);
                CUM[lane] = cs; ECUM[lane] = __expf(cs); BETA[lane] = beta; WSC[lane] = __expf(c63 - cs);
            }
#pragma unroll
            for (int n = 0; n < 4; ++n) st4_x<SITE(1)>(ZT, LS, 16 * n + r, 16 * w4 + 4 * q, zs[n]);
        }
        WG_BAR();
        const int m = w4;
        f32x4 QK[4];
        { const int lane = opaque_i(lane0), r = lane & 15, q = lane >> 4;
        {
            bf16x8 ak[2], aq[2];
#pragma unroll
            for (int k = 0; k < 2; ++k) { ak[k] = ld_frag(Km, LS, 16 * m + r, 32 * k, q); aq[k] = ld_frag(Qm, LS, 16 * m + r, 32 * k, q); }
            const f32x4 cumt4 = *(const LAS f32x4*)(CUM + 16 * m + 4 * q);
            const f32x4 bet4 = *(const LAS f32x4*)(BETA + 16 * m + 4 * q);
            const f32x4 ecum4 = *(const LAS f32x4*)(ECUM + 16 * m + 4 * q);
            const float cumr = CUM[16 * m + r];
#pragma unroll
            for (int n = 0; n < 4; ++n) { QK[n] = zero4(); if (n <= m) {
                f32x4 kk = zero4();
#pragma unroll
                for (int k = 0; k < 2; ++k) { const bf16x8 bk = ld_frag(Km, LS, 16 * n + r, 32 * k, q);
                    kk = MFMA16(ak[k], bk, kk);
                    QK[n] = MFMA16(bk, aq[k], QK[n]); }
                const float cums = CUM[16 * n + r];
                f32x4 av;
#pragma unroll
                for (int i = 0; i < 4; ++i) { const bool keep = (n < m) || (r < 4 * q + i); av[i] = keep ? bet4[i] * kk[i] * __expf(cumt4[i] - cums) : 0.f; }
                st4_x<SITE(2)>(AMT, LS, 16 * n + r, 16 * m + 4 * q, av);
                if (n == m) {
#pragma unroll
                    for (int i = 0; i < 4; ++i) AD[m * 256 + (4 * q + i) * 16 + r] = av[i]; }
                const f32x4 cs4 = *(const LAS f32x4*)(CUM + 16 * n + 4 * q);
#pragma unroll
                for (int i = 0; i < 4; ++i) { const bool keep = (n < m) || (4 * q + i <= r); QK[n][i] = keep ? QK[n][i] * __expf(cumr - cs4[i]) : 0.f; }
            } }
#pragma unroll
            for (int nv = 0; nv < 4; ++nv) { f32x4 kz = zero4();
#pragma unroll
                for (int k = 0; k < 2; ++k) kz = MFMA16(ak[k], ld_frag(ZT, LS, 16 * nv + r, 32 * k, q), kz);
                const v2u vr = *(const LAS v2u*)(VT + (16 * nv + r) * LS + 16 * m + 4 * q);
                f32x4 rh;
                rh[0] = bet4[0] * (__builtin_bit_cast(float, vr.x << 16) - ecum4[0] * kz[0]); rh[1] = bet4[1] * (__builtin_bit_cast(float, vr.x & 0xffff0000u) - ecum4[1] * kz[1]);
                rh[2] = bet4[2] * (__builtin_bit_cast(float, vr.y << 16) - ecum4[2] * kz[2]); rh[3] = bet4[3] * (__builtin_bit_cast(float, vr.y & 0xffff0000u) - ecum4[3] * kz[3]);
                st4_x<SITE(2)>(RHST, LS, 16 * nv + r, 16 * m + 4 * q, rh); }
        }
        }
        WG_BAR();
        { const int lane = opaque_i(lane0), r = lane & 15, q = lane >> 4;
        if (ch + 1 < SEQ / 64) load_raw(ch + 1, lane);
        {
            diag_inverse<SITE(5)>(AD, DT, lane);
            asm volatile("s_waitcnt lgkmcnt(0)" ::: "memory");
            f32x4 Tm[4];
            tri_inverse_row<SITE(6)>(AMT, DT, m, r, q, Tm);
            const f32x4 w4v = *(const LAS f32x4*)(WSC + 16 * m + 4 * q);
            const bf16x8 t0 = pack_frag_x<SITE(3)>(Tm[0], Tm[1]), t1 = pack_frag_x<SITE(3)>(Tm[2], Tm[3]);
#pragma unroll
            for (int nv = 0; nv < 4; ++nv) { f32x4 vn = zero4();
                vn = MFMA16(t0, ld_frag_perm(RHST, LS, 16 * nv + r, 0, q), vn);
                if (m >= 2) vn = MFMA16(t1, ld_frag_perm(RHST, LS, 16 * nv + r, 32, q), vn);
                st4_x<SITE(3)>(VNT, LS, 16 * nv + r, 16 * m + 4 * q, vn);
                st4_x<SITE(3)>(VNWT, LS, 16 * nv + r, 16 * m + 4 * q, vn * w4v); }
        }
        }
        WG_BAR();
        { const int lane = opaque_i(lane0), r = lane & 15, q = lane >> 4; const float* gnp = in.gdn_norm_g + layer * HD + 4 * q;
        {
            f32x4 O[4];
            bf16x8 aq[2];
#pragma unroll
            for (int k = 0; k < 2; ++k) aq[k] = ld_frag(Qm, LS, 16 * m + r, 32 * k, q);
            const float ect = ECUM[16 * m + r];
            const bf16x8 p0 = pack_frag_x<SITE(4)>(QK[0], QK[1]), p1 = pack_frag_x<SITE(4)>(QK[2], QK[3]);
            float ss = 0.f;
#pragma unroll
            for (int nv = 0; nv < 4; ++nv) { O[nv] = zero4();
#pragma unroll
                for (int k = 0; k < 2; ++k) O[nv] = MFMA16(ld_frag(ZT, LS, 16 * nv + r, 32 * k, q), aq[k], O[nv]);
                O[nv] = O[nv] * ect;
                O[nv] = MFMA16(ld_frag_perm(VNT, LS, 16 * nv + r, 0, q), p0, O[nv]);
                if (m >= 2) O[nv] = MFMA16(ld_frag_perm(VNT, LS, 16 * nv + r, 32, q), p1, O[nv]);
                ss += (O[nv][0] * O[nv][0] + O[nv][1] * O[nv][1]) + (O[nv][2] * O[nv][2] + O[nv][3] * O[nv][3]); }
            ss += __shfl_xor(ss, 16); ss += __shfl_xor(ss, 32);
            const float rs = rsqrtf(ss * (1.f / 64.f) + 1e-6f);
            const int t = ch * 64 + 16 * m + r;
#pragma unroll
            for (int nv = 0; nv < 4; ++nv) { const int dv0 = h * 64 + 16 * nv + 4 * q;
                const f32x4 gg = *(const f32x4*)(gnp + 16 * nv);
                const v2u zr = *(const v2u*)(P + (size_t)t * NP + C_Z + 256 + dv0);
                const float z0 = __builtin_bit_cast(float, zr.x << 16), z1 = __builtin_bit_cast(float, zr.x & 0xffff0000u), z2 = __builtin_bit_cast(float, zr.y << 16), z3 = __builtin_bit_cast(float, zr.y & 0xffff0000u);
                v2u o; o.x = pkx<SITE(4)>(O[nv][0] * rs * gg[0] * siluf_(z0), O[nv][1] * rs * gg[1] * siluf_(z1)); o.y = pkx<SITE(4)>(O[nv][2] * rs * gg[2] * siluf_(z2), O[nv][3] * rs * gg[3] * siluf_(z3));
                *(v2u*)(Yb + (size_t)t * DM + 256 + dv0) = o; }
            const float last = ECUM[63];
            bf16x8 akt[2];
#pragma unroll
            for (int k = 0; k < 2; ++k) akt[k] = ld_frag(KT, LS, 16 * w4 + r, 32 * k, q);
#pragma unroll
            for (int n = 0; n < 4; ++n) { zs[n] = zs[n] * last;
#pragma unroll
                for (int k = 0; k < 2; ++k) zs[n] = MFMA16(akt[k], ld_frag(VNWT, LS, 16 * n + r, 32 * k, q), zs[n]); }
        }
        }
        WG_BAR();
    }
}

__device__ __forceinline__ void mixopt_gdn2(const Inputs& in, const int layer, const bf16* __restrict__ PROJ, bf16* __restrict__ Yg, LAS unsigned char* L, const int b, const int h, const int tid) {
    const int lane0 = tid & 63, wave = __builtin_amdgcn_readfirstlane(tid >> 6), grp = wave >> 2, w4 = wave & 3;
    LAS bf16* Qm = (LAS bf16*)L; LAS bf16* Km = (LAS bf16*)(L + 9216); LAS bf16* KT = (LAS bf16*)(L + 18432); LAS bf16* VT = (LAS bf16*)(L + 27648); LAS bf16* ZT = (LAS bf16*)(L + 36864);
    LAS bf16* AMT = (LAS bf16*)(L + 46080); LAS bf16* RHST = (LAS bf16*)(L + 55296); LAS bf16* QKM = (LAS bf16*)(L + 64512); LAS float* AD = (LAS float*)(L + 73728); LAS bf16* DT = (LAS bf16*)(L + 77824);
    LAS float* CUM = (LAS float*)(L + 79872); LAS float* ECUM = CUM + 64; LAS float* BETA = CUM + 128; LAS float* WSC = CUM + 192;
    LAS bf16* VNWT = Km; LAS bf16* VNT = VT;
    const bf16* P = PROJ + (size_t)b * SEQ * NP; bf16* Yb = Yg + (size_t)b * SEQ * DM;
    const float* cw = in.gdn_conv_w + (size_t)layer * 4 * 768 + h * 64;
    const float Aneg = -__expf(in.gdn_a_log[layer * 4 + h]), dtb = in.gdn_dt_bias[layer * 4 + h];
    f32x4 zs[4];
#pragma unroll
    for (int n = 0; n < 4; ++n) zs[n] = zero4();
    bf16 ra[19], rb2[19]; bf16 rbt, rat;
    auto load_raw = [&](int ch, int lane) {
        const int c = h * 64 + lane;
        const int tb = ch * 64 + 16 * w4 - 3;
        if (grp == 0) {
#pragma unroll
            for (int j = 0; j < 19; ++j) { const int t = tb + j; const bool ok = (t >= 0); const bf16 a = P[(size_t)(ok ? t : 0) * NP + C_GD_K + c]; ra[j] = ok ? a : (bf16)0; }
            rbt = P[(size_t)(ch * 64 + lane) * NP + C_GD_BETA + h]; rat = P[(size_t)(ch * 64 + lane) * NP + C_GD_DEC + h];
        } else {
#pragma unroll
            for (int j = 0; j < 19; ++j) { const int t = tb + j; const bool ok = (t >= 0); const bf16* p0 = P + (size_t)(ok ? t : 0) * NP;
                const bf16 a = p0[C_GD_Q + c], bb = p0[C_GD_V + c]; ra[j] = ok ? a : (bf16)0; rb2[j] = ok ? bb : (bf16)0; }
        }
    };
    load_raw(0, lane0);
    for (int ch = 0; ch < SEQ / 64; ++ch) {
        { const int lane = opaque_i(lane0), r = lane & 15, q = lane >> 4;
          float tv[16]; float w0[4];
          if (grp == 0) {
#pragma unroll
            for (int j = 0; j < 4; ++j) w0[j] = cw[j * 768 + 256 + lane];
#pragma unroll
            for (int i = 0; i < 16; ++i) tv[i] = siluf_(w0[0] * RAWG(ra, i) + w0[1] * RAWG(ra, i + 1) + w0[2] * RAWG(ra, i + 2) + w0[3] * RAWG(ra, i + 3));
            { float sq[16];
#pragma unroll
              for (int i = 0; i < 16; ++i) sq[i] = tv[i] * tv[i];
              const float sred = tr_reduce16(sq, lane);
#pragma unroll
              for (int i = 0; i < 16; ++i) { tv[i] *= rsqrtf(rdlane(sred, 4 * i) + 1e-6f); Km[(16 * w4 + i) * LS + lane] = cvt_bf16(tv[i]); } }
            ssd_pack16(KT + lane * LS + 16 * w4, tv);
            if (w4 == 0) {
                const float beta = sigmoidf_(bf2f(rbt)); float cs = Aneg * softplusf_(bf2f(rat) + dtb);
#pragma unroll
                for (int o = 1; o < 64; o <<= 1) { const float u = __shfl_up(cs, o); if (lane >= o) cs += u; }
                const float c63 = __shfl(cs, 63);
                CUM[lane] = cs; ECUM[lane] = __expf(cs); BETA[lane] = beta; WSC[lane] = __expf(c63 - cs);
            }
#pragma unroll
            for (int n = 0; n < 4; ++n) st4(ZT, LS, 16 * n + r, 16 * w4 + 4 * q, zs[n]);
          } else {
#pragma unroll
            for (int j = 0; j < 4; ++j) w0[j] = cw[j * 768 + lane];
#pragma unroll
            for (int i = 0; i < 16; ++i) tv[i] = siluf_(w0[0] * RAWG(ra, i) + w0[1] * RAWG(ra, i + 1) + w0[2] * RAWG(ra, i + 2) + w0[3] * RAWG(ra, i + 3));
            { float sq[16];
#pragma unroll
              for (int i = 0; i < 16; ++i) sq[i] = tv[i] * tv[i];
              const float sred = tr_reduce16(sq, lane);
#pragma unroll
              for (int i = 0; i < 16; ++i) Qm[(16 * w4 + i) * LS + lane] = cvt_bf16(tv[i] * rsqrtf(rdlane(sred, 4 * i) + 1e-6f) * 0.125f); }
            asm volatile("" ::: "memory");
#pragma unroll
            for (int j = 0; j < 4; ++j) w0[j] = cw[j * 768 + 512 + lane];
#pragma unroll
            for (int i = 0; i < 16; ++i) tv[i] = siluf_(w0[0] * RAWG(rb2, i) + w0[1] * RAWG(rb2, i + 1) + w0[2] * RAWG(rb2, i + 2) + w0[3] * RAWG(rb2, i + 3));
            ssd_pack16(VT + lane * LS + 16 * w4, tv);
          }
        }
        WG_BAR();
        const int m = w4;
        { const int lane = opaque_i(lane0), r = lane & 15, q = lane >> 4;
          if (ch + 1 < SEQ / 64) load_raw(ch + 1, lane);
          if (grp == 0) {
            bf16x8 ak[2];
#pragma unroll
            for (int k = 0; k < 2; ++k) ak[k] = ld_frag(Km, LS, 16 * m + r, 32 * k, q);
            const f32x4 cumt4 = *(const LAS f32x4*)(CUM + 16 * m + 4 * q);
            const f32x4 bet4 = *(const LAS f32x4*)(BETA + 16 * m + 4 * q);
            const f32x4 ecum4 = *(const LAS f32x4*)(ECUM + 16 * m + 4 * q);
#pragma unroll
            for (int n = 0; n < 4; ++n) if (n <= m) {
                f32x4 kk = zero4();
#pragma unroll
                for (int k = 0; k < 2; ++k) kk = MFMA16(ak[k], ld_frag(Km, LS, 16 * n + r, 32 * k, q), kk);
                const float cums = CUM[16 * n + r];
                f32x4 av;
#pragma unroll
                for (int i = 0; i < 4; ++i) { const bool keep = (n < m) || (r < 4 * q + i); av[i] = keep ? bet4[i] * kk[i] * __expf(cumt4[i] - cums) : 0.f; }
                st4(AMT, LS, 16 * n + r, 16 * m + 4 * q, av);
                if (n == m) {
#pragma unroll
                    for (int i = 0; i < 4; ++i) AD[m * 256 + (4 * q + i) * 16 + r] = av[i]; }
            }
#pragma unroll
            for (int nv = 0; nv < 4; ++nv) { f32x4 kz = zero4();
#pragma unroll
                for (int k = 0; k < 2; ++k) kz = MFMA16(ak[k], ld_frag(ZT, LS, 16 * nv + r, 32 * k, q), kz);
                const v2u vr = *(const LAS v2u*)(VT + (16 * nv + r) * LS + 16 * m + 4 * q);
                f32x4 rh;
                rh[0] = bet4[0] * (__builtin_bit_cast(float, vr.x << 16) - ecum4[0] * kz[0]); rh[1] = bet4[1] * (__builtin_bit_cast(float, vr.x & 0xffff0000u) - ecum4[1] * kz[1]);
                rh[2] = bet4[2] * (__builtin_bit_cast(float, vr.y << 16) - ecum4[2] * kz[2]); rh[3] = bet4[3] * (__builtin_bit_cast(float, vr.y & 0xffff0000u) - ecum4[3] * kz[3]);
                st4(RHST, LS, 16 * nv + r, 16 * m + 4 * q, rh); }
          } else {
            bf16x8 aq[2];
#pragma unroll
            for (int k = 0; k < 2; ++k) aq[k] = ld_frag(Qm, LS, 16 * m + r, 32 * k, q);
            const float cumr = CUM[16 * m + r];
#pragma unroll
            for (int n = 0; n < 4; ++n) { f32x4 qk = zero4(); if (n <= m) {
#pragma unroll
                for (int k = 0; k < 2; ++k) qk = MFMA16(ld_frag(Km, LS, 16 * n + r, 32 * k, q), aq[k], qk);
                const f32x4 cs4 = *(const LAS f32x4*)(CUM + 16 * n + 4 * q);
#pragma unroll
                for (int i = 0; i < 4; ++i) { const bool keep = (n < m) || (4 * q + i <= r); qk[i] = keep ? qk[i] * __expf(cumr - cs4[i]) : 0.f; } }
                st4(QKM, LS, 16 * m + r, 16 * n + 4 * q, qk); }
          }
        }
        WG_BAR();
        f32x4 O[4];
        { const int lane = opaque_i(lane0), r = lane & 15, q = lane >> 4;
          if (grp == 0) {
            diag_inverse(AD, DT, lane);
            asm volatile("s_waitcnt lgkmcnt(0)" ::: "memory");
            f32x4 Tm[4];
            tri_inverse_row(AMT, DT, m, r, q, Tm);
            const f32x4 w4v = *(const LAS f32x4*)(WSC + 16 * m + 4 * q);
            const bf16x8 t0 = pack_frag(Tm[0], Tm[1]), t1 = pack_frag(Tm[2], Tm[3]);
#pragma unroll
            for (int nv = 0; nv < 4; ++nv) { f32x4 vn = zero4();
                vn = MFMA16(t0, ld_frag_perm(RHST, LS, 16 * nv + r, 0, q), vn);
                if (m >= 2) vn = MFMA16(t1, ld_frag_perm(RHST, LS, 16 * nv + r, 32, q), vn);
                st4(VNT, LS, 16 * nv + r, 16 * m + 4 * q, vn);
                st4(VNWT, LS, 16 * nv + r, 16 * m + 4 * q, vn * w4v); }
          } else {
            bf16x8 aq[2];
#pragma unroll
            for (int k = 0; k < 2; ++k) aq[k] = ld_frag(Qm, LS, 16 * m + r, 32 * k, q);
            const float ect = ECUM[16 * m + r];
#pragma unroll
            for (int nv = 0; nv < 4; ++nv) { O[nv] = zero4();
#pragma unroll
                for (int k = 0; k < 2; ++k) O[nv] = MFMA16(ld_frag(ZT, LS, 16 * nv + r, 32 * k, q), aq[k], O[nv]);
                O[nv] = O[nv] * ect; }
          }
        }
        WG_BAR();
        { const int lane = opaque_i(lane0), r = lane & 15, q = lane >> 4;
          if (grp == 0) {
            const float last = ECUM[63];
            bf16x8 akt[2];
#pragma unroll
            for (int k = 0; k < 2; ++k) akt[k] = ld_frag(KT, LS, 16 * w4 + r, 32 * k, q);
#pragma unroll
            for (int n = 0; n < 4; ++n) { zs[n] = zs[n] * last;
#pragma unroll
                for (int k = 0; k < 2; ++k) zs[n] = MFMA16(akt[k], ld_frag(VNWT, LS, 16 * n + r, 32 * k, q), zs[n]); }
          } else {
            bf16x8 pq[2];
#pragma unroll
            for (int k = 0; k < 2; ++k) pq[k] = ld_frag(QKM, LS, 16 * m + r, 32 * k, q);
            float ss = 0.f;
#pragma unroll
            for (int nv = 0; nv < 4; ++nv) {
                O[nv] = MFMA16(ld_frag(VNT, LS, 16 * nv + r, 0, q), pq[0], O[nv]);
                if (m >= 2) O[nv] = MFMA16(ld_frag(VNT, LS, 16 * nv + r, 32, q), pq[1], O[nv]);
                ss += (O[nv][0] * O[nv][0] + O[nv][1] * O[nv][1]) + (O[nv][2] * O[nv][2] + O[nv][3] * O[nv][3]); }
            ss += __shfl_xor(ss, 16); ss += __shfl_xor(ss, 32);
            const float rs = rsqrtf(ss * (1.f / 64.f) + 1e-6f);
            const int t = ch * 64 + 16 * m + r;
            const float* gnp = in.gdn_norm_g + layer * HD + 4 * q;
#pragma unroll
            for (int nv = 0; nv < 4; ++nv) { const int dv0 = h * 64 + 16 * nv + 4 * q;
                const f32x4 gg = *(const f32x4*)(gnp + 16 * nv);
                const v2u zr = *(const v2u*)(P + (size_t)t * NP + C_Z + 256 + dv0);
                const float z0 = __builtin_bit_cast(float, zr.x << 16), z1 = __builtin_bit_cast(float, zr.x & 0xffff0000u), z2 = __builtin_bit_cast(float, zr.y << 16), z3 = __builtin_bit_cast(float, zr.y & 0xffff0000u);
                v2u o; o.x = pk_bf16(O[nv][0] * rs * gg[0] * siluf_(z0), O[nv][1] * rs * gg[1] * siluf_(z1)); o.y = pk_bf16(O[nv][2] * rs * gg[2] * siluf_(z2), O[nv][3] * rs * gg[3] * siluf_(z3));
                *(v2u*)(Yb + (size_t)t * DM + 256 + dv0) = o; }
          }
        }
        WG_BAR();
    }
}

__device__ __forceinline__ void mixopt_ssd(const Inputs& in, const int layer, const bf16* __restrict__ PROJ, bf16* __restrict__ Yg, LAS unsigned char* ldsw, const int b, const int g, const int tid) {
    const int lane = tid & 63, wave = __builtin_amdgcn_readfirstlane(tid >> 6), hh = wave >> 2, w4 = wave & 3, h = g * 2 + hh, r = lane & 15, q = lane >> 4;
    LAS bf16* CM = (LAS bf16*)ldsw; LAS bf16* BM = (LAS bf16*)(ldsw + 17408); LAS bf16* BT = (LAS bf16*)(ldsw + 34816);
    LAS unsigned char* L = ldsw + 53248 + hh * 45056;
    LAS bf16* XVT = (LAS bf16*)L; LAS bf16* XVWT = (LAS bf16*)(L + MAT_B); LAS bf16* XR = (LAS bf16*)(L + 2 * MAT_B); LAS bf16* ZT = (LAS bf16*)(L + 3 * MAT_B);
    LAS float* CUM = (LAS float*)(ldsw + 143360 + hh * 1024); LAS float* ECUM = CUM + 64;
    LAS float* SS = (LAS float*)(ldsw + 145408);
    const bf16* P = PROJ + (size_t)b * SEQ * NP; bf16* Yb = Yg + (size_t)b * SEQ * DM;
    const int cx = h * 64 + lane, cbc = g * 128 + 64 * hh + lane;
    const float* cw = in.ssm_conv_w + (size_t)layer * 4 * 768; const float* cb = in.ssm_conv_b + (size_t)layer * 768;
    float wx[4], wB[4], wC[4];
#pragma unroll
    for (int j = 0; j < 4; ++j) { wx[j] = cw[j * 768 + cx]; wB[j] = cw[j * 768 + 256 + cbc]; wC[j] = cw[j * 768 + 512 + cbc]; }
    const float bx = cb[cx], bB = cb[256 + cbc], bC = cb[512 + cbc];
    const float Aneg = -__expf(in.ssm_a_log[layer * 4 + h]), dtb = in.ssm_dt_bias[layer * 4 + h], dsk = in.ssm_d[layer * 4 + h];
    const float* gnp = in.ssm_norm_g + layer * GW + h * 64 + 4 * q;
    f32x4 zs[2][4];
#pragma unroll
    for (int a = 0; a < 2; ++a)
#pragma unroll
        for (int n = 0; n < 4; ++n) zs[a][n] = zero4();
    typedef unsigned short us2 __attribute__((ext_vector_type(2)));
    bf16 rx[19], rB[19], rC[19]; bf16 rdt;
    auto load_raw = [&](int ch) {
        const int tb = ch * 64 + 16 * w4 - 3;
#pragma unroll
        for (int j = 0; j < 19; ++j) { const int t = tb + j; const bool ok = (t >= 0); const bf16* p0 = P + (size_t)(ok ? t : 0) * NP;
            const bf16 a = p0[C_SS_X + cx], bb = p0[C_SS_B + cbc], cc = p0[C_SS_C + cbc];
            rx[j] = ok ? a : (bf16)0; rB[j] = ok ? bb : (bf16)0; rC[j] = ok ? cc : (bf16)0; }
        rdt = P[(size_t)(ch * 64 + lane) * NP + C_SS_DT + h];
    };
    load_raw(0);
    for (int ch = 0; ch < SEQ / 64; ++ch) {
        {
            float tv[16];
#pragma unroll
            for (int i = 0; i < 16; ++i) { tv[i] = siluf_(wC[0] * RAWG(rC, i) + wC[1] * RAWG(rC, i + 1) + wC[2] * RAWG(rC, i + 2) + wC[3] * RAWG(rC, i + 3) + bC);
                CM[(16 * w4 + i) * LS2 + 64 * hh + lane] = cvt_bf16(tv[i]); }
            asm volatile("" ::: "memory");
#pragma unroll
            for (int i = 0; i < 16; ++i) { tv[i] = siluf_(wB[0] * RAWG(rB, i) + wB[1] * RAWG(rB, i + 1) + wB[2] * RAWG(rB, i + 2) + wB[3] * RAWG(rB, i + 3) + bB);
                BM[(16 * w4 + i) * LS2 + 64 * hh + lane] = cvt_bf16(tv[i]); }
            ssd_pack16(BT + (64 * hh + lane) * LS + 16 * w4, tv);
            asm volatile("" ::: "memory");
            const float dt = softplusf_(bf2f(rdt) + dtb); float cs = dt * Aneg;
#pragma unroll
            for (int o = 1; o < 64; o <<= 1) { const float u = __shfl_up(cs, o); if (lane >= o) cs += u; }
            const float c63 = __shfl(cs, 63);
            const float wsc = __expf(c63 - cs);
            if (w4 == 0) { CUM[lane] = cs; ECUM[lane] = __expf(cs); }
            float xw[16];
#pragma unroll
            for (int i = 0; i < 16; ++i) { const int t = 16 * w4 + i;
                const float xs = siluf_(wx[0] * RAWG(rx, i) + wx[1] * RAWG(rx, i + 1) + wx[2] * RAWG(rx, i + 2) + wx[3] * RAWG(rx, i + 3) + bx);
                XR[t * LS + lane] = cvt_bf16(xs); tv[i] = xs * __shfl(dt, t); xw[i] = tv[i] * __shfl(wsc, t); }
            ssd_pack16(XVT + lane * LS + 16 * w4, tv);
            ssd_pack16(XVWT + lane * LS + 16 * w4, xw);
#pragma unroll
            for (int a = 0; a < 2; ++a)
#pragma unroll
                for (int nv = 0; nv < 4; ++nv) st4(ZT, LS2, 16 * nv + r, 16 * (2 * w4 + a) + 4 * q, zs[a][nv]);
        }
        WG_BAR();
        if (ch + 1 < SEQ / 64) load_raw(ch + 1);
        f32x4 yv[4];
        {
            const int m = w4;
            f32x4 Pt[4];
#pragma unroll
            for (int n = 0; n < 4; ++n) Pt[n] = zero4();
            bf16x8 ac[4];
#pragma unroll
            for (int k = 0; k < 4; ++k) ac[k] = ld_frag(CM, LS2, 16 * m + r, 32 * k, q);
            const float cumt = CUM[16 * m + r];
#pragma unroll
            for (int n = 0; n < 4; ++n) if (n <= m) {
#pragma unroll
                for (int k = 0; k < 4; ++k) Pt[n] = MFMA16(ld_frag(BM, LS2, 16 * n + r, 32 * k, q), ac[k], Pt[n]);
                const f32x4 cs = *(const LAS f32x4*)(CUM + 16 * n + 4 * q);
#pragma unroll
                for (int i = 0; i < 4; ++i) { const bool keep = (n < m) || (4 * q + i <= r); Pt[n][i] = keep ? Pt[n][i] * __expf(cumt - cs[i]) : 0.f; }
            }
            f32x4 O[4];
            const float ect = ECUM[16 * m + r];
#pragma unroll
            for (int nv = 0; nv < 4; ++nv) O[nv] = zero4();
#pragma unroll
            for (int k = 0; k < 4; ++k)
#pragma unroll
                for (int nv = 0; nv < 4; ++nv) O[nv] = MFMA16(ld_frag(ZT, LS2, 16 * nv + r, 32 * k, q), ac[k], O[nv]);
#pragma unroll
            for (int nv = 0; nv < 4; ++nv) O[nv] = O[nv] * ect;
#pragma unroll
            for (int k = 0; k < 2; ++k) if (2 * k <= m) { const bf16x8 pf = pack_frag(Pt[2 * k], Pt[2 * k + 1]);
#pragma unroll
                for (int nv = 0; nv < 4; ++nv) O[nv] = MFMA16(ld_frag_perm(XVT, LS, 16 * nv + r, 32 * k, q), pf, O[nv]); }
            const int t = ch * 64 + 16 * m + r;
            float ss = 0.f;
#pragma unroll
            for (int nv = 0; nv < 4; ++nv) { const int p0 = 16 * nv + 4 * q;
                const v2u xr = *(const LAS v2u*)(XR + (16 * m + r) * LS + p0);
                const v2u zr = *(const v2u*)(P + (size_t)t * NP + C_Z + 512 + h * 64 + p0);
                const float x0 = __builtin_bit_cast(float, xr.x << 16), x1 = __builtin_bit_cast(float, xr.x & 0xffff0000u), x2 = __builtin_bit_cast(float, xr.y << 16), x3 = __builtin_bit_cast(float, xr.y & 0xffff0000u);
                const float z0 = __builtin_bit_cast(float, zr.x << 16), z1 = __builtin_bit_cast(float, zr.x & 0xffff0000u), z2 = __builtin_bit_cast(float, zr.y << 16), z3 = __builtin_bit_cast(float, zr.y & 0xffff0000u);
                yv[nv][0] = (O[nv][0] + x0 * dsk) * siluf_(z0); yv[nv][1] = (O[nv][1] + x1 * dsk) * siluf_(z1);
                yv[nv][2] = (O[nv][2] + x2 * dsk) * siluf_(z2); yv[nv][3] = (O[nv][3] + x3 * dsk) * siluf_(z3);
                ss += (yv[nv][0] * yv[nv][0] + yv[nv][1] * yv[nv][1]) + (yv[nv][2] * yv[nv][2] + yv[nv][3] * yv[nv][3]); }
            ss += __shfl_xor(ss, 16); ss += __shfl_xor(ss, 32);
            if (q == 0) SS[hh * 64 + 16 * m + r] = ss;
            const float el = ECUM[63];
#pragma unroll
            for (int a = 0; a < 2; ++a) { bf16x8 ab[2];
#pragma unroll
                for (int k = 0; k < 2; ++k) ab[k] = ld_frag(BT, LS, 16 * (2 * w4 + a) + r, 32 * k, q);
#pragma unroll
                for (int nv = 0; nv < 4; ++nv) { zs[a][nv] = zs[a][nv] * el;
#pragma unroll
                    for (int k = 0; k < 2; ++k) zs[a][nv] = MFMA16(ab[k], ld_frag(XVWT, LS, 16 * nv + r, 32 * k, q), zs[a][nv]); } }
        }
        WG_BAR();
        {
            const int m = w4, t = ch * 64 + 16 * m + r;
            const float tot = SS[16 * m + r] + SS[64 + 16 * m + r];
            const float rs = rsqrtf(tot * (1.f / 128.f) + 1e-6f);
#pragma unroll
            for (int nv = 0; nv < 4; ++nv) { const f32x4 gg = *(const f32x4*)(gnp + 16 * nv); v2u o; o.x = pk_bf16(yv[nv][0] * rs * gg[0], yv[nv][1] * rs * gg[1]); o.y = pk_bf16(yv[nv][2] * rs * gg[2], yv[nv][3] * rs * gg[3]);
                *(v2u*)(Yb + (size_t)t * DM + 512 + h * 64 + 16 * nv + 4 * q) = o; }
        }
    }
}

__device__ __forceinline__ void rwkv_pre_block(const Inputs& in, const int layer, const bf16* __restrict__ PROJ, float* __restrict__ CUMo, float* __restrict__ CUMPo, float* __restrict__ AV, LAS float* lds, const int m0, const int tid) {
    LAS float* SW = lds; LAS float* SA = lds + 4096; LAS float* HT = lds + 8192;
    const float* mu = in.rwkv_mu + (size_t)layer * 896;
    { const int j = tid & 63, tg = tid >> 6; const float muw = mu[768 + j], mua = mu[832 + j];
#pragma unroll
      for (int tt = 0; tt < 8; ++tt) { const int t = tg * 8 + tt, m = m0 + t; const bool first = ((m & (SEQ - 1)) == 0);
          const float xw = bf2f(PROJ[(size_t)m * NP + C_RW_WD + j]), xa = bf2f(PROJ[(size_t)m * NP + C_RW_AD + j]);
          const float pw = first ? 0.f : bf2f(PROJ[(size_t)(m - 1) * NP + C_RW_WD + j]), pa = first ? 0.f : bf2f(PROJ[(size_t)(m - 1) * NP + C_RW_AD + j]);
          SW[t * 64 + j] = tanhf(xw + (pw - xw) * muw); SA[t * 64 + j] = xa + (pa - xa) * mua; } }
    __syncthreads();
    { const int c = tid & 255, th = tid >> 8;
      float run = 0.f;
      { const float* wup = in.rwkv_w_up + (size_t)layer * 64 * GW + c;
        float wu[64];
#pragma unroll
        for (int j = 0; j < 64; ++j) wu[j] = wup[j * GW];
        const float w0 = in.rwkv_w0[layer * GW + c];
        for (int tt = 0; tt < 32; ++tt) { const int t = th * 32 + tt; float wl = w0;
#pragma unroll
            for (int j4 = 0; j4 < 16; ++j4) { const f32x4 sw = *(const LAS f32x4*)(SW + t * 64 + 4 * j4);
#pragma unroll
                for (int e = 0; e < 4; ++e) wl += sw[e] * wu[4 * j4 + e]; }
            const float w = -softplusf_(-wl) - 0.5f;
            const float lw = -__expf(w); run += lw;
            CUMo[(size_t)(m0 + t) * GW + c] = lw; } }
      asm volatile("" ::: "memory");
      { const float* aup = in.rwkv_a_up + (size_t)layer * 64 * GW + c;
        float au[64];
#pragma unroll
        for (int j = 0; j < 64; ++j) au[j] = aup[j * GW];
        const float a0 = in.rwkv_a0[layer * GW + c];
        for (int tt = 0; tt < 32; ++tt) { const int t = th * 32 + tt; float al = a0;
#pragma unroll
            for (int j4 = 0; j4 < 16; ++j4) { const f32x4 sa = *(const LAS f32x4*)(SA + t * 64 + 4 * j4);
#pragma unroll
                for (int e = 0; e < 4; ++e) al += sa[e] * au[4 * j4 + e]; }
            AV[(size_t)(m0 + t) * GW + c] = sigmoidf_(al); } }
      if (th == 0) HT[c] = run;
      __syncthreads();
      float acc = (th == 1) ? HT[c] : 0.f;
      for (int tt = 0; tt < 32; ++tt) { const int t = th * 32 + tt; const float lw = CUMo[(size_t)(m0 + t) * GW + c]; CUMPo[(size_t)(m0 + t) * GW + c] = acc; acc += lw; CUMo[(size_t)(m0 + t) * GW + c] = acc; } }
    __syncthreads();
}

__device__ __forceinline__ void mixopt_rwkv(const Inputs& in, const int layer, const bf16* __restrict__ PROJ, const float* __restrict__ CUMg, const float* __restrict__ CUMPg, const float* __restrict__ AV, bf16* __restrict__ Yg,
                                            LAS unsigned char* L, const int b, const int h, const int tid) {
    const int lane0 = tid & 63, wave = __builtin_amdgcn_readfirstlane(tid >> 6), w4 = wave & 3;
    const bool act = wave < 4;
    LAS bf16* AT = (LAS bf16*)L; LAS bf16* RT = (LAS bf16*)(L + 9216); LAS bf16* BL = (LAS bf16*)(L + 18432); LAS bf16* KL = (LAS bf16*)(L + 27648);
    LAS bf16* BTT = (LAS bf16*)(L + 36864); LAS bf16* KTT = (LAS bf16*)(L + 46080); LAS bf16* VT = (LAS bf16*)(L + 55296); LAS bf16* ZT = (LAS bf16*)(L + 64512);
    LAS bf16* AMT = (LAS bf16*)(L + 73728); LAS bf16* RHST = (LAS bf16*)(L + 82944); LAS float* AD = (LAS float*)(L + 92160); LAS bf16* DT = (LAS bf16*)(L + 96256);
    LAS float* QTOT = (LAS float*)(L + 98304); LAS float* ELAST = (LAS float*)(L + 99328); LAS float* BON = (LAS float*)(L + 99584);
    LAS bf16* SAT = AT;
    const bf16* P = PROJ + (size_t)b * SEQ * NP; bf16* Yb = Yg + (size_t)b * SEQ * DM;
    const float* CUMb = CUMg + (size_t)b * SEQ * GW; const float* CUMPb = CUMPg + (size_t)b * SEQ * GW; const float* AVb = AV + (size_t)b * SEQ * GW;
    const float* mu = in.rwkv_mu + (size_t)layer * 896 + h * 64;
    f32x4 zs[4];
#pragma unroll
    for (int n = 0; n < 4; ++n) zs[n] = zero4();
    LAS unsigned char* RAWT = L + 73728; LAS float* CMT = (LAS float*)(L + 99840); LAS float* AVT = (LAS float*)(L + 116480);
    v4u st[16];
    auto stage_load = [&](int ch, int ht) {
#pragma unroll
        for (int i = 0; i < 7; ++i) { const int u = ht + 256 * i; const int row = u / 24, rem = u - row * 24, seg = rem >> 3, part = rem & 7; const int t = ch * 64 - 1 + row;
            st[i] = (u < 1560 && t >= 0) ? *(const v4u*)(P + (size_t)t * NP + C_RW_R + seg * 256 + h * 64 + part * 8) : (v4u){0u, 0u, 0u, 0u}; }
#pragma unroll
        for (int i = 0; i < 5; ++i) { const int u = ht + 256 * i; const int row = u >> 4, part = u & 15; const int t = ch * 64 - 1 + row;
            st[7 + i] = (u < 1040 && t >= 0) ? *(const v4u*)(CUMb + (size_t)t * GW + h * 64 + part * 4) : (v4u){0u, 0u, 0u, 0u}; }
#pragma unroll
        for (int i = 0; i < 4; ++i) { const int u = ht + 256 * i; const int row = u >> 4, part = u & 15; const int t = ch * 64 + row;
            st[12 + i] = *(const v4u*)(AVb + (size_t)t * GW + h * 64 + part * 4); }
    };
    auto stage_store = [&](int ht) {
#pragma unroll
        for (int i = 0; i < 7; ++i) { const int u = ht + 256 * i; const int row = u / 24, rem = u - row * 24; if (u < 1560) *(LAS v4u*)(RAWT + row * 384 + rem * 16) = st[i]; }
#pragma unroll
        for (int i = 0; i < 5; ++i) { const int u = ht + 256 * i; if (u < 1040) *(LAS v4u*)((LAS unsigned char*)CMT + u * 16) = st[7 + i]; }
#pragma unroll
        for (int i = 0; i < 4; ++i) { const int u = ht + 256 * i; *(LAS v4u*)((LAS unsigned char*)AVT + u * 16) = st[12 + i]; }
    };
    if (!act) { const int ht = opaque_i(tid - 256); stage_load(0, ht); stage_store(ht); }
    WG_BAR();
    for (int ch = 0; ch < SEQ / 64; ++ch) {
        if (act) { const int lane = opaque_i(lane0), r = lane & 15, q = lane >> 4;
            float rs[16], k2[16], kkv[16], tv[16];
            const float mu_r = mu[lane], mu_k = mu[256 + lane], mu_v = mu[512 + lane];
            const float kkc = in.rwkv_k_k[layer * GW + h * 64 + lane], kac = in.rwkv_k_a[layer * GW + h * 64 + lane], rkc = in.rwkv_r_k[layer * GW + h * 64 + lane];
            { const LAS bf16* rw = (const LAS bf16*)RAWT + (16 * w4) * 192 + lane;
              float pr = bf2f(rw[0]), pk = bf2f(rw[64]), pv = bf2f(rw[128]);
#pragma unroll
              for (int i = 0; i < 16; ++i) { const float xr = bf2f(rw[(i + 1) * 192]), xk = bf2f(rw[(i + 1) * 192 + 64]), xv = bf2f(rw[(i + 1) * 192 + 128]);
                  const float av = AVT[(16 * w4 + i) * 64 + lane];
                  rs[i] = xr + (pr - xr) * mu_r; const float ks = xk + (pk - xk) * mu_k; tv[i] = xv + (pv - xv) * mu_v;
                  kkv[i] = ks * kkc; k2[i] = ks * (1.f + (av - 1.f) * kac); pr = xr; pk = xk; pv = xv; } }
            ssd_pack16(VT + lane * LS + 16 * w4, tv);
            { float sq[16];
#pragma unroll
              for (int i = 0; i < 16; ++i) sq[i] = kkv[i] * kkv[i];
              const float sred = tr_reduce16(sq, lane);
#pragma unroll
              for (int i = 0; i < 16; ++i) kkv[i] *= rsqrtf(rdlane(sred, 4 * i) + 1e-6f);
#pragma unroll
              for (int i = 0; i < 16; ++i) sq[i] = rs[i] * k2[i] * rkc;
              const float bred = tr_reduce16(sq, lane);
              if ((lane & 3) == 0) BON[16 * w4 + (lane >> 2)] = bred; }
#pragma unroll
            for (int i = 0; i < 16; ++i) { const float cum = CMT[(16 * w4 + i + 1) * 64 + lane]; const int t = 16 * w4 + i;
                const float en = __expf(-cum); const float cump = (i == 0 && w4 == 0) ? 0.f : CMT[(16 * w4 + i) * 64 + lane];
                AT[t * LS + lane] = cvt_bf16(-kkv[i] * __expf(cump));
                RT[t * LS + lane] = cvt_bf16(rs[i] * __expf(cum));
                kkv[i] = kkv[i] * AVT[(16 * w4 + i) * 64 + lane] * en; k2[i] = k2[i] * en;
                BL[t * LS + lane] = cvt_bf16(kkv[i]); KL[t * LS + lane] = cvt_bf16(k2[i]); }
            ssd_pack16(BTT + lane * LS + 16 * w4, kkv);
            ssd_pack16(KTT + lane * LS + 16 * w4, k2);
            if (w4 == 3) ELAST[lane] = __expf(CMT[64 * 64 + lane]);
#pragma unroll
            for (int n = 0; n < 4; ++n) st4(ZT, LS, 16 * n + r, 16 * w4 + 4 * q, zs[n]);
        }
        WG_BAR();
        if (!act && ch + 1 < SEQ / 64) stage_load(ch + 1, opaque_i(tid - 256));
        const int m = w4;
        if (act) { const int lane = opaque_i(lane0), r = lane & 15, q = lane >> 4;
            f32x4 Aak[4];
            bf16x8 aa[2];
#pragma unroll
            for (int k = 0; k < 2; ++k) aa[k] = ld_frag(AT, LS, 16 * m + r, 32 * k, q);
#pragma unroll
            for (int n = 0; n < 4; ++n) { Aak[n] = zero4(); if (n <= m) {
                f32x4 ab = zero4();
#pragma unroll
                for (int k = 0; k < 2; ++k) { const bf16x8 fb = ld_frag(BL, LS, 16 * n + r, 32 * k, q), fk = ld_frag(KL, LS, 16 * n + r, 32 * k, q);
                    ab = MFMA16(aa[k], fb, ab);
                    Aak[n] = MFMA16(fk, aa[k], Aak[n]); }
                f32x4 av;
#pragma unroll
                for (int i = 0; i < 4; ++i) { const bool keep = (n < m) || (r < 4 * q + i); av[i] = keep ? -ab[i] : 0.f; }
                st4(AMT, LS, 16 * n + r, 16 * m + 4 * q, av);
                if (n == m) {
#pragma unroll
                    for (int i = 0; i < 4; ++i) AD[m * 256 + (4 * q + i) * 16 + r] = av[i];
#pragma unroll
                    for (int i = 0; i < 4; ++i) { const bool strict = (4 * q + i < r); Aak[n][i] = strict ? Aak[n][i] : 0.f; } }
            } }
            const bf16x8 p0 = pack_frag(Aak[0], Aak[1]), p1 = pack_frag(Aak[2], Aak[3]);
#pragma unroll
            for (int nv = 0; nv < 4; ++nv) { f32x4 rh = zero4();
#pragma unroll
                for (int k = 0; k < 2; ++k) rh = MFMA16(aa[k], ld_frag(ZT, LS, 16 * nv + r, 32 * k, q), rh);
                rh = MFMA16(p0, ld_frag_perm(VT, LS, 16 * nv + r, 0, q), rh);
                if (m >= 2) rh = MFMA16(p1, ld_frag_perm(VT, LS, 16 * nv + r, 32, q), rh);
                st4(RHST, LS, 16 * nv + r, 16 * m + 4 * q, rh); }
        }
        WG_BAR();
        if (act) { const int lane = opaque_i(lane0), r = lane & 15, q = lane >> 4;
            diag_inverse(AD, DT, lane);
            asm volatile("s_waitcnt lgkmcnt(0)" ::: "memory");
            f32x4 Tm[4];
            tri_inverse_row(AMT, DT, m, r, q, Tm);
            const bf16x8 t0 = pack_frag(Tm[0], Tm[1]), t1 = pack_frag(Tm[2], Tm[3]);
#pragma unroll
            for (int nv = 0; nv < 4; ++nv) { f32x4 sa = zero4();
                sa = MFMA16(t0, ld_frag_perm(RHST, LS, 16 * nv + r, 0, q), sa);
                if (m >= 2) sa = MFMA16(t1, ld_frag_perm(RHST, LS, 16 * nv + r, 32, q), sa);
                st4(SAT, LS, 16 * nv + r, 16 * m + 4 * q, sa); }
        }
        WG_BAR();
        if (!act && ch + 1 < SEQ / 64) stage_store(opaque_i(tid - 256));
        if (act) { const int lane = opaque_i(lane0), r = lane & 15, q = lane >> 4;
            f32x4 O[4];
            bf16x8 ar[2];
#pragma unroll
            for (int k = 0; k < 2; ++k) ar[k] = ld_frag(RT, LS, 16 * m + r, 32 * k, q);
            f32x4 Arb[4], Ark[4];
#pragma unroll
            for (int n = 0; n < 4; ++n) { Arb[n] = zero4(); Ark[n] = zero4(); if (n <= m) {
#pragma unroll
                for (int k = 0; k < 2; ++k) { Arb[n] = MFMA16(ld_frag(BL, LS, 16 * n + r, 32 * k, q), ar[k], Arb[n]); Ark[n] = MFMA16(ld_frag(KL, LS, 16 * n + r, 32 * k, q), ar[k], Ark[n]); }
                if (n == m) {
#pragma unroll
                    for (int i = 0; i < 4; ++i) { const bool incl = (4 * q + i <= r); Arb[n][i] = incl ? Arb[n][i] : 0.f; Ark[n][i] = incl ? Ark[n][i] : 0.f; } } } }
            const bf16x8 b0 = pack_frag(Arb[0], Arb[1]), b1 = pack_frag(Arb[2], Arb[3]), k0 = pack_frag(Ark[0], Ark[1]), k1 = pack_frag(Ark[2], Ark[3]);
            float s1 = 0.f;
#pragma unroll
            for (int nv = 0; nv < 4; ++nv) { O[nv] = zero4();
#pragma unroll
                for (int k = 0; k < 2; ++k) O[nv] = MFMA16(ld_frag(ZT, LS, 16 * nv + r, 32 * k, q), ar[k], O[nv]);
                O[nv] = MFMA16(ld_frag_perm(SAT, LS, 16 * nv + r, 0, q), b0, O[nv]);
                O[nv] = MFMA16(ld_frag_perm(VT, LS, 16 * nv + r, 0, q), k0, O[nv]);
                if (m >= 2) { O[nv] = MFMA16(ld_frag_perm(SAT, LS, 16 * nv + r, 32, q), b1, O[nv]); O[nv] = MFMA16(ld_frag_perm(VT, LS, 16 * nv + r, 32, q), k1, O[nv]); }
                s1 += (O[nv][0] + O[nv][1]) + (O[nv][2] + O[nv][3]); }
            s1 += __shfl_xor(s1, 16); s1 += __shfl_xor(s1, 32);
            const float mean = s1 * (1.f / 64.f); float s2 = 0.f;
#pragma unroll
            for (int nv = 0; nv < 4; ++nv) { O[nv] = O[nv] - mean; s2 += (O[nv][0] * O[nv][0] + O[nv][1] * O[nv][1]) + (O[nv][2] * O[nv][2] + O[nv][3] * O[nv][3]); }
            s2 += __shfl_xor(s2, 16); s2 += __shfl_xor(s2, 32);
            const float rstd = rsqrtf(s2 * (1.f / 64.f) + 64e-5f);
            const int t = ch * 64 + 16 * m + r; const float bon = BON[16 * m + r];
#pragma unroll
            for (int nv = 0; nv < 4; ++nv) { const int dv0 = 16 * nv + 4 * q, cc = h * 64 + dv0;
                const f32x4 lw4 = *(const f32x4*)(in.rwkv_ln_w + layer * GW + cc); const f32x4 lb4 = *(const f32x4*)(in.rwkv_ln_b + layer * GW + cc);
                const v2u zr = *(const v2u*)(P + (size_t)t * NP + C_Z + 768 + cc);
                const float z0 = __builtin_bit_cast(float, zr.x << 16), z1 = __builtin_bit_cast(float, zr.x & 0xffff0000u), z2 = __builtin_bit_cast(float, zr.y << 16), z3 = __builtin_bit_cast(float, zr.y & 0xffff0000u);
                const float v0 = bf2f(VT[(dv0 + 0) * LS + 16 * m + r]), v1 = bf2f(VT[(dv0 + 1) * LS + 16 * m + r]), v2 = bf2f(VT[(dv0 + 2) * LS + 16 * m + r]), v3 = bf2f(VT[(dv0 + 3) * LS + 16 * m + r]);
                v2u o; o.x = pk_bf16((O[nv][0] * rstd * lw4[0] + lb4[0] + bon * v0) * siluf_(z0), (O[nv][1] * rstd * lw4[1] + lb4[1] + bon * v1) * siluf_(z1));
                o.y = pk_bf16((O[nv][2] * rstd * lw4[2] + lb4[2] + bon * v2) * siluf_(z2), (O[nv][3] * rstd * lw4[3] + lb4[3] + bon * v3) * siluf_(z3));
                *(v2u*)(Yb + (size_t)t * DM + 768 + cc) = o; }
            const f32x4 el = *(const LAS f32x4*)(ELAST + 16 * w4 + 4 * q);
            bf16x8 ab2[2], ak2[2];
#pragma unroll
            for (int k = 0; k < 2; ++k) { ab2[k] = ld_frag(BTT, LS, 16 * w4 + r, 32 * k, q); ak2[k] = ld_frag(KTT, LS, 16 * w4 + r, 32 * k, q); }
#pragma unroll
            for (int n = 0; n < 4; ++n) {
#pragma unroll
                for (int k = 0; k < 2; ++k) { zs[n] = MFMA16(ab2[k], ld_frag(SAT, LS, 16 * n + r, 32 * k, q), zs[n]); zs[n] = MFMA16(ak2[k], ld_frag(VT, LS, 16 * n + r, 32 * k, q), zs[n]); }
                zs[n] = zs[n] * el; }
        }
        WG_BAR();
    }
}

#ifndef MK_MASK
#define MK_MASK 31
#endif
#ifndef REP_MASK
#define REP_MASK 0
#endif

constexpr int NWAVES = 8;
constexpr size_t MiB = 1u << 20;
constexpr size_t WS_CTL = 0, CTL_ZERO_BYTES = 64 * 1024;
constexpr size_t WS_WIN = 1 * MiB;
constexpr size_t WS_WOUT = 18 * MiB;
constexpr size_t WS_U = 22 * MiB;
constexpr size_t WS_PROJ = 54 * MiB;
constexpr size_t WS_OUT = 190 * MiB;
constexpr int CW_BAR = 4096;
constexpr int LDSCTL_OFF = 147456, MISC_OFF = LDSCTL_OFF + 320, LDS_BYTES = 148480;

struct Args { Inputs in; float* out; unsigned char* ws; };
__device__ __forceinline__ int opaque_v(int v) { asm volatile("" : "+v"(v)); return v; }

__device__ __forceinline__ void wprep_load(const float* __restrict__ W, int N, int use_perm, int n0, int k0, int tid, LAS float* tile) {
    const int nn = tid & 31, kq = tid >> 5;
    const int oc = use_perm ? old_col(n0 + nn) : (n0 + nn);
#pragma unroll
    for (int i = 0; i < 8; ++i) { const int kk = kq + 8 * i; tile[kk * 33 + nn] = (oc >= 0) ? W[(size_t)(k0 + kk) * N + oc] : 0.f; }
}
__device__ __forceinline__ void wprep_store(bf16* __restrict__ WT, int K, int n0, int k0, int tid, const LAS float* tile) {
    const int n = tid >> 3, kc = (tid & 7) * 8;
    uint4 o;
    o.x = f2bf(tile[(kc + 0) * 33 + n]) | (f2bf(tile[(kc + 1) * 33 + n]) << 16);
    o.y = f2bf(tile[(kc + 2) * 33 + n]) | (f2bf(tile[(kc + 3) * 33 + n]) << 16);
    o.z = f2bf(tile[(kc + 4) * 33 + n]) | (f2bf(tile[(kc + 5) * 33 + n]) << 16);
    o.w = f2bf(tile[(kc + 6) * 33 + n]) | (f2bf(tile[(kc + 7) * 33 + n]) << 16);
    *(uint4*)(WT + (size_t)(n0 + n) * K + k0 + kc) = o;
}

__device__ __forceinline__ void rmsnorm_row_bf16(const float* __restrict__ hrow, const float* __restrict__ g, bf16* __restrict__ urow, int lane) {
    const float4* xr = (const float4*)hrow + lane; const float4* gr = (const float4*)g + lane;
    float4 v[4]; float s = 0.f;
#pragma unroll
    for (int j = 0; j < 4; ++j) { v[j] = xr[64 * j]; s += (v[j].x * v[j].x + v[j].y * v[j].y) + (v[j].z * v[j].z + v[j].w * v[j].w); }
    const float r = rsqrtf(wave_sum(s) * (1.f / DM) + 1e-6f);
    uint2* o8 = (uint2*)urow + lane;
#pragma unroll
    for (int j = 0; j < 4; ++j) { const float4 gg = gr[64 * j]; uint2 o;
        o.x = f2bf(v[j].x * r * gg.x) | (f2bf(v[j].y * r * gg.y) << 16); o.y = f2bf(v[j].z * r * gg.z) | (f2bf(v[j].w * r * gg.w) << 16); o8[64 * j] = o; }
}

__device__ __forceinline__ void post_row(const float* hrow, const float* __restrict__ orow_, const float* __restrict__ g, float* hnew, const float* __restrict__ g2, bf16* __restrict__ urow, int lane) {
    const float4* orow = (const float4*)orow_ + lane; const float4* hr = (const float4*)hrow + lane; const float4* gr = (const float4*)g + lane;
    float4 v[4]; float s = 0.f;
#pragma unroll
    for (int j = 0; j < 4; ++j) { v[j] = orow[64 * j]; s += (v[j].x * v[j].x + v[j].y * v[j].y) + (v[j].z * v[j].z + v[j].w * v[j].w); }
    const float r = rsqrtf(wave_sum(s) * (1.f / DM) + 1e-6f);
    float4* o = (float4*)hnew + lane; float s2 = 0.f;
#pragma unroll
    for (int j = 0; j < 4; ++j) { const float4 gg = gr[64 * j]; const float4 hh = hr[64 * j]; float4 w;
        w.x = hh.x + v[j].x * r * gg.x; w.y = hh.y + v[j].y * r * gg.y; w.z = hh.z + v[j].z * r * gg.z; w.w = hh.w + v[j].w * r * gg.w; o[64 * j] = w; v[j] = w;
        s2 += (w.x * w.x + w.y * w.y) + (w.z * w.z + w.w * w.w); }
    if (g2) {
        const float r2 = rsqrtf(wave_sum(s2) * (1.f / DM) + 1e-6f);
        const float4* g2r = (const float4*)g2 + lane; uint2* o8 = (uint2*)urow + lane;
#pragma unroll
        for (int j = 0; j < 4; ++j) { const float4 gg = g2r[64 * j]; uint2 q;
            q.x = f2bf(v[j].x * r2 * gg.x) | (f2bf(v[j].y * r2 * gg.y) << 16); q.y = f2bf(v[j].z * r2 * gg.z) | (f2bf(v[j].w * r2 * gg.w) << 16); o8[64 * j] = q; }
    }
}

#define CAS __attribute__((address_space(4)))
#define GRID_BAR() do { const CAS Args* apb = (const CAS Args*)__builtin_amdgcn_kernarg_segment_ptr(); asm volatile("" : "+s"(apb)); \
    XcdBarrier bq; bq.bar = (unsigned*)((gu32*)(apb->ws + WS_CTL) + CW_BAR); bq.x = xb_xcc_id(); bq.st = (volatile LAS unsigned*)(lds + MISC_OFF) + 8; \
    int wv_ = wave_k; asm volatile("" : "+s"(wv_)); xcd_barrier(bq, (wv_ << 6) | fresh_lane()); } while (0)
#define PHASE_LOCALS() \
    const CAS Args* ap = (const CAS Args*)__builtin_amdgcn_kernarg_segment_ptr(); asm volatile("" : "+s"(ap)); \
    Inputs in; in.x = ap->in.x; in.pre_norm_g = ap->in.pre_norm_g; in.w_in = ap->in.w_in; in.hgrn_lb = ap->in.hgrn_lb; in.hgrn_norm_g = ap->in.hgrn_norm_g; in.gdn_conv_w = ap->in.gdn_conv_w; in.gdn_a_log = ap->in.gdn_a_log; in.gdn_dt_bias = ap->in.gdn_dt_bias; in.gdn_norm_g = ap->in.gdn_norm_g; in.ssm_conv_w = ap->in.ssm_conv_w; in.ssm_conv_b = ap->in.ssm_conv_b; in.ssm_a_log = ap->in.ssm_a_log; in.ssm_dt_bias = ap->in.ssm_dt_bias; in.ssm_d = ap->in.ssm_d; in.ssm_norm_g = ap->in.ssm_norm_g; in.rwkv_mu = ap->in.rwkv_mu; in.rwkv_w0 = ap->in.rwkv_w0; in.rwkv_w_up = ap->in.rwkv_w_up; in.rwkv_a0 = ap->in.rwkv_a0; in.rwkv_a_up = ap->in.rwkv_a_up; in.rwkv_k_k = ap->in.rwkv_k_k; in.rwkv_k_a = ap->in.rwkv_k_a; in.rwkv_r_k = ap->in.rwkv_r_k; in.rwkv_ln_w = ap->in.rwkv_ln_w; in.rwkv_ln_b = ap->in.rwkv_ln_b; in.w_out = ap->in.w_out; in.post_norm_g = ap->in.post_norm_g; \
    unsigned char* ws = ap->ws; float* hout = ap->out; \
    int bx = blockIdx.x; asm volatile("" : "+s"(bx)); int G = gridDim.x; asm volatile("" : "+s"(G)); \
    const int lane = fresh_lane(); int wave = wave_k; asm volatile("" : "+s"(wave)); const int tid = (wave << 6) | lane; \
    bf16* Win = (bf16*)(ws + WS_WIN); bf16* Wout = (bf16*)(ws + WS_WOUT); bf16* U = (bf16*)(ws + WS_U); bf16* PROJ = (bf16*)(ws + WS_PROJ); float* OUT = (float*)(ws + WS_OUT); \
    (void)Win; (void)Wout; (void)U; (void)PROJ; (void)OUT; (void)hout; (void)bx; (void)G; (void)lane; (void)wave;

__global__ void __launch_bounds__(NWAVES * 64, 2) mk_fwd(Args args) {
    extern __shared__ __attribute__((aligned(16))) unsigned char lds_raw[];
    LAS unsigned char* lds = (LAS unsigned char*)lds_raw;
    volatile LAS unsigned* MISC = (volatile LAS unsigned*)(lds + MISC_OFF);
    const int wave_k = __builtin_amdgcn_readfirstlane((int)threadIdx.x >> 6);
    for (int u = threadIdx.x; u < (LDS_BYTES - LDSCTL_OFF) / 4; u += NWAVES * 64) ((LAS unsigned*)(lds + LDSCTL_OFF))[u] = 0u;
    __syncthreads();
    (void)xcd_barrier_post((unsigned*)((gu32*)(args.ws + WS_CTL) + CW_BAR), MISC + 8, (int)threadIdx.x);

    {
        PHASE_LOCALS();
        const int half = tid >> 8, t256 = tid & 255;
        LAS float* tile = (LAS float*)(lds + half * 16384);
        constexpr int IT_IN = (NP / 32) * (DM / 64), IT_OUT = (DM / 32) * (DM / 64), IT_ALL = NLAYER * (IT_IN + IT_OUT);
        for (int it0 = bx * 2; it0 < IT_ALL; it0 += G * 2) {
            const int it = it0 + half; const bool act = it < IT_ALL;
            const float* W = nullptr; bf16* WT = nullptr; int N = 0, perm = 0, n0 = 0, k0 = 0;
            if (act) { int r = it; const int l = r / (IT_IN + IT_OUT); r -= l * (IT_IN + IT_OUT);
                if (r < IT_IN) { W = in.w_in + (size_t)l * DM * IN_COLS; N = IN_COLS; perm = 1; WT = Win + (size_t)l * NP * DM; n0 = (r % (NP / 32)) * 32; k0 = (r / (NP / 32)) * 64; }
                else { r -= IT_IN; W = in.w_out + (size_t)l * DM * DM; N = DM; perm = 0; WT = Wout + (size_t)l * DM * DM; n0 = (r % (DM / 32)) * 32; k0 = (r / (DM / 32)) * 64; }
                wprep_load(W, N, perm, n0, k0, t256, tile); }
            __syncthreads();
            if (act) wprep_store(WT, DM, n0, k0, t256, tile);
            __syncthreads();
        }
        for (int m = bx * NWAVES + wave; m < MTOK; m += G * NWAVES) rmsnorm_row_bf16(in.x + (size_t)m * DM, in.pre_norm_g, U + (size_t)m * DM, lane);
    }
    GRID_BAR();

#pragma unroll
    for (int l = 0; l < NLAYER; ++l) {
        { PHASE_LOCALS();
          pg8::Gemm g; g.A = U; g.Bt = Win + (size_t)l * NP * DM; g.M = MTOK; g.N = NP; g.K = DM;
          pg8::StaticOrder S; S.init(MTOK, NP, G, bx); S.wave_id = wave;
          pg8::EpiBf16<0> E; E.O = PROJ; E.ldc = NP; E.bias = nullptr; E.split_cols = 0; E.split_stride = 0;
          for (int rep = 0; rep < ((REP_MASK & 32) ? 2 : 1); ++rep) pg8::gemm_phase<pg8::EpiBf16<0>, pg8::StaticOrder, false>(lds, g, S, E, nullptr); }
        GRID_BAR();
        { PHASE_LOCALS();
          float* CUMW = OUT; float* CUMPW = OUT + (size_t)MTOK * GW; float* AVW = OUT + (size_t)2 * MTOK * GW;
          for (int rep = 0; rep < ((REP_MASK & 16) ? 2 : 1); ++rep) for (int blk = bx; blk < MTOK / 64; blk += G) { const int tid_l = opaque_v(tid); rwkv_pre_block(in, l, PROJ, CUMW, CUMPW, AVW, (LAS float*)lds, blk * 64, tid_l); } }
        GRID_BAR();
        { PHASE_LOCALS();
          const float* CUMW = OUT; const float* CUMPW = OUT + (size_t)MTOK * GW; const float* AVW = OUT + (size_t)2 * MTOK * GW;
          if (bx < 16) mixopt_hgrn(in, l, PROJ, U, lds, (bx >> 1) & 7, bx & 1, (wave << 6) | fresh_lane());
          else if (bx < 48) mixopt_gdn2(in, l, PROJ, U, lds, (bx - 16) >> 2, (bx - 16) & 3, (wave << 6) | fresh_lane());
          else if (bx < 64) mixopt_ssd(in, l, PROJ, U, lds, ((bx - 48) >> 1) & 7, (bx - 48) & 1, (wave << 6) | fresh_lane());
          else if (bx < 96) mixopt_rwkv(in, l, PROJ, CUMW, CUMPW, AVW, U, lds, (bx - 64) >> 2, (bx - 64) & 3, (wave << 6) | fresh_lane()); }
        GRID_BAR();
        { PHASE_LOCALS();
          pg8::Gemm g; g.A = U; g.Bt = Wout + (size_t)l * DM * DM; g.M = MTOK; g.N = DM; g.K = DM;
          pg8::StaticOrder S; S.init(MTOK, DM, G, bx); S.wave_id = wave;
          pg8::EpiF32 E; E.C = OUT; E.ldc = DM; E.bias = nullptr;
          for (int rep = 0; rep < ((REP_MASK & 64) ? 2 : 1); ++rep) pg8::gemm_phase<pg8::EpiF32, pg8::StaticOrder, false>(lds, g, S, E, nullptr); }
        GRID_BAR();
        { PHASE_LOCALS();
          const float* hin = (l == 0) ? in.x : hout;
          for (int m = bx * NWAVES + wave; m < MTOK; m += G * NWAVES)
            post_row(hin + (size_t)m * DM, OUT + (size_t)m * DM, in.post_norm_g + (size_t)l * DM, hout + (size_t)m * DM,
                     (l + 1 < NLAYER) ? in.pre_norm_g + (size_t)(l + 1) * DM : nullptr, U + (size_t)m * DM, lane); }
        if (l + 1 < NLAYER) GRID_BAR();
    }
}

extern "C" void kernel_launch(void* const* d_in, const int* in_sizes, int n_in, void* d_out, int out_size, void* d_ws, size_t ws_size, hipStream_t stream) {
    static int grid = 0;
    if (grid == 0) {
        int dev = 0, cus = 0, per_cu = 0;
        if (hipGetDevice(&dev) != hipSuccess || hipDeviceGetAttribute(&cus, hipDeviceAttributeMultiprocessorCount, dev) != hipSuccess) { fprintf(stderr, "kernel_launch: device query failed\n"); grid = -1; return; }
        if (hipFuncSetAttribute((const void*)mk_fwd, hipFuncAttributeMaxDynamicSharedMemorySize, LDS_BYTES) != hipSuccess) { fprintf(stderr, "kernel_launch: hipFuncSetAttribute failed\n"); grid = -1; return; }
        if (hipOccupancyMaxActiveBlocksPerMultiprocessor(&per_cu, (const void*)mk_fwd, NWAVES * 64, LDS_BYTES) != hipSuccess || per_cu < 1)
            fprintf(stderr, "kernel_launch: note: occupancy query reports %d workgroups per CU\n", per_cu);
        (void)hipGetLastError();
        grid = cus;
    }
    if (grid < 0) return;
    if (hipMemsetAsync((char*)d_ws + WS_CTL, 0, CTL_ZERO_BYTES, stream) != hipSuccess) { fprintf(stderr, "kernel_launch: memset failed\n"); return; }
    Args a{};
    { const float** ip = (const float**)&a.in; for (int i = 0; i < 27; ++i) ip[i] = (const float*)d_in[i]; }
    a.out = (float*)d_out; a.ws = (unsigned char*)d_ws;
    hipLaunchKernelGGL(mk_fwd, dim3(grid), dim3(NWAVES * 64), LDS_BYTES, stream, a);
}
```

```cpp
#include <hip/hip_runtime.h>
#include <cstdio>
#include <cstdint>
#define REP_MASK 0
#define HWCVT 3
#define HWSITES 0
namespace pg8 {
#define PG8_LAS __attribute__((address_space(3)))
typedef unsigned short bf16_t;
typedef short bf16x8 __attribute__((ext_vector_type(8)));
typedef float f32x4 __attribute__((ext_vector_type(4)));
typedef unsigned u32x4 __attribute__((ext_vector_type(4)));
constexpr int BM = 256, BK = 64, HALF = 128, HTB = HALF * BK * 2  , STAGE_BYTES = 8 * HTB, NXCD = 8, WGM = 8;

__host__ __device__ __forceinline__ int lds_byte(int r, int c) { const int st = (r >> 4) * 2 + (c >> 5), rr = r & 15, cc = c & 31, ob = rr * 64 + cc * 2; return st * 1024 + (ob ^ (((ob >> 9) & 1) << 5)); }
__host__ __device__ __forceinline__ void stage_rc(int b, int& R, int& C) { const int st = b / 1024, sb = b % 1024, swz = sb ^ (((sb >> 9) & 1) << 5); R = (st >> 1) * 16 + swz / 64; C = (st & 1) * 32 + (swz % 64) / 2; }
__host__ __device__ __forceinline__ int perm32(int rho) { const int n = rho >> 4, i = rho & 15; return 8 * (i >> 2) + 4 * n + (i & 3); }

struct Unit { int pm, pn; };
struct Gemm { const bf16_t* A; const bf16_t* Bt; int M, N, K; };

struct StaticOrder {
    int nM, nN, nwg, G, c, wave_id;
    __host__ __device__ void init(int M, int N, int G_, int c_) { nM = M / BM; nN = N / BM; nwg = nM * nN; G = G_; c = c_; }
    __host__ __device__ bool next(int i, Unit& u) const {
        const long L = (long)i * G + c; if (L >= nwg) return false;
        int wgid = (int)L; { const int q = nwg / NXCD, r = nwg % NXCD, xcd = wgid % NXCD, off = wgid / NXCD; wgid = (xcd < r ? xcd * (q + 1) : r * (q + 1) + (xcd - r) * q) + off; }
        const int nig = WGM * nN, gid = wgid / nig, fm = gid * WGM, gsz = (nM - fm) < WGM ? (nM - fm) : WGM;
        u.pm = fm + ((wgid % nig) % gsz); u.pn = (wgid % nig) / gsz; return true;
    }
    __device__ __forceinline__ void a_ready(const Unit&) const {}
    __device__ __forceinline__ void done(const Unit&) const {}
};
__device__ __forceinline__ unsigned cvt_pk_bf16(float lo, float hi) { unsigned r; asm volatile("v_cvt_pk_bf16_f32 %0, %1, %2" : "=v"(r) : "v"(lo), "v"(hi)); return r; }
typedef float f32x2 __attribute__((ext_vector_type(2)));
__device__ __forceinline__ f32x2 gelu_pk(f32x2 v) {
    const f32x2 av = __builtin_elementwise_abs(v), d = av * 0.2316418882f + 1.0f;
    f32x2 t; t.x = __builtin_amdgcn_rcpf(d.x); t.y = __builtin_amdgcn_rcpf(d.y);
    f32x2 q = t * 0.5307027145f + (-0.7265760135f); q = q * t + 0.7107068705f; q = q * t + (-0.142248368f); q = q * t + 0.127414796f; q = q * t;
    const f32x2 s = (v * v) * (-0.72134752044f);
    f32x2 e; e.x = __builtin_amdgcn_exp2f(s.x); e.y = __builtin_amdgcn_exp2f(s.y);
    const f32x2 m = v * (q * e), r = v - m;
    f32x2 o; o.x = v.x < 0.f ? m.x : r.x; o.y = v.y < 0.f ? m.y : r.y; return o;
}

struct EpiF32 {
    static constexpr bool PERM = false, AFTER_DRAIN = false;
    float* C; int ldc; const float* bias;
    __device__ __forceinline__ void operator()(const f32x4 (&acc)[2][2][4][2], const Unit& u, int wr, int wc, int fr, int fq) const {
        const int row0 = u.pm * BM + wr * 64 + fr, col0 = u.pn * BM + wc * 32 + 4 * fq;
        f32x4 bv[2][2];
#pragma unroll
        for (int bj = 0; bj < 2; ++bj)
#pragma unroll
            for (int n = 0; n < 2; ++n) bv[bj][n] = bias ? *(const f32x4*)(bias + col0 + bj * HALF + n * 16) : (f32x4){0.f, 0.f, 0.f, 0.f};
#pragma unroll
        for (int ai = 0; ai < 2; ++ai)
#pragma unroll
            for (int m = 0; m < 4; ++m) { float* rowp = C + (size_t)(row0 + ai * HALF + m * 16) * ldc + col0;
#pragma unroll
                for (int bj = 0; bj < 2; ++bj)
#pragma unroll
                    for (int n = 0; n < 2; ++n) *(f32x4*)(rowp + bj * HALF + n * 16) = acc[ai][bj][m][n] + bv[bj][n]; }
    }
};
template <int ACT  > struct EpiBf16 {
    static constexpr bool PERM = true, AFTER_DRAIN = false;
    bf16_t* O; int ldc; const float* bias; int split_cols; size_t split_stride;
    __device__ __forceinline__ void operator()(const f32x4 (&acc)[2][2][4][2], const Unit& u, int wr, int wc, int fr, int fq) const {
        const int row0 = u.pm * BM + wr * 64 + fr; int colt = u.pn * BM; bf16_t* base = O;
        if (split_cols) { const int t = colt / split_cols; base += (size_t)t * split_stride; colt -= t * split_cols; }
        const int col0 = colt + wc * 32 + 8 * fq, bcol0 = u.pn * BM + wc * 32 + 8 * fq;
        f32x4 bv[2][2];
#pragma unroll
        for (int bj = 0; bj < 2; ++bj)
#pragma unroll
            for (int n = 0; n < 2; ++n) bv[bj][n] = bias ? *(const f32x4*)(bias + bcol0 + bj * HALF + 4 * n) : (f32x4){0.f, 0.f, 0.f, 0.f};
#pragma unroll
        for (int ai = 0; ai < 2; ++ai)
#pragma unroll
            for (int m = 0; m < 4; ++m) { bf16_t* rowp = base + (size_t)(row0 + ai * HALF + m * 16) * ldc + col0;
#pragma unroll
                for (int bj = 0; bj < 2; ++bj) { f32x4 v0 = acc[ai][bj][m][0] + bv[bj][0], v1 = acc[ai][bj][m][1] + bv[bj][1];
                    if (ACT == 1) { f32x2 a = gelu_pk((f32x2){v0[0], v0[1]}), b = gelu_pk((f32x2){v0[2], v0[3]}), c = gelu_pk((f32x2){v1[0], v1[1]}), d = gelu_pk((f32x2){v1[2], v1[3]});
                        v0 = (f32x4){a.x, a.y, b.x, b.y}; v1 = (f32x4){c.x, c.y, d.x, d.y}; }
                    if (ACT == 2) {
#pragma unroll
                        for (int j = 0; j < 4; ++j) { v0[j] = 0.5f * v0[j] * (1.0f + erff(v0[j] * 0.70710678f)); v1[j] = 0.5f * v1[j] * (1.0f + erff(v1[j] * 0.70710678f)); } }
                    u32x4 w; w.x = cvt_pk_bf16(v0[0], v0[1]); w.y = cvt_pk_bf16(v0[2], v0[3]); w.z = cvt_pk_bf16(v1[0], v1[1]); w.w = cvt_pk_bf16(v1[2], v1[3]);
                    *(u32x4*)(rowp + bj * HALF) = w; } }
    }
};
__device__ __forceinline__ int fresh_lane_pg8() { unsigned m_ = ~0u; asm volatile("" : "+s"(m_)); return (int)__builtin_amdgcn_mbcnt_hi(m_, __builtin_amdgcn_mbcnt_lo(m_, 0u)); }
template <class Epi, class Sched, bool STAMP = false>
__device__ __forceinline__ void gemm_phase(PG8_LAS unsigned char* lds, const Gemm g, const Sched& S, const Epi& E, unsigned long long* stamps) {
    int tid_op_ = (S.wave_id << 6) | fresh_lane_pg8(); const int tid = tid_op_, wid = __builtin_amdgcn_readfirstlane(tid >> 6), lane = tid & 63, wr = wid >> 2, wc = wid & 3, fr = lane & 15, fq = lane >> 4;
    const int K = g.K, nt = K / BK;
    int ts_lo = 0, ts_hi = 0, nts = 0; const unsigned long long rt_entry = STAMP ? (unsigned long long)wall_clock64() : 0ull;
#define PG8_STAMP() do { if (STAMP && wid == 0 && nts < 64) { const unsigned long long _c = (unsigned long long)clock64(); \
        ts_lo = (lane == nts) ? (int)(unsigned)_c : ts_lo; ts_hi = (lane == nts) ? (int)(unsigned)(_c >> 32) : ts_hi; ++nts; } } while (0)
    PG8_STAMP();
    unsigned voffA[2], voffB[2];
#pragma unroll
    for (int i = 0; i < 2; ++i) { int R, C; stage_rc(tid * 16 + i * 8192, R, C); const int Rb = Epi::PERM ? ((R & ~31) + perm32(R & 31)) : R;
        voffA[i] = (unsigned)(R * K + C) * 2u; voffB[i] = (unsigned)(Rb * K + C) * 2u; }
    const size_t kstep = (size_t)(BK * 2);
    const size_t hstep = (size_t)HALF * K * 2;
    const size_t tstep = 2 * hstep;
    const unsigned ldsw = (unsigned)wid * 1024u;
    const int aoff = lds_byte(wr * 64 + fr, fq * 8), boff = lds_byte(wc * 32 + fr, fq * 8);
#define PG8_SA(b, h) (((b) * 2 + (h)) * HTB)
#define PG8_SB(b, h) ((4 + (b) * 2 + (h)) * HTB)
#define PG8_STAGE(bufoff, gbase, voff) do { _Pragma("unroll") for (int _i = 0; _i < 2; ++_i) \
        __builtin_amdgcn_global_load_lds((const unsigned*)((const char*)(gbase) + (voff)[_i]), (PG8_LAS unsigned*)(lds + (bufoff) + ldsw + _i * 8192), 16, 0, 0); } while (0)
#define PG8_LDA(dst, b, h) do { _Pragma("unroll") for (int m = 0; m < 4; ++m) _Pragma("unroll") for (int k = 0; k < 2; ++k) dst[m][k] = *(const PG8_LAS bf16x8*)(lds + PG8_SA(b, h) + aoff + m * 2048 + k * 1024); } while (0)
#define PG8_LDB(dst, b, h) do { _Pragma("unroll") for (int n = 0; n < 2; ++n) _Pragma("unroll") for (int k = 0; k < 2; ++k) dst[n][k] = *(const PG8_LAS bf16x8*)(lds + PG8_SB(b, h) + boff + n * 2048 + k * 1024); } while (0)
#define PG8_MMA(ai, bj, At, Bt) do { __builtin_amdgcn_s_setprio(1); _Pragma("unroll") for (int m = 0; m < 4; ++m) _Pragma("unroll") for (int n = 0; n < 2; ++n) _Pragma("unroll") for (int k = 0; k < 2; ++k) \
        acc[ai][bj][m][n] = __builtin_amdgcn_mfma_f32_16x16x32_bf16(Bt[n][k], At[m][k], acc[ai][bj][m][n], 0, 0, 0); __builtin_amdgcn_s_setprio(0); } while (0)
#define PG8_WAIT_V(n) asm volatile("s_waitcnt vmcnt(" #n ")" ::: "memory")
#define PG8_WAIT_L(n) asm volatile("s_waitcnt lgkmcnt(" #n ")" ::: "memory")
#define PG8_BAR __builtin_amdgcn_s_barrier()
#define PG8_SCHED __builtin_amdgcn_sched_barrier(0)
    Unit cur, nxt; int ui = 0;
    if (!S.next(0, cur)) return;
    f32x4 acc[2][2][4][2];
#pragma unroll
    for (int a = 0; a < 2; ++a)
#pragma unroll
        for (int b = 0; b < 2; ++b)
#pragma unroll
            for (int m = 0; m < 4; ++m)
#pragma unroll
                for (int n = 0; n < 2; ++n) acc[a][b][m][n] = (f32x4){0.f, 0.f, 0.f, 0.f};
    bf16x8 At[4][2], B0[2][2], B1[2][2];
    const char* cA = (const char*)g.A + (size_t)cur.pm * tstep; const char* cB = (const char*)g.Bt + (size_t)cur.pn * tstep;
    S.a_ready(cur);
    PG8_STAGE(PG8_SB(0, 0), cB, voffB); PG8_STAGE(PG8_SA(0, 0), cA, voffA); PG8_STAGE(PG8_SB(0, 1), cB + hstep, voffB); PG8_STAGE(PG8_SA(0, 1), cA + hstep, voffA);
    if (wr == 1) PG8_BAR;
    PG8_WAIT_V(4); PG8_BAR;
    PG8_STAGE(PG8_SB(1, 0), cB + kstep, voffB); PG8_STAGE(PG8_SA(1, 0), cA + kstep, voffA); PG8_STAGE(PG8_SB(1, 1), cB + hstep + kstep, voffB);
    PG8_WAIT_V(6); PG8_BAR;
    PG8_STAMP();
    for (;;) {
        const bool has_next = S.next(ui + 1, nxt);
        const char* nA = has_next ? (const char*)g.A + (size_t)nxt.pm * tstep : cA; const char* nB = has_next ? (const char*)g.Bt + (size_t)nxt.pn * tstep : cB;
        for (int t = 0; t < nt; t += 2) {
            const bool last = (t == nt - 2);
            const char* a1 = cA + (size_t)(t + 1) * kstep;
            const char* a2 = last ? nA : cA + (size_t)(t + 2) * kstep; const char* b2 = last ? nB : cB + (size_t)(t + 2) * kstep;
            const char* a3 = a2 + kstep; const char* b3 = b2 + kstep;
            if (last && has_next) S.a_ready(nxt);
            PG8_LDB(B0, 0, 0); PG8_SCHED; PG8_LDA(At, 0, 0); PG8_STAGE(PG8_SA(1, 1), a1 + hstep, voffA);
            PG8_WAIT_L(8); PG8_BAR; PG8_WAIT_L(0); PG8_MMA(0, 0, At, B0); PG8_BAR; PG8_SCHED;
            PG8_LDB(B1, 0, 1); PG8_STAGE(PG8_SB(0, 0), b2, voffB);
            PG8_BAR; PG8_WAIT_L(0); PG8_MMA(0, 1, At, B1); PG8_BAR;
            PG8_LDA(At, 0, 1); PG8_STAGE(PG8_SA(0, 0), a2, voffA);
            PG8_BAR; PG8_WAIT_L(0); PG8_MMA(1, 0, At, B0); PG8_BAR; PG8_SCHED;
            PG8_STAGE(PG8_SB(0, 1), b2 + hstep, voffB);
            PG8_WAIT_V(6); PG8_BAR; PG8_MMA(1, 1, At, B1); PG8_BAR;
            PG8_LDB(B0, 1, 0); PG8_SCHED; PG8_LDA(At, 1, 0); PG8_STAGE(PG8_SA(0, 1), a2 + hstep, voffA);
            PG8_WAIT_L(8); PG8_BAR; PG8_WAIT_L(0); PG8_MMA(0, 0, At, B0); PG8_BAR; PG8_SCHED;
            PG8_LDB(B1, 1, 1); PG8_STAGE(PG8_SB(1, 0), b3, voffB);
            PG8_BAR; PG8_WAIT_L(0); PG8_MMA(0, 1, At, B1); PG8_BAR;
            PG8_LDA(At, 1, 1); PG8_STAGE(PG8_SA(1, 0), a3, voffA);
            PG8_BAR; PG8_WAIT_L(0); PG8_MMA(1, 0, At, B0); PG8_BAR; PG8_SCHED;
            PG8_STAGE(PG8_SB(1, 1), b3 + hstep, voffB);
            PG8_WAIT_V(6); PG8_BAR; PG8_MMA(1, 1, At, B1); PG8_BAR;
        }
        PG8_STAMP();
        if constexpr (!Epi::AFTER_DRAIN) { E(acc, cur, wr, wc, fr, fq); S.done(cur); }
        PG8_STAMP();
        if (!has_next) break;
#pragma unroll
        for (int a = 0; a < 2; ++a)
#pragma unroll
            for (int b = 0; b < 2; ++b)
#pragma unroll
                for (int m = 0; m < 4; ++m)
#pragma unroll
                    for (int n = 0; n < 2; ++n) acc[a][b][m][n] = (f32x4){0.f, 0.f, 0.f, 0.f};
        cur = nxt; cA = nA; cB = nB; ++ui;
    }
    PG8_WAIT_V(0);
    if (wr == 0) PG8_BAR;
    PG8_BAR;
    if constexpr (Epi::AFTER_DRAIN) { E.fused(acc, cur, wr, wc, fr, fq, lds, wid, lane); S.done(cur); }
    PG8_STAMP();
    if (STAMP && wid == 0) { stamps[lane] = lane < nts ? (((unsigned long long)(unsigned)ts_hi << 32) | (unsigned)ts_lo) : 0ull;
        if (lane == 62) stamps[62] = rt_entry; if (lane == 63) stamps[63] = (unsigned long long)wall_clock64(); }
#undef PG8_STAMP
#undef PG8_SA
#undef PG8_SB
#undef PG8_STAGE
#undef PG8_LDA
#undef PG8_LDB
#undef PG8_MMA
#undef PG8_WAIT_V
#undef PG8_WAIT_L
#undef PG8_BAR
#undef PG8_SCHED
}
}
#define GAS __attribute__((address_space(1)))
#define LAS __attribute__((address_space(3)))
typedef unsigned short bf16;
typedef unsigned v4u __attribute__((ext_vector_type(4)));
typedef float f32x4 __attribute__((ext_vector_type(4)));
typedef short bf16x8 __attribute__((ext_vector_type(8)));
typedef GAS unsigned gu32;
typedef GAS unsigned long long gu64;
__device__ __forceinline__ int fresh_lane() { unsigned m_ = ~0u; asm volatile("" : "+s"(m_)); return (int)__builtin_amdgcn_mbcnt_hi(m_, __builtin_amdgcn_mbcnt_lo(m_, 0u)); }
#define RLX_AGENT __ATOMIC_RELAXED, __HIP_MEMORY_SCOPE_AGENT
#define LDS_WAIT() asm volatile("s_waitcnt lgkmcnt(0)" ::: "memory")
#define VM_WAIT() asm volatile("s_waitcnt vmcnt(0)" ::: "memory")
__device__ __forceinline__ unsigned long long rt() { return __builtin_amdgcn_s_memrealtime(); }
__device__ __forceinline__ unsigned f2bf(float f) { unsigned u = __builtin_bit_cast(unsigned, f); return (u + 0x7fffu + ((u >> 16) & 1u)) >> 16; }
__device__ __forceinline__ unsigned pk2(float lo, float hi) { return f2bf(lo) | (f2bf(hi) << 16); }
#define XB_TMO      128
#define XB_XCNT(j)  (256  + 64 * (j))
#define XB_XSUB(j)  (1280 + 64 * (j))
#define XB_XGEN(j)  (2304 + 64 * (j))
#define XB_TOP      3328
#define XB_TOPGEN   3392
#define XCD_BAR_WORDS 3456
#define XB_SPIN_CAP (1u << 22)

__device__ __forceinline__ unsigned xb_ld(unsigned* p)              { return __hip_atomic_load(p, __ATOMIC_RELAXED, __HIP_MEMORY_SCOPE_AGENT); }
__device__ __forceinline__ unsigned xb_add(unsigned* p, unsigned v) { return __hip_atomic_fetch_add(p, v, __ATOMIC_RELAXED, __HIP_MEMORY_SCOPE_AGENT); }
__device__ __forceinline__ unsigned xb_xcc_id() { return (unsigned)__builtin_amdgcn_s_getreg((3 << 11) | 20) & 0xFu; }
#define XB_SPIN(cond, bar) do { unsigned _sp = 0; while (cond) { __builtin_amdgcn_s_sleep(1); \
    if ((++_sp & 255u) == 0u) { if (xb_ld(&(bar)[XB_TMO])) break; if (_sp > XB_SPIN_CAP) { atomicAdd(&(bar)[XB_TMO], 1u); break; } } } } while (0)

struct XcdBarrier {
    unsigned* bar; unsigned x;
    volatile LAS unsigned* st;
};

__device__ __forceinline__ XcdBarrier xcd_barrier_post(unsigned* bar, volatile LAS unsigned* st, const int tid_) {
    XcdBarrier b; b.bar = bar; b.x = xb_xcc_id(); b.st = st;
    if (tid_ == 0) (void)xb_add(&bar[XB_XCNT(b.x)], 1u);
    return b;
}
__device__ __forceinline__ void xcd_barrier_complete(unsigned* bar, unsigned x, unsigned& nloc, unsigned& nx) {
    const unsigned G = gridDim.x * gridDim.y * gridDim.z;
    unsigned sum, cnt, mine, sp = 0u;
    for (;;) {
        sum = 0u; cnt = 0u; mine = 0u;
#pragma unroll
        for (unsigned j = 0; j < 16; ++j) { const unsigned c = xb_ld(&bar[XB_XCNT(j)]); sum += c; cnt += (c > 0u) ? 1u : 0u; mine = (j == x) ? c : mine; }
        if (sum == G) break;
        __builtin_amdgcn_s_sleep(1);
        if ((++sp & 255u) == 0u) { if (xb_ld(&bar[XB_TMO])) break; if (sp > XB_SPIN_CAP) { atomicAdd(&bar[XB_TMO], 1u); break; } }
    }
    nloc = mine > 0u ? mine : 1u; nx = cnt > 0u ? cnt : 1u;
}

__device__ __forceinline__ void xcd_barrier(const XcdBarrier& b, const int tid_) {
    asm volatile("s_waitcnt vmcnt(0)" ::: "memory");
    __syncthreads();
    if (tid_ == 0) {
        unsigned* bar = b.bar;
        __builtin_amdgcn_s_waitcnt(0);
        unsigned nloc = b.st[0], nx = b.st[1];
        if (nloc == 0u) { xcd_barrier_complete(bar, b.x, nloc, nx); b.st[0] = nloc; b.st[1] = nx; }
        const unsigned old = xb_add(&bar[XB_XSUB(b.x)], 1u);
        const unsigned gen = old / nloc;
        if (old + 1u == (gen + 1u) * nloc) {
            __builtin_amdgcn_fence(__ATOMIC_RELEASE, "agent");
            asm volatile("s_waitcnt vmcnt(0)" ::: "memory");
            const unsigned og = xb_add(&bar[XB_TOP], 1u);
            const unsigned tg = og / nx;
            if (og + 1u == (tg + 1u) * nx) xb_add(&bar[XB_TOPGEN], 1u);
            else XB_SPIN(xb_ld(&bar[XB_TOPGEN]) == tg, bar);
            __builtin_amdgcn_fence(__ATOMIC_ACQUIRE, "agent");
            xb_add(&bar[XB_XGEN(b.x)], 1u);
            asm volatile("s_waitcnt vmcnt(0)" ::: "memory");
        } else {
            XB_SPIN(xb_ld(&bar[XB_XGEN(b.x)]) == gen, bar);
            __builtin_amdgcn_fence(__ATOMIC_ACQUIRE, "agent");
            asm volatile("s_waitcnt vmcnt(0)" ::: "memory");
        }
    }
    __syncthreads();
}

constexpr int BATCH = 8, SEQ = 2048, DM = 1024, MTOK = BATCH * SEQ, NLAYER = 2;
constexpr int GW = 256, HD = 64, NHEAD = 4;
constexpr int IN_COLS = 4236, NP = 4352;
constexpr int C_HG_Q = 0, C_HG_F = 256, C_HG_I = 512;
constexpr int C_GD_Q = 768, C_GD_K = 1024, C_GD_V = 1280;
constexpr int C_SS_X = 1536, C_SS_B = 1792, C_SS_C = 2048;
constexpr int C_RW_R = 2304, C_RW_K = 2560, C_RW_V = 2816;
constexpr int C_Z = 3072;
constexpr int C_GD_BETA = 4096, C_GD_DEC = 4100, C_SS_DT = 4104, C_RW_WD = 4112, C_RW_AD = 4176;

__host__ __device__ __forceinline__ int old_col(int n) {
    if (n < 1536) return n;
    if (n < 2304) return 1544 + (n - 1536);
    if (n < 3072) return 2316 + (n - 2304);
    if (n < 4096) return 3212 + (n - 3072);
    if (n < 4104) return 1536 + (n - 4096);
    if (n < 4108) return 2312 + (n - 4104);
    if (n < 4112) return -1;
    if (n < 4240) return 3084 + (n - 4112);
    return -1;
}
__device__ __forceinline__ float bf2f(bf16 b) { return __builtin_bit_cast(float, ((unsigned)b) << 16); }
__device__ __forceinline__ float wave_sum(float v) {
#pragma unroll
    for (int o = 1; o < 64; o <<= 1) v += __shfl_xor(v, o);
    return v;
}
__device__ __forceinline__ float sigmoidf_(float x) { return __builtin_amdgcn_rcpf(1.f + __expf(-x)); }
__device__ __forceinline__ float siluf_(float x) { return x * __builtin_amdgcn_rcpf(1.f + __expf(-x)); }
__device__ __forceinline__ float softplusf_(float x) { return x > 20.f ? x : log1pf(__expf(x)); }

struct Inputs {
    const float* x; const float* pre_norm_g; const float* w_in; const float* hgrn_lb; const float* hgrn_norm_g;
    const float* gdn_conv_w; const float* gdn_a_log; const float* gdn_dt_bias; const float* gdn_norm_g;
    const float* ssm_conv_w; const float* ssm_conv_b; const float* ssm_a_log; const float* ssm_dt_bias; const float* ssm_d; const float* ssm_norm_g;
    const float* rwkv_mu; const float* rwkv_w0; const float* rwkv_w_up; const float* rwkv_a0; const float* rwkv_a_up; const float* rwkv_k_k; const float* rwkv_k_a;
    const float* rwkv_r_k; const float* rwkv_ln_w; const float* rwkv_ln_b; const float* w_out; const float* post_norm_g;
};


typedef short bf16x4 __attribute__((ext_vector_type(4)));
typedef unsigned v2u __attribute__((ext_vector_type(2)));
#define MFMA16(a, b, c) __builtin_amdgcn_mfma_f32_16x16x32_bf16((a), (b), (c), 0, 0, 0)
constexpr int LS = 72;
constexpr int MAT_B = 64 * LS * 2;
constexpr int LS2 = 136;
constexpr int HEAD_LDS = 73728;

typedef float f32x2_ __attribute__((ext_vector_type(2)));
typedef __bf16 bf2_ __attribute__((ext_vector_type(2)));
#ifndef HWCVT
#define HWCVT 0
#endif
__device__ __forceinline__ unsigned pk_hw(float lo, float hi) { const f32x2_ v_ = {lo, hi}; const bf2_ r_ = __builtin_convertvector(v_, bf2_); return __builtin_bit_cast(unsigned, r_); }
__device__ __forceinline__ unsigned pk_sw(float lo, float hi) { return f2bf(lo) | (f2bf(hi) << 16); }
__device__ __forceinline__ unsigned pk_bf16(float lo, float hi) { return (HWCVT & 1) ? pk_hw(lo, hi) : pk_sw(lo, hi); }
__device__ __forceinline__ bf16 cvt_bf16(float x) { return (HWCVT & 2) ? (bf16)(pk_hw(x, x) & 0xffffu) : (bf16)f2bf(x); }
__device__ __forceinline__ bf16x8 ld_frag(const LAS bf16* base, int stride, int row, int kofs, int q) {
    return *(const LAS bf16x8*)(base + row * stride + kofs + 8 * q);
}
__device__ __forceinline__ bf16x8 ld_frag_perm(const LAS bf16* base, int stride, int row, int kofs, int q) {
    const bf16x4 lo = *(const LAS bf16x4*)(base + row * stride + kofs + 4 * q);
    const bf16x4 hi = *(const LAS bf16x4*)(base + row * stride + kofs + 16 + 4 * q);
    bf16x8 v; v[0] = lo[0]; v[1] = lo[1]; v[2] = lo[2]; v[3] = lo[3]; v[4] = hi[0]; v[5] = hi[1]; v[6] = hi[2]; v[7] = hi[3]; return v;
}
__device__ __forceinline__ bf16x8 pack_frag(const f32x4& a, const f32x4& b) {
    union { unsigned u[4]; bf16x8 v; } x;
    x.u[0] = pk_bf16(a[0], a[1]); x.u[1] = pk_bf16(a[2], a[3]); x.u[2] = pk_bf16(b[0], b[1]); x.u[3] = pk_bf16(b[2], b[3]); return x.v;
}
__device__ __forceinline__ void st4(LAS bf16* base, int stride, int row, int col, const f32x4& v) {
    v2u o; o.x = pk_bf16(v[0], v[1]); o.y = pk_bf16(v[2], v[3]); *(LAS v2u*)(base + row * stride + col) = o;
}
__device__ __forceinline__ f32x4 zero4() { return (f32x4){0.f, 0.f, 0.f, 0.f}; }
#define WG_BAR() __syncthreads()

__device__ __forceinline__ void ssd_pack16(LAS bf16* dst, const float* v) {
    v4u w0, w1;
    w0.x = pk_bf16(v[0], v[1]); w0.y = pk_bf16(v[2], v[3]); w0.z = pk_bf16(v[4], v[5]); w0.w = pk_bf16(v[6], v[7]);
    w1.x = pk_bf16(v[8], v[9]); w1.y = pk_bf16(v[10], v[11]); w1.z = pk_bf16(v[12], v[13]); w1.w = pk_bf16(v[14], v[15]);
    *(LAS v4u*)dst = w0; *(LAS v4u*)(dst + 8) = w1;
}
#define RAWF(arr, j) bf2f((arr)[(j) >> 1][(j) & 1])
__device__ __forceinline__ int opaque_i(int v) { asm volatile("" : "+v"(v)); return v; }
#define RAWG(arr, j) bf2f((arr)[(j)])

template <bool HW> __device__ __forceinline__ unsigned pkx(float lo, float hi) { if constexpr (HW) return pk_hw(lo, hi); else return pk_bf16(lo, hi); }
template <bool HW> __device__ __forceinline__ bf16x8 pack_frag_x(const f32x4& a, const f32x4& b) {
    union { unsigned u[4]; bf16x8 v; } x;
    x.u[0] = pkx<HW>(a[0], a[1]); x.u[1] = pkx<HW>(a[2], a[3]); x.u[2] = pkx<HW>(b[0], b[1]); x.u[3] = pkx<HW>(b[2], b[3]); return x.v; }
template <bool HW> __device__ __forceinline__ void st4_x(LAS bf16* base, int stride, int row, int col, const f32x4& v) {
    v2u o; o.x = pkx<HW>(v[0], v[1]); o.y = pkx<HW>(v[2], v[3]); *(LAS v2u*)(base + row * stride + col) = o; }
template <bool HW> __device__ __forceinline__ void pack16_x(LAS bf16* dst, const float* v) {
    v4u w0, w1;
    w0.x = pkx<HW>(v[0], v[1]); w0.y = pkx<HW>(v[2], v[3]); w0.z = pkx<HW>(v[4], v[5]); w0.w = pkx<HW>(v[6], v[7]);
    w1.x = pkx<HW>(v[8], v[9]); w1.y = pkx<HW>(v[10], v[11]); w1.z = pkx<HW>(v[12], v[13]); w1.w = pkx<HW>(v[14], v[15]);
    *(LAS v4u*)dst = w0; *(LAS v4u*)(dst + 8) = w1; }
#ifndef HWSITES
#define HWSITES 0
#endif
#define SITE(k) (((HWSITES) >> (k)) & 1)

__device__ __forceinline__ void mixopt_hgrn(const Inputs& in, const int layer, const bf16* __restrict__ PROJ, bf16* __restrict__ Yg, LAS unsigned char* ldsw, const int b, const int hp, const int tid) {
    const int lane = tid & 63, wave = __builtin_amdgcn_readfirstlane(tid >> 6), hh = wave >> 2, w4 = wave & 3, h = hp * 2 + hh, r = lane & 15, q = lane >> 4;
    LAS unsigned char* L = ldsw + hh * HEAD_LDS;
    LAS bf16* QT = (LAS bf16*)L; LAS bf16* KA = (LAS bf16*)(L + MAT_B); LAS bf16* KB = (LAS bf16*)(L + 2 * MAT_B); LAS bf16* R2 = (LAS bf16*)(L + 3 * MAT_B);
    LAS bf16* KDT = (LAS bf16*)(L + 4 * MAT_B); LAS bf16* VT = (LAS bf16*)(L + 5 * MAT_B); LAS bf16* ZT = (LAS bf16*)(L + 6 * MAT_B);
    LAS float* QTOT = (LAS float*)(L + 7 * MAT_B); LAS float* ELAST = QTOT + 256;
    const bf16* P = PROJ + (size_t)b * SEQ * NP; bf16* Yb = Yg + (size_t)b * SEQ * DM;
    const int c = h * 64 + lane;
    float lbv = 0.f;
    if (layer == 1) { const float x0 = in.hgrn_lb[c], x1 = in.hgrn_lb[GW + c]; const float mx = fmaxf(x0, x1); const float e0 = __expf(x0 - mx), e1 = __expf(x1 - mx); lbv = e1 / (e0 + e1); }
    f32x4 gn[4];
#pragma unroll
    for (int nv = 0; nv < 4; ++nv) gn[nv] = *(const f32x4*)(in.hgrn_norm_g + layer * HD + 16 * nv + 4 * q);
    f32x4 zs[4];
#pragma unroll
    for (int n = 0; n < 4; ++n) zs[n] = zero4();
    bf16 rq[16], rf[16], rv[16];
    { const bf16* p0 = P + (size_t)(16 * w4) * NP;
#pragma unroll
      for (int i = 0; i < 16; ++i) { rq[i] = p0[(size_t)i * NP + C_HG_Q + c]; rf[i] = p0[(size_t)i * NP + C_HG_F + c]; rv[i] = p0[(size_t)i * NP + C_HG_I + c]; } }
    for (int ch = 0; ch < SEQ / 64; ++ch) {
        float qv[16], kv[16], cl[16], vv[16]; float run = 0.f;
#pragma unroll
        for (int i = 0; i < 16; ++i) { const float x = bf2f(rq[i]); qv[i] = siluf_(x) * 0.125f; const float f = lbv + (1.f - lbv) * sigmoidf_(bf2f(rf[i])); kv[i] = 1.f - f; run += __logf(f); cl[i] = run; vv[i] = bf2f(rv[i]); }
        QTOT[w4 * 64 + lane] = run;
        if (ch + 1 < SEQ / 64) { const bf16* p0 = P + (size_t)((ch + 1) * 64 + 16 * w4) * NP;
#pragma unroll
            for (int i = 0; i < 16; ++i) { rq[i] = p0[(size_t)i * NP + C_HG_Q + c]; rf[i] = p0[(size_t)i * NP + C_HG_F + c]; rv[i] = p0[(size_t)i * NP + C_HG_I + c]; } }
        WG_BAR();
        {
            const float o0 = QTOT[lane], o1 = QTOT[64 + lane], o2 = QTOT[128 + lane], o3 = QTOT[192 + lane];
            const float base = (w4 > 0 ? o0 : 0.f) + (w4 > 1 ? o1 : 0.f) + (w4 > 2 ? o2 : 0.f);
            const float c31 = o0 + o1, c63 = c31 + o2 + o3, cI = (w4 >= 2) ? c31 : 0.f;
            float kd[16];
#pragma unroll
            for (int i = 0; i < 16; ++i) { const float cum = cl[i] + base; const int t = 16 * w4 + i;
                QT[t * LS + lane] = cvt_bf16(qv[i] * __expf(cum - cI));
                KA[t * LS + lane] = cvt_bf16(kv[i] * __expf(fminf(cI - cum, 80.f)));
                if (w4 < 2) KB[t * LS + lane] = cvt_bf16(kv[i] * __expf(c31 - cum));
                R2[t * LS + lane] = cvt_bf16(qv[i] * __expf(cum));
                kd[i] = kv[i] * __expf(c63 - cum); }
            v4u w0, w1;
            w0.x = pk_bf16(kd[0], kd[1]); w0.y = pk_bf16(kd[2], kd[3]); w0.z = pk_bf16(kd[4], kd[5]); w0.w = pk_bf16(kd[6], kd[7]);
            w1.x = pk_bf16(kd[8], kd[9]); w1.y = pk_bf16(kd[10], kd[11]); w1.z = pk_bf16(kd[12], kd[13]); w1.w = pk_bf16(kd[14], kd[15]);
            *(LAS v4u*)(KDT + lane * LS + 16 * w4) = w0; *(LAS v4u*)(KDT + lane * LS + 16 * w4 + 8) = w1;
            w0.x = pk_bf16(vv[0], vv[1]); w0.y = pk_bf16(vv[2], vv[3]); w0.z = pk_bf16(vv[4], vv[5]); w0.w = pk_bf16(vv[6], vv[7]);
            w1.x = pk_bf16(vv[8], vv[9]); w1.y = pk_bf16(vv[10], vv[11]); w1.z = pk_bf16(vv[12], vv[13]); w1.w = pk_bf16(vv[14], vv[15]);
            *(LAS v4u*)(VT + lane * LS + 16 * w4) = w0; *(LAS v4u*)(VT + lane * LS + 16 * w4 + 8) = w1;
            if (w4 == 0) ELAST[lane] = __expf(c63);
#pragma unroll
            for (int n = 0; n < 4; ++n) st4(ZT, LS, 16 * n + r, 16 * w4 + 4 * q, zs[n]);
        }
        WG_BAR();
        {
            const int m = w4;
            f32x4 Pt[4];
#pragma unroll
            for (int n = 0; n < 4; ++n) Pt[n] = zero4();
            bf16x8 aq[2];
#pragma unroll
            for (int k = 0; k < 2; ++k) aq[k] = ld_frag(QT, LS, 16 * m + r, 32 * k, q);
#pragma unroll
            for (int n = 0; n < 4; ++n) if (n <= m) {
                const LAS bf16* Bs = ((n >> 1) == (m >> 1)) ? KA : KB;
#pragma unroll
                for (int k = 0; k < 2; ++k) Pt[n] = MFMA16(ld_frag(Bs, LS, 16 * n + r, 32 * k, q), aq[k], Pt[n]);
                if (n == m) {
#pragma unroll
                    for (int i = 0; i < 4; ++i) if (4 * q + i > r) Pt[n][i] = 0.f; }
            }
            f32x4 O[4];
#pragma unroll
            for (int nv = 0; nv < 4; ++nv) O[nv] = zero4();
#pragma unroll
            for (int k = 0; k < 2; ++k) if (2 * k <= m) { const bf16x8 pf = pack_frag(Pt[2 * k], Pt[2 * k + 1]);
#pragma unroll
                for (int nv = 0; nv < 4; ++nv) O[nv] = MFMA16(ld_frag_perm(VT, LS, 16 * nv + r, 32 * k, q), pf, O[nv]); }
#pragma unroll
            for (int k = 0; k < 2; ++k) { const bf16x8 ar = ld_frag(R2, LS, 16 * m + r, 32 * k, q);
#pragma unroll
                for (int nv = 0; nv < 4; ++nv) O[nv] = MFMA16(ld_frag(ZT, LS, 16 * nv + r, 32 * k, q), ar, O[nv]); }
            float ss = 0.f;
#pragma unroll
            for (int nv = 0; nv < 4; ++nv) ss += (O[nv][0] * O[nv][0] + O[nv][1] * O[nv][1]) + (O[nv][2] * O[nv][2] + O[nv][3] * O[nv][3]);
            ss += __shfl_xor(ss, 16); ss += __shfl_xor(ss, 32);
            const float rs = rsqrtf(ss * (1.f / 64.f) + 1e-6f);
            const int t = ch * 64 + 16 * m + r;
#pragma unroll
            for (int nv = 0; nv < 4; ++nv) { const int dv0 = h * 64 + 16 * nv + 4 * q;
                const v2u zr = *(const v2u*)(P + (size_t)t * NP + C_Z + 0 + dv0);
                const float z0 = __builtin_bit_cast(float, zr.x << 16), z1 = __builtin_bit_cast(float, zr.x & 0xffff0000u), z2 = __builtin_bit_cast(float, zr.y << 16), z3 = __builtin_bit_cast(float, zr.y & 0xffff0000u);
                v2u o; o.x = pk_bf16(O[nv][0] * rs * gn[nv][0] * siluf_(z0), O[nv][1] * rs * gn[nv][1] * siluf_(z1));
                o.y = pk_bf16(O[nv][2] * rs * gn[nv][2] * siluf_(z2), O[nv][3] * rs * gn[nv][3] * siluf_(z3));
                *(v2u*)(Yb + (size_t)t * DM + 0 + dv0) = o; }
            const f32x4 el = *(const LAS f32x4*)(ELAST + 16 * w4 + 4 * q);
            bf16x8 ak[2];
#pragma unroll
            for (int k = 0; k < 2; ++k) ak[k] = ld_frag(KDT, LS, 16 * w4 + r, 32 * k, q);
#pragma unroll
            for (int n = 0; n < 4; ++n) { zs[n] = zs[n] * el;
#pragma unroll
                for (int k = 0; k < 2; ++k) zs[n] = MFMA16(ak[k], ld_frag(VT, LS, 16 * n + r, 32 * k, q), zs[n]); }
        }
        WG_BAR();
    }
}

__device__ __forceinline__ float tr_reduce16(const float* v, int lane) {
    float a[8], b[4], c[2], d;
    const bool b5 = lane & 32, b4 = lane & 16, b3 = lane & 8, b2 = lane & 4;
#pragma unroll
    for (int j = 0; j < 8; ++j) { const float snd = b5 ? v[j] : v[8 + j]; const float got = __shfl_xor(snd, 32); a[j] = (b5 ? v[8 + j] : v[j]) + got; }
#pragma unroll
    for (int j = 0; j < 4; ++j) { const float snd = b4 ? a[j] : a[4 + j]; const float got = __shfl_xor(snd, 16); b[j] = (b4 ? a[4 + j] : a[j]) + got; }
#pragma unroll
    for (int j = 0; j < 2; ++j) { const float snd = b3 ? b[j] : b[2 + j]; const float got = __shfl_xor(snd, 8); c[j] = (b3 ? b[2 + j] : b[j]) + got; }
    { const float snd = b2 ? c[0] : c[1]; const float got = __shfl_xor(snd, 4); d = (b2 ? c[1] : c[0]) + got; }
    d += __shfl_xor(d, 2); d += __shfl_xor(d, 1);
    return d;
}
__device__ __forceinline__ float rdlane(float x, int l) { return __builtin_bit_cast(float, __builtin_amdgcn_readlane(__builtin_bit_cast(int, x), l)); }

template <bool SW = false> __device__ __forceinline__ void diag_inverse(const LAS float* AD, LAS bf16* DT, int lane) {
    const int j = lane >> 4, c = lane & 15;
    const LAS float* A = AD + j * 256;
    float x[16];
#pragma unroll
    for (int i = 0; i < 16; ++i) {
        float s = (i == c) ? 1.f : 0.f;
#pragma unroll
        for (int k4 = 0; k4 < i; k4 += 4) { const f32x4 a = *(const LAS f32x4*)(A + i * 16 + k4);
#pragma unroll
            for (int kk = 0; kk < 4; ++kk) if (k4 + kk < i) s -= a[kk] * x[k4 + kk]; }
        x[i] = s;
    }
    v4u w0, w1;
    w0.x = pkx<SW>(x[0], x[1]); w0.y = pkx<SW>(x[2], x[3]); w0.z = pkx<SW>(x[4], x[5]); w0.w = pkx<SW>(x[6], x[7]);
    w1.x = pkx<SW>(x[8], x[9]); w1.y = pkx<SW>(x[10], x[11]); w1.z = pkx<SW>(x[12], x[13]); w1.w = pkx<SW>(x[14], x[15]);
    *(LAS v4u*)(DT + (j * 16 + c) * 16) = w0; *(LAS v4u*)(DT + (j * 16 + c) * 16 + 8) = w1;
}
__device__ __forceinline__ bf16x8 half_frag_lds(const LAS bf16* p) { const bf16x4 lo = *(const LAS bf16x4*)p; bf16x8 v; v[0] = lo[0]; v[1] = lo[1]; v[2] = lo[2]; v[3] = lo[3]; v[4] = 0; v[5] = 0; v[6] = 0; v[7] = 0; return v; }
__device__ __forceinline__ bf16x8 two_frag_lds(const LAS bf16* p0, const LAS bf16* p1) { const bf16x4 lo = *(const LAS bf16x4*)p0; const bf16x4 hi = *(const LAS bf16x4*)p1; bf16x8 v; v[0] = lo[0]; v[1] = lo[1]; v[2] = lo[2]; v[3] = lo[3]; v[4] = hi[0]; v[5] = hi[1]; v[6] = hi[2]; v[7] = hi[3]; return v; }
template <bool SW = false> __device__ __forceinline__ void tri_inverse_row(const LAS bf16* AMT, const LAS bf16* DT, int m, int r, int q, f32x4* Tm) {
    const f32x4 z4 = zero4();
    f32x4 dm;
#pragma unroll
    for (int i = 0; i < 4; ++i) dm[i] = bf2f(DT[(m * 16 + 4 * q + i) * 16 + r]);
#pragma unroll
    for (int n = 0; n < 4; ++n) Tm[n] = (n == m) ? dm : z4;
#pragma unroll
    for (int j = 2; j >= 0; --j) if (j < m) {
        f32x4 X = z4;
#pragma unroll
        for (int k = j + 1; k <= 3; k += 2) if (k <= m) {
            const LAS bf16* p0 = AMT + (16 * j + r) * LS + 16 * k + 4 * q;
            if (k + 1 <= 3) { const bf16x8 af = pack_frag_x<SW>(Tm[k], Tm[k + 1]); const bf16x8 bfr = two_frag_lds(p0, p0 + 16); X = MFMA16(bfr, af, X); }
            else { const bf16x8 af = pack_frag_x<SW>(Tm[k], z4); const bf16x8 bfr = half_frag_lds(p0); X = MFMA16(bfr, af, X); }
        }
        const bf16x8 xf = pack_frag_x<SW>(X, z4);
        const bf16x8 df = half_frag_lds(DT + (j * 16 + r) * 16 + 4 * q);
        const f32x4 Tj = MFMA16(df, xf, z4);
        Tm[j] = -Tj;
    }
}

__device__ __forceinline__ void mixopt_gdn(const Inputs& in, const int layer, const bf16* __restrict__ PROJ, bf16* __restrict__ Yg, LAS unsigned char* ldsw, const int b, const int hp, const int tid) {
    const int lane0 = tid & 63, wave = __builtin_amdgcn_readfirstlane(tid >> 6), hh = wave >> 2, w4 = wave & 3, h = hp * 2 + hh;
    LAS unsigned char* L = ldsw + hh * HEAD_LDS;
    LAS bf16* Qm = (LAS bf16*)L; LAS bf16* Km = (LAS bf16*)(L + 9216); LAS bf16* KT = (LAS bf16*)(L + 18432); LAS bf16* VT = (LAS bf16*)(L + 27648); LAS bf16* ZT = (LAS bf16*)(L + 36864);
    LAS bf16* AMT = (LAS bf16*)(L + 46080); LAS bf16* RHST = (LAS bf16*)(L + 55296); LAS float* AD = (LAS float*)(L + 64512); LAS bf16* DT = (LAS bf16*)(L + 68608);
    LAS float* CUM = (LAS float*)(L + 70656); LAS float* ECUM = CUM + 64; LAS float* BETA = CUM + 128; LAS float* WSC = CUM + 192;
    LAS bf16* VNWT = Km; LAS bf16* VNT = VT;
    const bf16* P = PROJ + (size_t)b * SEQ * NP; bf16* Yb = Yg + (size_t)b * SEQ * DM;
    const float* cw = in.gdn_conv_w + (size_t)layer * 4 * 768 + h * 64;
    const float Aneg = -__expf(in.gdn_a_log[layer * 4 + h]), dtb = in.gdn_dt_bias[layer * 4 + h];
    f32x4 zs[4];
#pragma unroll
    for (int n = 0; n < 4; ++n) zs[n] = zero4();
    typedef unsigned short us2 __attribute__((ext_vector_type(2)));
    bf16 rq[19], rk[19], rv[19]; bf16 rbt, rat;
    auto load_raw = [&](int ch, int lane) {
        const int c = h * 64 + lane;
        const int tb = ch * 64 + 16 * w4 - 3;
#pragma unroll
        for (int j = 0; j < 19; ++j) { const int t = tb + j; const bool ok = (t >= 0); const bf16* p0 = P + (size_t)(ok ? t : 0) * NP;
            const bf16 a = p0[C_GD_Q + c], bb = p0[C_GD_K + c], cc = p0[C_GD_V + c];
            rq[j] = ok ? a : (bf16)0; rk[j] = ok ? bb : (bf16)0; rv[j] = ok ? cc : (bf16)0; }
        rbt = P[(size_t)(ch * 64 + lane) * NP + C_GD_BETA + h]; rat = P[(size_t)(ch * 64 + lane) * NP + C_GD_DEC + h];
    };
    load_raw(0, lane0);
    for (int ch = 0; ch < SEQ / 64; ++ch) {
        const int lane = opaque_i(lane0), r = lane & 15, q = lane >> 4;
#ifndef GDN_REP
#define GDN_REP 0
#endif
        {
            float tv[16];
            float wq[4], wk[4], wv[4];
#pragma unroll
            for (int j = 0; j < 4; ++j) { wq[j] = cw[j * 768 + lane]; wk[j] = cw[j * 768 + 256 + lane]; wv[j] = cw[j * 768 + 512 + lane]; }
#pragma unroll
            for (int i = 0; i < 16; ++i) tv[i] = siluf_(wk[0] * RAWG(rk, i) + wk[1] * RAWG(rk, i + 1) + wk[2] * RAWG(rk, i + 2) + wk[3] * RAWG(rk, i + 3));
            { float sq[16];
#pragma unroll
              for (int i = 0; i < 16; ++i) sq[i] = tv[i] * tv[i];
              const float sred = tr_reduce16(sq, lane);
#pragma unroll
              for (int i = 0; i < 16; ++i) { tv[i] *= rsqrtf(rdlane(sred, 4 * i) + 1e-6f); Km[(16 * w4 + i) * LS + lane] = cvt_bf16(tv[i]); } }
            pack16_x<SITE(0)>(KT + lane * LS + 16 * w4, tv);
            asm volatile("" ::: "memory");
#pragma unroll
            for (int i = 0; i < 16; ++i) tv[i] = siluf_(wq[0] * RAWG(rq, i) + wq[1] * RAWG(rq, i + 1) + wq[2] * RAWG(rq, i + 2) + wq[3] * RAWG(rq, i + 3));
            { float sq[16];
#pragma unroll
              for (int i = 0; i < 16; ++i) sq[i] = tv[i] * tv[i];
              const float sred = tr_reduce16(sq, lane);
#pragma unroll
              for (int i = 0; i < 16; ++i) Qm[(16 * w4 + i) * LS + lane] = cvt_bf16(tv[i] * rsqrtf(rdlane(sred, 4 * i) + 1e-6f) * 0.125f); }
            asm volatile("" ::: "memory");
#pragma unroll
            for (int i = 0; i < 16; ++i) tv[i] = siluf_(wv[0] * RAWG(rv, i) + wv[1] * RAWG(rv, i + 1) + wv[2] * RAWG(rv, i + 2) + wv[3] * RAWG(rv, i + 3));
            pack16_x<SITE(0)>(VT + lane * LS + 16 * w4, tv);
            if (w4 == 0) {
                const float beta = sigmoidf_(bf2f(rbt)); float cs = Aneg * softplusf_(bf2f(rat) + dtb);
#pragma unroll
                for (int o = 1; o < 64; o <<= 1) { const float u = __shfl_up(cs, o); if (lane >= o) cs += u; }
                const float c63 = __shfl(cs, 63);
                CUM[lane] = cs; ECUM[lane] = __expf(cs); BETA[lane] = beta; WSC[lane] = __expf(c63 - cs);
            }
#pragma unroll
            for (int n = 0; n < 4; ++n) st4_x<SITE(1)>(ZT, LS, 16 * n + r, 16 * w4 + 4 * q, zs[n]);
        }
        WG_BAR();
        const int m = w4;
        f32x4 QK[4];
        { const int lane = opaque_i(lane0), r = lane & 15, q = lane >> 4;
        {
            bf16x8 ak[2], aq[2];
#pragma unroll
            for (int k = 0; k < 2; ++k) { ak[k] = ld_frag(Km, LS, 16 * m + r, 32 * k, q); aq[k] = ld_frag(Qm, LS, 16 * m + r, 32 * k, q); }
            const f32x4 cumt4 = *(const LAS f32x4*)(CUM + 16 * m + 4 * q);
            const f32x4 bet4 = *(const LAS f32x4*)(BETA + 16 * m + 4 * q);
            const f32x4 ecum4 = *(const LAS f32x4*)(ECUM + 16 * m + 4 * q);
            const float cumr = CUM[16 * m + r];
#pragma unroll
            for (int n = 0; n < 4; ++n) { QK[n] = zero4(); if (n <= m) {
                f32x4 kk = zero4();
#pragma unroll
                for (int k = 0; k < 2; ++k) { const bf16x8 bk = ld_frag(Km, LS, 16 * n + r, 32 * k, q);
                    kk = MFMA16(ak[k], bk, kk);
                    QK[n] = MFMA16(bk, aq[k], QK[n]); }
                const float cums = CUM[16 * n + r];
                f32x4 av;
#pragma unroll
                for (int i = 0; i < 4; ++i) { const bool keep = (n < m) || (r < 4 * q + i); av[i] = keep ? bet4[i] * kk[i] * __expf(cumt4[i] - cums) : 0.f; }
                st4_x<SITE(2)>(AMT, LS, 16 * n + r, 16 * m + 4 * q, av);
                if (n == m) {
#pragma unroll
                    for (int i = 0; i < 4; ++i) AD[m * 256 + (4 * q + i) * 16 + r] = av[i]; }
                const f32x4 cs4 = *(const LAS f32x4*)(CUM + 16 * n + 4 * q);
#pragma unroll
                for (int i = 0; i < 4; ++i) { const bool keep = (n < m) || (4 * q + i <= r); QK[n][i] = keep ? QK[n][i] * __expf(cumr - cs4[i]) : 0.f; }
            } }
#pragma unroll
            for (int nv = 0; nv < 4; ++nv) { f32x4 kz = zero4();
#pragma unroll
                for (int k = 0; k < 2; ++k) kz = MFMA16(ak[k], ld_frag(ZT, LS, 16 * nv + r, 32 * k, q), kz);
                const v2u vr = *(const LAS v2u*)(VT + (16 * nv + r) * LS + 16 * m + 4 * q);
                f32x4 rh;
                rh[0] = bet4[0] * (__builtin_bit_cast(float, vr.x << 16) - ecum4[0] * kz[0]); rh[1] = bet4[1] * (__builtin_bit_cast(float, vr.x & 0xffff0000u) - ecum4[1] * kz[1]);
                rh[2] = bet4[2] * (__builtin_bit_cast(float, vr.y << 16) - ecum4[2] * kz[2]); rh[3] = bet4[3] * (__builtin_bit_cast(float, vr.y & 0xffff0000u) - ecum4[3] * kz[3]);
                st4_x<SITE(2)>(RHST, LS, 16 * nv + r, 16 * m + 4 * q, rh); }
        }
        }
        WG_BAR();
        { const int lane = opaque_i(lane0), r = lane & 15, q = lane >> 4;
        if (ch + 1 < SEQ / 64) load_raw(ch + 1, lane);
        {
            diag_inverse<SITE(5)>(AD, DT, lane);
            asm volatile("s_waitcnt lgkmcnt(0)" ::: "memory");
            f32x4 Tm[4];
            tri_inverse_row<SITE(6)>(AMT, DT, m, r, q, Tm);
            const f32x4 w4v = *(const LAS f32x4*)(WSC + 16 * m + 4 * q);
            const bf16x8 t0 = pack_frag_x<SITE(3)>(Tm[0], Tm[1]), t1 = pack_frag_x<SITE(3)>(Tm[2], Tm[3]);
#pragma unroll
            for (int nv = 0; nv < 4; ++nv) { f32x4 vn = zero4();
                vn = MFMA16(t0, ld_frag_perm(RHST, LS, 16 * nv + r, 0, q), vn);
                if (m >= 2) vn = MFMA16(t1, ld_frag_perm(RHST, LS, 16 * nv + r, 32, q), vn);
                st4_x<SITE(3)>(VNT, LS, 16 * nv + r, 16 * m + 4 * q, vn);
                st4_x<SITE(3)>(VNWT, LS, 16 * nv + r, 16 * m + 4 * q, vn * w4v); }
        }
        }
        WG_BAR();
        { const int lane = opaque_i(lane0), r = lane & 15, q = lane >> 4; const float* gnp = in.gdn_norm_g + layer * HD + 4 * q;
        {
            f32x4 O[4];
            bf16x8 aq[2];
#pragma unroll
            for (int k = 0; k < 2; ++k) aq[k] = ld_frag(Qm, LS, 16 * m + r, 32 * k, q);
            const float ect = ECUM[16 * m + r];
            const bf16x8 p0 = pack_frag_x<SITE(4)>(QK[0], QK[1]), p1 = pack_frag_x<SITE(4)>(QK[2], QK[3]);
            float ss = 0.f;
#pragma unroll
            for (int nv = 0; nv < 4; ++nv) { O[nv] = zero4();
#pragma unroll
                for (int k = 0; k < 2; ++k) O[nv] = MFMA16(ld_frag(ZT, LS, 16 * nv + r, 32 * k, q), aq[k], O[nv]);
                O[nv] = O[nv] * ect;
                O[nv] = MFMA16(ld_frag_perm(VNT, LS, 16 * nv + r, 0, q), p0, O[nv]);
                if (m >= 2) O[nv] = MFMA16(ld_frag_perm(VNT, LS, 16 * nv + r, 32, q), p1, O[nv]);
                ss += (O[nv][0] * O[nv][0] + O[nv][1] * O[nv][1]) + (O[nv][2] * O[nv][2] + O[nv][3] * O[nv][3]); }
            ss += __shfl_xor(ss, 16); ss += __shfl_xor(ss, 32);
            const float rs = rsqrtf(ss * (1.f / 64.f) + 1e-6f);
            const int t = ch * 64 + 16 * m + r;
#pragma unroll
            for (int nv = 0; nv < 4; ++nv) { const int dv0 = h * 64 + 16 * nv + 4 * q;
                const f32x4 gg = *(const f32x4*)(gnp + 16 * nv);
                const v2u zr = *(const v2u*)(P + (size_t)t * NP + C_Z + 256 + dv0);
                const float z0 = __builtin_bit_cast(float, zr.x << 16), z1 = __builtin_bit_cast(float, zr.x & 0xffff0000u), z2 = __builtin_bit_cast(float, zr.y << 16), z3 = __builtin_bit_cast(float, zr.y & 0xffff0000u);
                v2u o; o.x = pkx<SITE(4)>(O[nv][0] * rs * gg[0] * siluf_(z0), O[nv][1] * rs * gg[1] * siluf_(z1)); o.y = pkx<SITE(4)>(O[nv][2] * rs * gg[2] * siluf_(z2), O[nv][3] * rs * gg[3] * siluf_(z3));
                *(v2u*)(Yb + (size_t)t * DM + 256 + dv0) = o; }
            const float last = ECUM[63];
            bf16x8 akt[2];
#pragma unroll
            for (int k = 0; k < 2; ++k) akt[k] = ld_frag(KT, LS, 16 * w4 + r, 32 * k, q);
#pragma unroll
            for (int n = 0; n < 4; ++n) { zs[n] = zs[n] * last;
#pragma unroll
                for (int k = 0; k < 2; ++k) zs[n] = MFMA16(akt[k], ld_frag(VNWT, LS, 16 * n + r, 32 * k, q), zs[n]); }
        }
        }
        WG_BAR();
    }
}

__device__ __forceinline__ void mixopt_gdn2(const Inputs& in, const int layer, const bf16* __restrict__ PROJ, bf16* __restrict__ Yg, LAS unsigned char* L, const int b, const int h, const int tid) {
    const int lane0 = tid & 63, wave = __builtin_amdgcn_readfirstlane(tid >> 6), grp = wave >> 2, w4 = wave & 3;
    LAS bf16* Qm = (LAS bf16*)L; LAS bf16* Km = (LAS bf16*)(L + 9216); LAS bf16* KT = (LAS bf16*)(L + 18432); LAS bf16* VT = (LAS bf16*)(L + 27648); LAS bf16* ZT = (LAS bf16*)(L + 36864);
    LAS bf16* AMT = (LAS bf16*)(L + 46080); LAS bf16* RHST = (LAS bf16*)(L + 55296); LAS bf16* QKM = (LAS bf16*)(L + 64512); LAS float* AD = (LAS float*)(L + 73728); LAS bf16* DT = (LAS bf16*)(L + 77824);
    LAS float* CUM = (LAS float*)(L + 79872); LAS float* ECUM = CUM + 64; LAS float* BETA = CUM + 128; LAS float* WSC = CUM + 192;
    LAS bf16* VNWT = Km; LAS bf16* VNT = VT;
    const bf16* P = PROJ + (size_t)b * SEQ * NP; bf16* Yb = Yg + (size_t)b * SEQ * DM;
    const float* cw = in.gdn_conv_w + (size_t)layer * 4 * 768 + h * 64;
    const float Aneg = -__expf(in.gdn_a_log[layer * 4 + h]), dtb = in.gdn_dt_bias[layer * 4 + h];
    f32x4 zs[4];
#pragma unroll
    for (int n = 0; n < 4; ++n) zs[n] = zero4();
    bf16 ra[19], rb2[19]; bf16 rbt, rat;
    auto load_raw = [&](int ch, int lane) {
        const int c = h * 64 + lane;
        const int tb = ch * 64 + 16 * w4 - 3;
        if (grp == 0) {
#pragma unroll
            for (int j = 0; j < 19; ++j) { const int t = tb + j; const bool ok = (t >= 0); const bf16 a = P[(size_t)(ok ? t : 0) * NP + C_GD_K + c]; ra[j] = ok ? a : (bf16)0; }
            rbt = P[(size_t)(ch * 64 + lane) * NP + C_GD_BETA + h]; rat = P[(size_t)(ch * 64 + lane) * NP + C_GD_DEC + h];
        } else {
#pragma unroll
            for (int j = 0; j < 19; ++j) { const int t = tb + j; const bool ok = (t >= 0); const bf16* p0 = P + (size_t)(ok ? t : 0) * NP;
                const bf16 a = p0[C_GD_Q + c], bb = p0[C_GD_V + c]; ra[j] = ok ? a : (bf16)0; rb2[j] = ok ? bb : (bf16)0; }
        }
    };
    load_raw(0, lane0);
    for (int ch = 0; ch < SEQ / 64; ++ch) {
        { const int lane = opaque_i(lane0), r = lane & 15, q = lane >> 4;
          float tv[16]; float w0[4];
          if (grp == 0) {
#pragma unroll
            for (int j = 0; j < 4; ++j) w0[j] = cw[j * 768 + 256 + lane];
#pragma unroll
            for (int i = 0; i < 16; ++i) tv[i] = siluf_(w0[0] * RAWG(ra, i) + w0[1] * RAWG(ra, i + 1) + w0[2] * RAWG(ra, i + 2) + w0[3] * RAWG(ra, i + 3));
            { float sq[16];
#pragma unroll
              for (int i = 0; i < 16; ++i) sq[i] = tv[i] * tv[i];
              const float sred = tr_reduce16(sq, lane);
#pragma unroll
              for (int i = 0; i < 16; ++i) { tv[i] *= rsqrtf(rdlane(sred, 4 * i) + 1e-6f); Km[(16 * w4 + i) * LS + lane] = cvt_bf16(tv[i]); } }
            ssd_pack16(KT + lane * LS + 16 * w4, tv);
            if (w4 == 0) {
                const float beta = sigmoidf_(bf2f(rbt)); float cs = Aneg * softplusf_(bf2f(rat) + dtb);
#pragma unroll
                for (int o = 1; o < 64; o <<= 1) { const float u = __shfl_up(cs, o); if (lane >= o) cs += u; }
                const float c63 = __shfl(cs, 63);
                CUM[lane] = cs; ECUM[lane] = __expf(cs); BETA[lane] = beta; WSC[lane] = __expf(c63 - cs);
            }
#pragma unroll
            for (int n = 0; n < 4; ++n) st4(ZT, LS, 16 * n + r, 16 * w4 + 4 * q, zs[n]);
          } else {
#pragma unroll
            for (int j = 0; j < 4; ++j) w0[j] = cw[j * 768 + lane];
#pragma unroll
            for (int i = 0; i < 16; ++i) tv[i] = siluf_(w0[0] * RAWG(ra, i) + w0[1] * RAWG(ra, i + 1) + w0[2] * RAWG(ra, i + 2) + w0[3] * RAWG(ra, i + 3));
            { float sq[16];
#pragma unroll
              for (int i = 0; i < 16; ++i) sq[i] = tv[i] * tv[i];
              const float sred = tr_reduce16(sq, lane);
#pragma unroll
              for (int i = 0; i < 16; ++i) Qm[(16 * w4 + i) * LS + lane] = cvt_bf16(tv[i] * rsqrtf(rdlane(sred, 4 * i) + 1e-6f) * 0.125f); }
            asm volatile("" ::: "memory");
#pragma unroll
            for (int j = 0; j < 4; ++j) w0[j] = cw[j * 768 + 512 + lane];
#pragma unroll
            for (int i = 0; i < 16; ++i) tv[i] = siluf_(w0[0] * RAWG(rb2, i) + w0[1] * RAWG(rb2, i + 1) + w0[2] * RAWG(rb2, i + 2) + w0[3] * RAWG(rb2, i + 3));
            ssd_pack16(VT + lane * LS + 16 * w4, tv);
          }
        }
        WG_BAR();
        const int m = w4;
        { const int lane = opaque_i(lane0), r = lane & 15, q = lane >> 4;
          if (ch + 1 < SEQ / 64) load_raw(ch + 1, lane);
          if (grp == 0) {
            bf16x8 ak[2];
#pragma unroll
            for (int k = 0; k < 2; ++k) ak[k] = ld_frag(Km, LS, 16 * m + r, 32 * k, q);
            const f32x4 cumt4 = *(const LAS f32x4*)(CUM + 16 * m + 4 * q);
            const f32x4 bet4 = *(const LAS f32x4*)(BETA + 16 * m + 4 * q);
            const f32x4 ecum4 = *(const LAS f32x4*)(ECUM + 16 * m + 4 * q);
#pragma unroll
            for (int n = 0; n < 4; ++n) if (n <= m) {
                f32x4 kk = zero4();
#pragma unroll
                for (int k = 0; k < 2; ++k) kk = MFMA16(ak[k], ld_frag(Km, LS, 16 * n + r, 32 * k, q), kk);
                const float cums = CUM[16 * n + r];
                f32x4 av;
#pragma unroll
                for (int i = 0; i < 4; ++i) { const bool keep = (n < m) || (r < 4 * q + i); av[i] = keep ? bet4[i] * kk[i] * __expf(cumt4[i] - cums) : 0.f; }
                st4(AMT, LS, 16 * n + r, 16 * m + 4 * q, av);
                if (n == m) {
#pragma unroll
                    for (int i = 0; i < 4; ++i) AD[m * 256 + (4 * q + i) * 16 + r] = av[i]; }
            }
#pragma unroll
            for (int nv = 0; nv < 4; ++nv) { f32x4 kz = zero4();
#pragma unroll
                for (int k = 0; k < 2; ++k) kz = MFMA16(ak[k], ld_frag(ZT, LS, 16 * nv + r, 32 * k, q), kz);
                const v2u vr = *(const LAS v2u*)(VT + (16 * nv + r) * LS + 16 * m + 4 * q);
                f32x4 rh;
                rh[0] = bet4[0] * (__builtin_bit_cast(float, vr.x << 16) - ecum4[0] * kz[0]); rh[1] = bet4[1] * (__builtin_bit_cast(float, vr.x & 0xffff0000u) - ecum4[1] * kz[1]);
                rh[2] = bet4[2] * (__builtin_bit_cast(float, vr.y << 16) - ecum4[2] * kz[2]); rh[3] = bet4[3] * (__builtin_bit_cast(float, vr.y & 0xffff0000u) - ecum4[3] * kz[3]);
                st4(RHST, LS, 16 * nv + r, 16 * m + 4 * q, rh); }
          } else {
            bf16x8 aq[2];
#pragma unroll
            for (int k = 0; k < 2; ++k) aq[k] = ld_frag(Qm, LS, 16 * m + r, 32 * k, q);
            const float cumr = CUM[16 * m + r];
#pragma unroll
            for (int n = 0; n < 4; ++n) { f32x4 qk = zero4(); if (n <= m) {
#pragma unroll
                for (int k = 0; k < 2; ++k) qk = MFMA16(ld_frag(Km, LS, 16 * n + r, 32 * k, q), aq[k], qk);
                const f32x4 cs4 = *(const LAS f32x4*)(CUM + 16 * n + 4 * q);
#pragma unroll
                for (int i = 0; i < 4; ++i) { const bool keep = (n < m) || (4 * q + i <= r); qk[i] = keep ? qk[i] * __expf(cumr - cs4[i]) : 0.f; } }
                st4(QKM, LS, 16 * m + r, 16 * n + 4 * q, qk); }
          }
        }
        WG_BAR();
        f32x4 O[4];
        { const int lane = opaque_i(lane0), r = lane & 15, q = lane >> 4;
          if (grp == 0) {
            diag_inverse(AD, DT, lane);
            asm volatile("s_waitcnt lgkmcnt(0)" ::: "memory");
            f32x4 Tm[4];
            tri_inverse_row(AMT, DT, m, r, q, Tm);
            const f32x4 w4v = *(const LAS f32x4*)(WSC + 16 * m + 4 * q);
            const bf16x8 t0 = pack_frag(Tm[0], Tm[1]), t1 = pack_frag(Tm[2], Tm[3]);
#pragma unroll
            for (int nv = 0; nv < 4; ++nv) { f32x4 vn = zero4();
                vn = MFMA16(t0, ld_frag_perm(RHST, LS, 16 * nv + r, 0, q), vn);
                if (m >= 2) vn = MFMA16(t1, ld_frag_perm(RHST, LS, 16 * nv + r, 32, q), vn);
                st4(VNT, LS, 16 * nv + r, 16 * m + 4 * q, vn);
                st4(VNWT, LS, 16 * nv + r, 16 * m + 4 * q, vn * w4v); }
          } else {
            bf16x8 aq[2];
#pragma unroll
            for (int k = 0; k < 2; ++k) aq[k] = ld_frag(Qm, LS, 16 * m + r, 32 * k, q);
            const float ect = ECUM[16 * m + r];
#pragma unroll
            for (int nv = 0; nv < 4; ++nv) { O[nv] = zero4();
#pragma unroll
                for (int k = 0; k < 2; ++k) O[nv] = MFMA16(ld_frag(ZT, LS, 16 * nv + r, 32 * k, q), aq[k], O[nv]);
                O[nv] = O[nv] * ect; }
          }
        }
        WG_BAR();
        { const int lane = opaque_i(lane0), r = lane & 15, q = lane >> 4;
          if (grp == 0) {
            const float last = ECUM[63];
            bf16x8 akt[2];
#pragma unroll
            for (int k = 0; k < 2; ++k) akt[k] = ld_frag(KT, LS, 16 * w4 + r, 32 * k, q);
#pragma unroll
            for (int n = 0; n < 4; ++n) { zs[n] = zs[n] * last;
#pragma unroll
                for (int k = 0; k < 2; ++k) zs[n] = MFMA16(akt[k], ld_frag(VNWT, LS, 16 * n + r, 32 * k, q), zs[n]); }
          } else {
            bf16x8 pq[2];
#pragma unroll
            for (int k = 0; k < 2; ++k) pq[k] = ld_frag(QKM, LS, 16 * m + r, 32 * k, q);
            float ss = 0.f;
#pragma unroll
            for (int nv = 0; nv < 4; ++nv) {
                O[nv] = MFMA16(ld_frag(VNT, LS, 16 * nv + r, 0, q), pq[0], O[nv]);
                if (m >= 2) O[nv] = MFMA16(ld_frag(VNT, LS, 16 * nv + r, 32, q), pq[1], O[nv]);
                ss += (O[nv][0] * O[nv][0] + O[nv][1] * O[nv][1]) + (O[nv][2] * O[nv][2] + O[nv][3] * O[nv][3]); }
            ss += __shfl_xor(ss, 16); ss += __shfl_xor(ss, 32);
            const float rs = rsqrtf(ss * (1.f / 64.f) + 1e-6f);
            const int t = ch * 64 + 16 * m + r;
            const float* gnp = in.gdn_norm_g + layer * HD + 4 * q;
#pragma unroll
            for (int nv = 0; nv < 4; ++nv) { const int dv0 = h * 64 + 16 * nv + 4 * q;
                const f32x4 gg = *(const f32x4*)(gnp + 16 * nv);
                const v2u zr = *(const v2u*)(P + (size_t)t * NP + C_Z + 256 + dv0);
                const float z0 = __builtin_bit_cast(float, zr.x << 16), z1 = __builtin_bit_cast(float, zr.x & 0xffff0000u), z2 = __builtin_bit_cast(float, zr.y << 16), z3 = __builtin_bit_cast(float, zr.y & 0xffff0000u);
                v2u o; o.x = pk_bf16(O[nv][0] * rs * gg[0] * siluf_(z0), O[nv][1] * rs * gg[1] * siluf_(z1)); o.y = pk_bf16(O[nv][2] * rs * gg[2] * siluf_(z2), O[nv][3] * rs * gg[3] * siluf_(z3));
                *(v2u*)(Yb + (size_t)t * DM + 256 + dv0) = o; }
          }
        }
        WG_BAR();
    }
}

__device__ __forceinline__ void mixopt_ssd(const Inputs& in, const int layer, const bf16* __restrict__ PROJ, bf16* __restrict__ Yg, LAS unsigned char* ldsw, const int b, const int g, const int tid) {
    const int lane = tid & 63, wave = __builtin_amdgcn_readfirstlane(tid >> 6), hh = wave >> 2, w4 = wave & 3, h = g * 2 + hh, r = lane & 15, q = lane >> 4;
    LAS bf16* CM = (LAS bf16*)ldsw; LAS bf16* BM = (LAS bf16*)(ldsw + 17408); LAS bf16* BT = (LAS bf16*)(ldsw + 34816);
    LAS unsigned char* L = ldsw + 53248 + hh * 45056;
    LAS bf16* XVT = (LAS bf16*)L; LAS bf16* XVWT = (LAS bf16*)(L + MAT_B); LAS bf16* XR = (LAS bf16*)(L + 2 * MAT_B); LAS bf16* ZT = (LAS bf16*)(L + 3 * MAT_B);
    LAS float* CUM = (LAS float*)(ldsw + 143360 + hh * 1024); LAS float* ECUM = CUM + 64;
    LAS float* SS = (LAS float*)(ldsw + 145408);
    const bf16* P = PROJ + (size_t)b * SEQ * NP; bf16* Yb = Yg + (size_t)b * SEQ * DM;
    const int cx = h * 64 + lane, cbc = g * 128 + 64 * hh + lane;
    const float* cw = in.ssm_conv_w + (size_t)layer * 4 * 768; const float* cb = in.ssm_conv_b + (size_t)layer * 768;
    float wx[4], wB[4], wC[4];
#pragma unroll
    for (int j = 0; j < 4; ++j) { wx[j] = cw[j * 768 + cx]; wB[j] = cw[j * 768 + 256 + cbc]; wC[j] = cw[j * 768 + 512 + cbc]; }
    const float bx = cb[cx], bB = cb[256 + cbc], bC = cb[512 + cbc];
    const float Aneg = -__expf(in.ssm_a_log[layer * 4 + h]), dtb = in.ssm_dt_bias[layer * 4 + h], dsk = in.ssm_d[layer * 4 + h];
    const float* gnp = in.ssm_norm_g + layer * GW + h * 64 + 4 * q;
    f32x4 zs[2][4];
#pragma unroll
    for (int a = 0; a < 2; ++a)
#pragma unroll
        for (int n = 0; n < 4; ++n) zs[a][n] = zero4();
    typedef unsigned short us2 __attribute__((ext_vector_type(2)));
    bf16 rx[19], rB[19], rC[19]; bf16 rdt;
    auto load_raw = [&](int ch) {
        const int tb = ch * 64 + 16 * w4 - 3;
#pragma unroll
        for (int j = 0; j < 19; ++j) { const int t = tb + j; const bool ok = (t >= 0); const bf16* p0 = P + (size_t)(ok ? t : 0) * NP;
            const bf16 a = p0[C_SS_X + cx], bb = p0[C_SS_B + cbc], cc = p0[C_SS_C + cbc];
            rx[j] = ok ? a : (bf16)0; rB[j] = ok ? bb : (bf16)0; rC[j] = ok ? cc : (bf16)0; }
        rdt = P[(size_t)(ch * 64 + lane) * NP + C_SS_DT + h];
    };
    load_raw(0);
    for (int ch = 0; ch < SEQ / 64; ++ch) {
        {
            float tv[16];
#pragma unroll
            for (int i = 0; i < 16; ++i) { tv[i] = siluf_(wC[0] * RAWG(rC, i) + wC[1] * RAWG(rC, i + 1) + wC[2] * RAWG(rC, i + 2) + wC[3] * RAWG(rC, i + 3) + bC);
                CM[(16 * w4 + i) * LS2 + 64 * hh + lane] = cvt_bf16(tv[i]); }
            asm volatile("" ::: "memory");
#pragma unroll
            for (int i = 0; i < 16; ++i) { tv[i] = siluf_(wB[0] * RAWG(rB, i) + wB[1] * RAWG(rB, i + 1) + wB[2] * RAWG(rB, i + 2) + wB[3] * RAWG(rB, i + 3) + bB);
                BM[(16 * w4 + i) * LS2 + 64 * hh + lane] = cvt_bf16(tv[i]); }
            ssd_pack16(BT + (64 * hh + lane) * LS + 16 * w4, tv);
            asm volatile("" ::: "memory");
            const float dt = softplusf_(bf2f(rdt) + dtb); float cs = dt * Aneg;
#pragma unroll
            for (int o = 1; o < 64; o <<= 1) { const float u = __shfl_up(cs, o); if (lane >= o) cs += u; }
            const float c63 = __shfl(cs, 63);
            const float wsc = __expf(c63 - cs);
            if (w4 == 0) { CUM[lane] = cs; ECUM[lane] = __expf(cs); }
            float xw[16];
#pragma unroll
            for (int i = 0; i < 16; ++i) { const int t = 16 * w4 + i;
                const float xs = siluf_(wx[0] * RAWG(rx, i) + wx[1] * RAWG(rx, i + 1) + wx[2] * RAWG(rx, i + 2) + wx[3] * RAWG(rx, i + 3) + bx);
                XR[t * LS + lane] = cvt_bf16(xs); tv[i] = xs * __shfl(dt, t); xw[i] = tv[i] * __shfl(wsc, t); }
            ssd_pack16(XVT + lane * LS + 16 * w4, tv);
            ssd_pack16(XVWT + lane * LS + 16 * w4, xw);
#pragma unroll
            for (int a = 0; a < 2; ++a)
#pragma unroll
                for (int nv = 0; nv < 4; ++nv) st4(ZT, LS2, 16 * nv + r, 16 * (2 * w4 + a) + 4 * q, zs[a][nv]);
        }
        WG_BAR();
        if (ch + 1 < SEQ / 64) load_raw(ch + 1);
        f32x4 yv[4];
        {
            const int m = w4;
            f32x4 Pt[4];
#pragma unroll
            for (int n = 0; n < 4; ++n) Pt[n] = zero4();
            bf16x8 ac[4];
#pragma unroll
            for (int k = 0; k < 4; ++k) ac[k] = ld_frag(CM, LS2, 16 * m + r, 32 * k, q);
            const float cumt = CUM[16 * m + r];
#pragma unroll
            for (int n = 0; n < 4; ++n) if (n <= m) {
#pragma unroll
                for (int k = 0; k < 4; ++k) Pt[n] = MFMA16(ld_frag(BM, LS2, 16 * n + r, 32 * k, q), ac[k], Pt[n]);
                const f32x4 cs = *(const LAS f32x4*)(CUM + 16 * n + 4 * q);
#pragma unroll
                for (int i = 0; i < 4; ++i) { const bool keep = (n < m) || (4 * q + i <= r); Pt[n][i] = keep ? Pt[n][i] * __expf(cumt - cs[i]) : 0.f; }
            }
            f32x4 O[4];
            const float ect = ECUM[16 * m + r];
#pragma unroll
            for (int nv = 0; nv < 4; ++nv) O[nv] = zero4();
#pragma unroll
            for (int k = 0; k < 4; ++k)
#pragma unroll
                for (int nv = 0; nv < 4; ++nv) O[nv] = MFMA16(ld_frag(ZT, LS2, 16 * nv + r, 32 * k, q), ac[k], O[nv]);
#pragma unroll
            for (int nv = 0; nv < 4; ++nv) O[nv] = O[nv] * ect;
#pragma unroll
            for (int k = 0; k < 2; ++k) if (2 * k <= m) { const bf16x8 pf = pack_frag(Pt[2 * k], Pt[2 * k + 1]);
#pragma unroll
                for (int nv = 0; nv < 4; ++nv) O[nv] = MFMA16(ld_frag_perm(XVT, LS, 16 * nv + r, 32 * k, q), pf, O[nv]); }
            const int t = ch * 64 + 16 * m + r;
            float ss = 0.f;
#pragma unroll
            for (int nv = 0; nv < 4; ++nv) { const int p0 = 16 * nv + 4 * q;
                const v2u xr = *(const LAS v2u*)(XR + (16 * m + r) * LS + p0);
                const v2u zr = *(const v2u*)(P + (size_t)t * NP + C_Z + 512 + h * 64 + p0);
                const float x0 = __builtin_bit_cast(float, xr.x << 16), x1 = __builtin_bit_cast(float, xr.x & 0xffff0000u), x2 = __builtin_bit_cast(float, xr.y << 16), x3 = __builtin_bit_cast(float, xr.y & 0xffff0000u);
                const float z0 = __builtin_bit_cast(float, zr.x << 16), z1 = __builtin_bit_cast(float, zr.x & 0xffff0000u), z2 = __builtin_bit_cast(float, zr.y << 16), z3 = __builtin_bit_cast(float, zr.y & 0xffff0000u);
                yv[nv][0] = (O[nv][0] + x0 * dsk) * siluf_(z0); yv[nv][1] = (O[nv][1] + x1 * dsk) * siluf_(z1);
                yv[nv][2] = (O[nv][2] + x2 * dsk) * siluf_(z2); yv[nv][3] = (O[nv][3] + x3 * dsk) * siluf_(z3);
                ss += (yv[nv][0] * yv[nv][0] + yv[nv][1] * yv[nv][1]) + (yv[nv][2] * yv[nv][2] + yv[nv][3] * yv[nv][3]); }
            ss += __shfl_xor(ss, 16); ss += __shfl_xor(ss, 32);
            if (q == 0) SS[hh * 64 + 16 * m + r] = ss;
            const float el = ECUM[63];
#pragma unroll
            for (int a = 0; a < 2; ++a) { bf16x8 ab[2];
#pragma unroll
                for (int k = 0; k < 2; ++k) ab[k] = ld_frag(BT, LS, 16 * (2 * w4 + a) + r, 32 * k, q);
#pragma unroll
                for (int nv = 0; nv < 4; ++nv) { zs[a][nv] = zs[a][nv] * el;
#pragma unroll
                    for (int k = 0; k < 2; ++k) zs[a][nv] = MFMA16(ab[k], ld_frag(XVWT, LS, 16 * nv + r, 32 * k, q), zs[a][nv]); } }
        }
        WG_BAR();
        {
            const int m = w4, t = ch * 64 + 16 * m + r;
            const float tot = SS[16 * m + r] + SS[64 + 16 * m + r];
            const float rs = rsqrtf(tot * (1.f / 128.f) + 1e-6f);
#pragma unroll
            for (int nv = 0; nv < 4; ++nv) { const f32x4 gg = *(const f32x4*)(gnp + 16 * nv); v2u o; o.x = pk_bf16(yv[nv][0] * rs * gg[0], yv[nv][1] * rs * gg[1]); o.y = pk_bf16(yv[nv][2] * rs * gg[2], yv[nv][3] * rs * gg[3]);
                *(v2u*)(Yb + (size_t)t * DM + 512 + h * 64 + 16 * nv + 4 * q) = o; }
        }
    }
}

__device__ __forceinline__ void rwkv_pre_block(const Inputs& in, const int layer, const bf16* __restrict__ PROJ, float* __restrict__ CUMo, float* __restrict__ CUMPo, float* __restrict__ AV, LAS float* lds, const int m0, const int tid) {
    LAS float* SW = lds; LAS float* SA = lds + 4096; LAS float* HT = lds + 8192;
    const float* mu = in.rwkv_mu + (size_t)layer * 896;
    { const int j = tid & 63, tg = tid >> 6; const float muw = mu[768 + j], mua = mu[832 + j];
#pragma unroll
      for (int tt = 0; tt < 8; ++tt) { const int t = tg * 8 + tt, m = m0 + t; const bool first = ((m & (SEQ - 1)) == 0);
          const float xw = bf2f(PROJ[(size_t)m * NP + C_RW_WD + j]), xa = bf2f(PROJ[(size_t)m * NP + C_RW_AD + j]);
          const float pw = first ? 0.f : bf2f(PROJ[(size_t)(m - 1) * NP + C_RW_WD + j]), pa = first ? 0.f : bf2f(PROJ[(size_t)(m - 1) * NP + C_RW_AD + j]);
          SW[t * 64 + j] = tanhf(xw + (pw - xw) * muw); SA[t * 64 + j] = xa + (pa - xa) * mua; } }
    __syncthreads();
    { const int c = tid & 255, th = tid >> 8;
      float run = 0.f;
      { const float* wup = in.rwkv_w_up + (size_t)layer * 64 * GW + c;
        float wu[64];
#pragma unroll
        for (int j = 0; j < 64; ++j) wu[j] = wup[j * GW];
        const float w0 = in.rwkv_w0[layer * GW + c];
        for (int tt = 0; tt < 32; ++tt) { const int t = th * 32 + tt; float wl = w0;
#pragma unroll
            for (int j4 = 0; j4 < 16; ++j4) { const f32x4 sw = *(const LAS f32x4*)(SW + t * 64 + 4 * j4);
#pragma unroll
                for (int e = 0; e < 4; ++e) wl += sw[e] * wu[4 * j4 + e]; }
            const float w = -softplusf_(-wl) - 0.5f;
            const float lw = -__expf(w); run += lw;
            CUMo[(size_t)(m0 + t) * GW + c] = lw; } }
      asm volatile("" ::: "memory");
      { const float* aup = in.rwkv_a_up + (size_t)layer * 64 * GW + c;
        float au[64];
#pragma unroll
        for (int j = 0; j < 64; ++j) au[j] = aup[j * GW];
        const float a0 = in.rwkv_a0[layer * GW + c];
        for (int tt = 0; tt < 32; ++tt) { const int t = th * 32 + tt; float al = a0;
#pragma unroll
            for (int j4 = 0; j4 < 16; ++j4) { const f32x4 sa = *(const LAS f32x4*)(SA + t * 64 + 4 * j4);
#pragma unroll
                for (int e = 0; e < 4; ++e) al += sa[e] * au[4 * j4 + e]; }
            AV[(size_t)(m0 + t) * GW + c] = sigmoidf_(al); } }
      if (th == 0) HT[c] = run;
      __syncthreads();
      float acc = (th == 1) ? HT[c] : 0.f;
      for (int tt = 0; tt < 32; ++tt) { const int t = th * 32 + tt; const float lw = CUMo[(size_t)(m0 + t) * GW + c]; CUMPo[(size_t)(m0 + t) * GW + c] = acc; acc += lw; CUMo[(size_t)(m0 + t) * GW + c] = acc; } }
    __syncthreads();
}

__device__ __forceinline__ void mixopt_rwkv(const Inputs& in, const int layer, const bf16* __restrict__ PROJ, const float* __restrict__ CUMg, const float* __restrict__ CUMPg, const float* __restrict__ AV, bf16* __restrict__ Yg,
                                            LAS unsigned char* L, const int b, const int h, const int tid) {
    const int lane0 = tid & 63, wave = __builtin_amdgcn_readfirstlane(tid >> 6), w4 = wave & 3;
    const bool act = wave < 4;
    LAS bf16* AT = (LAS bf16*)L; LAS bf16* RT = (LAS bf16*)(L + 9216); LAS bf16* BL = (LAS bf16*)(L + 18432); LAS bf16* KL = (LAS bf16*)(L + 27648);
    LAS bf16* BTT = (LAS bf16*)(L + 36864); LAS bf16* KTT = (LAS bf16*)(L + 46080); LAS bf16* VT = (LAS bf16*)(L + 55296); LAS bf16* ZT = (LAS bf16*)(L + 64512);
    LAS bf16* AMT = (LAS bf16*)(L + 73728); LAS bf16* RHST = (LAS bf16*)(L + 82944); LAS float* AD = (LAS float*)(L + 92160); LAS bf16* DT = (LAS bf16*)(L + 96256);
    LAS float* QTOT = (LAS float*)(L + 98304); LAS float* ELAST = (LAS float*)(L + 99328); LAS float* BON = (LAS float*)(L + 99584);
    LAS bf16* SAT = AT;
    const bf16* P = PROJ + (size_t)b * SEQ * NP; bf16* Yb = Yg + (size_t)b * SEQ * DM;
    const float* CUMb = CUMg + (size_t)b * SEQ * GW; const float* CUMPb = CUMPg + (size_t)b * SEQ * GW; const float* AVb = AV + (size_t)b * SEQ * GW;
    const float* mu = in.rwkv_mu + (size_t)layer * 896 + h * 64;
    f32x4 zs[4];
#pragma unroll
    for (int n = 0; n < 4; ++n) zs[n] = zero4();
    LAS unsigned char* RAWT = L + 73728; LAS float* CMT = (LAS float*)(L + 99840); LAS float* AVT = (LAS float*)(L + 116480);
    v4u st[16];
    auto stage_load = [&](int ch, int ht) {
#pragma unroll
        for (int i = 0; i < 7; ++i) { const int u = ht + 256 * i; const int row = u / 24, rem = u - row * 24, seg = rem >> 3, part = rem & 7; const int t = ch * 64 - 1 + row;
            st[i] = (u < 1560 && t >= 0) ? *(const v4u*)(P + (size_t)t * NP + C_RW_R + seg * 256 + h * 64 + part * 8) : (v4u){0u, 0u, 0u, 0u}; }
#pragma unroll
        for (int i = 0; i < 5; ++i) { const int u = ht + 256 * i; const int row = u >> 4, part = u & 15; const int t = ch * 64 - 1 + row;
            st[7 + i] = (u < 1040 && t >= 0) ? *(const v4u*)(CUMb + (size_t)t * GW + h * 64 + part * 4) : (v4u){0u, 0u, 0u, 0u}; }
#pragma unroll
        for (int i = 0; i < 4; ++i) { const int u = ht + 256 * i; const int row = u >> 4, part = u & 15; const int t = ch * 64 + row;
            st[12 + i] = *(const v4u*)(AVb + (size_t)t * GW + h * 64 + part * 4); }
    };
    auto stage_store = [&](int ht) {
#pragma unroll
        for (int i = 0; i < 7; ++i) { const int u = ht + 256 * i; const int row = u / 24, rem = u - row * 24; if (u < 1560) *(LAS v4u*)(RAWT + row * 384 + rem * 16) = st[i]; }
#pragma unroll
        for (int i = 0; i < 5; ++i) { const int u = ht + 256 * i; if (u < 1040) *(LAS v4u*)((LAS unsigned char*)CMT + u * 16) = st[7 + i]; }
#pragma unroll
        for (int i = 0; i < 4; ++i) { const int u = ht + 256 * i; *(LAS v4u*)((LAS unsigned char*)AVT + u * 16) = st[12 + i]; }
    };
    if (!act) { const int ht = opaque_i(tid - 256); stage_load(0, ht); stage_store(ht); }
    WG_BAR();
    for (int ch = 0; ch < SEQ / 64; ++ch) {
        if (act) { const int lane = opaque_i(lane0), r = lane & 15, q = lane >> 4;
            float rs[16], k2[16], kkv[16], tv[16];
            const float mu_r = mu[lane], mu_k = mu[256 + lane], mu_v = mu[512 + lane];
            const float kkc = in.rwkv_k_k[layer * GW + h * 64 + lane], kac = in.rwkv_k_a[layer * GW + h * 64 + lane], rkc = in.rwkv_r_k[layer * GW + h * 64 + lane];
            { const LAS bf16* rw = (const LAS bf16*)RAWT + (16 * w4) * 192 + lane;
              float pr = bf2f(rw[0]), pk = bf2f(rw[64]), pv = bf2f(rw[128]);
#pragma unroll
              for (int i = 0; i < 16; ++i) { const float xr = bf2f(rw[(i + 1) * 192]), xk = bf2f(rw[(i + 1) * 192 + 64]), xv = bf2f(rw[(i + 1) * 192 + 128]);
                  const float av = AVT[(16 * w4 + i) * 64 + lane];
                  rs[i] = xr + (pr - xr) * mu_r; const float ks = xk + (pk - xk) * mu_k; tv[i] = xv + (pv - xv) * mu_v;
                  kkv[i] = ks * kkc; k2[i] = ks * (1.f + (av - 1.f) * kac); pr = xr; pk = xk; pv = xv; } }
            ssd_pack16(VT + lane * LS + 16 * w4, tv);
            { float sq[16];
#pragma unroll
              for (int i = 0; i < 16; ++i) sq[i] = kkv[i] * kkv[i];
              const float sred = tr_reduce16(sq, lane);
#pragma unroll
              for (int i = 0; i < 16; ++i) kkv[i] *= rsqrtf(rdlane(sred, 4 * i) + 1e-6f);
#pragma unroll
              for (int i = 0; i < 16; ++i) sq[i] = rs[i] * k2[i] * rkc;
              const float bred = tr_reduce16(sq, lane);
              if ((lane & 3) == 0) BON[16 * w4 + (lane >> 2)] = bred; }
#pragma unroll
            for (int i = 0; i < 16; ++i) { const float cum = CMT[(16 * w4 + i + 1) * 64 + lane]; const int t = 16 * w4 + i;
                const float en = __expf(-cum); const float cump = (i == 0 && w4 == 0) ? 0.f : CMT[(16 * w4 + i) * 64 + lane];
                AT[t * LS + lane] = cvt_bf16(-kkv[i] * __expf(cump));
                RT[t * LS + lane] = cvt_bf16(rs[i] * __expf(cum));
                kkv[i] = kkv[i] * AVT[(16 * w4 + i) * 64 + lane] * en; k2[i] = k2[i] * en;
                BL[t * LS + lane] = cvt_bf16(kkv[i]); KL[t * LS + lane] = cvt_bf16(k2[i]); }
            ssd_pack16(BTT + lane * LS + 16 * w4, kkv);
            ssd_pack16(KTT + lane * LS + 16 * w4, k2);
            if (w4 == 3) ELAST[lane] = __expf(CMT[64 * 64 + lane]);
#pragma unroll
            for (int n = 0; n < 4; ++n) st4(ZT, LS, 16 * n + r, 16 * w4 + 4 * q, zs[n]);
        }
        WG_BAR();
        if (!act && ch + 1 < SEQ / 64) stage_load(ch + 1, opaque_i(tid - 256));
        const int m = w4;
        if (act) { const int lane = opaque_i(lane0), r = lane & 15, q = lane >> 4;
            f32x4 Aak[4];
            bf16x8 aa[2];
#pragma unroll
            for (int k = 0; k < 2; ++k) aa[k] = ld_frag(AT, LS, 16 * m + r, 32 * k, q);
#pragma unroll
            for (int n = 0; n < 4; ++n) { Aak[n] = zero4(); if (n <= m) {
                f32x4 ab = zero4();
#pragma unroll
                for (int k = 0; k < 2; ++k) { const bf16x8 fb = ld_frag(BL, LS, 16 * n + r, 32 * k, q), fk = ld_frag(KL, LS, 16 * n + r, 32 * k, q);
                    ab = MFMA16(aa[k], fb, ab);
                    Aak[n] = MFMA16(fk, aa[k], Aak[n]); }
                f32x4 av;
#pragma unroll
                for (int i = 0; i < 4; ++i) { const bool keep = (n < m) || (r < 4 * q + i); av[i] = keep ? -ab[i] : 0.f; }
                st4(AMT, LS, 16 * n + r, 16 * m + 4 * q, av);
                if (n == m) {
#pragma unroll
                    for (int i = 0; i < 4; ++i) AD[m * 256 + (4 * q + i) * 16 + r] = av[i];
#pragma unroll
                    for (int i = 0; i < 4; ++i) { const bool strict = (4 * q + i < r); Aak[n][i] = strict ? Aak[n][i] : 0.f; } }
            } }
            const bf16x8 p0 = pack_frag(Aak[0], Aak[1]), p1 = pack_frag(Aak[2], Aak[3]);
#pragma unroll
            for (int nv = 0; nv < 4; ++nv) { f32x4 rh = zero4();
#pragma unroll
                for (int k = 0; k < 2; ++k) rh = MFMA16(aa[k], ld_frag(ZT, LS, 16 * nv + r, 32 * k, q), rh);
                rh = MFMA16(p0, ld_frag_perm(VT, LS, 16 * nv + r, 0, q), rh);
                if (m >= 2) rh = MFMA16(p1, ld_frag_perm(VT, LS, 16 * nv + r, 32, q), rh);
                st4(RHST, LS, 16 * nv + r, 16 * m + 4 * q, rh); }
        }
        WG_BAR();
        if (act) { const int lane = opaque_i(lane0), r = lane & 15, q = lane >> 4;
            diag_inverse(AD, DT, lane);
            asm volatile("s_waitcnt lgkmcnt(0)" ::: "memory");
            f32x4 Tm[4];
            tri_inverse_row(AMT, DT, m, r, q, Tm);
            const bf16x8 t0 = pack_frag(Tm[0], Tm[1]), t1 = pack_frag(Tm[2], Tm[3]);
#pragma unroll
            for (int nv = 0; nv < 4; ++nv) { f32x4 sa = zero4();
                sa = MFMA16(t0, ld_frag_perm(RHST, LS, 16 * nv + r, 0, q), sa);
                if (m >= 2) sa = MFMA16(t1, ld_frag_perm(RHST, LS, 16 * nv + r, 32, q), sa);
                st4(SAT, LS, 16 * nv + r, 16 * m + 4 * q, sa); }
        }
        WG_BAR();
        if (!act && ch + 1 < SEQ / 64) stage_store(opaque_i(tid - 256));
        if (act) { const int lane = opaque_i(lane0), r = lane & 15, q = lane >> 4;
            f32x4 O[4];
            bf16x8 ar[2];
#pragma unroll
            for (int k = 0; k < 2; ++k) ar[k] = ld_frag(RT, LS, 16 * m + r, 32 * k, q);
            f32x4 Arb[4], Ark[4];
#pragma unroll
            for (int n = 0; n < 4; ++n) { Arb[n] = zero4(); Ark[n] = zero4(); if (n <= m) {
#pragma unroll
                for (int k = 0; k < 2; ++k) { Arb[n] = MFMA16(ld_frag(BL, LS, 16 * n + r, 32 * k, q), ar[k], Arb[n]); Ark[n] = MFMA16(ld_frag(KL, LS, 16 * n + r, 32 * k, q), ar[k], Ark[n]); }
                if (n == m) {
#pragma unroll
                    for (int i = 0; i < 4; ++i) { const bool incl = (4 * q + i <= r); Arb[n][i] = incl ? Arb[n][i] : 0.f; Ark[n][i] = incl ? Ark[n][i] : 0.f; } } } }
            const bf16x8 b0 = pack_frag(Arb[0], Arb[1]), b1 = pack_frag(Arb[2], Arb[3]), k0 = pack_frag(Ark[0], Ark[1]), k1 = pack_frag(Ark[2], Ark[3]);
            float s1 = 0.f;
#pragma unroll
            for (int nv = 0; nv < 4; ++nv) { O[nv] = zero4();
#pragma unroll
                for (int k = 0; k < 2; ++k) O[nv] = MFMA16(ld_frag(ZT, LS, 16 * nv + r, 32 * k, q), ar[k], O[nv]);
                O[nv] = MFMA16(ld_frag_perm(SAT, LS, 16 * nv + r, 0, q), b0, O[nv]);
                O[nv] = MFMA16(ld_frag_perm(VT, LS, 16 * nv + r, 0, q), k0, O[nv]);
                if (m >= 2) { O[nv] = MFMA16(ld_frag_perm(SAT, LS, 16 * nv + r, 32, q), b1, O[nv]); O[nv] = MFMA16(ld_frag_perm(VT, LS, 16 * nv + r, 32, q), k1, O[nv]); }
                s1 += (O[nv][0] + O[nv][1]) + (O[nv][2] + O[nv][3]); }
            s1 += __shfl_xor(s1, 16); s1 += __shfl_xor(s1, 32);
            const float mean = s1 * (1.f / 64.f); float s2 = 0.f;
#pragma unroll
            for (int nv = 0; nv < 4; ++nv) { O[nv] = O[nv] - mean; s2 += (O[nv][0] * O[nv][0] + O[nv][1] * O[nv][1]) + (O[nv][2] * O[nv][2] + O[nv][3] * O[nv][3]); }
            s2 += __shfl_xor(s2, 16); s2 += __shfl_xor(s2, 32);
            const float rstd = rsqrtf(s2 * (1.f / 64.f) + 64e-5f);
            const int t = ch * 64 + 16 * m + r; const float bon = BON[16 * m + r];
#pragma unroll
            for (int nv = 0; nv < 4; ++nv) { const int dv0 = 16 * nv + 4 * q, cc = h * 64 + dv0;
                const f32x4 lw4 = *(const f32x4*)(in.rwkv_ln_w + layer * GW + cc); const f32x4 lb4 = *(const f32x4*)(in.rwkv_ln_b + layer * GW + cc);
                const v2u zr = *(const v2u*)(P + (size_t)t * NP + C_Z + 768 + cc);
                const float z0 = __builtin_bit_cast(float, zr.x << 16), z1 = __builtin_bit_cast(float, zr.x & 0xffff0000u), z2 = __builtin_bit_cast(float, zr.y << 16), z3 = __builtin_bit_cast(float, zr.y & 0xffff0000u);
                const float v0 = bf2f(VT[(dv0 + 0) * LS + 16 * m + r]), v1 = bf2f(VT[(dv0 + 1) * LS + 16 * m + r]), v2 = bf2f(VT[(dv0 + 2) * LS + 16 * m + r]), v3 = bf2f(VT[(dv0 + 3) * LS + 16 * m + r]);
                v2u o; o.x = pk_bf16((O[nv][0] * rstd * lw4[0] + lb4[0] + bon * v0) * siluf_(z0), (O[nv][1] * rstd * lw4[1] + lb4[1] + bon * v1) * siluf_(z1));
                o.y = pk_bf16((O[nv][2] * rstd * lw4[2] + lb4[2] + bon * v2) * siluf_(z2), (O[nv][3] * rstd * lw4[3] + lb4[3] + bon * v3) * siluf_(z3));
                *(v2u*)(Yb + (size_t)t * DM + 768 + cc) = o; }
            const f32x4 el = *(const LAS f32x4*)(ELAST + 16 * w4 + 4 * q);
            bf16x8 ab2[2], ak2[2];
#pragma unroll
            for (int k = 0; k < 2; ++k) { ab2[k] = ld_frag(BTT, LS, 16 * w4 + r, 32 * k, q); ak2[k] = ld_frag(KTT, LS, 16 * w4 + r, 32 * k, q); }
#pragma unroll
            for (int n = 0; n < 4; ++n) {
#pragma unroll
                for (int k = 0; k < 2; ++k) { zs[n] = MFMA16(ab2[k], ld_frag(SAT, LS, 16 * n + r, 32 * k, q), zs[n]); zs[n] = MFMA16(ak2[k], ld_frag(VT, LS, 16 * n + r, 32 * k, q), zs[n]); }
                zs[n] = zs[n] * el; }
        }
        WG_BAR();
    }
}

__device__ __forceinline__ void mixopt_rwkv2(const Inputs& in, const int layer, const bf16* __restrict__ PROJ, const float* __restrict__ CUMg, const float* __restrict__ CUMPg, const float* __restrict__ AV, bf16* __restrict__ Yg,
                                            LAS unsigned char* L, const int b, const int h, const int tid) {
    const int lane0 = tid & 63, wave = __builtin_amdgcn_readfirstlane(tid >> 6), w4 = wave & 3;
    const bool act = wave < 4;
    LAS bf16* AT = (LAS bf16*)L; LAS bf16* RT = (LAS bf16*)(L + 9216); LAS bf16* BL = (LAS bf16*)(L + 18432); LAS bf16* KL = (LAS bf16*)(L + 27648);
    LAS bf16* BTT = (LAS bf16*)(L + 36864); LAS bf16* KTT = (LAS bf16*)(L + 46080); LAS bf16* VT = (LAS bf16*)(L + 55296); LAS bf16* ZT = (LAS bf16*)(L + 64512);
    LAS bf16* AMT = (LAS bf16*)(L + 73728); LAS bf16* RHST = (LAS bf16*)(L + 82944); LAS float* AD = (LAS float*)(L + 92160); LAS bf16* DT = (LAS bf16*)(L + 96256);
    LAS float* QTOT = (LAS float*)(L + 98304); LAS float* ELAST = (LAS float*)(L + 99328); LAS float* BON = (LAS float*)(L + 99584);
    LAS bf16* SAT = AT;
    const bf16* P = PROJ + (size_t)b * SEQ * NP; bf16* Yb = Yg + (size_t)b * SEQ * DM;
    const float* CUMb = CUMg + (size_t)b * SEQ * GW; const float* CUMPb = CUMPg + (size_t)b * SEQ * GW; const float* AVb = AV + (size_t)b * SEQ * GW;
    const float* mu = in.rwkv_mu + (size_t)layer * 896 + h * 64;
    f32x4 zs[4];
#pragma unroll
    for (int n = 0; n < 4; ++n) zs[n] = zero4();
#define O zs
    LAS unsigned char* RAWT = L + 73728; LAS float* CMT = (LAS float*)(L + 99840); LAS float* AVT = (LAS float*)(L + 120320);
    v4u st[9];
    auto stage_load_a = [&](int ch, int ht) {
#pragma unroll
        for (int i = 0; i < 5; ++i) { const int u = ht + 256 * i; const int row = u >> 4, part = u & 15; const int t = ch * 64 - 1 + row;
            st[i] = (u < 1040 && t >= 0) ? *(const v4u*)(CUMb + (size_t)t * GW + h * 64 + part * 4) : (v4u){0u, 0u, 0u, 0u}; }
#pragma unroll
        for (int i = 0; i < 4; ++i) { const int u = ht + 256 * i; const int row = u >> 4, part = u & 15; const int t = ch * 64 + row;
            st[5 + i] = *(const v4u*)(AVb + (size_t)t * GW + h * 64 + part * 4); }
    };
    auto stage_store_a = [&](int ht) {
#pragma unroll
        for (int i = 0; i < 5; ++i) { const int u = ht + 256 * i; if (u < 1040) *(LAS v4u*)((LAS unsigned char*)CMT + u * 16) = st[i]; }
#pragma unroll
        for (int i = 0; i < 4; ++i) { const int u = ht + 256 * i; *(LAS v4u*)((LAS unsigned char*)AVT + u * 16) = st[5 + i]; }
    };
    auto stage_dma_a = [&](int ch, int ht, int wv) {
#pragma unroll
        for (int i = 0; i < 5; ++i) { const int u = ht + 256 * i; const int uu = u < 1040 ? u : 1039; const int row = uu >> 4, part = uu & 15; const int t = ch * 64 - 1 + row;
            __builtin_amdgcn_global_load_lds((const GAS unsigned*)(CUMb + (size_t)t * GW + h * 64 + part * 4), (LAS unsigned*)((LAS unsigned char*)CMT + (64 * wv + 256 * i) * 16), 16, 0, 0); }
#pragma unroll
        for (int i = 0; i < 4; ++i) { const int u = ht + 256 * i; const int row = u >> 4, part = u & 15; const int t = ch * 64 + row;
            __builtin_amdgcn_global_load_lds((const GAS unsigned*)(AVb + (size_t)t * GW + h * 64 + part * 4), (LAS unsigned*)((LAS unsigned char*)AVT + (64 * wv + 256 * i) * 16), 16, 0, 0); }
    };
    auto stage_load_b = [&](int ch, int ht) {
#pragma unroll
        for (int i = 0; i < 7; ++i) { const int u = ht + 256 * i; const int row = u / 24, rem = u - row * 24, seg = rem >> 3, part = rem & 7; const int t = ch * 64 - 1 + row;
            st[i] = (u < 1560 && t >= 0) ? *(const v4u*)(P + (size_t)t * NP + C_RW_R + seg * 256 + h * 64 + part * 8) : (v4u){0u, 0u, 0u, 0u}; }
    };
    auto stage_store_b = [&](int ht) {
#pragma unroll
        for (int i = 0; i < 7; ++i) { const int u = ht + 256 * i; const int row = u / 24, rem = u - row * 24; if (u < 1560) *(LAS v4u*)(RAWT + row * 384 + rem * 16) = st[i]; }
    };
    if (!act) { const int ht = opaque_i(tid - 256); stage_load_a(0, ht); stage_store_a(ht); stage_load_b(0, ht); stage_store_b(ht); }
    WG_BAR();
    for (int ch = 0; ch < SEQ / 64; ++ch) {
        { const int lane = opaque_i(lane0), r = lane & 15, q = lane >> 4;
          const float mu_k = mu[256 + lane];
          const float kac = in.rwkv_k_a[layer * GW + h * 64 + lane];
          const LAS bf16* rw = (const LAS bf16*)RAWT + (16 * w4) * 192 + lane;
          float k2[16];
          if (act) {
            float kkv[16];
            const float kkc = in.rwkv_k_k[layer * GW + h * 64 + lane];
            { float pk = bf2f(rw[64]);
#pragma unroll
              for (int i = 0; i < 16; ++i) { const float xk = bf2f(rw[(i + 1) * 192 + 64]); const float av = AVT[(16 * w4 + i) * 64 + lane];
                  const float ks = xk + (pk - xk) * mu_k; kkv[i] = ks * kkc; k2[i] = ks * (1.f + (av - 1.f) * kac); pk = xk; } }
            { float sq[16];
#pragma unroll
              for (int i = 0; i < 16; ++i) sq[i] = kkv[i] * kkv[i];
              const float sred = tr_reduce16(sq, lane);
#pragma unroll
              for (int i = 0; i < 16; ++i) kkv[i] *= rsqrtf(rdlane(sred, 4 * i) + 1e-6f); }
#pragma unroll
            for (int i = 0; i < 16; ++i) { const float cum = CMT[(16 * w4 + i + 1) * 64 + lane]; const int t = 16 * w4 + i;
                const float en = __expf(-cum); const float cump = (i == 0 && w4 == 0) ? 0.f : CMT[(16 * w4 + i) * 64 + lane];
                AT[t * LS + lane] = cvt_bf16(-kkv[i] * __expf(cump));
                kkv[i] = kkv[i] * AVT[(16 * w4 + i) * 64 + lane] * en; k2[i] = k2[i] * en;
                BL[t * LS + lane] = cvt_bf16(kkv[i]); KL[t * LS + lane] = cvt_bf16(k2[i]); }
            ssd_pack16(BTT + lane * LS + 16 * w4, kkv);
            ssd_pack16(KTT + lane * LS + 16 * w4, k2);
            if (w4 == 3) ELAST[lane] = __expf(CMT[64 * 64 + lane]);
#pragma unroll
            for (int n = 0; n < 4; ++n) st4(ZT, LS, 16 * n + r, 16 * w4 + 4 * q, zs[n]);
          } else {
            float rs[16], tv[16];
            const float mu_r = mu[lane], mu_v = mu[512 + lane];
            const float rkc = in.rwkv_r_k[layer * GW + h * 64 + lane];
            { float pr = bf2f(rw[0]), pk = bf2f(rw[64]), pv = bf2f(rw[128]);
#pragma unroll
              for (int i = 0; i < 16; ++i) { const float xr = bf2f(rw[(i + 1) * 192]), xk = bf2f(rw[(i + 1) * 192 + 64]), xv = bf2f(rw[(i + 1) * 192 + 128]);
                  const float av = AVT[(16 * w4 + i) * 64 + lane];
                  rs[i] = xr + (pr - xr) * mu_r; const float ks = xk + (pk - xk) * mu_k; tv[i] = xv + (pv - xv) * mu_v;
                  k2[i] = ks * (1.f + (av - 1.f) * kac); pr = xr; pk = xk; pv = xv; } }
            ssd_pack16(VT + lane * LS + 16 * w4, tv);
            { float sq[16];
#pragma unroll
              for (int i = 0; i < 16; ++i) sq[i] = rs[i] * k2[i] * rkc;
              const float bred = tr_reduce16(sq, lane);
              if ((lane & 3) == 0) BON[16 * w4 + (lane >> 2)] = bred; }
#pragma unroll
            for (int i = 0; i < 16; ++i) RT[(16 * w4 + i) * LS + lane] = cvt_bf16(rs[i] * __expf(CMT[(16 * w4 + i + 1) * 64 + lane]));
          }
        }
        WG_BAR();
        if (!act && ch + 1 < SEQ / 64) stage_dma_a(ch + 1, opaque_i(tid - 256), wave - 4);
        const int m = w4;
        f32x4 Arb[4], Ark[4];
        if (!act) { const int lane = opaque_i(lane0), r = lane & 15, q = lane >> 4;
            bf16x8 ar[2];
#pragma unroll
            for (int k = 0; k < 2; ++k) ar[k] = ld_frag(RT, LS, 16 * m + r, 32 * k, q);
#pragma unroll
            for (int n = 0; n < 4; ++n) { Arb[n] = zero4(); Ark[n] = zero4(); if (n <= m) {
#pragma unroll
                for (int k = 0; k < 2; ++k) { Arb[n] = MFMA16(ld_frag(BL, LS, 16 * n + r, 32 * k, q), ar[k], Arb[n]); Ark[n] = MFMA16(ld_frag(KL, LS, 16 * n + r, 32 * k, q), ar[k], Ark[n]); }
                if (n == m) {
#pragma unroll
                    for (int i = 0; i < 4; ++i) { const bool incl = (4 * q + i <= r); Arb[n][i] = incl ? Arb[n][i] : 0.f; Ark[n][i] = incl ? Ark[n][i] : 0.f; } } } }
        }
        if (act) { const int lane = opaque_i(lane0), r = lane & 15, q = lane >> 4;
            f32x4 Aak[4];
            bf16x8 aa[2];
#pragma unroll
            for (int k = 0; k < 2; ++k) aa[k] = ld_frag(AT, LS, 16 * m + r, 32 * k, q);
#pragma unroll
            for (int n = 0; n < 4; ++n) { Aak[n] = zero4(); if (n <= m) {
                f32x4 ab = zero4();
#pragma unroll
                for (int k = 0; k < 2; ++k) { const bf16x8 fb = ld_frag(BL, LS, 16 * n + r, 32 * k, q), fk = ld_frag(KL, LS, 16 * n + r, 32 * k, q);
                    ab = MFMA16(aa[k], fb, ab);
                    Aak[n] = MFMA16(fk, aa[k], Aak[n]); }
                f32x4 av;
#pragma unroll
                for (int i = 0; i < 4; ++i) { const bool keep = (n < m) || (r < 4 * q + i); av[i] = keep ? -ab[i] : 0.f; }
                st4(AMT, LS, 16 * n + r, 16 * m + 4 * q, av);
                if (n == m) {
#pragma unroll
                    for (int i = 0; i < 4; ++i) AD[m * 256 + (4 * q + i) * 16 + r] = av[i];
#pragma unroll
                    for (int i = 0; i < 4; ++i) { const bool strict = (4 * q + i < r); Aak[n][i] = strict ? Aak[n][i] : 0.f; } }
            } }
            const bf16x8 p0 = pack_frag(Aak[0], Aak[1]), p1 = pack_frag(Aak[2], Aak[3]);
#pragma unroll
            for (int nv = 0; nv < 4; ++nv) { f32x4 rh = zero4();
#pragma unroll
                for (int k = 0; k < 2; ++k) rh = MFMA16(aa[k], ld_frag(ZT, LS, 16 * nv + r, 32 * k, q), rh);
                rh = MFMA16(p0, ld_frag_perm(VT, LS, 16 * nv + r, 0, q), rh);
                if (m >= 2) rh = MFMA16(p1, ld_frag_perm(VT, LS, 16 * nv + r, 32, q), rh);
                st4(RHST, LS, 16 * nv + r, 16 * m + 4 * q, rh); }
        }
        WG_BAR();
        if (!act) { const int lane = opaque_i(lane0), r = lane & 15, q = lane >> 4;
            if (ch + 1 < SEQ / 64) stage_load_b(ch + 1, opaque_i(tid - 256));
            bf16x8 ar[2];
#pragma unroll
            for (int k = 0; k < 2; ++k) ar[k] = ld_frag(RT, LS, 16 * m + r, 32 * k, q);
#pragma unroll
            for (int nv = 0; nv < 4; ++nv) { O[nv] = zero4();
#pragma unroll
                for (int k = 0; k < 2; ++k) O[nv] = MFMA16(ld_frag(ZT, LS, 16 * nv + r, 32 * k, q), ar[k], O[nv]); }
        }
        if (act) { const int lane = opaque_i(lane0), r = lane & 15, q = lane >> 4;
            diag_inverse(AD, DT, lane);
            asm volatile("s_waitcnt lgkmcnt(0)" ::: "memory");
            f32x4 Tm[4];
            tri_inverse_row(AMT, DT, m, r, q, Tm);
            const bf16x8 t0 = pack_frag(Tm[0], Tm[1]), t1 = pack_frag(Tm[2], Tm[3]);
#pragma unroll
            for (int nv = 0; nv < 4; ++nv) { f32x4 sa = zero4();
                sa = MFMA16(t0, ld_frag_perm(RHST, LS, 16 * nv + r, 0, q), sa);
                if (m >= 2) sa = MFMA16(t1, ld_frag_perm(RHST, LS, 16 * nv + r, 32, q), sa);
                st4(SAT, LS, 16 * nv + r, 16 * m + 4 * q, sa); }
        }
        WG_BAR();
        if (!act) { const int lane = opaque_i(lane0), r = lane & 15, q = lane >> 4;
            const bf16x8 b0 = pack_frag(Arb[0], Arb[1]), b1 = pack_frag(Arb[2], Arb[3]), k0 = pack_frag(Ark[0], Ark[1]), k1 = pack_frag(Ark[2], Ark[3]);
            float s1 = 0.f;
#pragma unroll
            for (int nv = 0; nv < 4; ++nv) {
                O[nv] = MFMA16(ld_frag_perm(SAT, LS, 16 * nv + r, 0, q), b0, O[nv]);
                O[nv] = MFMA16(ld_frag_perm(VT, LS, 16 * nv + r, 0, q), k0, O[nv]);
                if (m >= 2) { O[nv] = MFMA16(ld_frag_perm(SAT, LS, 16 * nv + r, 32, q), b1, O[nv]); O[nv] = MFMA16(ld_frag_perm(VT, LS, 16 * nv + r, 32, q), k1, O[nv]); }
                s1 += (O[nv][0] + O[nv][1]) + (O[nv][2] + O[nv][3]); }
            s1 += __shfl_xor(s1, 16); s1 += __shfl_xor(s1, 32);
            const float mean = s1 * (1.f / 64.f); float s2 = 0.f;
#pragma unroll
            for (int nv = 0; nv < 4; ++nv) { O[nv] = O[nv] - mean; s2 += (O[nv][0] * O[nv][0] + O[nv][1] * O[nv][1]) + (O[nv][2] * O[nv][2] + O[nv][3] * O[nv][3]); }
            s2 += __shfl_xor(s2, 16); s2 += __shfl_xor(s2, 32);
            const float rstd = rsqrtf(s2 * (1.f / 64.f) + 64e-5f);
            const int t = ch * 64 + 16 * m + r; const float bon = BON[16 * m + r];
#pragma unroll
            for (int nv = 0; nv < 4; ++nv) { const int dv0 = 16 * nv + 4 * q, cc = h * 64 + dv0;
                const f32x4 lw4 = *(const f32x4*)(in.rwkv_ln_w + layer * GW + cc); const f32x4 lb4 = *(const f32x4*)(in.rwkv_ln_b + layer * GW + cc);
                const v2u zr = *(const v2u*)(P + (size_t)t * NP + C_Z + 768 + cc);
                const float z0 = __builtin_bit_cast(float, zr.x << 16), z1 = __builtin_bit_cast(float, zr.x & 0xffff0000u), z2 = __builtin_bit_cast(float, zr.y << 16), z3 = __builtin_bit_cast(float, zr.y & 0xffff0000u);
                const float v0 = bf2f(VT[(dv0 + 0) * LS + 16 * m + r]), v1 = bf2f(VT[(dv0 + 1) * LS + 16 * m + r]), v2 = bf2f(VT[(dv0 + 2) * LS + 16 * m + r]), v3 = bf2f(VT[(dv0 + 3) * LS + 16 * m + r]);
                v2u o; o.x = pk_bf16((O[nv][0] * rstd * lw4[0] + lb4[0] + bon * v0) * siluf_(z0), (O[nv][1] * rstd * lw4[1] + lb4[1] + bon * v1) * siluf_(z1));
                o.y = pk_bf16((O[nv][2] * rstd * lw4[2] + lb4[2] + bon * v2) * siluf_(z2), (O[nv][3] * rstd * lw4[3] + lb4[3] + bon * v3) * siluf_(z3));
                *(v2u*)(Yb + (size_t)t * DM + 768 + cc) = o; }
            if (ch + 1 < SEQ / 64) stage_store_b(opaque_i(tid - 256));
        }
        if (act) { const int lane = opaque_i(lane0), r = lane & 15, q = lane >> 4;
            const f32x4 el = *(const LAS f32x4*)(ELAST + 16 * w4 + 4 * q);
            bf16x8 ab2[2], ak2[2];
#pragma unroll
            for (int k = 0; k < 2; ++k) { ab2[k] = ld_frag(BTT, LS, 16 * w4 + r, 32 * k, q); ak2[k] = ld_frag(KTT, LS, 16 * w4 + r, 32 * k, q); }
#pragma unroll
            for (int n = 0; n < 4; ++n) {
#pragma unroll
                for (int k = 0; k < 2; ++k) { zs[n] = MFMA16(ab2[k], ld_frag(SAT, LS, 16 * n + r, 32 * k, q), zs[n]); zs[n] = MFMA16(ak2[k], ld_frag(VT, LS, 16 * n + r, 32 * k, q), zs[n]); }
                zs[n] = zs[n] * el; }
        }
        WG_BAR();
    }
}
#undef O

#ifndef MK_MASK
#define MK_MASK 31
#endif
#ifndef REP_MASK
#define REP_MASK 0
#endif

constexpr int NWAVES = 8;
constexpr size_t MiB = 1u << 20;
constexpr size_t WS_CTL = 0, CTL_ZERO_BYTES = 64 * 1024;
constexpr size_t WS_WIN = 1 * MiB;
constexpr size_t WS_WOUT = 18 * MiB;
constexpr size_t WS_U = 22 * MiB;
constexpr size_t WS_PROJ = 54 * MiB;
constexpr size_t WS_OUT = 190 * MiB;
constexpr int CW_BAR = 4096;
constexpr int LDSCTL_OFF = 147456, MISC_OFF = LDSCTL_OFF + 320, LDS_BYTES = 148480;

struct Args { Inputs in; float* out; unsigned char* ws; };
__device__ __forceinline__ int opaque_v(int v) { asm volatile("" : "+v"(v)); return v; }

__device__ __forceinline__ void wprep_load(const float* __restrict__ W, int N, int use_perm, int n0, int k0, int tid, LAS float* tile) {
    const int nn = tid & 31, kq = tid >> 5;
    const int oc = use_perm ? old_col(n0 + nn) : (n0 + nn);
#pragma unroll
    for (int i = 0; i < 8; ++i) { const int kk = kq + 8 * i; tile[kk * 33 + nn] = (oc >= 0) ? W[(size_t)(k0 + kk) * N + oc] : 0.f; }
}
__device__ __forceinline__ void wprep_store(bf16* __restrict__ WT, int K, int n0, int k0, int tid, const LAS float* tile) {
    const int n = tid >> 3, kc = (tid & 7) * 8;
    uint4 o;
    o.x = f2bf(tile[(kc + 0) * 33 + n]) | (f2bf(tile[(kc + 1) * 33 + n]) << 16);
    o.y = f2bf(tile[(kc + 2) * 33 + n]) | (f2bf(tile[(kc + 3) * 33 + n]) << 16);
    o.z = f2bf(tile[(kc + 4) * 33 + n]) | (f2bf(tile[(kc + 5) * 33 + n]) << 16);
    o.w = f2bf(tile[(kc + 6) * 33 + n]) | (f2bf(tile[(kc + 7) * 33 + n]) << 16);
    *(uint4*)(WT + (size_t)(n0 + n) * K + k0 + kc) = o;
}

__device__ __forceinline__ void rmsnorm_row_bf16(const float* __restrict__ hrow, const float* __restrict__ g, bf16* __restrict__ urow, int lane) {
    const float4* xr = (const float4*)hrow + lane; const float4* gr = (const float4*)g + lane;
    float4 v[4]; float s = 0.f;
#pragma unroll
    for (int j = 0; j < 4; ++j) { v[j] = xr[64 * j]; s += (v[j].x * v[j].x + v[j].y * v[j].y) + (v[j].z * v[j].z + v[j].w * v[j].w); }
    const float r = rsqrtf(wave_sum(s) * (1.f / DM) + 1e-6f);
    uint2* o8 = (uint2*)urow + lane;
#pragma unroll
    for (int j = 0; j < 4; ++j) { const float4 gg = gr[64 * j]; uint2 o;
        o.x = f2bf(v[j].x * r * gg.x) | (f2bf(v[j].y * r * gg.y) << 16); o.y = f2bf(v[j].z * r * gg.z) | (f2bf(v[j].w * r * gg.w) << 16); o8[64 * j] = o; }
}

__device__ __forceinline__ void post_row(const float* hrow, const float* __restrict__ orow_, const float* __restrict__ g, float* hnew, const float* __restrict__ g2, bf16* __restrict__ urow, int lane) {
    const float4* orow = (const float4*)orow_ + lane; const float4* hr = (const float4*)hrow + lane; const float4* gr = (const float4*)g + lane;
    float4 v[4]; float s = 0.f;
#pragma unroll
    for (int j = 0; j < 4; ++j) { v[j] = orow[64 * j]; s += (v[j].x * v[j].x + v[j].y * v[j].y) + (v[j].z * v[j].z + v[j].w * v[j].w); }
    const float r = rsqrtf(wave_sum(s) * (1.f / DM) + 1e-6f);
    float4* o = (float4*)hnew + lane; float s2 = 0.f;
#pragma unroll
    for (int j = 0; j < 4; ++j) { const float4 gg = gr[64 * j]; const float4 hh = hr[64 * j]; float4 w;
        w.x = hh.x + v[j].x * r * gg.x; w.y = hh.y + v[j].y * r * gg.y; w.z = hh.z + v[j].z * r * gg.z; w.w = hh.w + v[j].w * r * gg.w; o[64 * j] = w; v[j] = w;
        s2 += (w.x * w.x + w.y * w.y) + (w.z * w.z + w.w * w.w); }
    if (g2) {
        const float r2 = rsqrtf(wave_sum(s2) * (1.f / DM) + 1e-6f);
        const float4* g2r = (const float4*)g2 + lane; uint2* o8 = (uint2*)urow + lane;
#pragma unroll
        for (int j = 0; j < 4; ++j) { const float4 gg = g2r[64 * j]; uint2 q;
            q.x = f2bf(v[j].x * r2 * gg.x) | (f2bf(v[j].y * r2 * gg.y) << 16); q.y = f2bf(v[j].z * r2 * gg.z) | (f2bf(v[j].w * r2 * gg.w) << 16); o8[64 * j] = q; }
    }
}

#define CAS __attribute__((address_space(4)))
#define GRID_BAR() do { const CAS Args* apb = (const CAS Args*)__builtin_amdgcn_kernarg_segment_ptr(); asm volatile("" : "+s"(apb)); \
    XcdBarrier bq; bq.bar = (unsigned*)((gu32*)(apb->ws + WS_CTL) + CW_BAR); bq.x = xb_xcc_id(); bq.st = (volatile LAS unsigned*)(lds + MISC_OFF) + 8; \
    int wv_ = wave_k; asm volatile("" : "+s"(wv_)); xcd_barrier(bq, (wv_ << 6) | fresh_lane()); } while (0)
#define PHASE_LOCALS() \
    const CAS Args* ap = (const CAS Args*)__builtin_amdgcn_kernarg_segment_ptr(); asm volatile("" : "+s"(ap)); \
    Inputs in; in.x = ap->in.x; in.pre_norm_g = ap->in.pre_norm_g; in.w_in = ap->in.w_in; in.hgrn_lb = ap->in.hgrn_lb; in.hgrn_norm_g = ap->in.hgrn_norm_g; in.gdn_conv_w = ap->in.gdn_conv_w; in.gdn_a_log = ap->in.gdn_a_log; in.gdn_dt_bias = ap->in.gdn_dt_bias; in.gdn_norm_g = ap->in.gdn_norm_g; in.ssm_conv_w = ap->in.ssm_conv_w; in.ssm_conv_b = ap->in.ssm_conv_b; in.ssm_a_log = ap->in.ssm_a_log; in.ssm_dt_bias = ap->in.ssm_dt_bias; in.ssm_d = ap->in.ssm_d; in.ssm_norm_g = ap->in.ssm_norm_g; in.rwkv_mu = ap->in.rwkv_mu; in.rwkv_w0 = ap->in.rwkv_w0; in.rwkv_w_up = ap->in.rwkv_w_up; in.rwkv_a0 = ap->in.rwkv_a0; in.rwkv_a_up = ap->in.rwkv_a_up; in.rwkv_k_k = ap->in.rwkv_k_k; in.rwkv_k_a = ap->in.rwkv_k_a; in.rwkv_r_k = ap->in.rwkv_r_k; in.rwkv_ln_w = ap->in.rwkv_ln_w; in.rwkv_ln_b = ap->in.rwkv_ln_b; in.w_out = ap->in.w_out; in.post_norm_g = ap->in.post_norm_g; \
    unsigned char* ws = ap->ws; float* hout = ap->out; \
    int bx = blockIdx.x; asm volatile("" : "+s"(bx)); int G = gridDim.x; asm volatile("" : "+s"(G)); \
    const int lane = fresh_lane(); int wave = wave_k; asm volatile("" : "+s"(wave)); const int tid = (wave << 6) | lane; \
    bf16* Win = (bf16*)(ws + WS_WIN); bf16* Wout = (bf16*)(ws + WS_WOUT); bf16* U = (bf16*)(ws + WS_U); bf16* PROJ = (bf16*)(ws + WS_PROJ); float* OUT = (float*)(ws + WS_OUT); \
    (void)Win; (void)Wout; (void)U; (void)PROJ; (void)OUT; (void)hout; (void)bx; (void)G; (void)lane; (void)wave;

__global__ void __launch_bounds__(NWAVES * 64, 2) mk_fwd(Args args) {
    extern __shared__ __attribute__((aligned(16))) unsigned char lds_raw[];
    LAS unsigned char* lds = (LAS unsigned char*)lds_raw;
    volatile LAS unsigned* MISC = (volatile LAS unsigned*)(lds + MISC_OFF);
    const int wave_k = __builtin_amdgcn_readfirstlane((int)threadIdx.x >> 6);
    for (int u = threadIdx.x; u < (LDS_BYTES - LDSCTL_OFF) / 4; u += NWAVES * 64) ((LAS unsigned*)(lds + LDSCTL_OFF))[u] = 0u;
    __syncthreads();
    (void)xcd_barrier_post((unsigned*)((gu32*)(args.ws + WS_CTL) + CW_BAR), MISC + 8, (int)threadIdx.x);

    {
        PHASE_LOCALS();
        const int half = tid >> 8, t256 = tid & 255;
        LAS float* tile = (LAS float*)(lds + half * 16384);
        constexpr int IT_IN = (NP / 32) * (DM / 64), IT_OUT = (DM / 32) * (DM / 64), IT_ALL = NLAYER * (IT_IN + IT_OUT);
        for (int it0 = bx * 2; it0 < IT_ALL; it0 += G * 2) {
            const int it = it0 + half; const bool act = it < IT_ALL;
            const float* W = nullptr; bf16* WT = nullptr; int N = 0, perm = 0, n0 = 0, k0 = 0;
            if (act) { int r = it; const int l = r / (IT_IN + IT_OUT); r -= l * (IT_IN + IT_OUT);
                if (r < IT_IN) { W = in.w_in + (size_t)l * DM * IN_COLS; N = IN_COLS; perm = 1; WT = Win + (size_t)l * NP * DM; n0 = (r % (NP / 32)) * 32; k0 = (r / (NP / 32)) * 64; }
                else { r -= IT_IN; W = in.w_out + (size_t)l * DM * DM; N = DM; perm = 0; WT = Wout + (size_t)l * DM * DM; n0 = (r % (DM / 32)) * 32; k0 = (r / (DM / 32)) * 64; }
                wprep_load(W, N, perm, n0, k0, t256, tile); }
            __syncthreads();
            if (act) wprep_store(WT, DM, n0, k0, t256, tile);
            __syncthreads();
        }
        for (int m = bx * NWAVES + wave; m < MTOK; m += G * NWAVES) rmsnorm_row_bf16(in.x + (size_t)m * DM, in.pre_norm_g, U + (size_t)m * DM, lane);
    }
    GRID_BAR();

#pragma unroll
    for (int l = 0; l < NLAYER; ++l) {
        { PHASE_LOCALS();
          pg8::Gemm g; g.A = U; g.Bt = Win + (size_t)l * NP * DM; g.M = MTOK; g.N = NP; g.K = DM;
          pg8::StaticOrder S; S.init(MTOK, NP, G, bx); S.wave_id = wave;
          pg8::EpiBf16<0> E; E.O = PROJ; E.ldc = NP; E.bias = nullptr; E.split_cols = 0; E.split_stride = 0;
          for (int rep = 0; rep < ((REP_MASK & 32) ? 2 : 1); ++rep) pg8::gemm_phase<pg8::EpiBf16<0>, pg8::StaticOrder, false>(lds, g, S, E, nullptr); }
        GRID_BAR();
        { PHASE_LOCALS();
          float* CUMW = OUT; float* CUMPW = OUT + (size_t)MTOK * GW; float* AVW = OUT + (size_t)2 * MTOK * GW;
          for (int rep = 0; rep < ((REP_MASK & 16) ? 2 : 1); ++rep) for (int blk = bx; blk < MTOK / 64; blk += G) { const int tid_l = opaque_v(tid); rwkv_pre_block(in, l, PROJ, CUMW, CUMPW, AVW, (LAS float*)lds, blk * 64, tid_l); } }
        GRID_BAR();
        { PHASE_LOCALS();
          const float* CUMW = OUT; const float* CUMPW = OUT + (size_t)MTOK * GW; const float* AVW = OUT + (size_t)2 * MTOK * GW;
          if (bx < 16) mixopt_hgrn(in, l, PROJ, U, lds, (bx >> 1) & 7, bx & 1, (wave << 6) | fresh_lane());
          else if (bx < 48) mixopt_gdn2(in, l, PROJ, U, lds, (bx - 16) >> 2, (bx - 16) & 3, (wave << 6) | fresh_lane());
          else if (bx < 64) mixopt_ssd(in, l, PROJ, U, lds, ((bx - 48) >> 1) & 7, (bx - 48) & 1, (wave << 6) | fresh_lane());
          else if (bx < 96) mixopt_rwkv2(in, l, PROJ, CUMW, CUMPW, AVW, U, lds, (bx - 64) >> 2, (bx - 64) & 3, (wave << 6) | fresh_lane()); }
        GRID_BAR();
        { PHASE_LOCALS();
          pg8::Gemm g; g.A = U; g.Bt = Wout + (size_t)l * DM * DM; g.M = MTOK; g.N = DM; g.K = DM;
          pg8::StaticOrder S; S.init(MTOK, DM, G, bx); S.wave_id = wave;
          pg8::EpiF32 E; E.C = OUT; E.ldc = DM; E.bias = nullptr;
          for (int rep = 0; rep < ((REP_MASK & 64) ? 2 : 1); ++rep) pg8::gemm_phase<pg8::EpiF32, pg8::StaticOrder, false>(lds, g, S, E, nullptr); }
        GRID_BAR();
        { PHASE_LOCALS();
          const float* hin = (l == 0) ? in.x : hout;
          for (int m = bx * NWAVES + wave; m < MTOK; m += G * NWAVES)
            post_row(hin + (size_t)m * DM, OUT + (size_t)m * DM, in.post_norm_g + (size_t)l * DM, hout + (size_t)m * DM,
                     (l + 1 < NLAYER) ? in.pre_norm_g + (size_t)(l + 1) * DM : nullptr, U + (size_t)m * DM, lane); }
        if (l + 1 < NLAYER) GRID_BAR();
    }
}

extern "C" void kernel_launch(void* const* d_in, const int* in_sizes, int n_in, void* d_out, int out_size, void* d_ws, size_t ws_size, hipStream_t stream) {
    static int grid = 0;
    if (grid == 0) {
        int dev = 0, cus = 0, per_cu = 0;
        if (hipGetDevice(&dev) != hipSuccess || hipDeviceGetAttribute(&cus, hipDeviceAttributeMultiprocessorCount, dev) != hipSuccess) { fprintf(stderr, "kernel_launch: device query failed\n"); grid = -1; return; }
        if (hipFuncSetAttribute((const void*)mk_fwd, hipFuncAttributeMaxDynamicSharedMemorySize, LDS_BYTES) != hipSuccess) { fprintf(stderr, "kernel_launch: hipFuncSetAttribute failed\n"); grid = -1; return; }
        if (hipOccupancyMaxActiveBlocksPerMultiprocessor(&per_cu, (const void*)mk_fwd, NWAVES * 64, LDS_BYTES) != hipSuccess || per_cu < 1)
            fprintf(stderr, "kernel_launch: note: occupancy query reports %d workgroups per CU\n", per_cu);
        (void)hipGetLastError();
        grid = cus;
    }
    if (grid < 0) return;
    if (hipMemsetAsync((char*)d_ws + WS_CTL, 0, CTL_ZERO_BYTES, stream) != hipSuccess) { fprintf(stderr, "kernel_launch: memset failed\n"); return; }
    Args a{};
    { const float** ip = (const float**)&a.in; for (int i = 0; i < 27; ++i) ip[i] = (const float*)d_in[i]; }
    a.out = (float*)d_out; a.ws = (unsigned char*)d_ws;
    hipLaunchKernelGGL(mk_fwd, dim3(grid), dim3(NWAVES * 64), LDS_BYTES, stream, a);
}
```

```cpp
#include <hip/hip_runtime.h>
#include <cstdio>
#include <cstdint>
#define REP_MASK 0
#define HWCVT 3
#define HWSITES 0
namespace pg8 {
#define PG8_LAS __attribute__((address_space(3)))
typedef unsigned short bf16_t;
typedef short bf16x8 __attribute__((ext_vector_type(8)));
typedef float f32x4 __attribute__((ext_vector_type(4)));
typedef unsigned u32x4 __attribute__((ext_vector_type(4)));
constexpr int BM = 256, BK = 64, HALF = 128, HTB = HALF * BK * 2  , STAGE_BYTES = 8 * HTB, NXCD = 8, WGM = 8;

__host__ __device__ __forceinline__ int lds_byte(int r, int c) { const int st = (r >> 4) * 2 + (c >> 5), rr = r & 15, cc = c & 31, ob = rr * 64 + cc * 2; return st * 1024 + (ob ^ (((ob >> 9) & 1) << 5)); }
__host__ __device__ __forceinline__ void stage_rc(int b, int& R, int& C) { const int st = b / 1024, sb = b % 1024, swz = sb ^ (((sb >> 9) & 1) << 5); R = (st >> 1) * 16 + swz / 64; C = (st & 1) * 32 + (swz % 64) / 2; }
__host__ __device__ __forceinline__ int perm32(int rho) { const int n = rho >> 4, i = rho & 15; return 8 * (i >> 2) + 4 * n + (i & 3); }

struct Unit { int pm, pn; };
struct Gemm { const bf16_t* A; const bf16_t* Bt; int M, N, K; };

struct StaticOrder {
    int nM, nN, nwg, G, c, wave_id;
    __host__ __device__ void init(int M, int N, int G_, int c_) { nM = M / BM; nN = N / BM; nwg = nM * nN; G = G_; c = c_; }
    __host__ __device__ bool next(int i, Unit& u) const {
        const long L = (long)i * G + c; if (L >= nwg) return false;
        int wgid = (int)L; { const int q = nwg / NXCD, r = nwg % NXCD, xcd = wgid % NXCD, off = wgid / NXCD; wgid = (xcd < r ? xcd * (q + 1) : r * (q + 1) + (xcd - r) * q) + off; }
        const int nig = WGM * nN, gid = wgid / nig, fm = gid * WGM, gsz = (nM - fm) < WGM ? (nM - fm) : WGM;
        u.pm = fm + ((wgid % nig) % gsz); u.pn = (wgid % nig) / gsz; return true;
    }
    __device__ __forceinline__ void a_ready(const Unit&) const {}
    __device__ __forceinline__ void done(const Unit&) const {}
};
__device__ __forceinline__ unsigned cvt_pk_bf16(float lo, float hi) { unsigned r; asm volatile("v_cvt_pk_bf16_f32 %0, %1, %2" : "=v"(r) : "v"(lo), "v"(hi)); return r; }
typedef float f32x2 __attribute__((ext_vector_type(2)));
__device__ __forceinline__ f32x2 gelu_pk(f32x2 v) {
    const f32x2 av = __builtin_elementwise_abs(v), d = av * 0.2316418882f + 1.0f;
    f32x2 t; t.x = __builtin_amdgcn_rcpf(d.x); t.y = __builtin_amdgcn_rcpf(d.y);
    f32x2 q = t * 0.5307027145f + (-0.7265760135f); q = q * t + 0.7107068705f; q = q * t + (-0.142248368f); q = q * t + 0.127414796f; q = q * t;
    const f32x2 s = (v * v) * (-0.72134752044f);
    f32x2 e; e.x = __builtin_amdgcn_exp2f(s.x); e.y = __builtin_amdgcn_exp2f(s.y);
    const f32x2 m = v * (q * e), r = v - m;
    f32x2 o; o.x = v.x < 0.f ? m.x : r.x; o.y = v.y < 0.f ? m.y : r.y; return o;
}

struct EpiF32 {
    static constexpr bool PERM = false, AFTER_DRAIN = false;
    float* C; int ldc; const float* bias;
    __device__ __forceinline__ void operator()(const f32x4 (&acc)[2][2][4][2], const Unit& u, int wr, int wc, int fr, int fq) const {
        const int row0 = u.pm * BM + wr * 64 + fr, col0 = u.pn * BM + wc * 32 + 4 * fq;
        f32x4 bv[2][2];
#pragma unroll
        for (int bj = 0; bj < 2; ++bj)
#pragma unroll
            for (int n = 0; n < 2; ++n) bv[bj][n] = bias ? *(const f32x4*)(bias + col0 + bj * HALF + n * 16) : (f32x4){0.f, 0.f, 0.f, 0.f};
#pragma unroll
        for (int ai = 0; ai < 2; ++ai)
#pragma unroll
            for (int m = 0; m < 4; ++m) { float* rowp = C + (size_t)(row0 + ai * HALF + m * 16) * ldc + col0;
#pragma unroll
                for (int bj = 0; bj < 2; ++bj)
#pragma unroll
                    for (int n = 0; n < 2; ++n) *(f32x4*)(rowp + bj * HALF + n * 16) = acc[ai][bj][m][n] + bv[bj][n]; }
    }
};
template <int ACT  > struct EpiBf16 {
    static constexpr bool PERM = true, AFTER_DRAIN = false;
    bf16_t* O; int ldc; const float* bias; int split_cols; size_t split_stride;
    __device__ __forceinline__ void operator()(const f32x4 (&acc)[2][2][4][2], const Unit& u, int wr, int wc, int fr, int fq) const {
        const int row0 = u.pm * BM + wr * 64 + fr; int colt = u.pn * BM; bf16_t* base = O;
        if (split_cols) { const int t = colt / split_cols; base += (size_t)t * split_stride; colt -= t * split_cols; }
        const int col0 = colt + wc * 32 + 8 * fq, bcol0 = u.pn * BM + wc * 32 + 8 * fq;
        f32x4 bv[2][2];
#pragma unroll
        for (int bj = 0; bj < 2; ++bj)
#pragma unroll
            for (int n = 0; n < 2; ++n) bv[bj][n] = bias ? *(const f32x4*)(bias + bcol0 + bj * HALF + 4 * n) : (f32x4){0.f, 0.f, 0.f, 0.f};
#pragma unroll
        for (int ai = 0; ai < 2; ++ai)
#pragma unroll
            for (int m = 0; m < 4; ++m) { bf16_t* rowp = base + (size_t)(row0 + ai * HALF + m * 16) * ldc + col0;
#pragma unroll
                for (int bj = 0; bj < 2; ++bj) { f32x4 v0 = acc[ai][bj][m][0] + bv[bj][0], v1 = acc[ai][bj][m][1] + bv[bj][1];
                    if (ACT == 1) { f32x2 a = gelu_pk((f32x2){v0[0], v0[1]}), b = gelu_pk((f32x2){v0[2], v0[3]}), c = gelu_pk((f32x2){v1[0], v1[1]}), d = gelu_pk((f32x2){v1[2], v1[3]});
                        v0 = (f32x4){a.x, a.y, b.x, b.y}; v1 = (f32x4){c.x, c.y, d.x, d.y}; }
                    if (ACT == 2) {
#pragma unroll
                        for (int j = 0; j < 4; ++j) { v0[j] = 0.5f * v0[j] * (1.0f + erff(v0[j] * 0.70710678f)); v1[j] = 0.5f * v1[j] * (1.0f + erff(v1[j] * 0.70710678f)); } }
                    u32x4 w; w.x = cvt_pk_bf16(v0[0], v0[1]); w.y = cvt_pk_bf16(v0[2], v0[3]); w.z = cvt_pk_bf16(v1[0], v1[1]); w.w = cvt_pk_bf16(v1[2], v1[3]);
                    *(u32x4*)(rowp + bj * HALF) = w; } }
    }
};
__device__ __forceinline__ int fresh_lane_pg8() { unsigned m_ = ~0u; asm volatile("" : "+s"(m_)); return (int)__builtin_amdgcn_mbcnt_hi(m_, __builtin_amdgcn_mbcnt_lo(m_, 0u)); }
template <class Epi, class Sched, bool STAMP = false>
__device__ __forceinline__ void gemm_phase(PG8_LAS unsigned char* lds, const Gemm g, const Sched& S, const Epi& E, unsigned long long* stamps) {
    int tid_op_ = (S.wave_id << 6) | fresh_lane_pg8(); const int tid = tid_op_, wid = __builtin_amdgcn_readfirstlane(tid >> 6), lane = tid & 63, wr = wid >> 2, wc = wid & 3, fr = lane & 15, fq = lane >> 4;
    const int K = g.K, nt = K / BK;
    int ts_lo = 0, ts_hi = 0, nts = 0; const unsigned long long rt_entry = STAMP ? (unsigned long long)wall_clock64() : 0ull;
#define PG8_STAMP() do { if (STAMP && wid == 0 && nts < 64) { const unsigned long long _c = (unsigned long long)clock64(); \
        ts_lo = (lane == nts) ? (int)(unsigned)_c : ts_lo; ts_hi = (lane == nts) ? (int)(unsigned)(_c >> 32) : ts_hi; ++nts; } } while (0)
    PG8_STAMP();
    unsigned voffA[2], voffB[2];
#pragma unroll
    for (int i = 0; i < 2; ++i) { int R, C; stage_rc(tid * 16 + i * 8192, R, C); const int Rb = Epi::PERM ? ((R & ~31) + perm32(R & 31)) : R;
        voffA[i] = (unsigned)(R * K + C) * 2u; voffB[i] = (unsigned)(Rb * K + C) * 2u; }
    const size_t kstep = (size_t)(BK * 2);
    const size_t hstep = (size_t)HALF * K * 2;
    const size_t tstep = 2 * hstep;
    const unsigned ldsw = (unsigned)wid * 1024u;
    const int aoff = lds_byte(wr * 64 + fr, fq * 8), boff = lds_byte(wc * 32 + fr, fq * 8);
#define PG8_SA(b, h) (((b) * 2 + (h)) * HTB)
#define PG8_SB(b, h) ((4 + (b) * 2 + (h)) * HTB)
#define PG8_STAGE(bufoff, gbase, voff) do { _Pragma("unroll") for (int _i = 0; _i < 2; ++_i) \
        __builtin_amdgcn_global_load_lds((const unsigned*)((const char*)(gbase) + (voff)[_i]), (PG8_LAS unsigned*)(lds + (bufoff) + ldsw + _i * 8192), 16, 0, 0); } while (0)
#define PG8_LDA(dst, b, h) do { _Pragma("unroll") for (int m = 0; m < 4; ++m) _Pragma("unroll") for (int k = 0; k < 2; ++k) dst[m][k] = *(const PG8_LAS bf16x8*)(lds + PG8_SA(b, h) + aoff + m * 2048 + k * 1024); } while (0)
#define PG8_LDB(dst, b, h) do { _Pragma("unroll") for (int n = 0; n < 2; ++n) _Pragma("unroll") for (int k = 0; k < 2; ++k) dst[n][k] = *(const PG8_LAS bf16x8*)(lds + PG8_SB(b, h) + boff + n * 2048 + k * 1024); } while (0)
#define PG8_MMA(ai, bj, At, Bt) do { __builtin_amdgcn_s_setprio(1); _Pragma("unroll") for (int m = 0; m < 4; ++m) _Pragma("unroll") for (int n = 0; n < 2; ++n) _Pragma("unroll") for (int k = 0; k < 2; ++k) \
        acc[ai][bj][m][n] = __builtin_amdgcn_mfma_f32_16x16x32_bf16(Bt[n][k], At[m][k], acc[ai][bj][m][n], 0, 0, 0); __builtin_amdgcn_s_setprio(0); } while (0)
#define PG8_WAIT_V(n) asm volatile("s_waitcnt vmcnt(" #n ")" ::: "memory")
#define PG8_WAIT_L(n) asm volatile("s_waitcnt lgkmcnt(" #n ")" ::: "memory")
#define PG8_BAR __builtin_amdgcn_s_barrier()
#define PG8_SCHED __builtin_amdgcn_sched_barrier(0)
    Unit cur, nxt; int ui = 0;
    if (!S.next(0, cur)) return;
    f32x4 acc[2][2][4][2];
#pragma unroll
    for (int a = 0; a < 2; ++a)
#pragma unroll
        for (int b = 0; b < 2; ++b)
#pragma unroll
            for (int m = 0; m < 4; ++m)
#pragma unroll
                for (int n = 0; n < 2; ++n) acc[a][b][m][n] = (f32x4){0.f, 0.f, 0.f, 0.f};
    bf16x8 At[4][2], B0[2][2], B1[2][2];
    const char* cA = (const char*)g.A + (size_t)cur.pm * tstep; const char* cB = (const char*)g.Bt + (size_t)cur.pn * tstep;
    S.a_ready(cur);
    PG8_STAGE(PG8_SB(0, 0), cB, voffB); PG8_STAGE(PG8_SA(0, 0), cA, voffA); PG8_STAGE(PG8_SB(0, 1), cB + hstep, voffB); PG8_STAGE(PG8_SA(0, 1), cA + hstep, voffA);
    if (wr == 1) PG8_BAR;
    PG8_WAIT_V(4); PG8_BAR;
    PG8_STAGE(PG8_SB(1, 0), cB + kstep, voffB); PG8_STAGE(PG8_SA(1, 0), cA + kstep, voffA); PG8_STAGE(PG8_SB(1, 1), cB + hstep + kstep, voffB);
    PG8_WAIT_V(6); PG8_BAR;
    PG8_STAMP();
    for (;;) {
        const bool has_next = S.next(ui + 1, nxt);
        const char* nA = has_next ? (const char*)g.A + (size_t)nxt.pm * tstep : cA; const char* nB = has_next ? (const char*)g.Bt + (size_t)nxt.pn * tstep : cB;
        for (int t = 0; t < nt; t += 2) {
            const bool last = (t == nt - 2);
            const char* a1 = cA + (size_t)(t + 1) * kstep;
            const char* a2 = last ? nA : cA + (size_t)(t + 2) * kstep; const char* b2 = last ? nB : cB + (size_t)(t + 2) * kstep;
            const char* a3 = a2 + kstep; const char* b3 = b2 + kstep;
            if (last && has_next) S.a_ready(nxt);
            PG8_LDB(B0, 0, 0); PG8_SCHED; PG8_LDA(At, 0, 0); PG8_STAGE(PG8_SA(1, 1), a1 + hstep, voffA);
            PG8_WAIT_L(8); PG8_BAR; PG8_WAIT_L(0); PG8_MMA(0, 0, At, B0); PG8_BAR; PG8_SCHED;
            PG8_LDB(B1, 0, 1); PG8_STAGE(PG8_SB(0, 0), b2, voffB);
            PG8_BAR; PG8_WAIT_L(0); PG8_MMA(0, 1, At, B1); PG8_BAR;
            PG8_LDA(At, 0, 1); PG8_STAGE(PG8_SA(0, 0), a2, voffA);
            PG8_BAR; PG8_WAIT_L(0); PG8_MMA(1, 0, At, B0); PG8_BAR; PG8_SCHED;
            PG8_STAGE(PG8_SB(0, 1), b2 + hstep, voffB);
            PG8_WAIT_V(6); PG8_BAR; PG8_MMA(1, 1, At, B1); PG8_BAR;
            PG8_LDB(B0, 1, 0); PG8_SCHED; PG8_LDA(At, 1, 0); PG8_STAGE(PG8_SA(0, 1), a2 + hstep, voffA);
            PG8_WAIT_L(8); PG8_BAR; PG8_WAIT_L(0); PG8_MMA(0, 0, At, B0); PG8_BAR; PG8_SCHED;
            PG8_LDB(B1, 1, 1); PG8_STAGE(PG8_SB(1, 0), b3, voffB);
            PG8_BAR; PG8_WAIT_L(0); PG8_MMA(0, 1, At, B1); PG8_BAR;
            PG8_LDA(At, 1, 1); PG8_STAGE(PG8_SA(1, 0), a3, voffA);
            PG8_BAR; PG8_WAIT_L(0); PG8_MMA(1, 0, At, B0); PG8_BAR; PG8_SCHED;
            PG8_STAGE(PG8_SB(1, 1), b3 + hstep, voffB);
            PG8_WAIT_V(6); PG8_BAR; PG8_MMA(1, 1, At, B1); PG8_BAR;
        }
        PG8_STAMP();
        if constexpr (!Epi::AFTER_DRAIN) { E(acc, cur, wr, wc, fr, fq); S.done(cur); }
        PG8_STAMP();
        if (!has_next) break;
#pragma unroll
        for (int a = 0; a < 2; ++a)
#pragma unroll
            for (int b = 0; b < 2; ++b)
#pragma unroll
                for (int m = 0; m < 4; ++m)
#pragma unroll
                    for (int n = 0; n < 2; ++n) acc[a][b][m][n] = (f32x4){0.f, 0.f, 0.f, 0.f};
        cur = nxt; cA = nA; cB = nB; ++ui;
    }
    PG8_WAIT_V(0);
    if (wr == 0) PG8_BAR;
    PG8_BAR;
    if constexpr (Epi::AFTER_DRAIN) { E.fused(acc, cur, wr, wc, fr, fq, lds, wid, lane); S.done(cur); }
    PG8_STAMP();
    if (STAMP && wid == 0) { stamps[lane] = lane < nts ? (((unsigned long long)(unsigned)ts_hi << 32) | (unsigned)ts_lo) : 0ull;
        if (lane == 62) stamps[62] = rt_entry; if (lane == 63) stamps[63] = (unsigned long long)wall_clock64(); }
#undef PG8_STAMP
#undef PG8_SA
#undef PG8_SB
#undef PG8_STAGE
#undef PG8_LDA
#undef PG8_LDB
#undef PG8_MMA
#undef PG8_WAIT_V
#undef PG8_WAIT_L
#undef PG8_BAR
#undef PG8_SCHED
}
}
#define GAS __attribute__((address_space(1)))
#define LAS __attribute__((address_space(3)))
typedef unsigned short bf16;
typedef unsigned v4u __attribute__((ext_vector_type(4)));
typedef float f32x4 __attribute__((ext_vector_type(4)));
typedef short bf16x8 __attribute__((ext_vector_type(8)));
typedef GAS unsigned gu32;
typedef GAS unsigned long long gu64;
__device__ __forceinline__ int fresh_lane() { unsigned m_ = ~0u; asm volatile("" : "+s"(m_)); return (int)__builtin_amdgcn_mbcnt_hi(m_, __builtin_amdgcn_mbcnt_lo(m_, 0u)); }
#define RLX_AGENT __ATOMIC_RELAXED, __HIP_MEMORY_SCOPE_AGENT
#define LDS_WAIT() asm volatile("s_waitcnt lgkmcnt(0)" ::: "memory")
#define VM_WAIT() asm volatile("s_waitcnt vmcnt(0)" ::: "memory")
__device__ __forceinline__ unsigned long long rt() { return __builtin_amdgcn_s_memrealtime(); }
__device__ __forceinline__ unsigned f2bf(float f) { unsigned u = __builtin_bit_cast(unsigned, f); return (u + 0x7fffu + ((u >> 16) & 1u)) >> 16; }
__device__ __forceinline__ unsigned pk2(float lo, float hi) { return f2bf(lo) | (f2bf(hi) << 16); }
#define XB_TMO      128
#define XB_XCNT(j)  (256  + 64 * (j))
#define XB_XSUB(j)  (1280 + 64 * (j))
#define XB_XGEN(j)  (2304 + 64 * (j))
#define XB_TOP      3328
#define XB_TOPGEN   3392
#define XCD_BAR_WORDS 3456
#define XB_SPIN_CAP (1u << 22)

__device__ __forceinline__ unsigned xb_ld(unsigned* p)              { return __hip_atomic_load(p, __ATOMIC_RELAXED, __HIP_MEMORY_SCOPE_AGENT); }
__device__ __forceinline__ unsigned xb_add(unsigned* p, unsigned v) { return __hip_atomic_fetch_add(p, v, __ATOMIC_RELAXED, __HIP_MEMORY_SCOPE_AGENT); }
__device__ __forceinline__ unsigned xb_xcc_id() { return (unsigned)__builtin_amdgcn_s_getreg((3 << 11) | 20) & 0xFu; }
#define XB_SPIN(cond, bar) do { unsigned _sp = 0; while (cond) { __builtin_amdgcn_s_sleep(1); \
    if ((++_sp & 255u) == 0u) { if (xb_ld(&(bar)[XB_TMO])) break; if (_sp > XB_SPIN_CAP) { atomicAdd(&(bar)[XB_TMO], 1u); break; } } } } while (0)

struct XcdBarrier {
    unsigned* bar; unsigned x;
    volatile LAS unsigned* st;
};

__device__ __forceinline__ XcdBarrier xcd_barrier_post(unsigned* bar, volatile LAS unsigned* st, const int tid_) {
    XcdBarrier b; b.bar = bar; b.x = xb_xcc_id(); b.st = st;
    if (tid_ == 0) (void)xb_add(&bar[XB_XCNT(b.x)], 1u);
    return b;
}
__device__ __forceinline__ void xcd_barrier_complete(unsigned* bar, unsigned x, unsigned& nloc, unsigned& nx) {
    const unsigned G = gridDim.x * gridDim.y * gridDim.z;
    unsigned sum, cnt, mine, sp = 0u;
    for (;;) {
        sum = 0u; cnt = 0u; mine = 0u;
#pragma unroll
        for (unsigned j = 0; j < 16; ++j) { const unsigned c = xb_ld(&bar[XB_XCNT(j)]); sum += c; cnt += (c > 0u) ? 1u : 0u; mine = (j == x) ? c : mine; }
        if (sum == G) break;
        __builtin_amdgcn_s_sleep(1);
        if ((++sp & 255u) == 0u) { if (xb_ld(&bar[XB_TMO])) break; if (sp > XB_SPIN_CAP) { atomicAdd(&bar[XB_TMO], 1u); break; } }
    }
    nloc = mine > 0u ? mine : 1u; nx = cnt > 0u ? cnt : 1u;
}

__device__ __forceinline__ void xcd_barrier(const XcdBarrier& b, const int tid_) {
    asm volatile("s_waitcnt vmcnt(0)" ::: "memory");
    __syncthreads();
    if (tid_ == 0) {
        unsigned* bar = b.bar;
        __builtin_amdgcn_s_waitcnt(0);
        unsigned nloc = b.st[0], nx = b.st[1];
        if (nloc == 0u) { xcd_barrier_complete(bar, b.x, nloc, nx); b.st[0] = nloc; b.st[1] = nx; }
        const unsigned old = xb_add(&bar[XB_XSUB(b.x)], 1u);
        const unsigned gen = old / nloc;
        if (old + 1u == (gen + 1u) * nloc) {
            __builtin_amdgcn_fence(__ATOMIC_RELEASE, "agent");
            asm volatile("s_waitcnt vmcnt(0)" ::: "memory");
            const unsigned og = xb_add(&bar[XB_TOP], 1u);
            const unsigned tg = og / nx;
            if (og + 1u == (tg + 1u) * nx) xb_add(&bar[XB_TOPGEN], 1u);
            else XB_SPIN(xb_ld(&bar[XB_TOPGEN]) == tg, bar);
            __builtin_amdgcn_fence(__ATOMIC_ACQUIRE, "agent");
            xb_add(&bar[XB_XGEN(b.x)], 1u);
            asm volatile("s_waitcnt vmcnt(0)" ::: "memory");
        } else {
            XB_SPIN(xb_ld(&bar[XB_XGEN(b.x)]) == gen, bar);
            __builtin_amdgcn_fence(__ATOMIC_ACQUIRE, "agent");
            asm volatile("s_waitcnt vmcnt(0)" ::: "memory");
        }
    }
    __syncthreads();
}

constexpr int BATCH = 8, SEQ = 2048, DM = 1024, MTOK = BATCH * SEQ, NLAYER = 2;
constexpr int GW = 256, HD = 64, NHEAD = 4;
constexpr int IN_COLS = 4236, NP = 4352;
constexpr int C_HG_Q = 0, C_HG_F = 256, C_HG_I = 512;
constexpr int C_GD_Q = 768, C_GD_K = 1024, C_GD_V = 1280;
constexpr int C_SS_X = 1536, C_SS_B = 1792, C_SS_C = 2048;
constexpr int C_RW_R = 2304, C_RW_K = 2560, C_RW_V = 2816;
constexpr int C_Z = 3072;
constexpr int C_GD_BETA = 4096, C_GD_DEC = 4100, C_SS_DT = 4104, C_RW_WD = 4112, C_RW_AD = 4176;

__host__ __device__ __forceinline__ int old_col(int n) {
    if (n < 1536) return n;
    if (n < 2304) return 1544 + (n - 1536);
    if (n < 3072) return 2316 + (n - 2304);
    if (n < 4096) return 3212 + (n - 3072);
    if (n < 4104) return 1536 + (n - 4096);
    if (n < 4108) return 2312 + (n - 4104);
    if (n < 4112) return -1;
    if (n < 4240) return 3084 + (n - 4112);
    return -1;
}
__device__ __forceinline__ float bf2f(bf16 b) { return __builtin_bit_cast(float, ((unsigned)b) << 16); }
__device__ __forceinline__ float wave_sum(float v) {
#pragma unroll
    for (int o = 1; o < 64; o <<= 1) v += __shfl_xor(v, o);
    return v;
}
__device__ __forceinline__ float sigmoidf_(float x) { return __builtin_amdgcn_rcpf(1.f + __expf(-x)); }
__device__ __forceinline__ float siluf_(float x) { return x * __builtin_amdgcn_rcpf(1.f + __expf(-x)); }
__device__ __forceinline__ float softplusf_(float x) { return x > 20.f ? x : log1pf(__expf(x)); }

struct Inputs {
    const float* x; const float* pre_norm_g; const float* w_in; const float* hgrn_lb; const float* hgrn_norm_g;
    const float* gdn_conv_w; const float* gdn_a_log; const float* gdn_dt_bias; const float* gdn_norm_g;
    const float* ssm_conv_w; const float* ssm_conv_b; const float* ssm_a_log; const float* ssm_dt_bias; const float* ssm_d; const float* ssm_norm_g;
    const float* rwkv_mu; const float* rwkv_w0; const float* rwkv_w_up; const float* rwkv_a0; const float* rwkv_a_up; const float* rwkv_k_k; const float* rwkv_k_a;
    const float* rwkv_r_k; const float* rwkv_ln_w; const float* rwkv_ln_b; const float* w_out; const float* post_norm_g;
};


typedef short bf16x4 __attribute__((ext_vector_type(4)));
typedef unsigned v2u __attribute__((ext_vector_type(2)));
#define MFMA16(a, b, c) __builtin_amdgcn_mfma_f32_16x16x32_bf16((a), (b), (c), 0, 0, 0)
constexpr int LS = 72;
constexpr int MAT_B = 64 * LS * 2;
constexpr int LS2 = 136;
constexpr int HEAD_LDS = 73728;

typedef float f32x2_ __attribute__((ext_vector_type(2)));
typedef __bf16 bf2_ __attribute__((ext_vector_type(2)));
#ifndef HWCVT
#define HWCVT 0
#endif
__device__ __forceinline__ unsigned pk_hw(float lo, float hi) { const f32x2_ v_ = {lo, hi}; const bf2_ r_ = __builtin_convertvector(v_, bf2_); return __builtin_bit_cast(unsigned, r_); }
__device__ __forceinline__ unsigned pk_sw(float lo, float hi) { return f2bf(lo) | (f2bf(hi) << 16); }
__device__ __forceinline__ unsigned pk_bf16(float lo, float hi) { return (HWCVT & 1) ? pk_hw(lo, hi) : pk_sw(lo, hi); }
__device__ __forceinline__ bf16 cvt_bf16(float x) { return (HWCVT & 2) ? (bf16)(pk_hw(x, x) & 0xffffu) : (bf16)f2bf(x); }
__device__ __forceinline__ bf16x8 ld_frag(const LAS bf16* base, int stride, int row, int kofs, int q) {
    return *(const LAS bf16x8*)(base + row * stride + kofs + 8 * q);
}
__device__ __forceinline__ bf16x8 ld_frag_perm(const LAS bf16* base, int stride, int row, int kofs, int q) {
    const bf16x4 lo = *(const LAS bf16x4*)(base + row * stride + kofs + 4 * q);
    const bf16x4 hi = *(const LAS bf16x4*)(base + row * stride + kofs + 16 + 4 * q);
    bf16x8 v; v[0] = lo[0]; v[1] = lo[1]; v[2] = lo[2]; v[3] = lo[3]; v[4] = hi[0]; v[5] = hi[1]; v[6] = hi[2]; v[7] = hi[3]; return v;
}
__device__ __forceinline__ bf16x8 pack_frag(const f32x4& a, const f32x4& b) {
    union { unsigned u[4]; bf16x8 v; } x;
    x.u[0] = pk_bf16(a[0], a[1]); x.u[1] = pk_bf16(a[2], a[3]); x.u[2] = pk_bf16(b[0], b[1]); x.u[3] = pk_bf16(b[2], b[3]); return x.v;
}
__device__ __forceinline__ void st4(LAS bf16* base, int stride, int row, int col, const f32x4& v) {
    v2u o; o.x = pk_bf16(v[0], v[1]); o.y = pk_bf16(v[2], v[3]); *(LAS v2u*)(base + row * stride + col) = o;
}
__device__ __forceinline__ f32x4 zero4() { return (f32x4){0.f, 0.f, 0.f, 0.f}; }
#define WG_BAR() __syncthreads()

__device__ __forceinline__ void ssd_pack16(LAS bf16* dst, const float* v) {
    v4u w0, w1;
    w0.x = pk_bf16(v[0], v[1]); w0.y = pk_bf16(v[2], v[3]); w0.z = pk_bf16(v[4], v[5]); w0.w = pk_bf16(v[6], v[7]);
    w1.x = pk_bf16(v[8], v[9]); w1.y = pk_bf16(v[10], v[11]); w1.z = pk_bf16(v[12], v[13]); w1.w = pk_bf16(v[14], v[15]);
    *(LAS v4u*)dst = w0; *(LAS v4u*)(dst + 8) = w1;
}
#define RAWF(arr, j) bf2f((arr)[(j) >> 1][(j) & 1])
__device__ __forceinline__ int opaque_i(int v) { asm volatile("" : "+v"(v)); return v; }
#define RAWG(arr, j) bf2f((arr)[(j)])

template <bool HW> __device__ __forceinline__ unsigned pkx(float lo, float hi) { if constexpr (HW) return pk_hw(lo, hi); else return pk_bf16(lo, hi); }
template <bool HW> __device__ __forceinline__ bf16x8 pack_frag_x(const f32x4& a, const f32x4& b) {
    union { unsigned u[4]; bf16x8 v; } x;
    x.u[0] = pkx<HW>(a[0], a[1]); x.u[1] = pkx<HW>(a[2], a[3]); x.u[2] = pkx<HW>(b[0], b[1]); x.u[3] = pkx<HW>(b[2], b[3]); return x.v; }
template <bool HW> __device__ __forceinline__ void st4_x(LAS bf16* base, int stride, int row, int col, const f32x4& v) {
    v2u o; o.x = pkx<HW>(v[0], v[1]); o.y = pkx<HW>(v[2], v[3]); *(LAS v2u*)(base + row * stride + col) = o; }
template <bool HW> __device__ __forceinline__ void pack16_x(LAS bf16* dst, const float* v) {
    v4u w0, w1;
    w0.x = pkx<HW>(v[0], v[1]); w0.y = pkx<HW>(v[2], v[3]); w0.z = pkx<HW>(v[4], v[5]); w0.w = pkx<HW>(v[6], v[7]);
    w1.x = pkx<HW>(v[8], v[9]); w1.y = pkx<HW>(v[10], v[11]); w1.z = pkx<HW>(v[12], v[13]); w1.w = pkx<HW>(v[14], v[15]);
    *(LAS v4u*)dst = w0; *(LAS v4u*)(dst + 8) = w1; }
#ifndef HWSITES
#define HWSITES 0
#endif
#define SITE(k) (((HWSITES) >> (k)) & 1)

__device__ __forceinline__ void mixopt_hgrn(const Inputs& in, const int layer, const bf16* __restrict__ PROJ, bf16* __restrict__ Yg, LAS unsigned char* ldsw, const int b, const int hp, const int tid) {
    const int lane = tid & 63, wave = __builtin_amdgcn_readfirstlane(tid >> 6), hh = wave >> 2, w4 = wave & 3, h = hp * 2 + hh, r = lane & 15, q = lane >> 4;
    LAS unsigned char* L = ldsw + hh * HEAD_LDS;
    LAS bf16* QT = (LAS bf16*)L; LAS bf16* KA = (LAS bf16*)(L + MAT_B); LAS bf16* KB = (LAS bf16*)(L + 2 * MAT_B); LAS bf16* R2 = (LAS bf16*)(L + 3 * MAT_B);
    LAS bf16* KDT = (LAS bf16*)(L + 4 * MAT_B); LAS bf16* VT = (LAS bf16*)(L + 5 * MAT_B); LAS bf16* ZT = (LAS bf16*)(L + 6 * MAT_B);
    LAS float* QTOT = (LAS float*)(L + 7 * MAT_B); LAS float* ELAST = QTOT + 256;
    const bf16* P = PROJ + (size_t)b * SEQ * NP; bf16* Yb = Yg + (size_t)b * SEQ * DM;
    const int c = h * 64 + lane;
    float lbv = 0.f;
    if (layer == 1) { const float x0 = in.hgrn_lb[c], x1 = in.hgrn_lb[GW + c]; const float mx = fmaxf(x0, x1); const float e0 = __expf(x0 - mx), e1 = __expf(x1 - mx); lbv = e1 / (e0 + e1); }
    f32x4 gn[4];
#pragma unroll
    for (int nv = 0; nv < 4; ++nv) gn[nv] = *(const f32x4*)(in.hgrn_norm_g + layer * HD + 16 * nv + 4 * q);
    f32x4 zs[4];
#pragma unroll
    for (int n = 0; n < 4; ++n) zs[n] = zero4();
    bf16 rq[16], rf[16], rv[16];
    { const bf16* p0 = P + (size_t)(16 * w4) * NP;
#pragma unroll
      for (int i = 0; i < 16; ++i) { rq[i] = p0[(size_t)i * NP + C_HG_Q + c]; rf[i] = p0[(size_t)i * NP + C_HG_F + c]; rv[i] = p0[(size_t)i * NP + C_HG_I + c]; } }
    for (int ch = 0; ch < SEQ / 64; ++ch) {
        float qv[16], kv[16], cl[16], vv[16]; float run = 0.f;
#pragma unroll
        for (int i = 0; i < 16; ++i) { const float x = bf2f(rq[i]); qv[i] = siluf_(x) * 0.125f; const float f = lbv + (1.f - lbv) * sigmoidf_(bf2f(rf[i])); kv[i] = 1.f - f; run += __logf(f); cl[i] = run; vv[i] = bf2f(rv[i]); }
        QTOT[w4 * 64 + lane] = run;
        if (ch + 1 < SEQ / 64) { const bf16* p0 = P + (size_t)((ch + 1) * 64 + 16 * w4) * NP;
#pragma unroll
            for (int i = 0; i < 16; ++i) { rq[i] = p0[(size_t)i * NP + C_HG_Q + c]; rf[i] = p0[(size_t)i * NP + C_HG_F + c]; rv[i] = p0[(size_t)i * NP + C_HG_I + c]; } }
        WG_BAR();
        {
            const float o0 = QTOT[lane], o1 = QTOT[64 + lane], o2 = QTOT[128 + lane], o3 = QTOT[192 + lane];
            const float base = (w4 > 0 ? o0 : 0.f) + (w4 > 1 ? o1 : 0.f) + (w4 > 2 ? o2 : 0.f);
            const float c31 = o0 + o1, c63 = c31 + o2 + o3, cI = (w4 >= 2) ? c31 : 0.f;
            float kd[16];
#pragma unroll
            for (int i = 0; i < 16; ++i) { const float cum = cl[i] + base; const int t = 16 * w4 + i;
                QT[t * LS + lane] = cvt_bf16(qv[i] * __expf(cum - cI));
                KA[t * LS + lane] = cvt_bf16(kv[i] * __expf(fminf(cI - cum, 80.f)));
                if (w4 < 2) KB[t * LS + lane] = cvt_bf16(kv[i] * __expf(c31 - cum));
                R2[t * LS + lane] = cvt_bf16(qv[i] * __expf(cum));
                kd[i] = kv[i] * __expf(c63 - cum); }
            v4u w0, w1;
            w0.x = pk_bf16(kd[0], kd[1]); w0.y = pk_bf16(kd[2], kd[3]); w0.z = pk_bf16(kd[4], kd[5]); w0.w = pk_bf16(kd[6], kd[7]);
            w1.x = pk_bf16(kd[8], kd[9]); w1.y = pk_bf16(kd[10], kd[11]); w1.z = pk_bf16(kd[12], kd[13]); w1.w = pk_bf16(kd[14], kd[15]);
            *(LAS v4u*)(KDT + lane * LS + 16 * w4) = w0; *(LAS v4u*)(KDT + lane * LS + 16 * w4 + 8) = w1;
            w0.x = pk_bf16(vv[0], vv[1]); w0.y = pk_bf16(vv[2], vv[3]); w0.z = pk_bf16(vv[4], vv[5]); w0.w = pk_bf16(vv[6], vv[7]);
            w1.x = pk_bf16(vv[8], vv[9]); w1.y = pk_bf16(vv[10], vv[11]); w1.z = pk_bf16(vv[12], vv[13]); w1.w = pk_bf16(vv[14], vv[15]);
            *(LAS v4u*)(VT + lane * LS + 16 * w4) = w0; *(LAS v4u*)(VT + lane * LS + 16 * w4 + 8) = w1;
            if (w4 == 0) ELAST[lane] = __expf(c63);
#pragma unroll
            for (int n = 0; n < 4; ++n) st4(ZT, LS, 16 * n + r, 16 * w4 + 4 * q, zs[n]);
        }
        WG_BAR();
        {
            const int m = w4;
            f32x4 Pt[4];
#pragma unroll
            for (int n = 0; n < 4; ++n) Pt[n] = zero4();
            bf16x8 aq[2];
#pragma unroll
            for (int k = 0; k < 2; ++k) aq[k] = ld_frag(QT, LS, 16 * m + r, 32 * k, q);
#pragma unroll
            for (int n = 0; n < 4; ++n) if (n <= m) {
                const LAS bf16* Bs = ((n >> 1) == (m >> 1)) ? KA : KB;
#pragma unroll
                for (int k = 0; k < 2; ++k) Pt[n] = MFMA16(ld_frag(Bs, LS, 16 * n + r, 32 * k, q), aq[k], Pt[n]);
                if (n == m) {
#pragma unroll
                    for (int i = 0; i < 4; ++i) if (4 * q + i > r) Pt[n][i] = 0.f; }
            }
            f32x4 O[4];
#pragma unroll
            for (int nv = 0; nv < 4; ++nv) O[nv] = zero4();
#pragma unroll
            for (int k = 0; k < 2; ++k) if (2 * k <= m) { const bf16x8 pf = pack_frag(Pt[2 * k], Pt[2 * k + 1]);
#pragma unroll
                for (int nv = 0; nv < 4; ++nv) O[nv] = MFMA16(ld_frag_perm(VT, LS, 16 * nv + r, 32 * k, q), pf, O[nv]); }
#pragma unroll
            for (int k = 0; k < 2; ++k) { const bf16x8 ar = ld_frag(R2, LS, 16 * m + r, 32 * k, q);
#pragma unroll
                for (int nv = 0; nv < 4; ++nv) O[nv] = MFMA16(ld_frag(ZT, LS, 16 * nv + r, 32 * k, q), ar, O[nv]); }
            float ss = 0.f;
#pragma unroll
            for (int nv = 0; nv < 4; ++nv) ss += (O[nv][0] * O[nv][0] + O[nv][1] * O[nv][1]) + (O[nv][2] * O[nv][2] + O[nv][3] * O[nv][3]);
            ss += __shfl_xor(ss, 16); ss += __shfl_xor(ss, 32);
            const float rs = rsqrtf(ss * (1.f / 64.f) + 1e-6f);
            const int t = ch * 64 + 16 * m + r;
#pragma unroll
            for (int nv = 0; nv < 4; ++nv) { const int dv0 = h * 64 + 16 * nv + 4 * q;
                const v2u zr = *(const v2u*)(P + (size_t)t * NP + C_Z + 0 + dv0);
                const float z0 = __builtin_bit_cast(float, zr.x << 16), z1 = __builtin_bit_cast(float, zr.x & 0xffff0000u), z2 = __builtin_bit_cast(float, zr.y << 16), z3 = __builtin_bit_cast(float, zr.y & 0xffff0000u);
                v2u o; o.x = pk_bf16(O[nv][0] * rs * gn[nv][0] * siluf_(z0), O[nv][1] * rs * gn[nv][1] * siluf_(z1));
                o.y = pk_bf16(O[nv][2] * rs * gn[nv][2] * siluf_(z2), O[nv][3] * rs * gn[nv][3] * siluf_(z3));
                *(v2u*)(Yb + (size_t)t * DM + 0 + dv0) = o; }
            const f32x4 el = *(const LAS f32x4*)(ELAST + 16 * w4 + 4 * q);
            bf16x8 ak[2];
#pragma unroll
            for (int k = 0; k < 2; ++k) ak[k] = ld_frag(KDT, LS, 16 * w4 + r, 32 * k, q);
#pragma unroll
            for (int n = 0; n < 4; ++n) { zs[n] = zs[n] * el;
#pragma unroll
                for (int k = 0; k < 2; ++k) zs[n] = MFMA16(ak[k], ld_frag(VT, LS, 16 * n + r, 32 * k, q), zs[n]); }
        }
        WG_BAR();
    }
}

__device__ __forceinline__ float tr_reduce16(const float* v, int lane) {
    float a[8], b[4], c[2], d;
    const bool b5 = lane & 32, b4 = lane & 16, b3 = lane & 8, b2 = lane & 4;
#pragma unroll
    for (int j = 0; j < 8; ++j) { const float snd = b5 ? v[j] : v[8 + j]; const float got = __shfl_xor(snd, 32); a[j] = (b5 ? v[8 + j] : v[j]) + got; }
#pragma unroll
    for (int j = 0; j < 4; ++j) { const float snd = b4 ? a[j] : a[4 + j]; const float got = __shfl_xor(snd, 16); b[j] = (b4 ? a[4 + j] : a[j]) + got; }
#pragma unroll
    for (int j = 0; j < 2; ++j) { const float snd = b3 ? b[j] : b[2 + j]; const float got = __shfl_xor(snd, 8); c[j] = (b3 ? b[2 + j] : b[j]) + got; }
    { const float snd = b2 ? c[0] : c[1]; const float got = __shfl_xor(snd, 4); d = (b2 ? c[1] : c[0]) + got; }
    d += __shfl_xor(d, 2); d += __shfl_xor(d, 1);
    return d;
}
__device__ __forceinline__ float rdlane(float x, int l) { return __builtin_bit_cast(float, __builtin_amdgcn_readlane(__builtin_bit_cast(int, x), l)); }

template <bool SW = false> __device__ __forceinline__ void diag_inverse(const LAS float* AD, LAS bf16* DT, int lane) {
    const int j = lane >> 4, c = lane & 15;
    const LAS float* A = AD + j * 256;
    float x[16];
#pragma unroll
    for (int i = 0; i < 16; ++i) {
        float s = (i == c) ? 1.f : 0.f;
#pragma unroll
        for (int k4 = 0; k4 < i; k4 += 4) { const f32x4 a = *(const LAS f32x4*)(A + i * 16 + k4);
#pragma unroll
            for (int kk = 0; kk < 4; ++kk) if (k4 + kk < i) s -= a[kk] * x[k4 + kk]; }
        x[i] = s;
    }
    v4u w0, w1;
    w0.x = pkx<SW>(x[0], x[1]); w0.y = pkx<SW>(x[2], x[3]); w0.z = pkx<SW>(x[4], x[5]); w0.w = pkx<SW>(x[6], x[7]);
    w1.x = pkx<SW>(x[8], x[9]); w1.y = pkx<SW>(x[10], x[11]); w1.z = pkx<SW>(x[12], x[13]); w1.w = pkx<SW>(x[14], x[15]);
    *(LAS v4u*)(DT + (j * 16 + c) * 16) = w0; *(LAS v4u*)(DT + (j * 16 + c) * 16 + 8) = w1;
}
__device__ __forceinline__ bf16x8 half_frag_lds(const LAS bf16* p) { const bf16x4 lo = *(const LAS bf16x4*)p; bf16x8 v; v[0] = lo[0]; v[1] = lo[1]; v[2] = lo[2]; v[3] = lo[3]; v[4] = 0; v[5] = 0; v[6] = 0; v[7] = 0; return v; }
__device__ __forceinline__ bf16x8 two_frag_lds(const LAS bf16* p0, const LAS bf16* p1) { const bf16x4 lo = *(const LAS bf16x4*)p0; const bf16x4 hi = *(const LAS bf16x4*)p1; bf16x8 v; v[0] = lo[0]; v[1] = lo[1]; v[2] = lo[2]; v[3] = lo[3]; v[4] = hi[0]; v[5] = hi[1]; v[6] = hi[2]; v[7] = hi[3]; return v; }
template <bool SW = false> __device__ __forceinline__ void tri_inverse_row(const LAS bf16* AMT, const LAS bf16* DT, int m, int r, int q, f32x4* Tm) {
    const f32x4 z4 = zero4();
    f32x4 dm;
#pragma unroll
    for (int i = 0; i < 4; ++i) dm[i] = bf2f(DT[(m * 16 + 4 * q + i) * 16 + r]);
#pragma unroll
    for (int n = 0; n < 4; ++n) Tm[n] = (n == m) ? dm : z4;
#pragma unroll
    for (int j = 2; j >= 0; --j) if (j < m) {
        f32x4 X = z4;
#pragma unroll
        for (int k = j + 1; k <= 3; k += 2) if (k <= m) {
            const LAS bf16* p0 = AMT + (16 * j + r) * LS + 16 * k + 4 * q;
            if (k + 1 <= 3) { const bf16x8 af = pack_frag_x<SW>(Tm[k], Tm[k + 1]); const bf16x8 bfr = two_frag_lds(p0, p0 + 16); X = MFMA16(bfr, af, X); }
            else { const bf16x8 af = pack_frag_x<SW>(Tm[k], z4); const bf16x8 bfr = half_frag_lds(p0); X = MFMA16(bfr, af, X); }
        }
        const bf16x8 xf = pack_frag_x<SW>(X, z4);
        const bf16x8 df = half_frag_lds(DT + (j * 16 + r) * 16 + 4 * q);
        const f32x4 Tj = MFMA16(df, xf, z4);
        Tm[j] = -Tj;
    }
}

__device__ __forceinline__ void mixopt_gdn(const Inputs& in, const int layer, const bf16* __restrict__ PROJ, bf16* __restrict__ Yg, LAS unsigned char* ldsw, const int b, const int hp, const int tid) {
    const int lane0 = tid & 63, wave = __builtin_amdgcn_readfirstlane(tid >> 6), hh = wave >> 2, w4 = wave & 3, h = hp * 2 + hh;
    LAS unsigned char* L = ldsw + hh * HEAD_LDS;
    LAS bf16* Qm = (LAS bf16*)L; LAS bf16* Km = (LAS bf16*)(L + 9216); LAS bf16* KT = (LAS bf16*)(L + 18432); LAS bf16* VT = (LAS bf16*)(L + 27648); LAS bf16* ZT = (LAS bf16*)(L + 36864);
    LAS bf16* AMT = (LAS bf16*)(L + 46080); LAS bf16* RHST = (LAS bf16*)(L + 55296); LAS float* AD = (LAS float*)(L + 64512); LAS bf16* DT = (LAS bf16*)(L + 68608);
    LAS float* CUM = (LAS float*)(L + 70656); LAS float* ECUM = CUM + 64; LAS float* BETA = CUM + 128; LAS float* WSC = CUM + 192;
    LAS bf16* VNWT = Km; LAS bf16* VNT = VT;
    const bf16* P = PROJ + (size_t)b * SEQ * NP; bf16* Yb = Yg + (size_t)b * SEQ * DM;
    const float* cw = in.gdn_conv_w + (size_t)layer * 4 * 768 + h * 64;
    const float Aneg = -__expf(in.gdn_a_log[layer * 4 + h]), dtb = in.gdn_dt_bias[layer * 4 + h];
    f32x4 zs[4];
#pragma unroll
    for (int n = 0; n < 4; ++n) zs[n] = zero4();
    typedef unsigned short us2 __attribute__((ext_vector_type(2)));
    bf16 rq[19], rk[19], rv[19]; bf16 rbt, rat;
    auto load_raw = [&](int ch, int lane) {
        const int c = h * 64 + lane;
        const int tb = ch * 64 + 16 * w4 - 3;
#pragma unroll
        for (int j = 0; j < 19; ++j) { const int t = tb + j; const bool ok = (t >= 0); const bf16* p0 = P + (size_t)(ok ? t : 0) * NP;
            const bf16 a = p0[C_GD_Q + c], bb = p0[C_GD_K + c], cc = p0[C_GD_V + c];
            rq[j] = ok ? a : (bf16)0; rk[j] = ok ? bb : (bf16)0; rv[j] = ok ? cc : (bf16)0; }
        rbt = P[(size_t)(ch * 64 + lane) * NP + C_GD_BETA + h]; rat = P[(size_t)(ch * 64 + lane) * NP + C_GD_DEC + h];
    };
    load_raw(0, lane0);
    for (int ch = 0; ch < SEQ / 64; ++ch) {
        const int lane = opaque_i(lane0), r = lane & 15, q = lane >> 4;
#ifndef GDN_REP
#define GDN_REP 0
#endif
        {
            float tv[16];
            float wq[4], wk[4], wv[4];
#pragma unroll
            for (int j = 0; j < 4; ++j) { wq[j] = cw[j * 768 + lane]; wk[j] = cw[j * 768 + 256 + lane]; wv[j] = cw[j * 768 + 512 + lane]; }
#pragma unroll
            for (int i = 0; i < 16; ++i) tv[i] = siluf_(wk[0] * RAWG(rk, i) + wk[1] * RAWG(rk, i + 1) + wk[2] * RAWG(rk, i + 2) + wk[3] * RAWG(rk, i + 3));
            { float sq[16];
#pragma unroll
              for (int i = 0; i < 16; ++i) sq[i] = tv[i] * tv[i];
              const float sred = tr_reduce16(sq, lane);
#pragma unroll
              for (int i = 0; i < 16; ++i) { tv[i] *= rsqrtf(rdlane(sred, 4 * i) + 1e-6f); Km[(16 * w4 + i) * LS + lane] = cvt_bf16(tv[i]); } }
            pack16_x<SITE(0)>(KT + lane * LS + 16 * w4, tv);
            asm volatile("" ::: "memory");
#pragma unroll
            for (int i = 0; i < 16; ++i) tv[i] = siluf_(wq[0] * RAWG(rq, i) + wq[1] * RAWG(rq, i + 1) + wq[2] * RAWG(rq, i + 2) + wq[3] * RAWG(rq, i + 3));
            { float sq[16];
#pragma unroll
              for (int i = 0; i < 16; ++i) sq[i] = tv[i] * tv[i];
              const float sred = tr_reduce16(sq, lane);
#pragma unroll
              for (int i = 0; i < 16; ++i) Qm[(16 * w4 + i) * LS + lane] = cvt_bf16(tv[i] * rsqrtf(rdlane(sred, 4 * i) + 1e-6f) * 0.125f); }
            asm volatile("" ::: "memory");
#pragma unroll
            for (int i = 0; i < 16; ++i) tv[i] = siluf_(wv[0] * RAWG(rv, i) + wv[1] * RAWG(rv, i + 1) + wv[2] * RAWG(rv, i + 2) + wv[3] * RAWG(rv, i + 3));
            pack16_x<SITE(0)>(VT + lane * LS + 16 * w4, tv);
            if (w4 == 0) {
                const float beta = sigmoidf_(bf2f(rbt)); float cs = Aneg * softplusf_(bf2f(rat) + dtb);
#pragma unroll
                for (int o = 1; o < 64; o <<= 1) { const float u = __shfl_up(cs, o); if (lane >= o) cs += u; }
                const float c63 = __shfl(cs, 63);
                CUM[lane] = cs; ECUM[lane] = __expf(cs); BETA[lane] = beta; WSC[lane] = __expf(c63 - cs);
            }
#pragma unroll
            for (int n = 0; n < 4; ++n) st4_x<SITE(1)>(ZT, LS, 16 * n + r, 16 * w4 + 4 * q, zs[n]);
        }
        WG_BAR();
        const int m = w4;
        f32x4 QK[4];
        { const int lane = opaque_i(lane0), r = lane & 15, q = lane >> 4;
        {
            bf16x8 ak[2], aq[2];
#pragma unroll
            for (int k = 0; k < 2; ++k) { ak[k] = ld_frag(Km, LS, 16 * m + r, 32 * k, q); aq[k] = ld_frag(Qm, LS, 16 * m + r, 32 * k, q); }
            const f32x4 cumt4 = *(const LAS f32x4*)(CUM + 16 * m + 4 * q);
            const f32x4 bet4 = *(const LAS f32x4*)(BETA + 16 * m + 4 * q);
            const f32x4 ecum4 = *(const LAS f32x4*)(ECUM + 16 * m + 4 * q);
            const float cumr = CUM[16 * m + r];
#pragma unroll
            for (int n = 0; n < 4; ++n) { QK[n] = zero4(); if (n <= m) {
                f32x4 kk = zero4();
#pragma unroll
                for (int k = 0; k < 2; ++k) { const bf16x8 bk = ld_frag(Km, LS, 16 * n + r, 32 * k, q);
                    kk = MFMA16(ak[k], bk, kk);
                    QK[n] = MFMA16(bk, aq[k], QK[n]); }
                const float cums = CUM[16 * n + r];
                f32x4 av;
#pragma unroll
                for (int i = 0; i < 4; ++i) { const bool keep = (n < m) || (r < 4 * q + i); av[i] = keep ? bet4[i] * kk[i] * __expf(cumt4[i] - cums) : 0.f; }
                st4_x<SITE(2)>(AMT, LS, 16 * n + r, 16 * m + 4 * q, av);
                if (n == m) {
#pragma unroll
                    for (int i = 0; i < 4; ++i) AD[m * 256 + (4 * q + i) * 16 + r] = av[i]; }
                const f32x4 cs4 = *(const LAS f32x4*)(CUM + 16 * n + 4 * q);
#pragma unroll
                for (int i = 0; i < 4; ++i) { const bool keep = (n < m) || (4 * q + i <= r); QK[n][i] = keep ? QK[n][i] * __expf(cumr - cs4[i]) : 0.f; }
            } }
#pragma unroll
            for (int nv = 0; nv < 4; ++nv) { f32x4 kz = zero4();
#pragma unroll
                for (int k = 0; k < 2; ++k) kz = MFMA16(ak[k], ld_frag(ZT, LS, 16 * nv + r, 32 * k, q), kz);
                const v2u vr = *(const LAS v2u*)(VT + (16 * nv + r) * LS + 16 * m + 4 * q);
                f32x4 rh;
                rh[0] = bet4[0] * (__builtin_bit_cast(float, vr.x << 16) - ecum4[0] * kz[0]); rh[1] = bet4[1] * (__builtin_bit_cast(float, vr.x & 0xffff0000u) - ecum4[1] * kz[1]);
                rh[2] = bet4[2] * (__builtin_bit_cast(float, vr.y << 16) - ecum4[2] * kz[2]); rh[3] = bet4[3] * (__builtin_bit_cast(float, vr.y & 0xffff0000u) - ecum4[3] * kz[3]);
                st4_x<SITE(2)>(RHST, LS, 16 * nv + r, 16 * m + 4 * q, rh); }
        }
        }
        WG_BAR();
        { const int lane = opaque_i(lane0), r = lane & 15, q = lane >> 4;
        if (ch + 1 < SEQ / 64) load_raw(ch + 1, lane);
        {
            diag_inverse<SITE(5)>(AD, DT, lane);
            asm volatile("s_waitcnt lgkmcnt(0)" ::: "memory");
            f32x4 Tm[4];
            tri_inverse_row<SITE(6)>(AMT, DT, m, r, q, Tm);
            const f32x4 w4v = *(const LAS f32x4*)(WSC + 16 * m + 4 * q);
            const bf16x8 t0 = pack_frag_x<SITE(3)>(Tm[0], Tm[1]), t1 = pack_frag_x<SITE(3)>(Tm[2], Tm[3]);
#pragma unroll
            for (int nv = 0; nv < 4; ++nv) { f32x4 vn = zero4();
                vn = MFMA16(t0, ld_frag_perm(RHST, LS, 16 * nv + r, 0, q), vn);
                if (m >= 2) vn = MFMA16(t1, ld_frag_perm(RHST, LS, 16 * nv + r, 32, q), vn);
                st4_x<SITE(3)>(VNT, LS, 16 * nv + r, 16 * m + 4 * q, vn);
                st4_x<SITE(3)>(VNWT, LS, 16 * nv + r, 16 * m + 4 * q, vn * w4v); }
        }
        }
        WG_BAR();
        { const int lane = opaque_i(lane0), r = lane & 15, q = lane >> 4; const float* gnp = in.gdn_norm_g + layer * HD + 4 * q;
        {
            f32x4 O[4];
            bf16x8 aq[2];
#pragma unroll
            for (int k = 0; k < 2; ++k) aq[k] = ld_frag(Qm, LS, 16 * m + r, 32 * k, q);
            const float ect = ECUM[16 * m + r];
            const bf16x8 p0 = pack_frag_x<SITE(4)>(QK[0], QK[1]), p1 = pack_frag_x<SITE(4)>(QK[2], QK[3]);
            float ss = 0.f;
#pragma unroll
            for (int nv = 0; nv < 4; ++nv) { O[nv] = zero4();
#pragma unroll
                for (int k = 0; k < 2; ++k) O[nv] = MFMA16(ld_frag(ZT, LS, 16 * nv + r, 32 * k, q), aq[k], O[nv]);
                O[nv] = O[nv] * ect;
                O[nv] = MFMA16(ld_frag_perm(VNT, LS, 16 * nv + r, 0, q), p0, O[nv]);
                if (m >= 2) O[nv] = MFMA16(ld_frag_perm(VNT, LS, 16 * nv + r, 32, q), p1, O[nv]);
                ss += (O[nv][0] * O[nv][0] + O[nv][1] * O[nv][1]) + (O[nv][2] * O[nv][2] + O[nv][3] * O[nv][3]); }
            ss += __shfl_xor(ss, 16); ss += __shfl_xor(ss, 32);
            const float rs = rsqrtf(ss * (1.f / 64.f) + 1e-6f);
            const int t = ch * 64 + 16 * m + r;
#pragma unroll
            for (int nv = 0; nv < 4; ++nv) { const int dv0 = h * 64 + 16 * nv + 4 * q;
                const f32x4 gg = *(const f32x4*)(gnp + 16 * nv);
                const v2u zr = *(const v2u*)(P + (size_t)t * NP + C_Z + 256 + dv0);
                const float z0 = __builtin_bit_cast(float, zr.x << 16), z1 = __builtin_bit_cast(float, zr.x & 0xffff0000u), z2 = __builtin_bit_cast(float, zr.y << 16), z3 = __builtin_bit_cast(float, zr.y & 0xffff0000u);
                v2u o; o.x = pkx<SITE(4)>(O[nv][0] * rs * gg[0] * siluf_(z0), O[nv][1] * rs * gg[1] * siluf_(z1)); o.y = pkx<SITE(4)>(O[nv][2] * rs * gg[2] * siluf_(z2), O[nv][3] * rs * gg[3] * siluf_(z3));
                *(v2u*)(Yb + (size_t)t * DM + 256 + dv0) = o; }
            const float last = ECUM[63];
            bf16x8 akt[2];
#pragma unroll
            for (int k = 0; k < 2; ++k) akt[k] = ld_frag(KT, LS, 16 * w4 + r, 32 * k, q);
#pragma unroll
            for (int n = 0; n < 4; ++n) { zs[n] = zs[n] * last;
#pragma unroll
                for (int k = 0; k < 2; ++k) zs[n] = MFMA16(akt[k], ld_frag(VNWT, LS, 16 * n + r, 32 * k, q), zs[n]); }
        }
        }
        WG_BAR();
    }
}

__device__ __forceinline__ void mixopt_gdn2(const Inputs& in, const int layer, const bf16* __restrict__ PROJ, bf16* __restrict__ Yg, LAS unsigned char* L, const int b, const int h, const int tid) {
    const int lane0 = tid & 63, wave = __builtin_amdgcn_readfirstlane(tid >> 6), grp = wave >> 2, w4 = wave & 3;
    LAS bf16* Qm = (LAS bf16*)L; LAS bf16* Km = (LAS bf16*)(L + 9216); LAS bf16* KT = (LAS bf16*)(L + 18432); LAS bf16* VT = (LAS bf16*)(L + 27648); LAS bf16* ZT = (LAS bf16*)(L + 36864);
    LAS bf16* AMT = (LAS bf16*)(L + 46080); LAS bf16* RHST = (LAS bf16*)(L + 55296); LAS bf16* QKM = (LAS bf16*)(L + 64512); LAS float* AD = (LAS float*)(L + 73728); LAS bf16* DT = (LAS bf16*)(L + 77824);
    LAS float* CUM = (LAS float*)(L + 79872); LAS float* ECUM = CUM + 64; LAS float* BETA = CUM + 128; LAS float* WSC = CUM + 192;
    LAS bf16* VNWT = Km; LAS bf16* VNT = VT;
    const bf16* P = PROJ + (size_t)b * SEQ * NP; bf16* Yb = Yg + (size_t)b * SEQ * DM;
    const float* cw = in.gdn_conv_w + (size_t)layer * 4 * 768 + h * 64;
    const float Aneg = -__expf(in.gdn_a_log[layer * 4 + h]), dtb = in.gdn_dt_bias[layer * 4 + h];
    f32x4 zs[4];
#pragma unroll
    for (int n = 0; n < 4; ++n) zs[n] = zero4();
    bf16 ra[19], rb2[19]; bf16 rbt, rat;
    auto load_raw = [&](int ch, int lane) {
        const int c = h * 64 + lane;
        const int tb = ch * 64 + 16 * w4 - 3;
        if (grp == 0) {
#pragma unroll
            for (int j = 0; j < 19; ++j) { const int t = tb + j; const bool ok = (t >= 0); const bf16 a = P[(size_t)(ok ? t : 0) * NP + C_GD_K + c]; ra[j] = ok ? a : (bf16)0; }
            rbt = P[(size_t)(ch * 64 + lane) * NP + C_GD_BETA + h]; rat = P[(size_t)(ch * 64 + lane) * NP + C_GD_DEC + h];
        } else {
#pragma unroll
            for (int j = 0; j < 19; ++j) { const int t = tb + j; const bool ok = (t >= 0); const bf16* p0 = P + (size_t)(ok ? t : 0) * NP;
                const bf16 a = p0[C_GD_Q + c], bb = p0[C_GD_V + c]; ra[j] = ok ? a : (bf16)0; rb2[j] = ok ? bb : (bf16)0; }
        }
    };
    load_raw(0, lane0);
    for (int ch = 0; ch < SEQ / 64; ++ch) {
        { const int lane = opaque_i(lane0), r = lane & 15, q = lane >> 4;
          float tv[16]; float w0[4];
          if (grp == 0) {
#pragma unroll
            for (int j = 0; j < 4; ++j) w0[j] = cw[j * 768 + 256 + lane];
#pragma unroll
            for (int i = 0; i < 16; ++i) tv[i] = siluf_(w0[0] * RAWG(ra, i) + w0[1] * RAWG(ra, i + 1) + w0[2] * RAWG(ra, i + 2) + w0[3] * RAWG(ra, i + 3));
            { float sq[16];
#pragma unroll
              for (int i = 0; i < 16; ++i) sq[i] = tv[i] * tv[i];
              const float sred = tr_reduce16(sq, lane);
#pragma unroll
              for (int i = 0; i < 16; ++i) { tv[i] *= rsqrtf(rdlane(sred, 4 * i) + 1e-6f); Km[(16 * w4 + i) * LS + lane] = cvt_bf16(tv[i]); } }
            ssd_pack16(KT + lane * LS + 16 * w4, tv);
            if (w4 == 0) {
                const float beta = sigmoidf_(bf2f(rbt)); float cs = Aneg * softplusf_(bf2f(rat) + dtb);
#pragma unroll
                for (int o = 1; o < 64; o <<= 1) { const float u = __shfl_up(cs, o); if (lane >= o) cs += u; }
                const float c63 = __shfl(cs, 63);
                CUM[lane] = cs; ECUM[lane] = __expf(cs); BETA[lane] = beta; WSC[lane] = __expf(c63 - cs);
            }
#pragma unroll
            for (int n = 0; n < 4; ++n) st4(ZT, LS, 16 * n + r, 16 * w4 + 4 * q, zs[n]);
          } else {
#pragma unroll
            for (int j = 0; j < 4; ++j) w0[j] = cw[j * 768 + lane];
#pragma unroll
            for (int i = 0; i < 16; ++i) tv[i] = siluf_(w0[0] * RAWG(ra, i) + w0[1] * RAWG(ra, i + 1) + w0[2] * RAWG(ra, i + 2) + w0[3] * RAWG(ra, i + 3));
            { float sq[16];
#pragma unroll
              for (int i = 0; i < 16; ++i) sq[i] = tv[i] * tv[i];
              const float sred = tr_reduce16(sq, lane);
#pragma unroll
              for (int i = 0; i < 16; ++i) Qm[(16 * w4 + i) * LS + lane] = cvt_bf16(tv[i] * rsqrtf(rdlane(sred, 4 * i) + 1e-6f) * 0.125f); }
            asm volatile("" ::: "memory");
#pragma unroll
            for (int j = 0; j < 4; ++j) w0[j] = cw[j * 768 + 512 + lane];
#pragma unroll
            for (int i = 0; i < 16; ++i) tv[i] = siluf_(w0[0] * RAWG(rb2, i) + w0[1] * RAWG(rb2, i + 1) + w0[2] * RAWG(rb2, i + 2) + w0[3] * RAWG(rb2, i + 3));
            ssd_pack16(VT + lane * LS + 16 * w4, tv);
          }
        }
        WG_BAR();
        const int m = w4;
        { const int lane = opaque_i(lane0), r = lane & 15, q = lane >> 4;
          if (ch + 1 < SEQ / 64) load_raw(ch + 1, lane);
          if (grp == 0) {
            bf16x8 ak[2];
#pragma unroll
            for (int k = 0; k < 2; ++k) ak[k] = ld_frag(Km, LS, 16 * m + r, 32 * k, q);
            const f32x4 cumt4 = *(const LAS f32x4*)(CUM + 16 * m + 4 * q);
            const f32x4 bet4 = *(const LAS f32x4*)(BETA + 16 * m + 4 * q);
            const f32x4 ecum4 = *(const LAS f32x4*)(ECUM + 16 * m + 4 * q);
#pragma unroll
            for (int n = 0; n < 4; ++n) if (n <= m) {
                f32x4 kk = zero4();
#pragma unroll
                for (int k = 0; k < 2; ++k) kk = MFMA16(ak[k], ld_frag(Km, LS, 16 * n + r, 32 * k, q), kk);
                const float cums = CUM[16 * n + r];
                f32x4 av;
#pragma unroll
                for (int i = 0; i < 4; ++i) { const bool keep = (n < m) || (r < 4 * q + i); av[i] = keep ? bet4[i] * kk[i] * __expf(cumt4[i] - cums) : 0.f; }
                st4(AMT, LS, 16 * n + r, 16 * m + 4 * q, av);
                if (n == m) {
#pragma unroll
                    for (int i = 0; i < 4; ++i) AD[m * 256 + (4 * q + i) * 16 + r] = av[i]; }
            }
#pragma unroll
            for (int nv = 0; nv < 4; ++nv) { f32x4 kz = zero4();
#pragma unroll
                for (int k = 0; k < 2; ++k) kz = MFMA16(ak[k], ld_frag(ZT, LS, 16 * nv + r, 32 * k, q), kz);
                const v2u vr = *(const LAS v2u*)(VT + (16 * nv + r) * LS + 16 * m + 4 * q);
                f32x4 rh;
                rh[0] = bet4[0] * (__builtin_bit_cast(float, vr.x << 16) - ecum4[0] * kz[0]); rh[1] = bet4[1] * (__builtin_bit_cast(float, vr.x & 0xffff0000u) - ecum4[1] * kz[1]);
                rh[2] = bet4[2] * (__builtin_bit_cast(float, vr.y << 16) - ecum4[2] * kz[2]); rh[3] = bet4[3] * (__builtin_bit_cast(float, vr.y & 0xffff0000u) - ecum4[3] * kz[3]);
                st4(RHST, LS, 16 * nv + r, 16 * m + 4 * q, rh); }
          } else {
            bf16x8 aq[2];
#pragma unroll
            for (int k = 0; k < 2; ++k) aq[k] = ld_frag(Qm, LS, 16 * m + r, 32 * k, q);
            const float cumr = CUM[16 * m + r];
#pragma unroll
            for (int n = 0; n < 4; ++n) { f32x4 qk = zero4(); if (n <= m) {
#pragma unroll
                for (int k = 0; k < 2; ++k) qk = MFMA16(ld_frag(Km, LS, 16 * n + r, 32 * k, q), aq[k], qk);
                const f32x4 cs4 = *(const LAS f32x4*)(CUM + 16 * n + 4 * q);
#pragma unroll
                for (int i = 0; i < 4; ++i) { const bool keep = (n < m) || (4 * q + i <= r); qk[i] = keep ? qk[i] * __expf(cumr - cs4[i]) : 0.f; } }
                st4(QKM, LS, 16 * m + r, 16 * n + 4 * q, qk); }
          }
        }
        WG_BAR();
        f32x4 O[4];
        { const int lane = opaque_i(lane0), r = lane & 15, q = lane >> 4;
          if (grp == 0) {
            diag_inverse(AD, DT, lane);
            asm volatile("s_waitcnt lgkmcnt(0)" ::: "memory");
            f32x4 Tm[4];
            tri_inverse_row(AMT, DT, m, r, q, Tm);
            const f32x4 w4v = *(const LAS f32x4*)(WSC + 16 * m + 4 * q);
            const bf16x8 t0 = pack_frag(Tm[0], Tm[1]), t1 = pack_frag(Tm[2], Tm[3]);
#pragma unroll
            for (int nv = 0; nv < 4; ++nv) { f32x4 vn = zero4();
                vn = MFMA16(t0, ld_frag_perm(RHST, LS, 16 * nv + r, 0, q), vn);
                if (m >= 2) vn = MFMA16(t1, ld_frag_perm(RHST, LS, 16 * nv + r, 32, q), vn);
                st4(VNT, LS, 16 * nv + r, 16 * m + 4 * q, vn);
                st4(VNWT, LS, 16 * nv + r, 16 * m + 4 * q, vn * w4v); }
          } else {
            bf16x8 aq[2];
#pragma unroll
            for (int k = 0; k < 2; ++k) aq[k] = ld_frag(Qm, LS, 16 * m + r, 32 * k, q);
            const float ect = ECUM[16 * m + r];
#pragma unroll
            for (int nv = 0; nv < 4; ++nv) { O[nv] = zero4();
#pragma unroll
                for (int k = 0; k < 2; ++k) O[nv] = MFMA16(ld_frag(ZT, LS, 16 * nv + r, 32 * k, q), aq[k], O[nv]);
                O[nv] = O[nv] * ect; }
          }
        }
        WG_BAR();
        { const int lane = opaque_i(lane0), r = lane & 15, q = lane >> 4;
          if (grp == 0) {
            const float last = ECUM[63];
            bf16x8 akt[2];
#pragma unroll
            for (int k = 0; k < 2; ++k) akt[k] = ld_frag(KT, LS, 16 * w4 + r, 32 * k, q);
#pragma unroll
            for (int n = 0; n < 4; ++n) { zs[n] = zs[n] * last;
#pragma unroll
                for (int k = 0; k < 2; ++k) zs[n] = MFMA16(akt[k], ld_frag(VNWT, LS, 16 * n + r, 32 * k, q), zs[n]); }
          } else {
            bf16x8 pq[2];
#pragma unroll
            for (int k = 0; k < 2; ++k) pq[k] = ld_frag(QKM, LS, 16 * m + r, 32 * k, q);
            float ss = 0.f;
#pragma unroll
            for (int nv = 0; nv < 4; ++nv) {
                O[nv] = MFMA16(ld_frag(VNT, LS, 16 * nv + r, 0, q), pq[0], O[nv]);
                if (m >= 2) O[nv] = MFMA16(ld_frag(VNT, LS, 16 * nv + r, 32, q), pq[1], O[nv]);
                ss += (O[nv][0] * O[nv][0] + O[nv][1] * O[nv][1]) + (O[nv][2] * O[nv][2] + O[nv][3] * O[nv][3]); }
            ss += __shfl_xor(ss, 16); ss += __shfl_xor(ss, 32);
            const float rs = rsqrtf(ss * (1.f / 64.f) + 1e-6f);
            const int t = ch * 64 + 16 * m + r;
            const float* gnp = in.gdn_norm_g + layer * HD + 4 * q;
#pragma unroll
            for (int nv = 0; nv < 4; ++nv) { const int dv0 = h * 64 + 16 * nv + 4 * q;
                const f32x4 gg = *(const f32x4*)(gnp + 16 * nv);
                const v2u zr = *(const v2u*)(P + (size_t)t * NP + C_Z + 256 + dv0);
                const float z0 = __builtin_bit_cast(float, zr.x << 16), z1 = __builtin_bit_cast(float, zr.x & 0xffff0000u), z2 = __builtin_bit_cast(float, zr.y << 16), z3 = __builtin_bit_cast(float, zr.y & 0xffff0000u);
                v2u o; o.x = pk_bf16(O[nv][0] * rs * gg[0] * siluf_(z0), O[nv][1] * rs * gg[1] * siluf_(z1)); o.y = pk_bf16(O[nv][2] * rs * gg[2] * siluf_(z2), O[nv][3] * rs * gg[3] * siluf_(z3));
                *(v2u*)(Yb + (size_t)t * DM + 256 + dv0) = o; }
          }
        }
        WG_BAR();
    }
}

__device__ __forceinline__ void mixopt_ssd(const Inputs& in, const int layer, const bf16* __restrict__ PROJ, bf16* __restrict__ Yg, LAS unsigned char* ldsw, const int b, const int g, const int tid) {
    const int lane = tid & 63, wave = __builtin_amdgcn_readfirstlane(tid >> 6), hh = wave >> 2, w4 = wave & 3, h = g * 2 + hh, r = lane & 15, q = lane >> 4;
    LAS bf16* CM = (LAS bf16*)ldsw; LAS bf16* BM = (LAS bf16*)(ldsw + 17408); LAS bf16* BT = (LAS bf16*)(ldsw + 34816);
    LAS unsigned char* L = ldsw + 53248 + hh * 45056;
    LAS bf16* XVT = (LAS bf16*)L; LAS bf16* XVWT = (LAS bf16*)(L + MAT_B); LAS bf16* XR = (LAS bf16*)(L + 2 * MAT_B); LAS bf16* ZT = (LAS bf16*)(L + 3 * MAT_B);
    LAS float* CUM = (LAS float*)(ldsw + 143360 + hh * 1024); LAS float* ECUM = CUM + 64;
    LAS float* SS = (LAS float*)(ldsw + 145408);
    const bf16* P = PROJ + (size_t)b * SEQ * NP; bf16* Yb = Yg + (size_t)b * SEQ * DM;
    const int cx = h * 64 + lane, cbc = g * 128 + 64 * hh + lane;
    const float* cw = in.ssm_conv_w + (size_t)layer * 4 * 768; const float* cb = in.ssm_conv_b + (size_t)layer * 768;
    float wx[4], wB[4], wC[4];
#pragma unroll
    for (int j = 0; j < 4; ++j) { wx[j] = cw[j * 768 + cx]; wB[j] = cw[j * 768 + 256 + cbc]; wC[j] = cw[j * 768 + 512 + cbc]; }
    const float bx = cb[cx], bB = cb[256 + cbc], bC = cb[512 + cbc];
    const float Aneg = -__expf(in.ssm_a_log[layer * 4 + h]), dtb = in.ssm_dt_bias[layer * 4 + h], dsk = in.ssm_d[layer * 4 + h];
    const float* gnp = in.ssm_norm_g + layer * GW + h * 64 + 4 * q;
    f32x4 zs[2][4];
#pragma unroll
    for (int a = 0; a < 2; ++a)
#pragma unroll
        for (int n = 0; n < 4; ++n) zs[a][n] = zero4();
    typedef unsigned short us2 __attribute__((ext_vector_type(2)));
    bf16 rx[19], rB[19], rC[19]; bf16 rdt;
    auto load_raw = [&](int ch) {
        const int tb = ch * 64 + 16 * w4 - 3;
#pragma unroll
        for (int j = 0; j < 19; ++j) { const int t = tb + j; const bool ok = (t >= 0); const bf16* p0 = P + (size_t)(ok ? t : 0) * NP;
            const bf16 a = p0[C_SS_X + cx], bb = p0[C_SS_B + cbc], cc = p0[C_SS_C + cbc];
            rx[j] = ok ? a : (bf16)0; rB[j] = ok ? bb : (bf16)0; rC[j] = ok ? cc : (bf16)0; }
        rdt = P[(size_t)(ch * 64 + lane) * NP + C_SS_DT + h];
    };
    load_raw(0);
    for (int ch = 0; ch < SEQ / 64; ++ch) {
        {
            float tv[16];
#pragma unroll
            for (int i = 0; i < 16; ++i) { tv[i] = siluf_(wC[0] * RAWG(rC, i) + wC[1] * RAWG(rC, i + 1) + wC[2] * RAWG(rC, i + 2) + wC[3] * RAWG(rC, i + 3) + bC);
                CM[(16 * w4 + i) * LS2 + 64 * hh + lane] = cvt_bf16(tv[i]); }
            asm volatile("" ::: "memory");
#pragma unroll
            for (int i = 0; i < 16; ++i) { tv[i] = siluf_(wB[0] * RAWG(rB, i) + wB[1] * RAWG(rB, i + 1) + wB[2] * RAWG(rB, i + 2) + wB[3] * RAWG(rB, i + 3) + bB);
                BM[(16 * w4 + i) * LS2 + 64 * hh + lane] = cvt_bf16(tv[i]); }
            ssd_pack16(BT + (64 * hh + lane) * LS + 16 * w4, tv);
            asm volatile("" ::: "memory");
            const float dt = softplusf_(bf2f(rdt) + dtb); float cs = dt * Aneg;
#pragma unroll
            for (int o = 1; o < 64; o <<= 1) { const float u = __shfl_up(cs, o); if (lane >= o) cs += u; }
            const float c63 = __shfl(cs, 63);
            const float wsc = __expf(c63 - cs);
            if (w4 == 0) { CUM[lane] = cs; ECUM[lane] = __expf(cs); }
            float xw[16];
#pragma unroll
            for (int i = 0; i < 16; ++i) { const int t = 16 * w4 + i;
                const float xs = siluf_(wx[0] * RAWG(rx, i) + wx[1] * RAWG(rx, i + 1) + wx[2] * RAWG(rx, i + 2) + wx[3] * RAWG(rx, i + 3) + bx);
                XR[t * LS + lane] = cvt_bf16(xs); tv[i] = xs * __shfl(dt, t); xw[i] = tv[i] * __shfl(wsc, t); }
            ssd_pack16(XVT + lane * LS + 16 * w4, tv);
            ssd_pack16(XVWT + lane * LS + 16 * w4, xw);
#pragma unroll
            for (int a = 0; a < 2; ++a)
#pragma unroll
                for (int nv = 0; nv < 4; ++nv) st4(ZT, LS2, 16 * nv + r, 16 * (2 * w4 + a) + 4 * q, zs[a][nv]);
        }
        WG_BAR();
        if (ch + 1 < SEQ / 64) load_raw(ch + 1);
        f32x4 yv[4];
        {
            const int m = w4;
            f32x4 Pt[4];
#pragma unroll
            for (int n = 0; n < 4; ++n) Pt[n] = zero4();
            bf16x8 ac[4];
#pragma unroll
            for (int k = 0; k < 4; ++k) ac[k] = ld_frag(CM, LS2, 16 * m + r, 32 * k, q);
            const float cumt = CUM[16 * m + r];
#pragma unroll
            for (int n = 0; n < 4; ++n) if (n <= m) {
#pragma unroll
                for (int k = 0; k < 4; ++k) Pt[n] = MFMA16(ld_frag(BM, LS2, 16 * n + r, 32 * k, q), ac[k], Pt[n]);
                const f32x4 cs = *(const LAS f32x4*)(CUM + 16 * n + 4 * q);
#pragma unroll
                for (int i = 0; i < 4; ++i) { const bool keep = (n < m) || (4 * q + i <= r); Pt[n][i] = keep ? Pt[n][i] * __expf(cumt - cs[i]) : 0.f; }
            }
            f32x4 O[4];
            const float ect = ECUM[16 * m + r];
#pragma unroll
            for (int nv = 0; nv < 4; ++nv) O[nv] = zero4();
#pragma unroll
            for (int k = 0; k < 4; ++k)
#pragma unroll
                for (int nv = 0; nv < 4; ++nv) O[nv] = MFMA16(ld_frag(ZT, LS2, 16 * nv + r, 32 * k, q), ac[k], O[nv]);
#pragma unroll
            for (int nv = 0; nv < 4; ++nv) O[nv] = O[nv] * ect;
#pragma unroll
            for (int k = 0; k < 2; ++k) if (2 * k <= m) { const bf16x8 pf = pack_frag(Pt[2 * k], Pt[2 * k + 1]);
#pragma unroll
                for (int nv = 0; nv < 4; ++nv) O[nv] = MFMA16(ld_frag_perm(XVT, LS, 16 * nv + r, 32 * k, q), pf, O[nv]); }
            const int t = ch * 64 + 16 * m + r;
            float ss = 0.f;
#pragma unroll
            for (int nv = 0; nv < 4; ++nv) { const int p0 = 16 * nv + 4 * q;
                const v2u xr = *(const LAS v2u*)(XR + (16 * m + r) * LS + p0);
                const v2u zr = *(const v2u*)(P + (size_t)t * NP + C_Z + 512 + h * 64 + p0);
                const float x0 = __builtin_bit_cast(float, xr.x << 16), x1 = __builtin_bit_cast(float, xr.x & 0xffff0000u), x2 = __builtin_bit_cast(float, xr.y << 16), x3 = __builtin_bit_cast(float, xr.y & 0xffff0000u);
                const float z0 = __builtin_bit_cast(float, zr.x << 16), z1 = __builtin_bit_cast(float, zr.x & 0xffff0000u), z2 = __builtin_bit_cast(float, zr.y << 16), z3 = __builtin_bit_cast(float, zr.y & 0xffff0000u);
                yv[nv][0] = (O[nv][0] + x0 * dsk) * siluf_(z0); yv[nv][1] = (O[nv][1] + x1 * dsk) * siluf_(z1);
                yv[nv][2] = (O[nv][2] + x2 * dsk) * siluf_(z2); yv[nv][3] = (O[nv][3] + x3 * dsk) * siluf_(z3);
                ss += (yv[nv][0] * yv[nv][0] + yv[nv][1] * yv[nv][1]) + (yv[nv][2] * yv[nv][2] + yv[nv][3] * yv[nv][3]); }
            ss += __shfl_xor(ss, 16); ss += __shfl_xor(ss, 32);
            if (q == 0) SS[hh * 64 + 16 * m + r] = ss;
            const float el = ECUM[63];
#pragma unroll
            for (int a = 0; a < 2; ++a) { bf16x8 ab[2];
#pragma unroll
                for (int k = 0; k < 2; ++k) ab[k] = ld_frag(BT, LS, 16 * (2 * w4 + a) + r, 32 * k, q);
#pragma unroll
                for (int nv = 0; nv < 4; ++nv) { zs[a][nv] = zs[a][nv] * el;
#pragma unroll
                    for (int k = 0; k < 2; ++k) zs[a][nv] = MFMA16(ab[k], ld_frag(XVWT, LS, 16 * nv + r, 32 * k, q), zs[a][nv]); } }
        }
        WG_BAR();
        {
            const int m = w4, t = ch * 64 + 16 * m + r;
            const float tot = SS[16 * m + r] + SS[64 + 16 * m + r];
            const float rs = rsqrtf(tot * (1.f / 128.f) + 1e-6f);
#pragma unroll
            for (int nv = 0; nv < 4; ++nv) { const f32x4 gg = *(const f32x4*)(gnp + 16 * nv); v2u o; o.x = pk_bf16(yv[nv][0] * rs * gg[0], yv[nv][1] * rs * gg[1]); o.y = pk_bf16(yv[nv][2] * rs * gg[2], yv[nv][3] * rs * gg[3]);
                *(v2u*)(Yb + (size_t)t * DM + 512 + h * 64 + 16 * nv + 4 * q) = o; }
        }
    }
}

__device__ __forceinline__ void rwkv_pre_block(const Inputs& in, const int layer, const bf16* __restrict__ PROJ, float* __restrict__ CUMo, float* __restrict__ CUMPo, float* __restrict__ AV, LAS float* ldsf, const int m0, const int tid) {
    LAS bf16* SWH = (LAS bf16*)ldsf; LAS bf16* SWL = SWH + 64 * LS; LAS bf16* SAH = SWL + 64 * LS;
    const float* mu = in.rwkv_mu + (size_t)layer * 896;
    { const int j = tid & 63, tg = tid >> 6; const float muw = mu[768 + j], mua = mu[832 + j];
#pragma unroll
      for (int tt = 0; tt < 8; ++tt) { const int t = tg * 8 + tt, m = m0 + t; const bool first = ((m & (SEQ - 1)) == 0);
          const float xw = bf2f(PROJ[(size_t)m * NP + C_RW_WD + j]), xa = bf2f(PROJ[(size_t)m * NP + C_RW_AD + j]);
          const float pw = first ? 0.f : bf2f(PROJ[(size_t)(m - 1) * NP + C_RW_WD + j]), pa = first ? 0.f : bf2f(PROJ[(size_t)(m - 1) * NP + C_RW_AD + j]);
          const float sw = tanhf(xw + (pw - xw) * muw), sa = xa + (pa - xa) * mua;
          const unsigned hw = f2bf(sw); const float hwf = __builtin_bit_cast(float, hw << 16);
          SWH[t * LS + j] = (bf16)hw; SWL[t * LS + j] = (bf16)f2bf(sw - hwf); SAH[t * LS + j] = (bf16)f2bf(sa); } }
    __syncthreads();
    { const int lane = tid & 63, w8 = __builtin_amdgcn_readfirstlane(tid >> 6), r = lane & 15, q = lane >> 4;
      const float* wup = in.rwkv_w_up + (size_t)layer * 64 * GW; const float* aup = in.rwkv_a_up + (size_t)layer * 64 * GW;
#pragma unroll
      for (int nn = 0; nn < 2; ++nn) {
          const int c = 32 * w8 + 16 * nn + r;
          bf16x8 bwh[2], bwl[2], bah[2];
#pragma unroll
          for (int kk = 0; kk < 2; ++kk) { union { unsigned u[4]; bf16x8 v; } xh, xl, xa;
#pragma unroll
              for (int p = 0; p < 4; ++p) { const int j0 = 32 * kk + 8 * q + 2 * p;
                  const float w0 = wup[(size_t)j0 * GW + c], w1 = wup[(size_t)(j0 + 1) * GW + c], a0 = aup[(size_t)j0 * GW + c], a1 = aup[(size_t)(j0 + 1) * GW + c];
                  const unsigned h0 = f2bf(w0), h1 = f2bf(w1);
                  xh.u[p] = h0 | (h1 << 16);
                  xl.u[p] = f2bf(w0 - __builtin_bit_cast(float, h0 << 16)) | (f2bf(w1 - __builtin_bit_cast(float, h1 << 16)) << 16);
                  xa.u[p] = f2bf(a0) | (f2bf(a1) << 16); }
              bwh[kk] = xh.v; bwl[kk] = xl.v; bah[kk] = xa.v; }
          const float w0c = in.rwkv_w0[layer * GW + c], a0c = in.rwkv_a0[layer * GW + c];
          f32x4 lwv[4];
#pragma unroll
          for (int m = 0; m < 4; ++m) { f32x4 wl = zero4(), al = zero4();
#pragma unroll
              for (int kk = 0; kk < 2; ++kk) { const bf16x8 ah = ld_frag(SWH, LS, 16 * m + r, 32 * kk, q), alo = ld_frag(SWL, LS, 16 * m + r, 32 * kk, q), aa = ld_frag(SAH, LS, 16 * m + r, 32 * kk, q);
                  wl = MFMA16(ah, bwh[kk], wl); wl = MFMA16(alo, bwh[kk], wl); wl = MFMA16(ah, bwl[kk], wl);
                  al = MFMA16(aa, bah[kk], al); }
#pragma unroll
              for (int i = 0; i < 4; ++i) { const float w = -softplusf_(-(wl[i] + w0c)) - 0.5f; lwv[m][i] = -__expf(w);
                  AV[(size_t)(m0 + 16 * m + 4 * q + i) * GW + c] = sigmoidf_(al[i] + a0c); } }
          float base = 0.f;
#pragma unroll
          for (int m = 0; m < 4; ++m) { const float s = (lwv[m][0] + lwv[m][1]) + (lwv[m][2] + lwv[m][3]);
              const float s0 = __shfl(s, r), s1 = __shfl(s, 16 + r), s2 = __shfl(s, 32 + r), s3 = __shfl(s, 48 + r);
              float run = base + (q > 0 ? s0 : 0.f) + (q > 1 ? s1 : 0.f) + (q > 2 ? s2 : 0.f);
#pragma unroll
              for (int i = 0; i < 4; ++i) { run += lwv[m][i]; CUMo[(size_t)(m0 + 16 * m + 4 * q + i) * GW + c] = run; }
              base += (s0 + s1) + (s2 + s3); }
      }
    }
    __syncthreads();
}

__device__ __forceinline__ void mixopt_rwkv(const Inputs& in, const int layer, const bf16* __restrict__ PROJ, const float* __restrict__ CUMg, const float* __restrict__ CUMPg, const float* __restrict__ AV, bf16* __restrict__ Yg,
                                            LAS unsigned char* L, const int b, const int h, const int tid) {
    const int lane0 = tid & 63, wave = __builtin_amdgcn_readfirstlane(tid >> 6), w4 = wave & 3;
    const bool act = wave < 4;
    LAS bf16* AT = (LAS bf16*)L; LAS bf16* RT = (LAS bf16*)(L + 9216); LAS bf16* BL = (LAS bf16*)(L + 18432); LAS bf16* KL = (LAS bf16*)(L + 27648);
    LAS bf16* BTT = (LAS bf16*)(L + 36864); LAS bf16* KTT = (LAS bf16*)(L + 46080); LAS bf16* VT = (LAS bf16*)(L + 55296); LAS bf16* ZT = (LAS bf16*)(L + 64512);
    LAS bf16* AMT = (LAS bf16*)(L + 73728); LAS bf16* RHST = (LAS bf16*)(L + 82944); LAS float* AD = (LAS float*)(L + 92160); LAS bf16* DT = (LAS bf16*)(L + 96256);
    LAS float* QTOT = (LAS float*)(L + 98304); LAS float* ELAST = (LAS float*)(L + 99328); LAS float* BON = (LAS float*)(L + 99584);
    LAS bf16* SAT = AT;
    const bf16* P = PROJ + (size_t)b * SEQ * NP; bf16* Yb = Yg + (size_t)b * SEQ * DM;
    const float* CUMb = CUMg + (size_t)b * SEQ * GW; const float* CUMPb = CUMPg + (size_t)b * SEQ * GW; const float* AVb = AV + (size_t)b * SEQ * GW;
    const float* mu = in.rwkv_mu + (size_t)layer * 896 + h * 64;
    f32x4 zs[4];
#pragma unroll
    for (int n = 0; n < 4; ++n) zs[n] = zero4();
    LAS unsigned char* RAWT = L + 73728; LAS float* CMT = (LAS float*)(L + 99840); LAS float* AVT = (LAS float*)(L + 116480);
    v4u st[16];
    auto stage_load = [&](int ch, int ht) {
#pragma unroll
        for (int i = 0; i < 7; ++i) { const int u = ht + 256 * i; const int row = u / 24, rem = u - row * 24, seg = rem >> 3, part = rem & 7; const int t = ch * 64 - 1 + row;
            st[i] = (u < 1560 && t >= 0) ? *(const v4u*)(P + (size_t)t * NP + C_RW_R + seg * 256 + h * 64 + part * 8) : (v4u){0u, 0u, 0u, 0u}; }
#pragma unroll
        for (int i = 0; i < 5; ++i) { const int u = ht + 256 * i; const int row = u >> 4, part = u & 15; const int t = ch * 64 - 1 + row;
            st[7 + i] = (u < 1040 && t >= 0) ? *(const v4u*)(CUMb + (size_t)t * GW + h * 64 + part * 4) : (v4u){0u, 0u, 0u, 0u}; }
#pragma unroll
        for (int i = 0; i < 4; ++i) { const int u = ht + 256 * i; const int row = u >> 4, part = u & 15; const int t = ch * 64 + row;
            st[12 + i] = *(const v4u*)(AVb + (size_t)t * GW + h * 64 + part * 4); }
    };
    auto stage_store = [&](int ht) {
#pragma unroll
        for (int i = 0; i < 7; ++i) { const int u = ht + 256 * i; const int row = u / 24, rem = u - row * 24; if (u < 1560) *(LAS v4u*)(RAWT + row * 384 + rem * 16) = st[i]; }
#pragma unroll
        for (int i = 0; i < 5; ++i) { const int u = ht + 256 * i; if (u < 1040) *(LAS v4u*)((LAS unsigned char*)CMT + u * 16) = st[7 + i]; }
#pragma unroll
        for (int i = 0; i < 4; ++i) { const int u = ht + 256 * i; *(LAS v4u*)((LAS unsigned char*)AVT + u * 16) = st[12 + i]; }
    };
    if (!act) { const int ht = opaque_i(tid - 256); stage_load(0, ht); stage_store(ht); }
    WG_BAR();
    for (int ch = 0; ch < SEQ / 64; ++ch) {
        if (act) { const int lane = opaque_i(lane0), r = lane & 15, q = lane >> 4;
            float rs[16], k2[16], kkv[16], tv[16];
            const float mu_r = mu[lane], mu_k = mu[256 + lane], mu_v = mu[512 + lane];
            const float kkc = in.rwkv_k_k[layer * GW + h * 64 + lane], kac = in.rwkv_k_a[layer * GW + h * 64 + lane], rkc = in.rwkv_r_k[layer * GW + h * 64 + lane];
            { const LAS bf16* rw = (const LAS bf16*)RAWT + (16 * w4) * 192 + lane;
              float pr = bf2f(rw[0]), pk = bf2f(rw[64]), pv = bf2f(rw[128]);
#pragma unroll
              for (int i = 0; i < 16; ++i) { const float xr = bf2f(rw[(i + 1) * 192]), xk = bf2f(rw[(i + 1) * 192 + 64]), xv = bf2f(rw[(i + 1) * 192 + 128]);
                  const float av = AVT[(16 * w4 + i) * 64 + lane];
                  rs[i] = xr + (pr - xr) * mu_r; const float ks = xk + (pk - xk) * mu_k; tv[i] = xv + (pv - xv) * mu_v;
                  kkv[i] = ks * kkc; k2[i] = ks * (1.f + (av - 1.f) * kac); pr = xr; pk = xk; pv = xv; } }
            ssd_pack16(VT + lane * LS + 16 * w4, tv);
            { float sq[16];
#pragma unroll
              for (int i = 0; i < 16; ++i) sq[i] = kkv[i] * kkv[i];
              const float sred = tr_reduce16(sq, lane);
#pragma unroll
              for (int i = 0; i < 16; ++i) kkv[i] *= rsqrtf(rdlane(sred, 4 * i) + 1e-6f);
#pragma unroll
              for (int i = 0; i < 16; ++i) sq[i] = rs[i] * k2[i] * rkc;
              const float bred = tr_reduce16(sq, lane);
              if ((lane & 3) == 0) BON[16 * w4 + (lane >> 2)] = bred; }
#pragma unroll
            for (int i = 0; i < 16; ++i) { const float cum = CMT[(16 * w4 + i + 1) * 64 + lane]; const int t = 16 * w4 + i;
                const float en = __expf(-cum); const float cump = (i == 0 && w4 == 0) ? 0.f : CMT[(16 * w4 + i) * 64 + lane];
                AT[t * LS + lane] = cvt_bf16(-kkv[i] * __expf(cump));
                RT[t * LS + lane] = cvt_bf16(rs[i] * __expf(cum));
                kkv[i] = kkv[i] * AVT[(16 * w4 + i) * 64 + lane] * en; k2[i] = k2[i] * en;
                BL[t * LS + lane] = cvt_bf16(kkv[i]); KL[t * LS + lane] = cvt_bf16(k2[i]); }
            ssd_pack16(BTT + lane * LS + 16 * w4, kkv);
            ssd_pack16(KTT + lane * LS + 16 * w4, k2);
            if (w4 == 3) ELAST[lane] = __expf(CMT[64 * 64 + lane]);
#pragma unroll
            for (int n = 0; n < 4; ++n) st4(ZT, LS, 16 * n + r, 16 * w4 + 4 * q, zs[n]);
        }
        WG_BAR();
        if (!act && ch + 1 < SEQ / 64) stage_load(ch + 1, opaque_i(tid - 256));
        const int m = w4;
        if (act) { const int lane = opaque_i(lane0), r = lane & 15, q = lane >> 4;
            f32x4 Aak[4];
            bf16x8 aa[2];
#pragma unroll
            for (int k = 0; k < 2; ++k) aa[k] = ld_frag(AT, LS, 16 * m + r, 32 * k, q);
#pragma unroll
            for (int n = 0; n < 4; ++n) { Aak[n] = zero4(); if (n <= m) {
                f32x4 ab = zero4();
#pragma unroll
                for (int k = 0; k < 2; ++k) { const bf16x8 fb = ld_frag(BL, LS, 16 * n + r, 32 * k, q), fk = ld_frag(KL, LS, 16 * n + r, 32 * k, q);
                    ab = MFMA16(aa[k], fb, ab);
                    Aak[n] = MFMA16(fk, aa[k], Aak[n]); }
                f32x4 av;
#pragma unroll
                for (int i = 0; i < 4; ++i) { const bool keep = (n < m) || (r < 4 * q + i); av[i] = keep ? -ab[i] : 0.f; }
                st4(AMT, LS, 16 * n + r, 16 * m + 4 * q, av);
                if (n == m) {
#pragma unroll
                    for (int i = 0; i < 4; ++i) AD[m * 256 + (4 * q + i) * 16 + r] = av[i];
#pragma unroll
                    for (int i = 0; i < 4; ++i) { const bool strict = (4 * q + i < r); Aak[n][i] = strict ? Aak[n][i] : 0.f; } }
            } }
            const bf16x8 p0 = pack_frag(Aak[0], Aak[1]), p1 = pack_frag(Aak[2], Aak[3]);
#pragma unroll
            for (int nv = 0; nv < 4; ++nv) { f32x4 rh = zero4();
#pragma unroll
                for (int k = 0; k < 2; ++k) rh = MFMA16(aa[k], ld_frag(ZT, LS, 16 * nv + r, 32 * k, q), rh);
                rh = MFMA16(p0, ld_frag_perm(VT, LS, 16 * nv + r, 0, q), rh);
                if (m >= 2) rh = MFMA16(p1, ld_frag_perm(VT, LS, 16 * nv + r, 32, q), rh);
                st4(RHST, LS, 16 * nv + r, 16 * m + 4 * q, rh); }
        }
        WG_BAR();
        if (act) { const int lane = opaque_i(lane0), r = lane & 15, q = lane >> 4;
            diag_inverse(AD, DT, lane);
            asm volatile("s_waitcnt lgkmcnt(0)" ::: "memory");
            f32x4 Tm[4];
            tri_inverse_row(AMT, DT, m, r, q, Tm);
            const bf16x8 t0 = pack_frag(Tm[0], Tm[1]), t1 = pack_frag(Tm[2], Tm[3]);
#pragma unroll
            for (int nv = 0; nv < 4; ++nv) { f32x4 sa = zero4();
                sa = MFMA16(t0, ld_frag_perm(RHST, LS, 16 * nv + r, 0, q), sa);
                if (m >= 2) sa = MFMA16(t1, ld_frag_perm(RHST, LS, 16 * nv + r, 32, q), sa);
                st4(SAT, LS, 16 * nv + r, 16 * m + 4 * q, sa); }
        }
        WG_BAR();
        if (!act && ch + 1 < SEQ / 64) stage_store(opaque_i(tid - 256));
        if (act) { const int lane = opaque_i(lane0), r = lane & 15, q = lane >> 4;
            f32x4 O[4];
            bf16x8 ar[2];
#pragma unroll
            for (int k = 0; k < 2; ++k) ar[k] = ld_frag(RT, LS, 16 * m + r, 32 * k, q);
            f32x4 Arb[4], Ark[4];
#pragma unroll
            for (int n = 0; n < 4; ++n) { Arb[n] = zero4(); Ark[n] = zero4(); if (n <= m) {
#pragma unroll
                for (int k = 0; k < 2; ++k) { Arb[n] = MFMA16(ld_frag(BL, LS, 16 * n + r, 32 * k, q), ar[k], Arb[n]); Ark[n] = MFMA16(ld_frag(KL, LS, 16 * n + r, 32 * k, q), ar[k], Ark[n]); }
                if (n == m) {
#pragma unroll
                    for (int i = 0; i < 4; ++i) { const bool incl = (4 * q + i <= r); Arb[n][i] = incl ? Arb[n][i] : 0.f; Ark[n][i] = incl ? Ark[n][i] : 0.f; } } } }
            const bf16x8 b0 = pack_frag(Arb[0], Arb[1]), b1 = pack_frag(Arb[2], Arb[3]), k0 = pack_frag(Ark[0], Ark[1]), k1 = pack_frag(Ark[2], Ark[3]);
            float s1 = 0.f;
#pragma unroll
            for (int nv = 0; nv < 4; ++nv) { O[nv] = zero4();
#pragma unroll
                for (int k = 0; k < 2; ++k) O[nv] = MFMA16(ld_frag(ZT, LS, 16 * nv + r, 32 * k, q), ar[k], O[nv]);
                O[nv] = MFMA16(ld_frag_perm(SAT, LS, 16 * nv + r, 0, q), b0, O[nv]);
                O[nv] = MFMA16(ld_frag_perm(VT, LS, 16 * nv + r, 0, q), k0, O[nv]);
                if (m >= 2) { O[nv] = MFMA16(ld_frag_perm(SAT, LS, 16 * nv + r, 32, q), b1, O[nv]); O[nv] = MFMA16(ld_frag_perm(VT, LS, 16 * nv + r, 32, q), k1, O[nv]); }
                s1 += (O[nv][0] + O[nv][1]) + (O[nv][2] + O[nv][3]); }
            s1 += __shfl_xor(s1, 16); s1 += __shfl_xor(s1, 32);
            const float mean = s1 * (1.f / 64.f); float s2 = 0.f;
#pragma unroll
            for (int nv = 0; nv < 4; ++nv) { O[nv] = O[nv] - mean; s2 += (O[nv][0] * O[nv][0] + O[nv][1] * O[nv][1]) + (O[nv][2] * O[nv][2] + O[nv][3] * O[nv][3]); }
            s2 += __shfl_xor(s2, 16); s2 += __shfl_xor(s2, 32);
            const float rstd = rsqrtf(s2 * (1.f / 64.f) + 64e-5f);
            const int t = ch * 64 + 16 * m + r; const float bon = BON[16 * m + r];
#pragma unroll
            for (int nv = 0; nv < 4; ++nv) { const int dv0 = 16 * nv + 4 * q, cc = h * 64 + dv0;
                const f32x4 lw4 = *(const f32x4*)(in.rwkv_ln_w + layer * GW + cc); const f32x4 lb4 = *(const f32x4*)(in.rwkv_ln_b + layer * GW + cc);
                const v2u zr = *(const v2u*)(P + (size_t)t * NP + C_Z + 768 + cc);
                const float z0 = __builtin_bit_cast(float, zr.x << 16), z1 = __builtin_bit_cast(float, zr.x & 0xffff0000u), z2 = __builtin_bit_cast(float, zr.y << 16), z3 = __builtin_bit_cast(float, zr.y & 0xffff0000u);
                const float v0 = bf2f(VT[(dv0 + 0) * LS + 16 * m + r]), v1 = bf2f(VT[(dv0 + 1) * LS + 16 * m + r]), v2 = bf2f(VT[(dv0 + 2) * LS + 16 * m + r]), v3 = bf2f(VT[(dv0 + 3) * LS + 16 * m + r]);
                v2u o; o.x = pk_bf16((O[nv][0] * rstd * lw4[0] + lb4[0] + bon * v0) * siluf_(z0), (O[nv][1] * rstd * lw4[1] + lb4[1] + bon * v1) * siluf_(z1));
                o.y = pk_bf16((O[nv][2] * rstd * lw4[2] + lb4[2] + bon * v2) * siluf_(z2), (O[nv][3] * rstd * lw4[3] + lb4[3] + bon * v3) * siluf_(z3));
                *(v2u*)(Yb + (size_t)t * DM + 768 + cc) = o; }
            const f32x4 el = *(const LAS f32x4*)(ELAST + 16 * w4 + 4 * q);
            bf16x8 ab2[2], ak2[2];
#pragma unroll
            for (int k = 0; k < 2; ++k) { ab2[k] = ld_frag(BTT, LS, 16 * w4 + r, 32 * k, q); ak2[k] = ld_frag(KTT, LS, 16 * w4 + r, 32 * k, q); }
#pragma unroll
            for (int n = 0; n < 4; ++n) {
#pragma unroll
                for (int k = 0; k < 2; ++k) { zs[n] = MFMA16(ab2[k], ld_frag(SAT, LS, 16 * n + r, 32 * k, q), zs[n]); zs[n] = MFMA16(ak2[k], ld_frag(VT, LS, 16 * n + r, 32 * k, q), zs[n]); }
                zs[n] = zs[n] * el; }
        }
        WG_BAR();
    }
}

__device__ __forceinline__ void mixopt_rwkv2(const Inputs& in, const int layer, const bf16* __restrict__ PROJ, const float* __restrict__ CUMg, const float* __restrict__ CUMPg, const float* __restrict__ AV, bf16* __restrict__ Yg,
                                            LAS unsigned char* L, const int b, const int h, const int tid) {
    const int lane0 = tid & 63, wave = __builtin_amdgcn_readfirstlane(tid >> 6), w4 = wave & 3;
    const bool act = wave < 4;
    LAS bf16* AT = (LAS bf16*)L; LAS bf16* RT = (LAS bf16*)(L + 9216); LAS bf16* BL = (LAS bf16*)(L + 18432); LAS bf16* KL = (LAS bf16*)(L + 27648);
    LAS bf16* BTT = (LAS bf16*)(L + 36864); LAS bf16* KTT = (LAS bf16*)(L + 46080); LAS bf16* VT = (LAS bf16*)(L + 55296); LAS bf16* ZT = (LAS bf16*)(L + 64512);
    LAS bf16* AMT = (LAS bf16*)(L + 73728); LAS bf16* RHST = (LAS bf16*)(L + 82944); LAS float* AD = (LAS float*)(L + 92160); LAS bf16* DT = (LAS bf16*)(L + 96256);
    LAS float* QTOT = (LAS float*)(L + 98304); LAS float* ELAST = (LAS float*)(L + 99328); LAS float* BON = (LAS float*)(L + 99584);
    LAS bf16* SAT = AT;
    const bf16* P = PROJ + (size_t)b * SEQ * NP; bf16* Yb = Yg + (size_t)b * SEQ * DM;
    const float* CUMb = CUMg + (size_t)b * SEQ * GW; const float* CUMPb = CUMPg + (size_t)b * SEQ * GW; const float* AVb = AV + (size_t)b * SEQ * GW;
    const float* mu = in.rwkv_mu + (size_t)layer * 896 + h * 64;
    f32x4 zs[4];
#pragma unroll
    for (int n = 0; n < 4; ++n) zs[n] = zero4();
#define O zs
    LAS unsigned char* RAWT = L + 73728; LAS float* CMT = (LAS float*)(L + 99840); LAS float* AVT = (LAS float*)(L + 120320);
    v4u st[9];
    auto stage_load_a = [&](int ch, int ht) {
#pragma unroll
        for (int i = 0; i < 5; ++i) { const int u = ht + 256 * i; const int row = u >> 4, part = u & 15; const int t = ch * 64 - 1 + row;
            st[i] = (u < 1040 && t >= 0) ? *(const v4u*)(CUMb + (size_t)t * GW + h * 64 + part * 4) : (v4u){0u, 0u, 0u, 0u}; }
#pragma unroll
        for (int i = 0; i < 4; ++i) { const int u = ht + 256 * i; const int row = u >> 4, part = u & 15; const int t = ch * 64 + row;
            st[5 + i] = *(const v4u*)(AVb + (size_t)t * GW + h * 64 + part * 4); }
    };
    auto stage_store_a = [&](int ht) {
#pragma unroll
        for (int i = 0; i < 5; ++i) { const int u = ht + 256 * i; if (u < 1040) *(LAS v4u*)((LAS unsigned char*)CMT + u * 16) = st[i]; }
#pragma unroll
        for (int i = 0; i < 4; ++i) { const int u = ht + 256 * i; *(LAS v4u*)((LAS unsigned char*)AVT + u * 16) = st[5 + i]; }
    };
    auto stage_dma_a = [&](int ch, int ht, int wv) {
#pragma unroll
        for (int i = 0; i < 5; ++i) { const int u = ht + 256 * i; const int uu = u < 1040 ? u : 1039; const int row = uu >> 4, part = uu & 15; const int t = ch * 64 - 1 + row;
            __builtin_amdgcn_global_load_lds((const GAS unsigned*)(CUMb + (size_t)t * GW + h * 64 + part * 4), (LAS unsigned*)((LAS unsigned char*)CMT + (64 * wv + 256 * i) * 16), 16, 0, 0); }
#pragma unroll
        for (int i = 0; i < 4; ++i) { const int u = ht + 256 * i; const int row = u >> 4, part = u & 15; const int t = ch * 64 + row;
            __builtin_amdgcn_global_load_lds((const GAS unsigned*)(AVb + (size_t)t * GW + h * 64 + part * 4), (LAS unsigned*)((LAS unsigned char*)AVT + (64 * wv + 256 * i) * 16), 16, 0, 0); }
    };
    auto stage_load_b = [&](int ch, int ht) {
#pragma unroll
        for (int i = 0; i < 7; ++i) { const int u = ht + 256 * i; const int row = u / 24, rem = u - row * 24, seg = rem >> 3, part = rem & 7; const int t = ch * 64 - 1 + row;
            st[i] = (u < 1560 && t >= 0) ? *(const v4u*)(P + (size_t)t * NP + C_RW_R + seg * 256 + h * 64 + part * 8) : (v4u){0u, 0u, 0u, 0u}; }
    };
    auto stage_store_b = [&](int ht) {
#pragma unroll
        for (int i = 0; i < 7; ++i) { const int u = ht + 256 * i; const int row = u / 24, rem = u - row * 24; if (u < 1560) *(LAS v4u*)(RAWT + row * 384 + rem * 16) = st[i]; }
    };
    if (!act) { const int ht = opaque_i(tid - 256); stage_load_a(0, ht); stage_store_a(ht); stage_load_b(0, ht); stage_store_b(ht); }
    WG_BAR();
    for (int ch = 0; ch < SEQ / 64; ++ch) {
        { const int lane = opaque_i(lane0), r = lane & 15, q = lane >> 4;
          const float mu_k = mu[256 + lane];
          const float kac = in.rwkv_k_a[layer * GW + h * 64 + lane];
          const LAS bf16* rw = (const LAS bf16*)RAWT + (16 * w4) * 192 + lane;
          float k2[16];
          if (act) {
            float kkv[16];
            const float kkc = in.rwkv_k_k[layer * GW + h * 64 + lane];
            { float pk = bf2f(rw[64]);
#pragma unroll
              for (int i = 0; i < 16; ++i) { const float xk = bf2f(rw[(i + 1) * 192 + 64]); const float av = AVT[(16 * w4 + i) * 64 + lane];
                  const float ks = xk + (pk - xk) * mu_k; kkv[i] = ks * kkc; k2[i] = ks * (1.f + (av - 1.f) * kac); pk = xk; } }
            { float sq[16];
#pragma unroll
              for (int i = 0; i < 16; ++i) sq[i] = kkv[i] * kkv[i];
              const float sred = tr_reduce16(sq, lane);
#pragma unroll
              for (int i = 0; i < 16; ++i) kkv[i] *= rsqrtf(rdlane(sred, 4 * i) + 1e-6f); }
#pragma unroll
            for (int i = 0; i < 16; ++i) { const float cum = CMT[(16 * w4 + i + 1) * 64 + lane]; const int t = 16 * w4 + i;
                const float en = __expf(-cum); const float cump = (i == 0 && w4 == 0) ? 0.f : CMT[(16 * w4 + i) * 64 + lane];
                AT[t * LS + lane] = cvt_bf16(-kkv[i] * __expf(cump));
                kkv[i] = kkv[i] * AVT[(16 * w4 + i) * 64 + lane] * en; k2[i] = k2[i] * en;
                BL[t * LS + lane] = cvt_bf16(kkv[i]); KL[t * LS + lane] = cvt_bf16(k2[i]); }
            ssd_pack16(BTT + lane * LS + 16 * w4, kkv);
            ssd_pack16(KTT + lane * LS + 16 * w4, k2);
            if (w4 == 3) ELAST[lane] = __expf(CMT[64 * 64 + lane]);
#pragma unroll
            for (int n = 0; n < 4; ++n) st4(ZT, LS, 16 * n + r, 16 * w4 + 4 * q, zs[n]);
          } else {
            float rs[16], tv[16];
            const float mu_r = mu[lane], mu_v = mu[512 + lane];
            const float rkc = in.rwkv_r_k[layer * GW + h * 64 + lane];
            { float pr = bf2f(rw[0]), pk = bf2f(rw[64]), pv = bf2f(rw[128]);
#pragma unroll
              for (int i = 0; i < 16; ++i) { const float xr = bf2f(rw[(i + 1) * 192]), xk = bf2f(rw[(i + 1) * 192 + 64]), xv = bf2f(rw[(i + 1) * 192 + 128]);
                  const float av = AVT[(16 * w4 + i) * 64 + lane];
                  rs[i] = xr + (pr - xr) * mu_r; const float ks = xk + (pk - xk) * mu_k; tv[i] = xv + (pv - xv) * mu_v;
                  k2[i] = ks * (1.f + (av - 1.f) * kac); pr = xr; pk = xk; pv = xv; } }
            ssd_pack16(VT + lane * LS + 16 * w4, tv);
            { float sq[16];
#pragma unroll
              for (int i = 0; i < 16; ++i) sq[i] = rs[i] * k2[i] * rkc;
              const float bred = tr_reduce16(sq, lane);
              if ((lane & 3) == 0) BON[16 * w4 + (lane >> 2)] = bred; }
#pragma unroll
            for (int i = 0; i < 16; ++i) RT[(16 * w4 + i) * LS + lane] = cvt_bf16(rs[i] * __expf(CMT[(16 * w4 + i + 1) * 64 + lane]));
          }
        }
        WG_BAR();
        if (!act && ch + 1 < SEQ / 64) stage_dma_a(ch + 1, opaque_i(tid - 256), wave - 4);
        const int m = w4;
        f32x4 Arb[4], Ark[4];
        if (!act) { const int lane = opaque_i(lane0), r = lane & 15, q = lane >> 4;
            bf16x8 ar[2];
#pragma unroll
            for (int k = 0; k < 2; ++k) ar[k] = ld_frag(RT, LS, 16 * m + r, 32 * k, q);
#pragma unroll
            for (int n = 0; n < 4; ++n) { Arb[n] = zero4(); Ark[n] = zero4(); if (n <= m) {
#pragma unroll
                for (int k = 0; k < 2; ++k) { Arb[n] = MFMA16(ld_frag(BL, LS, 16 * n + r, 32 * k, q), ar[k], Arb[n]); Ark[n] = MFMA16(ld_frag(KL, LS, 16 * n + r, 32 * k, q), ar[k], Ark[n]); }
                if (n == m) {
#pragma unroll
                    for (int i = 0; i < 4; ++i) { const bool incl = (4 * q + i <= r); Arb[n][i] = incl ? Arb[n][i] : 0.f; Ark[n][i] = incl ? Ark[n][i] : 0.f; } } } }
        }
        if (act) { const int lane = opaque_i(lane0), r = lane & 15, q = lane >> 4;
            f32x4 Aak[4];
            bf16x8 aa[2];
#pragma unroll
            for (int k = 0; k < 2; ++k) aa[k] = ld_frag(AT, LS, 16 * m + r, 32 * k, q);
#pragma unroll
            for (int n = 0; n < 4; ++n) { Aak[n] = zero4(); if (n <= m) {
                f32x4 ab = zero4();
#pragma unroll
                for (int k = 0; k < 2; ++k) { const bf16x8 fb = ld_frag(BL, LS, 16 * n + r, 32 * k, q), fk = ld_frag(KL, LS, 16 * n + r, 32 * k, q);
                    ab = MFMA16(aa[k], fb, ab);
                    Aak[n] = MFMA16(fk, aa[k], Aak[n]); }
                f32x4 av;
#pragma unroll
                for (int i = 0; i < 4; ++i) { const bool keep = (n < m) || (r < 4 * q + i); av[i] = keep ? -ab[i] : 0.f; }
                st4(AMT, LS, 16 * n + r, 16 * m + 4 * q, av);
                if (n == m) {
#pragma unroll
                    for (int i = 0; i < 4; ++i) AD[m * 256 + (4 * q + i) * 16 + r] = av[i];
#pragma unroll
                    for (int i = 0; i < 4; ++i) { const bool strict = (4 * q + i < r); Aak[n][i] = strict ? Aak[n][i] : 0.f; } }
            } }
            const bf16x8 p0 = pack_frag(Aak[0], Aak[1]), p1 = pack_frag(Aak[2], Aak[3]);
#pragma unroll
            for (int nv = 0; nv < 4; ++nv) { f32x4 rh = zero4();
#pragma unroll
                for (int k = 0; k < 2; ++k) rh = MFMA16(aa[k], ld_frag(ZT, LS, 16 * nv + r, 32 * k, q), rh);
                rh = MFMA16(p0, ld_frag_perm(VT, LS, 16 * nv + r, 0, q), rh);
                if (m >= 2) rh = MFMA16(p1, ld_frag_perm(VT, LS, 16 * nv + r, 32, q), rh);
                st4(RHST, LS, 16 * nv + r, 16 * m + 4 * q, rh); }
        }
        WG_BAR();
        if (!act) { const int lane = opaque_i(lane0), r = lane & 15, q = lane >> 4;
            if (ch + 1 < SEQ / 64) stage_load_b(ch + 1, opaque_i(tid - 256));
            bf16x8 ar[2];
#pragma unroll
            for (int k = 0; k < 2; ++k) ar[k] = ld_frag(RT, LS, 16 * m + r, 32 * k, q);
#pragma unroll
            for (int nv = 0; nv < 4; ++nv) { O[nv] = zero4();
#pragma unroll
                for (int k = 0; k < 2; ++k) O[nv] = MFMA16(ld_frag(ZT, LS, 16 * nv + r, 32 * k, q), ar[k], O[nv]); }
        }
        if (act) { const int lane = opaque_i(lane0), r = lane & 15, q = lane >> 4;
            diag_inverse(AD, DT, lane);
            asm volatile("s_waitcnt lgkmcnt(0)" ::: "memory");
            f32x4 Tm[4];
            tri_inverse_row(AMT, DT, m, r, q, Tm);
            const bf16x8 t0 = pack_frag(Tm[0], Tm[1]), t1 = pack_frag(Tm[2], Tm[3]);
#pragma unroll
            for (int nv = 0; nv < 4; ++nv) { f32x4 sa = zero4();
                sa = MFMA16(t0, ld_frag_perm(RHST, LS, 16 * nv + r, 0, q), sa);
                if (m >= 2) sa = MFMA16(t1, ld_frag_perm(RHST, LS, 16 * nv + r, 32, q), sa);
                st4(SAT, LS, 16 * nv + r, 16 * m + 4 * q, sa); }
        }
        WG_BAR();
        if (!act) { const int lane = opaque_i(lane0), r = lane & 15, q = lane >> 4;
            const bf16x8 b0 = pack_frag(Arb[0], Arb[1]), b1 = pack_frag(Arb[2], Arb[3]), k0 = pack_frag(Ark[0], Ark[1]), k1 = pack_frag(Ark[2], Ark[3]);
            float s1 = 0.f;
#pragma unroll
            for (int nv = 0; nv < 4; ++nv) {
                O[nv] = MFMA16(ld_frag_perm(SAT, LS, 16 * nv + r, 0, q), b0, O[nv]);
                O[nv] = MFMA16(ld_frag_perm(VT, LS, 16 * nv + r, 0, q), k0, O[nv]);
                if (m >= 2) { O[nv] = MFMA16(ld_frag_perm(SAT, LS, 16 * nv + r, 32, q), b1, O[nv]); O[nv] = MFMA16(ld_frag_perm(VT, LS, 16 * nv + r, 32, q), k1, O[nv]); }
                s1 += (O[nv][0] + O[nv][1]) + (O[nv][2] + O[nv][3]); }
            s1 += __shfl_xor(s1, 16); s1 += __shfl_xor(s1, 32);
            const float mean = s1 * (1.f / 64.f); float s2 = 0.f;
#pragma unroll
            for (int nv = 0; nv < 4; ++nv) { O[nv] = O[nv] - mean; s2 += (O[nv][0] * O[nv][0] + O[nv][1] * O[nv][1]) + (O[nv][2] * O[nv][2] + O[nv][3] * O[nv][3]); }
            s2 += __shfl_xor(s2, 16); s2 += __shfl_xor(s2, 32);
            const float rstd = rsqrtf(s2 * (1.f / 64.f) + 64e-5f);
            const int t = ch * 64 + 16 * m + r; const float bon = BON[16 * m + r];
#pragma unroll
            for (int nv = 0; nv < 4; ++nv) { const int dv0 = 16 * nv + 4 * q, cc = h * 64 + dv0;
                const f32x4 lw4 = *(const f32x4*)(in.rwkv_ln_w + layer * GW + cc); const f32x4 lb4 = *(const f32x4*)(in.rwkv_ln_b + layer * GW + cc);
                const v2u zr = *(const v2u*)(P + (size_t)t * NP + C_Z + 768 + cc);
                const float z0 = __builtin_bit_cast(float, zr.x << 16), z1 = __builtin_bit_cast(float, zr.x & 0xffff0000u), z2 = __builtin_bit_cast(float, zr.y << 16), z3 = __builtin_bit_cast(float, zr.y & 0xffff0000u);
                const float v0 = bf2f(VT[(dv0 + 0) * LS + 16 * m + r]), v1 = bf2f(VT[(dv0 + 1) * LS + 16 * m + r]), v2 = bf2f(VT[(dv0 + 2) * LS + 16 * m + r]), v3 = bf2f(VT[(dv0 + 3) * LS + 16 * m + r]);
                v2u o; o.x = pk_bf16((O[nv][0] * rstd * lw4[0] + lb4[0] + bon * v0) * siluf_(z0), (O[nv][1] * rstd * lw4[1] + lb4[1] + bon * v1) * siluf_(z1));
                o.y = pk_bf16((O[nv][2] * rstd * lw4[2] + lb4[2] + bon * v2) * siluf_(z2), (O[nv][3] * rstd * lw4[3] + lb4[3] + bon * v3) * siluf_(z3));
                *(v2u*)(Yb + (size_t)t * DM + 768 + cc) = o; }
            if (ch + 1 < SEQ / 64) stage_store_b(opaque_i(tid - 256));
        }
        if (act) { const int lane = opaque_i(lane0), r = lane & 15, q = lane >> 4;
            const f32x4 el = *(const LAS f32x4*)(ELAST + 16 * w4 + 4 * q);
            bf16x8 ab2[2], ak2[2];
#pragma unroll
            for (int k = 0; k < 2; ++k) { ab2[k] = ld_frag(BTT, LS, 16 * w4 + r, 32 * k, q); ak2[k] = ld_frag(KTT, LS, 16 * w4 + r, 32 * k, q); }
#pragma unroll
            for (int n = 0; n < 4; ++n) {
#pragma unroll
                for (int k = 0; k < 2; ++k) { zs[n] = MFMA16(ab2[k], ld_frag(SAT, LS, 16 * n + r, 32 * k, q), zs[n]); zs[n] = MFMA16(ak2[k], ld_frag(VT, LS, 16 * n + r, 32 * k, q), zs[n]); }
                zs[n] = zs[n] * el; }
        }
        WG_BAR();
    }
}
#undef O

#ifndef MK_MASK
#define MK_MASK 31
#endif
#ifndef REP_MASK
#define REP_MASK 0
#endif

constexpr int NWAVES = 8;
constexpr size_t MiB = 1u << 20;
constexpr size_t WS_CTL = 0, CTL_ZERO_BYTES = 64 * 1024;
constexpr size_t WS_WIN = 1 * MiB;
constexpr size_t WS_WOUT = 18 * MiB;
constexpr size_t WS_U = 22 * MiB;
constexpr size_t WS_PROJ = 54 * MiB;
constexpr size_t WS_OUT = 190 * MiB;
constexpr int CW_BAR = 4096;
constexpr int LDSCTL_OFF = 147456, MISC_OFF = LDSCTL_OFF + 320, LDS_BYTES = 148480;

struct Args { Inputs in; float* out; unsigned char* ws; };
__device__ __forceinline__ int opaque_v(int v) { asm volatile("" : "+v"(v)); return v; }

__device__ __forceinline__ void wprep_load(const float* __restrict__ W, int N, int use_perm, int n0, int k0, int tid, LAS float* tile) {
    const int nn = tid & 31, kq = tid >> 5;
    const int oc = use_perm ? old_col(n0 + nn) : (n0 + nn);
#pragma unroll
    for (int i = 0; i < 8; ++i) { const int kk = kq + 8 * i; tile[kk * 33 + nn] = (oc >= 0) ? W[(size_t)(k0 + kk) * N + oc] : 0.f; }
}
__device__ __forceinline__ void wprep_store(bf16* __restrict__ WT, int K, int n0, int k0, int tid, const LAS float* tile) {
    const int n = tid >> 3, kc = (tid & 7) * 8;
    uint4 o;
    o.x = f2bf(tile[(kc + 0) * 33 + n]) | (f2bf(tile[(kc + 1) * 33 + n]) << 16);
    o.y = f2bf(tile[(kc + 2) * 33 + n]) | (f2bf(tile[(kc + 3) * 33 + n]) << 16);
    o.z = f2bf(tile[(kc + 4) * 33 + n]) | (f2bf(tile[(kc + 5) * 33 + n]) << 16);
    o.w = f2bf(tile[(kc + 6) * 33 + n]) | (f2bf(tile[(kc + 7) * 33 + n]) << 16);
    *(uint4*)(WT + (size_t)(n0 + n) * K + k0 + kc) = o;
}

__device__ __forceinline__ void rmsnorm_row_bf16(const float* __restrict__ hrow, const float* __restrict__ g, bf16* __restrict__ urow, int lane) {
    const float4* xr = (const float4*)hrow + lane; const float4* gr = (const float4*)g + lane;
    float4 v[4]; float s = 0.f;
#pragma unroll
    for (int j = 0; j < 4; ++j) { v[j] = xr[64 * j]; s += (v[j].x * v[j].x + v[j].y * v[j].y) + (v[j].z * v[j].z + v[j].w * v[j].w); }
    const float r = rsqrtf(wave_sum(s) * (1.f / DM) + 1e-6f);
    uint2* o8 = (uint2*)urow + lane;
#pragma unroll
    for (int j = 0; j < 4; ++j) { const float4 gg = gr[64 * j]; uint2 o;
        o.x = f2bf(v[j].x * r * gg.x) | (f2bf(v[j].y * r * gg.y) << 16); o.y = f2bf(v[j].z * r * gg.z) | (f2bf(v[j].w * r * gg.w) << 16); o8[64 * j] = o; }
}

__device__ __forceinline__ void post_row(const float* hrow, const float* __restrict__ orow_, const float* __restrict__ g, float* hnew, const float* __restrict__ g2, bf16* __restrict__ urow, int lane) {
    const float4* orow = (const float4*)orow_ + lane; const float4* hr = (const float4*)hrow + lane; const float4* gr = (const float4*)g + lane;
    float4 v[4]; float s = 0.f;
#pragma unroll
    for (int j = 0; j < 4; ++j) { v[j] = orow[64 * j]; s += (v[j].x * v[j].x + v[j].y * v[j].y) + (v[j].z * v[j].z + v[j].w * v[j].w); }
    const float r = rsqrtf(wave_sum(s) * (1.f / DM) + 1e-6f);
    float4* o = (float4*)hnew + lane; float s2 = 0.f;
#pragma unroll
    for (int j = 0; j < 4; ++j) { const float4 gg = gr[64 * j]; const float4 hh = hr[64 * j]; float4 w;
        w.x = hh.x + v[j].x * r * gg.x; w.y = hh.y + v[j].y * r * gg.y; w.z = hh.z + v[j].z * r * gg.z; w.w = hh.w + v[j].w * r * gg.w; o[64 * j] = w; v[j] = w;
        s2 += (w.x * w.x + w.y * w.y) + (w.z * w.z + w.w * w.w); }
    if (g2) {
        const float r2 = rsqrtf(wave_sum(s2) * (1.f / DM) + 1e-6f);
        const float4* g2r = (const float4*)g2 + lane; uint2* o8 = (uint2*)urow + lane;
#pragma unroll
        for (int j = 0; j < 4; ++j) { const float4 gg = g2r[64 * j]; uint2 q;
            q.x = f2bf(v[j].x * r2 * gg.x) | (f2bf(v[j].y * r2 * gg.y) << 16); q.y = f2bf(v[j].z * r2 * gg.z) | (f2bf(v[j].w * r2 * gg.w) << 16); o8[64 * j] = q; }
    }
}

#define CAS __attribute__((address_space(4)))
#define GRID_BAR() do { const CAS Args* apb = (const CAS Args*)__builtin_amdgcn_kernarg_segment_ptr(); asm volatile("" : "+s"(apb)); \
    XcdBarrier bq; bq.bar = (unsigned*)((gu32*)(apb->ws + WS_CTL) + CW_BAR); bq.x = xb_xcc_id(); bq.st = (volatile LAS unsigned*)(lds + MISC_OFF) + 8; \
    int wv_ = wave_k; asm volatile("" : "+s"(wv_)); xcd_barrier(bq, (wv_ << 6) | fresh_lane()); } while (0)
#define PHASE_LOCALS() \
    const CAS Args* ap = (const CAS Args*)__builtin_amdgcn_kernarg_segment_ptr(); asm volatile("" : "+s"(ap)); \
    Inputs in; in.x = ap->in.x; in.pre_norm_g = ap->in.pre_norm_g; in.w_in = ap->in.w_in; in.hgrn_lb = ap->in.hgrn_lb; in.hgrn_norm_g = ap->in.hgrn_norm_g; in.gdn_conv_w = ap->in.gdn_conv_w; in.gdn_a_log = ap->in.gdn_a_log; in.gdn_dt_bias = ap->in.gdn_dt_bias; in.gdn_norm_g = ap->in.gdn_norm_g; in.ssm_conv_w = ap->in.ssm_conv_w; in.ssm_conv_b = ap->in.ssm_conv_b; in.ssm_a_log = ap->in.ssm_a_log; in.ssm_dt_bias = ap->in.ssm_dt_bias; in.ssm_d = ap->in.ssm_d; in.ssm_norm_g = ap->in.ssm_norm_g; in.rwkv_mu = ap->in.rwkv_mu; in.rwkv_w0 = ap->in.rwkv_w0; in.rwkv_w_up = ap->in.rwkv_w_up; in.rwkv_a0 = ap->in.rwkv_a0; in.rwkv_a_up = ap->in.rwkv_a_up; in.rwkv_k_k = ap->in.rwkv_k_k; in.rwkv_k_a = ap->in.rwkv_k_a; in.rwkv_r_k = ap->in.rwkv_r_k; in.rwkv_ln_w = ap->in.rwkv_ln_w; in.rwkv_ln_b = ap->in.rwkv_ln_b; in.w_out = ap->in.w_out; in.post_norm_g = ap->in.post_norm_g; \
    unsigned char* ws = ap->ws; float* hout = ap->out; \
    int bx = blockIdx.x; asm volatile("" : "+s"(bx)); int G = gridDim.x; asm volatile("" : "+s"(G)); \
    const int lane = fresh_lane(); int wave = wave_k; asm volatile("" : "+s"(wave)); const int tid = (wave << 6) | lane; \
    bf16* Win = (bf16*)(ws + WS_WIN); bf16* Wout = (bf16*)(ws + WS_WOUT); bf16* U = (bf16*)(ws + WS_U); bf16* PROJ = (bf16*)(ws + WS_PROJ); float* OUT = (float*)(ws + WS_OUT); \
    (void)Win; (void)Wout; (void)U; (void)PROJ; (void)OUT; (void)hout; (void)bx; (void)G; (void)lane; (void)wave;

__global__ void __launch_bounds__(NWAVES * 64, 2) mk_fwd(Args args) {
    extern __shared__ __attribute__((aligned(16))) unsigned char lds_raw[];
    LAS unsigned char* lds = (LAS unsigned char*)lds_raw;
    volatile LAS unsigned* MISC = (volatile LAS unsigned*)(lds + MISC_OFF);
    const int wave_k = __builtin_amdgcn_readfirstlane((int)threadIdx.x >> 6);
    for (int u = threadIdx.x; u < (LDS_BYTES - LDSCTL_OFF) / 4; u += NWAVES * 64) ((LAS unsigned*)(lds + LDSCTL_OFF))[u] = 0u;
    __syncthreads();
    (void)xcd_barrier_post((unsigned*)((gu32*)(args.ws + WS_CTL) + CW_BAR), MISC + 8, (int)threadIdx.x);

    for (int rep0 = 0; rep0 < ((REP_MASK & 256) ? 2 : 1); ++rep0) {
        PHASE_LOCALS();
        const int half = tid >> 8, t256 = tid & 255;
        LAS float* tile = (LAS float*)(lds + half * 16384);
        constexpr int IT_IN = (NP / 32) * (DM / 64), IT_OUT = (DM / 32) * (DM / 64), IT_ALL = NLAYER * (IT_IN + IT_OUT);
        for (int it0 = bx * 2; it0 < IT_ALL; it0 += G * 2) {
            const int it = it0 + half; const bool act = it < IT_ALL;
            const float* W = nullptr; bf16* WT = nullptr; int N = 0, perm = 0, n0 = 0, k0 = 0;
            if (act) { int r = it; const int l = r / (IT_IN + IT_OUT); r -= l * (IT_IN + IT_OUT);
                if (r < IT_IN) { W = in.w_in + (size_t)l * DM * IN_COLS; N = IN_COLS; perm = 1; WT = Win + (size_t)l * NP * DM; n0 = (r % (NP / 32)) * 32; k0 = (r / (NP / 32)) * 64; }
                else { r -= IT_IN; W = in.w_out + (size_t)l * DM * DM; N = DM; perm = 0; WT = Wout + (size_t)l * DM * DM; n0 = (r % (DM / 32)) * 32; k0 = (r / (DM / 32)) * 64; }
                wprep_load(W, N, perm, n0, k0, t256, tile); }
            __syncthreads();
            if (act) wprep_store(WT, DM, n0, k0, t256, tile);
            __syncthreads();
        }
        for (int m = bx * NWAVES + wave; m < MTOK; m += G * NWAVES) rmsnorm_row_bf16(in.x + (size_t)m * DM, in.pre_norm_g, U + (size_t)m * DM, lane);
    }
    GRID_BAR();

#pragma unroll
    for (int l = 0; l < NLAYER; ++l) {
        { PHASE_LOCALS();
          pg8::Gemm g; g.A = U; g.Bt = Win + (size_t)l * NP * DM; g.M = MTOK; g.N = NP; g.K = DM;
          pg8::StaticOrder S; S.init(MTOK, NP, G, bx); S.wave_id = wave;
          pg8::EpiBf16<0> E; E.O = PROJ; E.ldc = NP; E.bias = nullptr; E.split_cols = 0; E.split_stride = 0;
          for (int rep = 0; rep < ((REP_MASK & 32) ? 2 : 1); ++rep) pg8::gemm_phase<pg8::EpiBf16<0>, pg8::StaticOrder, false>(lds, g, S, E, nullptr); }
        GRID_BAR();
        { PHASE_LOCALS();
          float* CUMW = OUT; float* CUMPW = OUT + (size_t)MTOK * GW; float* AVW = OUT + (size_t)2 * MTOK * GW;
          for (int rep = 0; rep < ((REP_MASK & 16) ? 2 : 1); ++rep) for (int blk = bx; blk < MTOK / 64; blk += G) { const int tid_l = opaque_v(tid); rwkv_pre_block(in, l, PROJ, CUMW, CUMPW, AVW, (LAS float*)lds, blk * 64, tid_l); } }
        GRID_BAR();
        { PHASE_LOCALS();
          const float* CUMW = OUT; const float* CUMPW = OUT + (size_t)MTOK * GW; const float* AVW = OUT + (size_t)2 * MTOK * GW;
          if (bx < 16) mixopt_hgrn(in, l, PROJ, U, lds, (bx >> 1) & 7, bx & 1, (wave << 6) | fresh_lane());
          else if (bx < 48) mixopt_gdn2(in, l, PROJ, U, lds, (bx - 16) >> 2, (bx - 16) & 3, (wave << 6) | fresh_lane());
          else if (bx < 64) mixopt_ssd(in, l, PROJ, U, lds, ((bx - 48) >> 1) & 7, (bx - 48) & 1, (wave << 6) | fresh_lane());
          else if (bx < 96) mixopt_rwkv2(in, l, PROJ, CUMW, CUMPW, AVW, U, lds, (bx - 64) >> 2, (bx - 64) & 3, (wave << 6) | fresh_lane()); }
        GRID_BAR();
        { PHASE_LOCALS();
          pg8::Gemm g; g.A = U; g.Bt = Wout + (size_t)l * DM * DM; g.M = MTOK; g.N = DM; g.K = DM;
          pg8::StaticOrder S; S.init(MTOK, DM, G, bx); S.wave_id = wave;
          pg8::EpiF32 E; E.C = OUT; E.ldc = DM; E.bias = nullptr;
          for (int rep = 0; rep < ((REP_MASK & 64) ? 2 : 1); ++rep) pg8::gemm_phase<pg8::EpiF32, pg8::StaticOrder, false>(lds, g, S, E, nullptr); }
        GRID_BAR();
        { PHASE_LOCALS();
          const float* hin = (l == 0) ? in.x : hout;
          for (int m = bx * NWAVES + wave; m < MTOK; m += G * NWAVES)
            post_row(hin + (size_t)m * DM, OUT + (size_t)m * DM, in.post_norm_g + (size_t)l * DM, hout + (size_t)m * DM,
                     (l + 1 < NLAYER) ? in.pre_norm_g + (size_t)(l + 1) * DM : nullptr, U + (size_t)m * DM, lane); }
        if (l + 1 < NLAYER) GRID_BAR();
    }
}

extern "C" void kernel_launch(void* const* d_in, const int* in_sizes, int n_in, void* d_out, int out_size, void* d_ws, size_t ws_size, hipStream_t stream) {
    static int grid = 0;
    if (grid == 0) {
        int dev = 0, cus = 0, per_cu = 0;
        if (hipGetDevice(&dev) != hipSuccess || hipDeviceGetAttribute(&cus, hipDeviceAttributeMultiprocessorCount, dev) != hipSuccess) { fprintf(stderr, "kernel_launch: device query failed\n"); grid = -1; return; }
        if (hipFuncSetAttribute((const void*)mk_fwd, hipFuncAttributeMaxDynamicSharedMemorySize, LDS_BYTES) != hipSuccess) { fprintf(stderr, "kernel_launch: hipFuncSetAttribute failed\n"); grid = -1; return; }
        if (hipOccupancyMaxActiveBlocksPerMultiprocessor(&per_cu, (const void*)mk_fwd, NWAVES * 64, LDS_BYTES) != hipSuccess || per_cu < 1)
            fprintf(stderr, "kernel_launch: note: occupancy query reports %d workgroups per CU\n", per_cu);
        (void)hipGetLastError();
        grid = cus;
    }
    if (grid < 0) return;
    if (hipMemsetAsync((char*)d_ws + WS_CTL, 0, CTL_ZERO_BYTES, stream) != hipSuccess) { fprintf(stderr, "kernel_launch: memset failed\n"); return; }
    Args a{};
    { const float** ip = (const float**)&a.in; for (int i = 0; i < 27; ++i) ip[i] = (const float*)d_in[i]; }
    a.out = (float*)d_out; a.ws = (unsigned char*)d_ws;
    hipLaunchKernelGGL(mk_fwd, dim3(grid), dim3(NWAVES * 64), LDS_BYTES, stream, a);
}
```

```cpp
#include <hip/hip_runtime.h>
#include <cstdio>
#include <cstdint>
#define REP_MASK 0
#define HWCVT 3
#define HWSITES 0
namespace pg8 {
#define PG8_LAS __attribute__((address_space(3)))
typedef unsigned short bf16_t;
typedef short bf16x8 __attribute__((ext_vector_type(8)));
typedef float f32x4 __attribute__((ext_vector_type(4)));
typedef unsigned u32x4 __attribute__((ext_vector_type(4)));
constexpr int BM = 256, BK = 64, HALF = 128, HTB = HALF * BK * 2  , STAGE_BYTES = 8 * HTB, NXCD = 8, WGM = 8;

__host__ __device__ __forceinline__ int lds_byte(int r, int c) { const int st = (r >> 4) * 2 + (c >> 5), rr = r & 15, cc = c & 31, ob = rr * 64 + cc * 2; return st * 1024 + (ob ^ (((ob >> 9) & 1) << 5)); }
__host__ __device__ __forceinline__ void stage_rc(int b, int& R, int& C) { const int st = b / 1024, sb = b % 1024, swz = sb ^ (((sb >> 9) & 1) << 5); R = (st >> 1) * 16 + swz / 64; C = (st & 1) * 32 + (swz % 64) / 2; }
__host__ __device__ __forceinline__ int perm32(int rho) { const int n = rho >> 4, i = rho & 15; return 8 * (i >> 2) + 4 * n + (i & 3); }

struct Unit { int pm, pn; };
struct Gemm { const bf16_t* A; const bf16_t* Bt; int M, N, K; };

struct StaticOrder {
    int nM, nN, nwg, G, c, wave_id;
    __host__ __device__ void init(int M, int N, int G_, int c_) { nM = M / BM; nN = N / BM; nwg = nM * nN; G = G_; c = c_; }
    __host__ __device__ bool next(int i, Unit& u) const {
        const long L = (long)i * G + c; if (L >= nwg) return false;
        int wgid = (int)L; { const int q = nwg / NXCD, r = nwg % NXCD, xcd = wgid % NXCD, off = wgid / NXCD; wgid = (xcd < r ? xcd * (q + 1) : r * (q + 1) + (xcd - r) * q) + off; }
        const int nig = WGM * nN, gid = wgid / nig, fm = gid * WGM, gsz = (nM - fm) < WGM ? (nM - fm) : WGM;
        u.pm = fm + ((wgid % nig) % gsz); u.pn = (wgid % nig) / gsz; return true;
    }
    __device__ __forceinline__ void a_ready(const Unit&) const {}
    __device__ __forceinline__ void done(const Unit&) const {}
};
__device__ __forceinline__ unsigned cvt_pk_bf16(float lo, float hi) { unsigned r; asm volatile("v_cvt_pk_bf16_f32 %0, %1, %2" : "=v"(r) : "v"(lo), "v"(hi)); return r; }
typedef float f32x2 __attribute__((ext_vector_type(2)));
__device__ __forceinline__ f32x2 gelu_pk(f32x2 v) {
    const f32x2 av = __builtin_elementwise_abs(v), d = av * 0.2316418882f + 1.0f;
    f32x2 t; t.x = __builtin_amdgcn_rcpf(d.x); t.y = __builtin_amdgcn_rcpf(d.y);
    f32x2 q = t * 0.5307027145f + (-0.7265760135f); q = q * t + 0.7107068705f; q = q * t + (-0.142248368f); q = q * t + 0.127414796f; q = q * t;
    const f32x2 s = (v * v) * (-0.72134752044f);
    f32x2 e; e.x = __builtin_amdgcn_exp2f(s.x); e.y = __builtin_amdgcn_exp2f(s.y);
    const f32x2 m = v * (q * e), r = v - m;
    f32x2 o; o.x = v.x < 0.f ? m.x : r.x; o.y = v.y < 0.f ? m.y : r.y; return o;
}

struct EpiF32 {
    static constexpr bool PERM = false, AFTER_DRAIN = false;
    float* C; int ldc; const float* bias;
    __device__ __forceinline__ void operator()(const f32x4 (&acc)[2][2][4][2], const Unit& u, int wr, int wc, int fr, int fq) const {
        const int row0 = u.pm * BM + wr * 64 + fr, col0 = u.pn * BM + wc * 32 + 4 * fq;
        f32x4 bv[2][2];
#pragma unroll
        for (int bj = 0; bj < 2; ++bj)
#pragma unroll
            for (int n = 0; n < 2; ++n) bv[bj][n] = bias ? *(const f32x4*)(bias + col0 + bj * HALF + n * 16) : (f32x4){0.f, 0.f, 0.f, 0.f};
#pragma unroll
        for (int ai = 0; ai < 2; ++ai)
#pragma unroll
            for (int m = 0; m < 4; ++m) { float* rowp = C + (size_t)(row0 + ai * HALF + m * 16) * ldc + col0;
#pragma unroll
                for (int bj = 0; bj < 2; ++bj)
#pragma unroll
                    for (int n = 0; n < 2; ++n) *(f32x4*)(rowp + bj * HALF + n * 16) = acc[ai][bj][m][n] + bv[bj][n]; }
    }
};
template <int ACT  > struct EpiBf16 {
    static constexpr bool PERM = true, AFTER_DRAIN = false;
    bf16_t* O; int ldc; const float* bias; int split_cols; size_t split_stride;
    __device__ __forceinline__ void operator()(const f32x4 (&acc)[2][2][4][2], const Unit& u, int wr, int wc, int fr, int fq) const {
        const int row0 = u.pm * BM + wr * 64 + fr; int colt = u.pn * BM; bf16_t* base = O;
        if (split_cols) { const int t = colt / split_cols; base += (size_t)t * split_stride; colt -= t * split_cols; }
        const int col0 = colt + wc * 32 + 8 * fq, bcol0 = u.pn * BM + wc * 32 + 8 * fq;
        f32x4 bv[2][2];
#pragma unroll
        for (int bj = 0; bj < 2; ++bj)
#pragma unroll
            for (int n = 0; n < 2; ++n) bv[bj][n] = bias ? *(const f32x4*)(bias + bcol0 + bj * HALF + 4 * n) : (f32x4){0.f, 0.f, 0.f, 0.f};
#pragma unroll
        for (int ai = 0; ai < 2; ++ai)
#pragma unroll
            for (int m = 0; m < 4; ++m) { bf16_t* rowp = base + (size_t)(row0 + ai * HALF + m * 16) * ldc + col0;
#pragma unroll
                for (int bj = 0; bj < 2; ++bj) { f32x4 v0 = acc[ai][bj][m][0] + bv[bj][0], v1 = acc[ai][bj][m][1] + bv[bj][1];
                    if (ACT == 1) { f32x2 a = gelu_pk((f32x2){v0[0], v0[1]}), b = gelu_pk((f32x2){v0[2], v0[3]}), c = gelu_pk((f32x2){v1[0], v1[1]}), d = gelu_pk((f32x2){v1[2], v1[3]});
                        v0 = (f32x4){a.x, a.y, b.x, b.y}; v1 = (f32x4){c.x, c.y, d.x, d.y}; }
                    if (ACT == 2) {
#pragma unroll
                        for (int j = 0; j < 4; ++j) { v0[j] = 0.5f * v0[j] * (1.0f + erff(v0[j] * 0.70710678f)); v1[j] = 0.5f * v1[j] * (1.0f + erff(v1[j] * 0.70710678f)); } }
                    u32x4 w; w.x = cvt_pk_bf16(v0[0], v0[1]); w.y = cvt_pk_bf16(v0[2], v0[3]); w.z = cvt_pk_bf16(v1[0], v1[1]); w.w = cvt_pk_bf16(v1[2], v1[3]);
                    *(u32x4*)(rowp + bj * HALF) = w; } }
    }
};
__device__ __forceinline__ int fresh_lane_pg8() { unsigned m_ = ~0u; asm volatile("" : "+s"(m_)); return (int)__builtin_amdgcn_mbcnt_hi(m_, __builtin_amdgcn_mbcnt_lo(m_, 0u)); }
template <class Epi, class Sched, bool STAMP = false>
__device__ __forceinline__ void gemm_phase(PG8_LAS unsigned char* lds, const Gemm g, const Sched& S, const Epi& E, unsigned long long* stamps) {
    int tid_op_ = (S.wave_id << 6) | fresh_lane_pg8(); const int tid = tid_op_, wid = __builtin_amdgcn_readfirstlane(tid >> 6), lane = tid & 63, wr = wid >> 2, wc = wid & 3, fr = lane & 15, fq = lane >> 4;
    const int K = g.K, nt = K / BK;
    int ts_lo = 0, ts_hi = 0, nts = 0; const unsigned long long rt_entry = STAMP ? (unsigned long long)wall_clock64() : 0ull;
#define PG8_STAMP() do { if (STAMP && wid == 0 && nts < 64) { const unsigned long long _c = (unsigned long long)clock64(); \
        ts_lo = (lane == nts) ? (int)(unsigned)_c : ts_lo; ts_hi = (lane == nts) ? (int)(unsigned)(_c >> 32) : ts_hi; ++nts; } } while (0)
    PG8_STAMP();
    unsigned voffA[2], voffB[2];
#pragma unroll
    for (int i = 0; i < 2; ++i) { int R, C; stage_rc(tid * 16 + i * 8192, R, C); const int Rb = Epi::PERM ? ((R & ~31) + perm32(R & 31)) : R;
        voffA[i] = (unsigned)(R * K + C) * 2u; voffB[i] = (unsigned)(Rb * K + C) * 2u; }
    const size_t kstep = (size_t)(BK * 2);
    const size_t hstep = (size_t)HALF * K * 2;
    const size_t tstep = 2 * hstep;
    const unsigned ldsw = (unsigned)wid * 1024u;
    const int aoff = lds_byte(wr * 64 + fr, fq * 8), boff = lds_byte(wc * 32 + fr, fq * 8);
#define PG8_SA(b, h) (((b) * 2 + (h)) * HTB)
#define PG8_SB(b, h) ((4 + (b) * 2 + (h)) * HTB)
#define PG8_STAGE(bufoff, gbase, voff) do { _Pragma("unroll") for (int _i = 0; _i < 2; ++_i) \
        __builtin_amdgcn_global_load_lds((const unsigned*)((const char*)(gbase) + (voff)[_i]), (PG8_LAS unsigned*)(lds + (bufoff) + ldsw + _i * 8192), 16, 0, 0); } while (0)
#define PG8_LDA(dst, b, h) do { _Pragma("unroll") for (int m = 0; m < 4; ++m) _Pragma("unroll") for (int k = 0; k < 2; ++k) dst[m][k] = *(const PG8_LAS bf16x8*)(lds + PG8_SA(b, h) + aoff + m * 2048 + k * 1024); } while (0)
#define PG8_LDB(dst, b, h) do { _Pragma("unroll") for (int n = 0; n < 2; ++n) _Pragma("unroll") for (int k = 0; k < 2; ++k) dst[n][k] = *(const PG8_LAS bf16x8*)(lds + PG8_SB(b, h) + boff + n * 2048 + k * 1024); } while (0)
#define PG8_MMA(ai, bj, At, Bt) do { __builtin_amdgcn_s_setprio(1); _Pragma("unroll") for (int m = 0; m < 4; ++m) _Pragma("unroll") for (int n = 0; n < 2; ++n) _Pragma("unroll") for (int k = 0; k < 2; ++k) \
        acc[ai][bj][m][n] = __builtin_amdgcn_mfma_f32_16x16x32_bf16(Bt[n][k], At[m][k], acc[ai][bj][m][n], 0, 0, 0); __builtin_amdgcn_s_setprio(0); } while (0)
#define PG8_WAIT_V(n) asm volatile("s_waitcnt vmcnt(" #n ")" ::: "memory")
#define PG8_WAIT_L(n) asm volatile("s_waitcnt lgkmcnt(" #n ")" ::: "memory")
#define PG8_BAR __builtin_amdgcn_s_barrier()
#define PG8_SCHED __builtin_amdgcn_sched_barrier(0)
    Unit cur, nxt; int ui = 0;
    if (!S.next(0, cur)) return;
    f32x4 acc[2][2][4][2];
#pragma unroll
    for (int a = 0; a < 2; ++a)
#pragma unroll
        for (int b = 0; b < 2; ++b)
#pragma unroll
            for (int m = 0; m < 4; ++m)
#pragma unroll
                for (int n = 0; n < 2; ++n) acc[a][b][m][n] = (f32x4){0.f, 0.f, 0.f, 0.f};
    bf16x8 At[4][2], B0[2][2], B1[2][2];
    const char* cA = (const char*)g.A + (size_t)cur.pm * tstep; const char* cB = (const char*)g.Bt + (size_t)cur.pn * tstep;
    S.a_ready(cur);
    PG8_STAGE(PG8_SB(0, 0), cB, voffB); PG8_STAGE(PG8_SA(0, 0), cA, voffA); PG8_STAGE(PG8_SB(0, 1), cB + hstep, voffB); PG8_STAGE(PG8_SA(0, 1), cA + hstep, voffA);
    if (wr == 1) PG8_BAR;
    PG8_WAIT_V(4); PG8_BAR;
    PG8_STAGE(PG8_SB(1, 0), cB + kstep, voffB); PG8_STAGE(PG8_SA(1, 0), cA + kstep, voffA); PG8_STAGE(PG8_SB(1, 1), cB + hstep + kstep, voffB);
    PG8_WAIT_V(6); PG8_BAR;
    PG8_STAMP();
    for (;;) {
        const bool has_next = S.next(ui + 1, nxt);
        const char* nA = has_next ? (const char*)g.A + (size_t)nxt.pm * tstep : cA; const char* nB = has_next ? (const char*)g.Bt + (size_t)nxt.pn * tstep : cB;
        for (int t = 0; t < nt; t += 2) {
            const bool last = (t == nt - 2);
            const char* a1 = cA + (size_t)(t + 1) * kstep;
            const char* a2 = last ? nA : cA + (size_t)(t + 2) * kstep; const char* b2 = last ? nB : cB + (size_t)(t + 2) * kstep;
            const char* a3 = a2 + kstep; const char* b3 = b2 + kstep;
            if (last && has_next) S.a_ready(nxt);
            PG8_LDB(B0, 0, 0); PG8_SCHED; PG8_LDA(At, 0, 0); PG8_STAGE(PG8_SA(1, 1), a1 + hstep, voffA);
            PG8_WAIT_L(8); PG8_BAR; PG8_WAIT_L(0); PG8_MMA(0, 0, At, B0); PG8_BAR; PG8_SCHED;
            PG8_LDB(B1, 0, 1); PG8_STAGE(PG8_SB(0, 0), b2, voffB);
            PG8_BAR; PG8_WAIT_L(0); PG8_MMA(0, 1, At, B1); PG8_BAR;
            PG8_LDA(At, 0, 1); PG8_STAGE(PG8_SA(0, 0), a2, voffA);
            PG8_BAR; PG8_WAIT_L(0); PG8_MMA(1, 0, At, B0); PG8_BAR; PG8_SCHED;
            PG8_STAGE(PG8_SB(0, 1), b2 + hstep, voffB);
            PG8_WAIT_V(6); PG8_BAR; PG8_MMA(1, 1, At, B1); PG8_BAR;
            PG8_LDB(B0, 1, 0); PG8_SCHED; PG8_LDA(At, 1, 0); PG8_STAGE(PG8_SA(0, 1), a2 + hstep, voffA);
            PG8_WAIT_L(8); PG8_BAR; PG8_WAIT_L(0); PG8_MMA(0, 0, At, B0); PG8_BAR; PG8_SCHED;
            PG8_LDB(B1, 1, 1); PG8_STAGE(PG8_SB(1, 0), b3, voffB);
            PG8_BAR; PG8_WAIT_L(0); PG8_MMA(0, 1, At, B1); PG8_BAR;
            PG8_LDA(At, 1, 1); PG8_STAGE(PG8_SA(1, 0), a3, voffA);
            PG8_BAR; PG8_WAIT_L(0); PG8_MMA(1, 0, At, B0); PG8_BAR; PG8_SCHED;
            PG8_STAGE(PG8_SB(1, 1), b3 + hstep, voffB);
            PG8_WAIT_V(6); PG8_BAR; PG8_MMA(1, 1, At, B1); PG8_BAR;
        }
        PG8_STAMP();
        if constexpr (!Epi::AFTER_DRAIN) { E(acc, cur, wr, wc, fr, fq); S.done(cur); }
        PG8_STAMP();
        if (!has_next) break;
#pragma unroll
        for (int a = 0; a < 2; ++a)
#pragma unroll
            for (int b = 0; b < 2; ++b)
#pragma unroll
                for (int m = 0; m < 4; ++m)
#pragma unroll
                    for (int n = 0; n < 2; ++n) acc[a][b][m][n] = (f32x4){0.f, 0.f, 0.f, 0.f};
        cur = nxt; cA = nA; cB = nB; ++ui;
    }
    PG8_WAIT_V(0);
    if (wr == 0) PG8_BAR;
    PG8_BAR;
    if constexpr (Epi::AFTER_DRAIN) { E.fused(acc, cur, wr, wc, fr, fq, lds, wid, lane); S.done(cur); }
    PG8_STAMP();
    if (STAMP && wid == 0) { stamps[lane] = lane < nts ? (((unsigned long long)(unsigned)ts_hi << 32) | (unsigned)ts_lo) : 0ull;
        if (lane == 62) stamps[62] = rt_entry; if (lane == 63) stamps[63] = (unsigned long long)wall_clock64(); }
#undef PG8_STAMP
#undef PG8_SA
#undef PG8_SB
#undef PG8_STAGE
#undef PG8_LDA
#undef PG8_LDB
#undef PG8_MMA
#undef PG8_WAIT_V
#undef PG8_WAIT_L
#undef PG8_BAR
#undef PG8_SCHED
}
}
#define GAS __attribute__((address_space(1)))
#define LAS __attribute__((address_space(3)))
typedef unsigned short bf16;
typedef unsigned v4u __attribute__((ext_vector_type(4)));
typedef float f32x4 __attribute__((ext_vector_type(4)));
typedef short bf16x8 __attribute__((ext_vector_type(8)));
typedef GAS unsigned gu32;
typedef GAS unsigned long long gu64;
__device__ __forceinline__ int fresh_lane() { unsigned m_ = ~0u; asm volatile("" : "+s"(m_)); return (int)__builtin_amdgcn_mbcnt_hi(m_, __builtin_amdgcn_mbcnt_lo(m_, 0u)); }
#define RLX_AGENT __ATOMIC_RELAXED, __HIP_MEMORY_SCOPE_AGENT
#define LDS_WAIT() asm volatile("s_waitcnt lgkmcnt(0)" ::: "memory")
#define VM_WAIT() asm volatile("s_waitcnt vmcnt(0)" ::: "memory")
__device__ __forceinline__ unsigned long long rt() { return __builtin_amdgcn_s_memrealtime(); }
__device__ __forceinline__ unsigned f2bf(float f) { unsigned u = __builtin_bit_cast(unsigned, f); return (u + 0x7fffu + ((u >> 16) & 1u)) >> 16; }
__device__ __forceinline__ unsigned pk2(float lo, float hi) { return f2bf(lo) | (f2bf(hi) << 16); }
#define XB_TMO      128
#define XB_XCNT(j)  (256  + 64 * (j))
#define XB_XSUB(j)  (1280 + 64 * (j))
#define XB_XGEN(j)  (2304 + 64 * (j))
#define XB_TOP      3328
#define XB_TOPGEN   3392
#define XCD_BAR_WORDS 3456
#define XB_SPIN_CAP (1u << 22)

__device__ __forceinline__ unsigned xb_ld(unsigned* p)              { return __hip_atomic_load(p, __ATOMIC_RELAXED, __HIP_MEMORY_SCOPE_AGENT); }
__device__ __forceinline__ unsigned xb_add(unsigned* p, unsigned v) { return __hip_atomic_fetch_add(p, v, __ATOMIC_RELAXED, __HIP_MEMORY_SCOPE_AGENT); }
__device__ __forceinline__ unsigned xb_xcc_id() { return (unsigned)__builtin_amdgcn_s_getreg((3 << 11) | 20) & 0xFu; }
#define XB_SPIN(cond, bar) do { unsigned _sp = 0; while (cond) { __builtin_amdgcn_s_sleep(1); \
    if ((++_sp & 255u) == 0u) { if (xb_ld(&(bar)[XB_TMO])) break; if (_sp > XB_SPIN_CAP) { atomicAdd(&(bar)[XB_TMO], 1u); break; } } } } while (0)

struct XcdBarrier {
    unsigned* bar; unsigned x;
    volatile LAS unsigned* st;
};

__device__ __forceinline__ XcdBarrier xcd_barrier_post(unsigned* bar, volatile LAS unsigned* st, const int tid_) {
    XcdBarrier b; b.bar = bar; b.x = xb_xcc_id(); b.st = st;
    if (tid_ == 0) (void)xb_add(&bar[XB_XCNT(b.x)], 1u);
    return b;
}
__device__ __forceinline__ void xcd_barrier_complete(unsigned* bar, unsigned x, unsigned& nloc, unsigned& nx) {
    const unsigned G = gridDim.x * gridDim.y * gridDim.z;
    unsigned sum, cnt, mine, sp = 0u;
    for (;;) {
        sum = 0u; cnt = 0u; mine = 0u;
#pragma unroll
        for (unsigned j = 0; j < 16; ++j) { const unsigned c = xb_ld(&bar[XB_XCNT(j)]); sum += c; cnt += (c > 0u) ? 1u : 0u; mine = (j == x) ? c : mine; }
        if (sum == G) break;
        __builtin_amdgcn_s_sleep(1);
        if ((++sp & 255u) == 0u) { if (xb_ld(&bar[XB_TMO])) break; if (sp > XB_SPIN_CAP) { atomicAdd(&bar[XB_TMO], 1u); break; } }
    }
    nloc = mine > 0u ? mine : 1u; nx = cnt > 0u ? cnt : 1u;
}

__device__ __forceinline__ void xcd_barrier(const XcdBarrier& b, const int tid_) {
    asm volatile("s_waitcnt vmcnt(0)" ::: "memory");
    __syncthreads();
    if (tid_ == 0) {
        unsigned* bar = b.bar;
        __builtin_amdgcn_s_waitcnt(0);
        unsigned nloc = b.st[0], nx = b.st[1];
        if (nloc == 0u) { xcd_barrier_complete(bar, b.x, nloc, nx); b.st[0] = nloc; b.st[1] = nx; }
        const unsigned old = xb_add(&bar[XB_XSUB(b.x)], 1u);
        const unsigned gen = old / nloc;
        if (old + 1u == (gen + 1u) * nloc) {
            __builtin_amdgcn_fence(__ATOMIC_RELEASE, "agent");
            asm volatile("s_waitcnt vmcnt(0)" ::: "memory");
            const unsigned og = xb_add(&bar[XB_TOP], 1u);
            const unsigned tg = og / nx;
            if (og + 1u == (tg + 1u) * nx) xb_add(&bar[XB_TOPGEN], 1u);
            else XB_SPIN(xb_ld(&bar[XB_TOPGEN]) == tg, bar);
            __builtin_amdgcn_fence(__ATOMIC_ACQUIRE, "agent");
            xb_add(&bar[XB_XGEN(b.x)], 1u);
            asm volatile("s_waitcnt vmcnt(0)" ::: "memory");
        } else {
            XB_SPIN(xb_ld(&bar[XB_XGEN(b.x)]) == gen, bar);
            __builtin_amdgcn_fence(__ATOMIC_ACQUIRE, "agent");
            asm volatile("s_waitcnt vmcnt(0)" ::: "memory");
        }
    }
    __syncthreads();
}

constexpr int BATCH = 8, SEQ = 2048, DM = 1024, MTOK = BATCH * SEQ, NLAYER = 2;
constexpr int GW = 256, HD = 64, NHEAD = 4;
constexpr int IN_COLS = 4236, NP = 4352;
constexpr int C_HG_Q = 0, C_HG_F = 256, C_HG_I = 512;
constexpr int C_GD_Q = 768, C_GD_K = 1024, C_GD_V = 1280;
constexpr int C_SS_X = 1536, C_SS_B = 1792, C_SS_C = 2048;
constexpr int C_RW_R = 2304, C_RW_K = 2560, C_RW_V = 2816;
constexpr int C_Z = 3072;
constexpr int C_GD_BETA = 4096, C_GD_DEC = 4100, C_SS_DT = 4104, C_RW_WD = 4112, C_RW_AD = 4176;

__host__ __device__ __forceinline__ int old_col(int n) {
    if (n < 1536) return n;
    if (n < 2304) return 1544 + (n - 1536);
    if (n < 3072) return 2316 + (n - 2304);
    if (n < 4096) return 3212 + (n - 3072);
    if (n < 4104) return 1536 + (n - 4096);
    if (n < 4108) return 2312 + (n - 4104);
    if (n < 4112) return -1;
    if (n < 4240) return 3084 + (n - 4112);
    return -1;
}
__device__ __forceinline__ float bf2f(bf16 b) { return __builtin_bit_cast(float, ((unsigned)b) << 16); }
__device__ __forceinline__ float wave_sum(float v) {
#pragma unroll
    for (int o = 1; o < 64; o <<= 1) v += __shfl_xor(v, o);
    return v;
}
__device__ __forceinline__ float sigmoidf_(float x) { return __builtin_amdgcn_rcpf(1.f + __expf(-x)); }
__device__ __forceinline__ float siluf_(float x) { return x * __builtin_amdgcn_rcpf(1.f + __expf(-x)); }
__device__ __forceinline__ float softplusf_(float x) { return x > 20.f ? x : log1pf(__expf(x)); }

struct Inputs {
    const float* x; const float* pre_norm_g; const float* w_in; const float* hgrn_lb; const float* hgrn_norm_g;
    const float* gdn_conv_w; const float* gdn_a_log; const float* gdn_dt_bias; const float* gdn_norm_g;
    const float* ssm_conv_w; const float* ssm_conv_b; const float* ssm_a_log; const float* ssm_dt_bias; const float* ssm_d; const float* ssm_norm_g;
    const float* rwkv_mu; const float* rwkv_w0; const float* rwkv_w_up; const float* rwkv_a0; const float* rwkv_a_up; const float* rwkv_k_k; const float* rwkv_k_a;
    const float* rwkv_r_k; const float* rwkv_ln_w; const float* rwkv_ln_b; const float* w_out; const float* post_norm_g;
};


typedef short bf16x4 __attribute__((ext_vector_type(4)));
typedef unsigned v2u __attribute__((ext_vector_type(2)));
#define MFMA16(a, b, c) __builtin_amdgcn_mfma_f32_16x16x32_bf16((a), (b), (c), 0, 0, 0)
constexpr int LS = 72;
constexpr int MAT_B = 64 * LS * 2;
constexpr int LS2 = 136;
constexpr int HEAD_LDS = 73728;

typedef float f32x2_ __attribute__((ext_vector_type(2)));
typedef __bf16 bf2_ __attribute__((ext_vector_type(2)));
#ifndef HWCVT
#define HWCVT 0
#endif
__device__ __forceinline__ unsigned pk_hw(float lo, float hi) { const f32x2_ v_ = {lo, hi}; const bf2_ r_ = __builtin_convertvector(v_, bf2_); return __builtin_bit_cast(unsigned, r_); }
__device__ __forceinline__ unsigned pk_sw(float lo, float hi) { return f2bf(lo) | (f2bf(hi) << 16); }
__device__ __forceinline__ unsigned pk_bf16(float lo, float hi) { return (HWCVT & 1) ? pk_hw(lo, hi) : pk_sw(lo, hi); }
__device__ __forceinline__ bf16 cvt_bf16(float x) { return (HWCVT & 2) ? (bf16)(pk_hw(x, x) & 0xffffu) : (bf16)f2bf(x); }
__device__ __forceinline__ bf16x8 ld_frag(const LAS bf16* base, int stride, int row, int kofs, int q) {
    return *(const LAS bf16x8*)(base + row * stride + kofs + 8 * q);
}
__device__ __forceinline__ bf16x8 ld_frag_perm(const LAS bf16* base, int stride, int row, int kofs, int q) {
    const bf16x4 lo = *(const LAS bf16x4*)(base + row * stride + kofs + 4 * q);
    const bf16x4 hi = *(const LAS bf16x4*)(base + row * stride + kofs + 16 + 4 * q);
    bf16x8 v; v[0] = lo[0]; v[1] = lo[1]; v[2] = lo[2]; v[3] = lo[3]; v[4] = hi[0]; v[5] = hi[1]; v[6] = hi[2]; v[7] = hi[3]; return v;
}
__device__ __forceinline__ bf16x8 pack_frag(const f32x4& a, const f32x4& b) {
    union { unsigned u[4]; bf16x8 v; } x;
    x.u[0] = pk_bf16(a[0], a[1]); x.u[1] = pk_bf16(a[2], a[3]); x.u[2] = pk_bf16(b[0], b[1]); x.u[3] = pk_bf16(b[2], b[3]); return x.v;
}
__device__ __forceinline__ void st4(LAS bf16* base, int stride, int row, int col, const f32x4& v) {
    v2u o; o.x = pk_bf16(v[0], v[1]); o.y = pk_bf16(v[2], v[3]); *(LAS v2u*)(base + row * stride + col) = o;
}
__device__ __forceinline__ f32x4 zero4() { return (f32x4){0.f, 0.f, 0.f, 0.f}; }
#define WG_BAR() __syncthreads()

__device__ __forceinline__ void ssd_pack16(LAS bf16* dst, const float* v) {
    v4u w0, w1;
    w0.x = pk_bf16(v[0], v[1]); w0.y = pk_bf16(v[2], v[3]); w0.z = pk_bf16(v[4], v[5]); w0.w = pk_bf16(v[6], v[7]);
    w1.x = pk_bf16(v[8], v[9]); w1.y = pk_bf16(v[10], v[11]); w1.z = pk_bf16(v[12], v[13]); w1.w = pk_bf16(v[14], v[15]);
    *(LAS v4u*)dst = w0; *(LAS v4u*)(dst + 8) = w1;
}
#define RAWF(arr, j) bf2f((arr)[(j) >> 1][(j) & 1])
__device__ __forceinline__ int opaque_i(int v) { asm volatile("" : "+v"(v)); return v; }
#define RAWG(arr, j) bf2f((arr)[(j)])

template <bool HW> __device__ __forceinline__ unsigned pkx(float lo, float hi) { if constexpr (HW) return pk_hw(lo, hi); else return pk_bf16(lo, hi); }
template <bool HW> __device__ __forceinline__ bf16x8 pack_frag_x(const f32x4& a, const f32x4& b) {
    union { unsigned u[4]; bf16x8 v; } x;
    x.u[0] = pkx<HW>(a[0], a[1]); x.u[1] = pkx<HW>(a[2], a[3]); x.u[2] = pkx<HW>(b[0], b[1]); x.u[3] = pkx<HW>(b[2], b[3]); return x.v; }
template <bool HW> __device__ __forceinline__ void st4_x(LAS bf16* base, int stride, int row, int col, const f32x4& v) {
    v2u o; o.x = pkx<HW>(v[0], v[1]); o.y = pkx<HW>(v[2], v[3]); *(LAS v2u*)(base + row * stride + col) = o; }
template <bool HW> __device__ __forceinline__ void pack16_x(LAS bf16* dst, const float* v) {
    v4u w0, w1;
    w0.x = pkx<HW>(v[0], v[1]); w0.y = pkx<HW>(v[2], v[3]); w0.z = pkx<HW>(v[4], v[5]); w0.w = pkx<HW>(v[6], v[7]);
    w1.x = pkx<HW>(v[8], v[9]); w1.y = pkx<HW>(v[10], v[11]); w1.z = pkx<HW>(v[12], v[13]); w1.w = pkx<HW>(v[14], v[15]);
    *(LAS v4u*)dst = w0; *(LAS v4u*)(dst + 8) = w1; }
#ifndef HWSITES
#define HWSITES 0
#endif
#define SITE(k) (((HWSITES) >> (k)) & 1)

constexpr int CSPLIT = 18, NSEG2 = SEQ / 64 - CSPLIT;

__device__ __forceinline__ void corr_item_rms(const float* __restrict__ gain, const bf16* __restrict__ P  , bf16* __restrict__ Yb  , const int zcol  , const int ycol,
                                              const bf16* __restrict__ ZT  , const bf16* __restrict__ CB  , const int ch, const int m, const int lane) {
    const int r = lane & 15, q = lane >> 4;
    const bf16* O0 = CB; const bf16* Gm = CB + 4096;
    bf16x8 ag[2];
#pragma unroll
    for (int k = 0; k < 2; ++k) ag[k] = *(const bf16x8*)(Gm + (16 * m + r) * 64 + 32 * k + 8 * q);
    f32x4 O[4]; float ss = 0.f;
#pragma unroll
    for (int nv = 0; nv < 4; ++nv) { const v2u o0 = *(const v2u*)(O0 + (16 * m + r) * 64 + 16 * nv + 4 * q);
        O[nv][0] = __builtin_bit_cast(float, o0.x << 16); O[nv][1] = __builtin_bit_cast(float, o0.x & 0xffff0000u); O[nv][2] = __builtin_bit_cast(float, o0.y << 16); O[nv][3] = __builtin_bit_cast(float, o0.y & 0xffff0000u);
#pragma unroll
        for (int k = 0; k < 2; ++k) O[nv] = MFMA16(*(const bf16x8*)(ZT + (16 * nv + r) * 64 + 32 * k + 8 * q), ag[k], O[nv]);
        ss += (O[nv][0] * O[nv][0] + O[nv][1] * O[nv][1]) + (O[nv][2] * O[nv][2] + O[nv][3] * O[nv][3]); }
    ss += __shfl_xor(ss, 16); ss += __shfl_xor(ss, 32);
    const float rs = rsqrtf(ss * (1.f / 64.f) + 1e-6f);
    const int t = ch * 64 + 16 * m + r;
#pragma unroll
    for (int nv = 0; nv < 4; ++nv) { const int dv0 = 16 * nv + 4 * q;
        const f32x4 gg = *(const f32x4*)(gain + dv0);
        const v2u zr = *(const v2u*)(P + (size_t)t * NP + zcol + dv0);
        const float z0 = __builtin_bit_cast(float, zr.x << 16), z1 = __builtin_bit_cast(float, zr.x & 0xffff0000u), z2 = __builtin_bit_cast(float, zr.y << 16), z3 = __builtin_bit_cast(float, zr.y & 0xffff0000u);
        v2u o; o.x = pk_bf16(O[nv][0] * rs * gg[0] * siluf_(z0), O[nv][1] * rs * gg[1] * siluf_(z1)); o.y = pk_bf16(O[nv][2] * rs * gg[2] * siluf_(z2), O[nv][3] * rs * gg[3] * siluf_(z3));
        *(v2u*)(Yb + (size_t)t * DM + ycol + dv0) = o; }
}

__device__ __forceinline__ void corr_item_ssd(const float* __restrict__ gain  , const bf16* __restrict__ P, bf16* __restrict__ Yb, const int h, const int hh,
                                              const bf16* __restrict__ ZT  , const unsigned char* __restrict__ CBh  , const bf16* __restrict__ Cg  ,
                                              const int ch, const int m, const int lane, LAS float* SSx) {
    const int r = lane & 15, q = lane >> 4;
    const bf16* O0 = (const bf16*)CBh; const float sc = ((const float*)(CBh + 8192))[16 * m + r];
    bf16x8 ac[4];
#pragma unroll
    for (int k = 0; k < 4; ++k) ac[k] = *(const bf16x8*)(Cg + (16 * m + r) * 128 + 32 * k + 8 * q);
    const int t = ch * 64 + 16 * m + r;
    f32x4 yv[4]; float ss = 0.f;
#pragma unroll
    for (int nv = 0; nv < 4; ++nv) { f32x4 os = zero4();
#pragma unroll
        for (int k = 0; k < 4; ++k) os = MFMA16(*(const bf16x8*)(ZT + (16 * nv + r) * 128 + 32 * k + 8 * q), ac[k], os);
        const v2u o0 = *(const v2u*)(O0 + (16 * m + r) * 64 + 16 * nv + 4 * q);
        const v2u zr = *(const v2u*)(P + (size_t)t * NP + C_Z + 512 + h * 64 + 16 * nv + 4 * q);
        const float z0 = __builtin_bit_cast(float, zr.x << 16), z1 = __builtin_bit_cast(float, zr.x & 0xffff0000u), z2 = __builtin_bit_cast(float, zr.y << 16), z3 = __builtin_bit_cast(float, zr.y & 0xffff0000u);
        yv[nv][0] = (__builtin_bit_cast(float, o0.x << 16) + sc * os[0]) * siluf_(z0); yv[nv][1] = (__builtin_bit_cast(float, o0.x & 0xffff0000u) + sc * os[1]) * siluf_(z1);
        yv[nv][2] = (__builtin_bit_cast(float, o0.y << 16) + sc * os[2]) * siluf_(z2); yv[nv][3] = (__builtin_bit_cast(float, o0.y & 0xffff0000u) + sc * os[3]) * siluf_(z3);
        ss += (yv[nv][0] * yv[nv][0] + yv[nv][1] * yv[nv][1]) + (yv[nv][2] * yv[nv][2] + yv[nv][3] * yv[nv][3]); }
    ss += __shfl_xor(ss, 16); ss += __shfl_xor(ss, 32);
    if (q == 0) SSx[hh * 64 + 16 * m + r] = ss;
    __syncthreads();
    const float tot = SSx[16 * m + r] + SSx[64 + 16 * m + r];
    const float rs = rsqrtf(tot * (1.f / 128.f) + 1e-6f);
#pragma unroll
    for (int nv = 0; nv < 4; ++nv) { const f32x4 gg = *(const f32x4*)(gain + 16 * nv + 4 * q); v2u o; o.x = pk_bf16(yv[nv][0] * rs * gg[0], yv[nv][1] * rs * gg[1]); o.y = pk_bf16(yv[nv][2] * rs * gg[2], yv[nv][3] * rs * gg[3]);
        *(v2u*)(Yb + (size_t)t * DM + 512 + h * 64 + 16 * nv + 4 * q) = o; }
    __syncthreads();
}

__device__ __forceinline__ void corr_item_rwkv(const Inputs& in, const int layer, const bf16* __restrict__ P, bf16* __restrict__ Yb, const int h, const bf16* __restrict__ ZT, const unsigned char* __restrict__ CB,
                                               const int ch, const int m, const int lane) {
    const int r = lane & 15, q = lane >> 4;
    const bf16* O0 = (const bf16*)CB; const bf16* Gm = (const bf16*)(CB + 8192); const float bon = ((const float*)(CB + 16384))[16 * m + r];
    bf16x8 ag[2];
#pragma unroll
    for (int k = 0; k < 2; ++k) ag[k] = *(const bf16x8*)(Gm + (16 * m + r) * 64 + 32 * k + 8 * q);
    f32x4 O[4]; float s1 = 0.f;
#pragma unroll
    for (int nv = 0; nv < 4; ++nv) { const v2u o0 = *(const v2u*)(O0 + (16 * m + r) * 64 + 16 * nv + 4 * q);
        O[nv][0] = __builtin_bit_cast(float, o0.x << 16); O[nv][1] = __builtin_bit_cast(float, o0.x & 0xffff0000u); O[nv][2] = __builtin_bit_cast(float, o0.y << 16); O[nv][3] = __builtin_bit_cast(float, o0.y & 0xffff0000u);
#pragma unroll
        for (int k = 0; k < 2; ++k) O[nv] = MFMA16(*(const bf16x8*)(ZT + (16 * nv + r) * 64 + 32 * k + 8 * q), ag[k], O[nv]);
        s1 += (O[nv][0] + O[nv][1]) + (O[nv][2] + O[nv][3]); }
    s1 += __shfl_xor(s1, 16); s1 += __shfl_xor(s1, 32);
    const float mean = s1 * (1.f / 64.f); float s2 = 0.f;
#pragma unroll
    for (int nv = 0; nv < 4; ++nv) { O[nv] = O[nv] - mean; s2 += (O[nv][0] * O[nv][0] + O[nv][1] * O[nv][1]) + (O[nv][2] * O[nv][2] + O[nv][3] * O[nv][3]); }
    s2 += __shfl_xor(s2, 16); s2 += __shfl_xor(s2, 32);
    const float rstd = rsqrtf(s2 * (1.f / 64.f) + 64e-5f);
    const int t = ch * 64 + 16 * m + r;
    const float* mu = in.rwkv_mu + (size_t)layer * 896 + 512 + h * 64;
#pragma unroll
    for (int nv = 0; nv < 4; ++nv) { const int dv0 = 16 * nv + 4 * q, cc = h * 64 + dv0;
        const f32x4 lw4 = *(const f32x4*)(in.rwkv_ln_w + layer * GW + cc); const f32x4 lb4 = *(const f32x4*)(in.rwkv_ln_b + layer * GW + cc); const f32x4 mu4 = *(const f32x4*)(mu + dv0);
        const v2u zr = *(const v2u*)(P + (size_t)t * NP + C_Z + 768 + cc);
        const v2u vx = *(const v2u*)(P + (size_t)t * NP + C_RW_V + cc); const v2u vp = *(const v2u*)(P + (size_t)(t - 1) * NP + C_RW_V + cc);
        const float z0 = __builtin_bit_cast(float, zr.x << 16), z1 = __builtin_bit_cast(float, zr.x & 0xffff0000u), z2 = __builtin_bit_cast(float, zr.y << 16), z3 = __builtin_bit_cast(float, zr.y & 0xffff0000u);
        const float x0 = __builtin_bit_cast(float, vx.x << 16), x1 = __builtin_bit_cast(float, vx.x & 0xffff0000u), x2 = __builtin_bit_cast(float, vx.y << 16), x3 = __builtin_bit_cast(float, vx.y & 0xffff0000u);
        const float p0 = __builtin_bit_cast(float, vp.x << 16), p1 = __builtin_bit_cast(float, vp.x & 0xffff0000u), p2 = __builtin_bit_cast(float, vp.y << 16), p3 = __builtin_bit_cast(float, vp.y & 0xffff0000u);
        const float v0 = x0 + (p0 - x0) * mu4[0], v1 = x1 + (p1 - x1) * mu4[1], v2 = x2 + (p2 - x2) * mu4[2], v3 = x3 + (p3 - x3) * mu4[3];
        v2u o; o.x = pk_bf16((O[nv][0] * rstd * lw4[0] + lb4[0] + bon * v0) * siluf_(z0), (O[nv][1] * rstd * lw4[1] + lb4[1] + bon * v1) * siluf_(z1));
        o.y = pk_bf16((O[nv][2] * rstd * lw4[2] + lb4[2] + bon * v2) * siluf_(z2), (O[nv][3] * rstd * lw4[3] + lb4[3] + bon * v3) * siluf_(z3));
        *(v2u*)(Yb + (size_t)t * DM + 768 + cc) = o; }
}

template <int NH> __device__ __forceinline__ void mixopt_hgrn(const Inputs& in, const int layer, const bf16* __restrict__ PROJ, bf16* __restrict__ Yg, LAS unsigned char* ldsw, const int b, const int hp, const int tid,
                                                              const int seg, bf16* __restrict__ sbuf, bf16* __restrict__ cbuf) {
    const int ch_lo = (seg == 2) ? CSPLIT : 0, ch_hi = (seg == 1) ? CSPLIT : SEQ / 64;
    const int lane = tid & 63, wave = __builtin_amdgcn_readfirstlane(tid >> 6), hh = wave >> 2, w4 = wave & 3, h = (NH == 2) ? hp * 2 + hh : hp, r = lane & 15, q = lane >> 4;
    const bool act = (NH == 2) || (hh == 0);
    LAS unsigned char* L = ldsw + hh * HEAD_LDS;
    LAS bf16* QT = (LAS bf16*)L; LAS bf16* KA = (LAS bf16*)(L + MAT_B); LAS bf16* KB = (LAS bf16*)(L + 2 * MAT_B); LAS bf16* R2 = (LAS bf16*)(L + 3 * MAT_B);
    LAS bf16* KDT = (LAS bf16*)(L + 4 * MAT_B); LAS bf16* VT = (LAS bf16*)(L + 5 * MAT_B); LAS bf16* ZT = (LAS bf16*)(L + 6 * MAT_B);
    LAS float* QTOT = (LAS float*)(L + 7 * MAT_B); LAS float* ELAST = QTOT + 256;
    const bf16* P = PROJ + (size_t)b * SEQ * NP; bf16* Yb = Yg + (size_t)b * SEQ * DM;
    const int c = h * 64 + lane;
    float lbv = 0.f;
    if (layer == 1) { const float x0 = in.hgrn_lb[c], x1 = in.hgrn_lb[GW + c]; const float mx = fmaxf(x0, x1); const float e0 = __expf(x0 - mx), e1 = __expf(x1 - mx); lbv = e1 / (e0 + e1); }
    f32x4 gn[4];
#pragma unroll
    for (int nv = 0; nv < 4; ++nv) gn[nv] = *(const f32x4*)(in.hgrn_norm_g + layer * HD + 16 * nv + 4 * q);
    f32x4 zs[4];
#pragma unroll
    for (int n = 0; n < 4; ++n) zs[n] = zero4();
    bf16 rq[16], rf[16], rv[16];
    if (act) { const bf16* p0 = P + (size_t)(ch_lo * 64 + 16 * w4) * NP;
#pragma unroll
      for (int i = 0; i < 16; ++i) { rq[i] = p0[(size_t)i * NP + C_HG_Q + c]; rf[i] = p0[(size_t)i * NP + C_HG_F + c]; rv[i] = p0[(size_t)i * NP + C_HG_I + c]; } }
    float phis = 0.f;
    for (int ch = ch_lo; ch < ch_hi; ++ch) {
        float qv[16], kv[16], cl[16], vv[16]; float run = 0.f;
        if (act) {
#pragma unroll
        for (int i = 0; i < 16; ++i) { const float x = bf2f(rq[i]); qv[i] = siluf_(x) * 0.125f; const float f = lbv + (1.f - lbv) * sigmoidf_(bf2f(rf[i])); kv[i] = 1.f - f; run += __logf(f); cl[i] = run; vv[i] = bf2f(rv[i]); }
        QTOT[w4 * 64 + lane] = run;
        if (ch + 1 < ch_hi) { const bf16* p0 = P + (size_t)((ch + 1) * 64 + 16 * w4) * NP;
#pragma unroll
            for (int i = 0; i < 16; ++i) { rq[i] = p0[(size_t)i * NP + C_HG_Q + c]; rf[i] = p0[(size_t)i * NP + C_HG_F + c]; rv[i] = p0[(size_t)i * NP + C_HG_I + c]; } }
        }
        WG_BAR();
        if (act) {
            const float o0 = QTOT[lane], o1 = QTOT[64 + lane], o2 = QTOT[128 + lane], o3 = QTOT[192 + lane];
            const float base = (w4 > 0 ? o0 : 0.f) + (w4 > 1 ? o1 : 0.f) + (w4 > 2 ? o2 : 0.f);
            const float c31 = o0 + o1, c63 = c31 + o2 + o3, cI = (w4 >= 2) ? c31 : 0.f;
            float kd[16];
#pragma unroll
            for (int i = 0; i < 16; ++i) { const float cum = cl[i] + base; const int t = 16 * w4 + i;
                QT[t * LS + lane] = cvt_bf16(qv[i] * __expf(cum - cI));
                KA[t * LS + lane] = cvt_bf16(kv[i] * __expf(fminf(cI - cum, 80.f)));
                if (w4 < 2) KB[t * LS + lane] = cvt_bf16(kv[i] * __expf(c31 - cum));
                R2[t * LS + lane] = cvt_bf16(qv[i] * __expf(cum));
                if (seg == 2) cbuf[(size_t)(ch - CSPLIT) * 8192 + 4096 + t * 64 + lane] = cvt_bf16(qv[i] * __expf(cum + phis));
                kd[i] = kv[i] * __expf(c63 - cum); }
            v4u w0, w1;
            w0.x = pk_bf16(kd[0], kd[1]); w0.y = pk_bf16(kd[2], kd[3]); w0.z = pk_bf16(kd[4], kd[5]); w0.w = pk_bf16(kd[6], kd[7]);
            w1.x = pk_bf16(kd[8], kd[9]); w1.y = pk_bf16(kd[10], kd[11]); w1.z = pk_bf16(kd[12], kd[13]); w1.w = pk_bf16(kd[14], kd[15]);
            *(LAS v4u*)(KDT + lane * LS + 16 * w4) = w0; *(LAS v4u*)(KDT + lane * LS + 16 * w4 + 8) = w1;
            w0.x = pk_bf16(vv[0], vv[1]); w0.y = pk_bf16(vv[2], vv[3]); w0.z = pk_bf16(vv[4], vv[5]); w0.w = pk_bf16(vv[6], vv[7]);
            w1.x = pk_bf16(vv[8], vv[9]); w1.y = pk_bf16(vv[10], vv[11]); w1.z = pk_bf16(vv[12], vv[13]); w1.w = pk_bf16(vv[14], vv[15]);
            *(LAS v4u*)(VT + lane * LS + 16 * w4) = w0; *(LAS v4u*)(VT + lane * LS + 16 * w4 + 8) = w1;
            if (w4 == 0) ELAST[lane] = __expf(c63);
            phis += c63;
#pragma unroll
            for (int n = 0; n < 4; ++n) st4(ZT, LS, 16 * n + r, 16 * w4 + 4 * q, zs[n]);
        }
        WG_BAR();
        if (act) {
            const int m = w4;
            f32x4 Pt[4];
#pragma unroll
            for (int n = 0; n < 4; ++n) Pt[n] = zero4();
            bf16x8 aq[2];
#pragma unroll
            for (int k = 0; k < 2; ++k) aq[k] = ld_frag(QT, LS, 16 * m + r, 32 * k, q);
#pragma unroll
            for (int n = 0; n < 4; ++n) if (n <= m) {
                const LAS bf16* Bs = ((n >> 1) == (m >> 1)) ? KA : KB;
#pragma unroll
                for (int k = 0; k < 2; ++k) Pt[n] = MFMA16(ld_frag(Bs, LS, 16 * n + r, 32 * k, q), aq[k], Pt[n]);
                if (n == m) {
#pragma unroll
                    for (int i = 0; i < 4; ++i) if (4 * q + i > r) Pt[n][i] = 0.f; }
            }
            f32x4 O[4];
#pragma unroll
            for (int nv = 0; nv < 4; ++nv) O[nv] = zero4();
#pragma unroll
            for (int k = 0; k < 2; ++k) if (2 * k <= m) { const bf16x8 pf = pack_frag(Pt[2 * k], Pt[2 * k + 1]);
#pragma unroll
                for (int nv = 0; nv < 4; ++nv) O[nv] = MFMA16(ld_frag_perm(VT, LS, 16 * nv + r, 32 * k, q), pf, O[nv]); }
#pragma unroll
            for (int k = 0; k < 2; ++k) { const bf16x8 ar = ld_frag(R2, LS, 16 * m + r, 32 * k, q);
#pragma unroll
                for (int nv = 0; nv < 4; ++nv) O[nv] = MFMA16(ld_frag(ZT, LS, 16 * nv + r, 32 * k, q), ar, O[nv]); }
            if (seg == 2) {
#pragma unroll
                for (int nv = 0; nv < 4; ++nv) { v2u o; o.x = pk_bf16(O[nv][0], O[nv][1]); o.y = pk_bf16(O[nv][2], O[nv][3]);
                    *(v2u*)(cbuf + (size_t)(ch - CSPLIT) * 8192 + (16 * m + r) * 64 + 16 * nv + 4 * q) = o; }
            } else {
            float ss = 0.f;
#pragma unroll
            for (int nv = 0; nv < 4; ++nv) ss += (O[nv][0] * O[nv][0] + O[nv][1] * O[nv][1]) + (O[nv][2] * O[nv][2] + O[nv][3] * O[nv][3]);
            ss += __shfl_xor(ss, 16); ss += __shfl_xor(ss, 32);
            const float rs = rsqrtf(ss * (1.f / 64.f) + 1e-6f);
            const int t = ch * 64 + 16 * m + r;
#pragma unroll
            for (int nv = 0; nv < 4; ++nv) { const int dv0 = h * 64 + 16 * nv + 4 * q;
                const v2u zr = *(const v2u*)(P + (size_t)t * NP + C_Z + 0 + dv0);
                const float z0 = __builtin_bit_cast(float, zr.x << 16), z1 = __builtin_bit_cast(float, zr.x & 0xffff0000u), z2 = __builtin_bit_cast(float, zr.y << 16), z3 = __builtin_bit_cast(float, zr.y & 0xffff0000u);
                v2u o; o.x = pk_bf16(O[nv][0] * rs * gn[nv][0] * siluf_(z0), O[nv][1] * rs * gn[nv][1] * siluf_(z1));
                o.y = pk_bf16(O[nv][2] * rs * gn[nv][2] * siluf_(z2), O[nv][3] * rs * gn[nv][3] * siluf_(z3));
                *(v2u*)(Yb + (size_t)t * DM + 0 + dv0) = o; }
            }
            const f32x4 el = *(const LAS f32x4*)(ELAST + 16 * w4 + 4 * q);
            bf16x8 ak[2];
#pragma unroll
            for (int k = 0; k < 2; ++k) ak[k] = ld_frag(KDT, LS, 16 * w4 + r, 32 * k, q);
#pragma unroll
            for (int n = 0; n < 4; ++n) { zs[n] = zs[n] * el;
#pragma unroll
                for (int k = 0; k < 2; ++k) zs[n] = MFMA16(ak[k], ld_frag(VT, LS, 16 * n + r, 32 * k, q), zs[n]); }
        }
        WG_BAR();
    }
    if (seg == 1 && act) {
#pragma unroll
        for (int n = 0; n < 4; ++n) { v2u o; o.x = pk_bf16(zs[n][0], zs[n][1]); o.y = pk_bf16(zs[n][2], zs[n][3]); *(v2u*)(sbuf + (16 * n + r) * 64 + 16 * w4 + 4 * q) = o; }
    }
}

__device__ __forceinline__ float tr_reduce16(const float* v, int lane) {
    float a[8], b[4], c[2], d;
    const bool b5 = lane & 32, b4 = lane & 16, b3 = lane & 8, b2 = lane & 4;
#pragma unroll
    for (int j = 0; j < 8; ++j) { const float snd = b5 ? v[j] : v[8 + j]; const float got = __shfl_xor(snd, 32); a[j] = (b5 ? v[8 + j] : v[j]) + got; }
#pragma unroll
    for (int j = 0; j < 4; ++j) { const float snd = b4 ? a[j] : a[4 + j]; const float got = __shfl_xor(snd, 16); b[j] = (b4 ? a[4 + j] : a[j]) + got; }
#pragma unroll
    for (int j = 0; j < 2; ++j) { const float snd = b3 ? b[j] : b[2 + j]; const float got = __shfl_xor(snd, 8); c[j] = (b3 ? b[2 + j] : b[j]) + got; }
    { const float snd = b2 ? c[0] : c[1]; const float got = __shfl_xor(snd, 4); d = (b2 ? c[1] : c[0]) + got; }
    d += __shfl_xor(d, 2); d += __shfl_xor(d, 1);
    return d;
}
__device__ __forceinline__ float rdlane(float x, int l) { return __builtin_bit_cast(float, __builtin_amdgcn_readlane(__builtin_bit_cast(int, x), l)); }

template <bool SW = false> __device__ __forceinline__ void diag_inverse(const LAS float* AD, LAS bf16* DT, int lane) {
    const int j = lane >> 4, c = lane & 15;
    const LAS float* A = AD + j * 256;
    float x[16];
#pragma unroll
    for (int i = 0; i < 16; ++i) {
        float s = (i == c) ? 1.f : 0.f;
#pragma unroll
        for (int k4 = 0; k4 < i; k4 += 4) { const f32x4 a = *(const LAS f32x4*)(A + i * 16 + k4);
#pragma unroll
            for (int kk = 0; kk < 4; ++kk) if (k4 + kk < i) s -= a[kk] * x[k4 + kk]; }
        x[i] = s;
    }
    v4u w0, w1;
    w0.x = pkx<SW>(x[0], x[1]); w0.y = pkx<SW>(x[2], x[3]); w0.z = pkx<SW>(x[4], x[5]); w0.w = pkx<SW>(x[6], x[7]);
    w1.x = pkx<SW>(x[8], x[9]); w1.y = pkx<SW>(x[10], x[11]); w1.z = pkx<SW>(x[12], x[13]); w1.w = pkx<SW>(x[14], x[15]);
    *(LAS v4u*)(DT + (j * 16 + c) * 16) = w0; *(LAS v4u*)(DT + (j * 16 + c) * 16 + 8) = w1;
}
__device__ __forceinline__ bf16x8 half_frag_lds(const LAS bf16* p) { const bf16x4 lo = *(const LAS bf16x4*)p; bf16x8 v; v[0] = lo[0]; v[1] = lo[1]; v[2] = lo[2]; v[3] = lo[3]; v[4] = 0; v[5] = 0; v[6] = 0; v[7] = 0; return v; }
__device__ __forceinline__ bf16x8 two_frag_lds(const LAS bf16* p0, const LAS bf16* p1) { const bf16x4 lo = *(const LAS bf16x4*)p0; const bf16x4 hi = *(const LAS bf16x4*)p1; bf16x8 v; v[0] = lo[0]; v[1] = lo[1]; v[2] = lo[2]; v[3] = lo[3]; v[4] = hi[0]; v[5] = hi[1]; v[6] = hi[2]; v[7] = hi[3]; return v; }
template <bool SW = false> __device__ __forceinline__ void tri_inverse_row(const LAS bf16* AMT, const LAS bf16* DT, int m, int r, int q, f32x4* Tm) {
    const f32x4 z4 = zero4();
    f32x4 dm;
#pragma unroll
    for (int i = 0; i < 4; ++i) dm[i] = bf2f(DT[(m * 16 + 4 * q + i) * 16 + r]);
#pragma unroll
    for (int n = 0; n < 4; ++n) Tm[n] = (n == m) ? dm : z4;
#pragma unroll
    for (int j = 2; j >= 0; --j) if (j < m) {
        f32x4 X = z4;
#pragma unroll
        for (int k = j + 1; k <= 3; k += 2) if (k <= m) {
            const LAS bf16* p0 = AMT + (16 * j + r) * LS + 16 * k + 4 * q;
            if (k + 1 <= 3) { const bf16x8 af = pack_frag_x<SW>(Tm[k], Tm[k + 1]); const bf16x8 bfr = two_frag_lds(p0, p0 + 16); X = MFMA16(bfr, af, X); }
            else { const bf16x8 af = pack_frag_x<SW>(Tm[k], z4); const bf16x8 bfr = half_frag_lds(p0); X = MFMA16(bfr, af, X); }
        }
        const bf16x8 xf = pack_frag_x<SW>(X, z4);
        const bf16x8 df = half_frag_lds(DT + (j * 16 + r) * 16 + 4 * q);
        const f32x4 Tj = MFMA16(df, xf, z4);
        Tm[j] = -Tj;
    }
}

__device__ __forceinline__ void mixopt_gdn(const Inputs& in, const int layer, const bf16* __restrict__ PROJ, bf16* __restrict__ Yg, LAS unsigned char* ldsw, const int b, const int hp, const int tid) {
    const int lane0 = tid & 63, wave = __builtin_amdgcn_readfirstlane(tid >> 6), hh = wave >> 2, w4 = wave & 3, h = hp * 2 + hh;
    LAS unsigned char* L = ldsw + hh * HEAD_LDS;
    LAS bf16* Qm = (LAS bf16*)L; LAS bf16* Km = (LAS bf16*)(L + 9216); LAS bf16* KT = (LAS bf16*)(L + 18432); LAS bf16* VT = (LAS bf16*)(L + 27648); LAS bf16* ZT = (LAS bf16*)(L + 36864);
    LAS bf16* AMT = (LAS bf16*)(L + 46080); LAS bf16* RHST = (LAS bf16*)(L + 55296); LAS float* AD = (LAS float*)(L + 64512); LAS bf16* DT = (LAS bf16*)(L + 68608);
    LAS float* CUM = (LAS float*)(L + 70656); LAS float* ECUM = CUM + 64; LAS float* BETA = CUM + 128; LAS float* WSC = CUM + 192;
    LAS bf16* VNWT = Km; LAS bf16* VNT = VT;
    const bf16* P = PROJ + (size_t)b * SEQ * NP; bf16* Yb = Yg + (size_t)b * SEQ * DM;
    const float* cw = in.gdn_conv_w + (size_t)layer * 4 * 768 + h * 64;
    const float Aneg = -__expf(in.gdn_a_log[layer * 4 + h]), dtb = in.gdn_dt_bias[layer * 4 + h];
    f32x4 zs[4];
#pragma unroll
    for (int n = 0; n < 4; ++n) zs[n] = zero4();
    typedef unsigned short us2 __attribute__((ext_vector_type(2)));
    bf16 rq[19], rk[19], rv[19]; bf16 rbt, rat;
    auto load_raw = [&](int ch, int lane) {
        const int c = h * 64 + lane;
        const int tb = ch * 64 + 16 * w4 - 3;
#pragma unroll
        for (int j = 0; j < 19; ++j) { const int t = tb + j; const bool ok = (t >= 0); const bf16* p0 = P + (size_t)(ok ? t : 0) * NP;
            const bf16 a = p0[C_GD_Q + c], bb = p0[C_GD_K + c], cc = p0[C_GD_V + c];
            rq[j] = ok ? a : (bf16)0; rk[j] = ok ? bb : (bf16)0; rv[j] = ok ? cc : (bf16)0; }
        rbt = P[(size_t)(ch * 64 + lane) * NP + C_GD_BETA + h]; rat = P[(size_t)(ch * 64 + lane) * NP + C_GD_DEC + h];
    };
    load_raw(0, lane0);
    for (int ch = 0; ch < SEQ / 64; ++ch) {
        const int lane = opaque_i(lane0), r = lane & 15, q = lane >> 4;
#ifndef GDN_REP
#define GDN_REP 0
#endif
        {
            float tv[16];
            float wq[4], wk[4], wv[4];
#pragma unroll
            for (int j = 0; j < 4; ++j) { wq[j] = cw[j * 768 + lane]; wk[j] = cw[j * 768 + 256 + lane]; wv[j] = cw[j * 768 + 512 + lane]; }
#pragma unroll
            for (int i = 0; i < 16; ++i) tv[i] = siluf_(wk[0] * RAWG(rk, i) + wk[1] * RAWG(rk, i + 1) + wk[2] * RAWG(rk, i + 2) + wk[3] * RAWG(rk, i + 3));
            { float sq[16];
#pragma unroll
              for (int i = 0; i < 16; ++i) sq[i] = tv[i] * tv[i];
              const float sred = tr_reduce16(sq, lane);
#pragma unroll
              for (int i = 0; i < 16; ++i) { tv[i] *= rsqrtf(rdlane(sred, 4 * i) + 1e-6f); Km[(16 * w4 + i) * LS + lane] = cvt_bf16(tv[i]); } }
            pack16_x<SITE(0)>(KT + lane * LS + 16 * w4, tv);
            asm volatile("" ::: "memory");
#pragma unroll
            for (int i = 0; i < 16; ++i) tv[i] = siluf_(wq[0] * RAWG(rq, i) + wq[1] * RAWG(rq, i + 1) + wq[2] * RAWG(rq, i + 2) + wq[3] * RAWG(rq, i + 3));
            { float sq[16];
#pragma unroll
              for (int i = 0; i < 16; ++i) sq[i] = tv[i] * tv[i];
              const float sred = tr_reduce16(sq, lane);
#pragma unroll
              for (int i = 0; i < 16; ++i) Qm[(16 * w4 + i) * LS + lane] = cvt_bf16(tv[i] * rsqrtf(rdlane(sred, 4 * i) + 1e-6f) * 0.125f); }
            asm volatile("" ::: "memory");
#pragma unroll
            for (int i = 0; i < 16; ++i) tv[i] = siluf_(wv[0] * RAWG(rv, i) + wv[1] * RAWG(rv, i + 1) + wv[2] * RAWG(rv, i + 2) + wv[3] * RAWG(rv, i + 3));
            pack16_x<SITE(0)>(VT + lane * LS + 16 * w4, tv);
            if (w4 == 0) {
                const float beta = sigmoidf_(bf2f(rbt)); float cs = Aneg * softplusf_(bf2f(rat) + dtb);
#pragma unroll
                for (int o = 1; o < 64; o <<= 1) { const float u = __shfl_up(cs, o); if (lane >= o) cs += u; }
                const float c63 = __shfl(cs, 63);
                CUM[lane] = cs; ECUM[lane] = __expf(cs); BETA[lane] = beta; WSC[lane] = __expf(c63 - cs);
            }
#pragma unroll
            for (int n = 0; n < 4; ++n) st4_x<SITE(1)>(ZT, LS, 16 * n + r, 16 * w4 + 4 * q, zs[n]);
        }
        WG_BAR();
        const int m = w4;
        f32x4 QK[4];
        { const int lane = opaque_i(lane0), r = lane & 15, q = lane >> 4;
        {
            bf16x8 ak[2], aq[2];
#pragma unroll
            for (int k = 0; k < 2; ++k) { ak[k] = ld_frag(Km, LS, 16 * m + r, 32 * k, q); aq[k] = ld_frag(Qm, LS, 16 * m + r, 32 * k, q); }
            const f32x4 cumt4 = *(const LAS f32x4*)(CUM + 16 * m + 4 * q);
            const f32x4 bet4 = *(const LAS f32x4*)(BETA + 16 * m + 4 * q);
            const f32x4 ecum4 = *(const LAS f32x4*)(ECUM + 16 * m + 4 * q);
            const float cumr = CUM[16 * m + r];
#pragma unroll
            for (int n = 0; n < 4; ++n) { QK[n] = zero4(); if (n <= m) {
                f32x4 kk = zero4();
#pragma unroll
                for (int k = 0; k < 2; ++k) { const bf16x8 bk = ld_frag(Km, LS, 16 * n + r, 32 * k, q);
                    kk = MFMA16(ak[k], bk, kk);
                    QK[n] = MFMA16(bk, aq[k], QK[n]); }
                const float cums = CUM[16 * n + r];
                f32x4 av;
#pragma unroll
                for (int i = 0; i < 4; ++i) { const bool keep = (n < m) || (r < 4 * q + i); av[i] = keep ? bet4[i] * kk[i] * __expf(cumt4[i] - cums) : 0.f; }
                st4_x<SITE(2)>(AMT, LS, 16 * n + r, 16 * m + 4 * q, av);
                if (n == m) {
#pragma unroll
                    for (int i = 0; i < 4; ++i) AD[m * 256 + (4 * q + i) * 16 + r] = av[i]; }
                const f32x4 cs4 = *(const LAS f32x4*)(CUM + 16 * n + 4 * q);
#pragma unroll
                for (int i = 0; i < 4; ++i) { const bool keep = (n < m) || (4 * q + i <= r); QK[n][i] = keep ? QK[n][i] * __expf(cumr - cs4[i]) : 0.f; }
            } }
#pragma unroll
            for (int nv = 0; nv < 4; ++nv) { f32x4 kz = zero4();
#pragma unroll
                for (int k = 0; k < 2; ++k) kz = MFMA16(ak[k], ld_frag(ZT, LS, 16 * nv + r, 32 * k, q), kz);
                const v2u vr = *(const LAS v2u*)(VT + (16 * nv + r) * LS + 16 * m + 4 * q);
                f32x4 rh;
                rh[0] = bet4[0] * (__builtin_bit_cast(float, vr.x << 16) - ecum4[0] * kz[0]); rh[1] = bet4[1] * (__builtin_bit_cast(float, vr.x & 0xffff0000u) - ecum4[1] * kz[1]);
                rh[2] = bet4[2] * (__builtin_bit_cast(float, vr.y << 16) - ecum4[2] * kz[2]); rh[3] = bet4[3] * (__builtin_bit_cast(float, vr.y & 0xffff0000u) - ecum4[3] * kz[3]);
                st4_x<SITE(2)>(RHST, LS, 16 * nv + r, 16 * m + 4 * q, rh); }
        }
        }
        WG_BAR();
        { const int lane = opaque_i(lane0), r = lane & 15, q = lane >> 4;
        if (ch + 1 < SEQ / 64) load_raw(ch + 1, lane);
        {
            diag_inverse<SITE(5)>(AD, DT, lane);
            asm volatile("s_waitcnt lgkmcnt(0)" ::: "memory");
            f32x4 Tm[4];
            tri_inverse_row<SITE(6)>(AMT, DT, m, r, q, Tm);
            const f32x4 w4v = *(const LAS f32x4*)(WSC + 16 * m + 4 * q);
            const bf16x8 t0 = pack_frag_x<SITE(3)>(Tm[0], Tm[1]), t1 = pack_frag_x<SITE(3)>(Tm[2], Tm[3]);
#pragma unroll
            for (int nv = 0; nv < 4; ++nv) { f32x4 vn = zero4();
                vn = MFMA16(t0, ld_frag_perm(RHST, LS, 16 * nv + r, 0, q), vn);
                if (m >= 2) vn = MFMA16(t1, ld_frag_perm(RHST, LS, 16 * nv + r, 32, q), vn);
                st4_x<SITE(3)>(VNT, LS, 16 * nv + r, 16 * m + 4 * q, vn);
                st4_x<SITE(3)>(VNWT, LS, 16 * nv + r, 16 * m + 4 * q, vn * w4v); }
        }
        }
        WG_BAR();
        { const int lane = opaque_i(lane0), r = lane & 15, q = lane >> 4; const float* gnp = in.gdn_norm_g + layer * HD + 4 * q;
        {
            f32x4 O[4];
            bf16x8 aq[2];
#pragma unroll
            for (int k = 0; k < 2; ++k) aq[k] = ld_frag(Qm, LS, 16 * m + r, 32 * k, q);
            const float ect = ECUM[16 * m + r];
            const bf16x8 p0 = pack_frag_x<SITE(4)>(QK[0], QK[1]), p1 = pack_frag_x<SITE(4)>(QK[2], QK[3]);
            float ss = 0.f;
#pragma unroll
            for (int nv = 0; nv < 4; ++nv) { O[nv] = zero4();
#pragma unroll
                for (int k = 0; k < 2; ++k) O[nv] = MFMA16(ld_frag(ZT, LS, 16 * nv + r, 32 * k, q), aq[k], O[nv]);
                O[nv] = O[nv] * ect;
                O[nv] = MFMA16(ld_frag_perm(VNT, LS, 16 * nv + r, 0, q), p0, O[nv]);
                if (m >= 2) O[nv] = MFMA16(ld_frag_perm(VNT, LS, 16 * nv + r, 32, q), p1, O[nv]);
                ss += (O[nv][0] * O[nv][0] + O[nv][1] * O[nv][1]) + (O[nv][2] * O[nv][2] + O[nv][3] * O[nv][3]); }
            ss += __shfl_xor(ss, 16); ss += __shfl_xor(ss, 32);
            const float rs = rsqrtf(ss * (1.f / 64.f) + 1e-6f);
            const int t = ch * 64 + 16 * m + r;
#pragma unroll
            for (int nv = 0; nv < 4; ++nv) { const int dv0 = h * 64 + 16 * nv + 4 * q;
                const f32x4 gg = *(const f32x4*)(gnp + 16 * nv);
                const v2u zr = *(const v2u*)(P + (size_t)t * NP + C_Z + 256 + dv0);
                const float z0 = __builtin_bit_cast(float, zr.x << 16), z1 = __builtin_bit_cast(float, zr.x & 0xffff0000u), z2 = __builtin_bit_cast(float, zr.y << 16), z3 = __builtin_bit_cast(float, zr.y & 0xffff0000u);
                v2u o; o.x = pkx<SITE(4)>(O[nv][0] * rs * gg[0] * siluf_(z0), O[nv][1] * rs * gg[1] * siluf_(z1)); o.y = pkx<SITE(4)>(O[nv][2] * rs * gg[2] * siluf_(z2), O[nv][3] * rs * gg[3] * siluf_(z3));
                *(v2u*)(Yb + (size_t)t * DM + 256 + dv0) = o; }
            const float last = ECUM[63];
            bf16x8 akt[2];
#pragma unroll
            for (int k = 0; k < 2; ++k) akt[k] = ld_frag(KT, LS, 16 * w4 + r, 32 * k, q);
#pragma unroll
            for (int n = 0; n < 4; ++n) { zs[n] = zs[n] * last;
#pragma unroll
                for (int k = 0; k < 2; ++k) zs[n] = MFMA16(akt[k], ld_frag(VNWT, LS, 16 * n + r, 32 * k, q), zs[n]); }
        }
        }
        WG_BAR();
    }
}

__device__ __forceinline__ void mixopt_gdn2(const Inputs& in, const int layer, const bf16* __restrict__ PROJ, bf16* __restrict__ Yg, LAS unsigned char* L, const int b, const int h, const int tid,
                                            const int seg, bf16* __restrict__ sbuf, bf16* __restrict__ cbuf) {
    const int ch_lo = (seg == 2) ? CSPLIT : 0, ch_hi = (seg == 1) ? CSPLIT : SEQ / 64;
    LAS bf16* PT = (LAS bf16*)(L + 80896); LAS bf16* RHSHT = (LAS bf16*)(L + 90112); LAS bf16* VNHT = (LAS bf16*)(L + 99328); LAS bf16* VNHWT = (LAS bf16*)(L + 108544);
    const int lane0 = tid & 63, wave = __builtin_amdgcn_readfirstlane(tid >> 6), grp = wave >> 2, w4 = wave & 3;
    LAS bf16* Qm = (LAS bf16*)L; LAS bf16* Km = (LAS bf16*)(L + 9216); LAS bf16* KT = (LAS bf16*)(L + 18432); LAS bf16* VT = (LAS bf16*)(L + 27648); LAS bf16* ZT = (LAS bf16*)(L + 36864);
    LAS bf16* AMT = (LAS bf16*)(L + 46080); LAS bf16* RHST = (LAS bf16*)(L + 55296); LAS bf16* QKM = (LAS bf16*)(L + 64512); LAS float* AD = (LAS float*)(L + 73728); LAS bf16* DT = (LAS bf16*)(L + 77824);
    LAS float* CUM = (LAS float*)(L + 79872); LAS float* ECUM = CUM + 64; LAS float* BETA = CUM + 128; LAS float* WSC = CUM + 192;
    LAS bf16* VNWT = Km; LAS bf16* VNT = VT;
    const bf16* P = PROJ + (size_t)b * SEQ * NP; bf16* Yb = Yg + (size_t)b * SEQ * DM;
    const float* cw = in.gdn_conv_w + (size_t)layer * 4 * 768 + h * 64;
    const float Aneg = -__expf(in.gdn_a_log[layer * 4 + h]), dtb = in.gdn_dt_bias[layer * 4 + h];
    f32x4 zs[4];
#pragma unroll
    for (int n = 0; n < 4; ++n) zs[n] = zero4();
    f32x4 ps[4];
    { const int lane_i = opaque_i(lane0), r0 = lane_i & 15, q0 = lane_i >> 4;
#pragma unroll
      for (int n = 0; n < 4; ++n)
#pragma unroll
          for (int i = 0; i < 4; ++i) ps[n][i] = (16 * w4 + 4 * q0 + i == 16 * n + r0) ? 1.f : 0.f; }
    bf16 ra[19], rb2[19]; bf16 rbt, rat;
    auto load_raw = [&](int ch, int lane) {
        const int c = h * 64 + lane;
        const int tb = ch * 64 + 16 * w4 - 3;
        if (grp == 0) {
#pragma unroll
            for (int j = 0; j < 19; ++j) { const int t = tb + j; const bool ok = (t >= 0); const bf16 a = P[(size_t)(ok ? t : 0) * NP + C_GD_K + c]; ra[j] = ok ? a : (bf16)0; }
            rbt = P[(size_t)(ch * 64 + lane) * NP + C_GD_BETA + h]; rat = P[(size_t)(ch * 64 + lane) * NP + C_GD_DEC + h];
        } else {
#pragma unroll
            for (int j = 0; j < 19; ++j) { const int t = tb + j; const bool ok = (t >= 0); const bf16* p0 = P + (size_t)(ok ? t : 0) * NP;
                const bf16 a = p0[C_GD_Q + c], bb = p0[C_GD_V + c]; ra[j] = ok ? a : (bf16)0; rb2[j] = ok ? bb : (bf16)0; }
        }
    };
    load_raw(ch_lo, lane0);
    for (int ch = ch_lo; ch < ch_hi; ++ch) {
        { const int lane = opaque_i(lane0), r = lane & 15, q = lane >> 4;
          float tv[16]; float w0[4];
          if (grp == 0) {
#pragma unroll
            for (int j = 0; j < 4; ++j) w0[j] = cw[j * 768 + 256 + lane];
#pragma unroll
            for (int i = 0; i < 16; ++i) tv[i] = siluf_(w0[0] * RAWG(ra, i) + w0[1] * RAWG(ra, i + 1) + w0[2] * RAWG(ra, i + 2) + w0[3] * RAWG(ra, i + 3));
            { float sq[16];
#pragma unroll
              for (int i = 0; i < 16; ++i) sq[i] = tv[i] * tv[i];
              const float sred = tr_reduce16(sq, lane);
#pragma unroll
              for (int i = 0; i < 16; ++i) { tv[i] *= rsqrtf(rdlane(sred, 4 * i) + 1e-6f); Km[(16 * w4 + i) * LS + lane] = cvt_bf16(tv[i]); } }
            ssd_pack16(KT + lane * LS + 16 * w4, tv);
            if (w4 == 0) {
                const float beta = sigmoidf_(bf2f(rbt)); float cs = Aneg * softplusf_(bf2f(rat) + dtb);
#pragma unroll
                for (int o = 1; o < 64; o <<= 1) { const float u = __shfl_up(cs, o); if (lane >= o) cs += u; }
                const float c63 = __shfl(cs, 63);
                CUM[lane] = cs; ECUM[lane] = __expf(cs); BETA[lane] = beta; WSC[lane] = __expf(c63 - cs);
            }
#pragma unroll
            for (int n = 0; n < 4; ++n) st4(ZT, LS, 16 * n + r, 16 * w4 + 4 * q, zs[n]);
            if (seg == 2) {
#pragma unroll
                for (int n = 0; n < 4; ++n) st4(PT, LS, 16 * n + r, 16 * w4 + 4 * q, ps[n]); }
          } else {
#pragma unroll
            for (int j = 0; j < 4; ++j) w0[j] = cw[j * 768 + lane];
#pragma unroll
            for (int i = 0; i < 16; ++i) tv[i] = siluf_(w0[0] * RAWG(ra, i) + w0[1] * RAWG(ra, i + 1) + w0[2] * RAWG(ra, i + 2) + w0[3] * RAWG(ra, i + 3));
            { float sq[16];
#pragma unroll
              for (int i = 0; i < 16; ++i) sq[i] = tv[i] * tv[i];
              const float sred = tr_reduce16(sq, lane);
#pragma unroll
              for (int i = 0; i < 16; ++i) Qm[(16 * w4 + i) * LS + lane] = cvt_bf16(tv[i] * rsqrtf(rdlane(sred, 4 * i) + 1e-6f) * 0.125f); }
            asm volatile("" ::: "memory");
#pragma unroll
            for (int j = 0; j < 4; ++j) w0[j] = cw[j * 768 + 512 + lane];
#pragma unroll
            for (int i = 0; i < 16; ++i) tv[i] = siluf_(w0[0] * RAWG(rb2, i) + w0[1] * RAWG(rb2, i + 1) + w0[2] * RAWG(rb2, i + 2) + w0[3] * RAWG(rb2, i + 3));
            ssd_pack16(VT + lane * LS + 16 * w4, tv);
          }
        }
        WG_BAR();
        const int m = w4;
        { const int lane = opaque_i(lane0), r = lane & 15, q = lane >> 4;
          if (ch + 1 < ch_hi) load_raw(ch + 1, lane);
          if (grp == 0) {
            bf16x8 ak[2];
#pragma unroll
            for (int k = 0; k < 2; ++k) ak[k] = ld_frag(Km, LS, 16 * m + r, 32 * k, q);
            const f32x4 cumt4 = *(const LAS f32x4*)(CUM + 16 * m + 4 * q);
            const f32x4 bet4 = *(const LAS f32x4*)(BETA + 16 * m + 4 * q);
            const f32x4 ecum4 = *(const LAS f32x4*)(ECUM + 16 * m + 4 * q);
#pragma unroll
            for (int n = 0; n < 4; ++n) if (n <= m) {
                f32x4 kk = zero4();
#pragma unroll
                for (int k = 0; k < 2; ++k) kk = MFMA16(ak[k], ld_frag(Km, LS, 16 * n + r, 32 * k, q), kk);
                const float cums = CUM[16 * n + r];
                f32x4 av;
#pragma unroll
                for (int i = 0; i < 4; ++i) { const bool keep = (n < m) || (r < 4 * q + i); av[i] = keep ? bet4[i] * kk[i] * __expf(cumt4[i] - cums) : 0.f; }
                st4(AMT, LS, 16 * n + r, 16 * m + 4 * q, av);
                if (n == m) {
#pragma unroll
                    for (int i = 0; i < 4; ++i) AD[m * 256 + (4 * q + i) * 16 + r] = av[i]; }
            }
#pragma unroll
            for (int nv = 0; nv < 4; ++nv) { f32x4 kz = zero4();
#pragma unroll
                for (int k = 0; k < 2; ++k) kz = MFMA16(ak[k], ld_frag(ZT, LS, 16 * nv + r, 32 * k, q), kz);
                const v2u vr = *(const LAS v2u*)(VT + (16 * nv + r) * LS + 16 * m + 4 * q);
                f32x4 rh;
                rh[0] = bet4[0] * (__builtin_bit_cast(float, vr.x << 16) - ecum4[0] * kz[0]); rh[1] = bet4[1] * (__builtin_bit_cast(float, vr.x & 0xffff0000u) - ecum4[1] * kz[1]);
                rh[2] = bet4[2] * (__builtin_bit_cast(float, vr.y << 16) - ecum4[2] * kz[2]); rh[3] = bet4[3] * (__builtin_bit_cast(float, vr.y & 0xffff0000u) - ecum4[3] * kz[3]);
                st4(RHST, LS, 16 * nv + r, 16 * m + 4 * q, rh);
                if (seg == 2) { f32x4 kp = zero4();
#pragma unroll
                    for (int k = 0; k < 2; ++k) kp = MFMA16(ak[k], ld_frag(PT, LS, 16 * nv + r, 32 * k, q), kp);
                    f32x4 rhh; rhh[0] = -bet4[0] * ecum4[0] * kp[0]; rhh[1] = -bet4[1] * ecum4[1] * kp[1]; rhh[2] = -bet4[2] * ecum4[2] * kp[2]; rhh[3] = -bet4[3] * ecum4[3] * kp[3];
                    st4(RHSHT, LS, 16 * nv + r, 16 * m + 4 * q, rhh); } }
          } else {
            bf16x8 aq[2];
#pragma unroll
            for (int k = 0; k < 2; ++k) aq[k] = ld_frag(Qm, LS, 16 * m + r, 32 * k, q);
            const float cumr = CUM[16 * m + r];
#pragma unroll
            for (int n = 0; n < 4; ++n) { f32x4 qk = zero4(); if (n <= m) {
#pragma unroll
                for (int k = 0; k < 2; ++k) qk = MFMA16(ld_frag(Km, LS, 16 * n + r, 32 * k, q), aq[k], qk);
                const f32x4 cs4 = *(const LAS f32x4*)(CUM + 16 * n + 4 * q);
#pragma unroll
                for (int i = 0; i < 4; ++i) { const bool keep = (n < m) || (4 * q + i <= r); qk[i] = keep ? qk[i] * __expf(cumr - cs4[i]) : 0.f; } }
                st4(QKM, LS, 16 * m + r, 16 * n + 4 * q, qk); }
          }
        }
        WG_BAR();
        f32x4 O[4];
        { const int lane = opaque_i(lane0), r = lane & 15, q = lane >> 4;
          if (grp == 0) {
            diag_inverse(AD, DT, lane);
            asm volatile("s_waitcnt lgkmcnt(0)" ::: "memory");
            f32x4 Tm[4];
            tri_inverse_row(AMT, DT, m, r, q, Tm);
            const f32x4 w4v = *(const LAS f32x4*)(WSC + 16 * m + 4 * q);
            const bf16x8 t0 = pack_frag(Tm[0], Tm[1]), t1 = pack_frag(Tm[2], Tm[3]);
#pragma unroll
            for (int nv = 0; nv < 4; ++nv) { f32x4 vn = zero4();
                vn = MFMA16(t0, ld_frag_perm(RHST, LS, 16 * nv + r, 0, q), vn);
                if (m >= 2) vn = MFMA16(t1, ld_frag_perm(RHST, LS, 16 * nv + r, 32, q), vn);
                st4(VNT, LS, 16 * nv + r, 16 * m + 4 * q, vn);
                st4(VNWT, LS, 16 * nv + r, 16 * m + 4 * q, vn * w4v);
                if (seg == 2) { f32x4 vh = zero4();
                    vh = MFMA16(t0, ld_frag_perm(RHSHT, LS, 16 * nv + r, 0, q), vh);
                    if (m >= 2) vh = MFMA16(t1, ld_frag_perm(RHSHT, LS, 16 * nv + r, 32, q), vh);
                    st4(VNHT, LS, 16 * nv + r, 16 * m + 4 * q, vh);
                    st4(VNHWT, LS, 16 * nv + r, 16 * m + 4 * q, vh * w4v); } }
          } else {
            bf16x8 aq[2];
#pragma unroll
            for (int k = 0; k < 2; ++k) aq[k] = ld_frag(Qm, LS, 16 * m + r, 32 * k, q);
            const float ect = ECUM[16 * m + r];
#pragma unroll
            for (int nv = 0; nv < 4; ++nv) { O[nv] = zero4();
#pragma unroll
                for (int k = 0; k < 2; ++k) O[nv] = MFMA16(ld_frag(ZT, LS, 16 * nv + r, 32 * k, q), aq[k], O[nv]);
                O[nv] = O[nv] * ect;
                if (seg == 2) { ps[nv] = zero4();
#pragma unroll
                    for (int k = 0; k < 2; ++k) ps[nv] = MFMA16(ld_frag(PT, LS, 16 * nv + r, 32 * k, q), aq[k], ps[nv]);
                    ps[nv] = ps[nv] * ect; } }
          }
        }
        WG_BAR();
        { const int lane = opaque_i(lane0), r = lane & 15, q = lane >> 4;
          if (grp == 0) {
            const float last = ECUM[63];
            bf16x8 akt[2];
#pragma unroll
            for (int k = 0; k < 2; ++k) akt[k] = ld_frag(KT, LS, 16 * w4 + r, 32 * k, q);
#pragma unroll
            for (int n = 0; n < 4; ++n) { zs[n] = zs[n] * last;
#pragma unroll
                for (int k = 0; k < 2; ++k) zs[n] = MFMA16(akt[k], ld_frag(VNWT, LS, 16 * n + r, 32 * k, q), zs[n]); }
            if (seg == 2) {
#pragma unroll
                for (int n = 0; n < 4; ++n) { ps[n] = ps[n] * last;
#pragma unroll
                    for (int k = 0; k < 2; ++k) ps[n] = MFMA16(akt[k], ld_frag(VNHWT, LS, 16 * n + r, 32 * k, q), ps[n]); } }
          } else {
            bf16x8 pq[2];
#pragma unroll
            for (int k = 0; k < 2; ++k) pq[k] = ld_frag(QKM, LS, 16 * m + r, 32 * k, q);
            float ss = 0.f;
#pragma unroll
            for (int nv = 0; nv < 4; ++nv) {
                O[nv] = MFMA16(ld_frag(VNT, LS, 16 * nv + r, 0, q), pq[0], O[nv]);
                if (m >= 2) O[nv] = MFMA16(ld_frag(VNT, LS, 16 * nv + r, 32, q), pq[1], O[nv]);
                ss += (O[nv][0] * O[nv][0] + O[nv][1] * O[nv][1]) + (O[nv][2] * O[nv][2] + O[nv][3] * O[nv][3]); }
            if (seg == 2) { bf16* cb = cbuf + (size_t)(ch - CSPLIT) * 8192;
#pragma unroll
                for (int nv = 0; nv < 4; ++nv) {
                    ps[nv] = MFMA16(ld_frag(VNHT, LS, 16 * nv + r, 0, q), pq[0], ps[nv]);
                    if (m >= 2) ps[nv] = MFMA16(ld_frag(VNHT, LS, 16 * nv + r, 32, q), pq[1], ps[nv]);
                    v2u o; o.x = pk_bf16(O[nv][0], O[nv][1]); o.y = pk_bf16(O[nv][2], O[nv][3]); *(v2u*)(cb + (16 * m + r) * 64 + 16 * nv + 4 * q) = o;
                    v2u g; g.x = pk_bf16(ps[nv][0], ps[nv][1]); g.y = pk_bf16(ps[nv][2], ps[nv][3]); *(v2u*)(cb + 4096 + (16 * m + r) * 64 + 16 * nv + 4 * q) = g; }
            } else {
            ss += __shfl_xor(ss, 16); ss += __shfl_xor(ss, 32);
            const float rs = rsqrtf(ss * (1.f / 64.f) + 1e-6f);
            const int t = ch * 64 + 16 * m + r;
            const float* gnp = in.gdn_norm_g + layer * HD + 4 * q;
#pragma unroll
            for (int nv = 0; nv < 4; ++nv) { const int dv0 = h * 64 + 16 * nv + 4 * q;
                const f32x4 gg = *(const f32x4*)(gnp + 16 * nv);
                const v2u zr = *(const v2u*)(P + (size_t)t * NP + C_Z + 256 + dv0);
                const float z0 = __builtin_bit_cast(float, zr.x << 16), z1 = __builtin_bit_cast(float, zr.x & 0xffff0000u), z2 = __builtin_bit_cast(float, zr.y << 16), z3 = __builtin_bit_cast(float, zr.y & 0xffff0000u);
                v2u o; o.x = pk_bf16(O[nv][0] * rs * gg[0] * siluf_(z0), O[nv][1] * rs * gg[1] * siluf_(z1)); o.y = pk_bf16(O[nv][2] * rs * gg[2] * siluf_(z2), O[nv][3] * rs * gg[3] * siluf_(z3));
                *(v2u*)(Yb + (size_t)t * DM + 256 + dv0) = o; }
            }
          }
        }
        WG_BAR();
    }
    if (seg == 1 && grp == 0) { const int lane = opaque_i(lane0), r = lane & 15, q = lane >> 4;
#pragma unroll
        for (int n = 0; n < 4; ++n) { v2u o; o.x = pk_bf16(zs[n][0], zs[n][1]); o.y = pk_bf16(zs[n][2], zs[n][3]); *(v2u*)(sbuf + (16 * n + r) * 64 + 16 * w4 + 4 * q) = o; }
    }
}

__device__ __forceinline__ void mixopt_ssd(const Inputs& in, const int layer, const bf16* __restrict__ PROJ, bf16* __restrict__ Yg, LAS unsigned char* ldsw, const int b, const int g, const int tid,
                                           const int seg, unsigned char* __restrict__ sbuf, unsigned char* __restrict__ cbuf_h, unsigned char* __restrict__ cbuf_c) {
    const int ch_lo = (seg == 2) ? CSPLIT : 0, ch_hi = (seg == 1) ? CSPLIT : SEQ / 64;
    const int lane = tid & 63, wave = __builtin_amdgcn_readfirstlane(tid >> 6), hh = wave >> 2, w4 = wave & 3, h = g * 2 + hh, r = lane & 15, q = lane >> 4;
    LAS bf16* CM = (LAS bf16*)ldsw; LAS bf16* BM = (LAS bf16*)(ldsw + 17408); LAS bf16* BT = (LAS bf16*)(ldsw + 34816);
    LAS unsigned char* L = ldsw + 53248 + hh * 45056;
    LAS bf16* XVT = (LAS bf16*)L; LAS bf16* XVWT = (LAS bf16*)(L + MAT_B); LAS bf16* XR = (LAS bf16*)(L + 2 * MAT_B); LAS bf16* ZT = (LAS bf16*)(L + 3 * MAT_B);
    LAS float* CUM = (LAS float*)(ldsw + 143360 + hh * 1024); LAS float* ECUM = CUM + 64;
    LAS float* SS = (LAS float*)(ldsw + 145408);
    const bf16* P = PROJ + (size_t)b * SEQ * NP; bf16* Yb = Yg + (size_t)b * SEQ * DM;
    const int cx = h * 64 + lane, cbc = g * 128 + 64 * hh + lane;
    const float* cw = in.ssm_conv_w + (size_t)layer * 4 * 768; const float* cb = in.ssm_conv_b + (size_t)layer * 768;
    float wx[4], wB[4], wC[4];
#pragma unroll
    for (int j = 0; j < 4; ++j) { wx[j] = cw[j * 768 + cx]; wB[j] = cw[j * 768 + 256 + cbc]; wC[j] = cw[j * 768 + 512 + cbc]; }
    const float bx = cb[cx], bB = cb[256 + cbc], bC = cb[512 + cbc];
    const float Aneg = -__expf(in.ssm_a_log[layer * 4 + h]), dtb = in.ssm_dt_bias[layer * 4 + h], dsk = in.ssm_d[layer * 4 + h];
    const float* gnp = in.ssm_norm_g + layer * GW + h * 64 + 4 * q;
    f32x4 zs[2][4];
#pragma unroll
    for (int a = 0; a < 2; ++a)
#pragma unroll
        for (int n = 0; n < 4; ++n) zs[a][n] = zero4();
    typedef unsigned short us2 __attribute__((ext_vector_type(2)));
    bf16 rx[19], rB[19], rC[19]; bf16 rdt;
    auto load_raw = [&](int ch) {
        const int tb = ch * 64 + 16 * w4 - 3;
#pragma unroll
        for (int j = 0; j < 19; ++j) { const int t = tb + j; const bool ok = (t >= 0); const bf16* p0 = P + (size_t)(ok ? t : 0) * NP;
            const bf16 a = p0[C_SS_X + cx], bb = p0[C_SS_B + cbc], cc = p0[C_SS_C + cbc];
            rx[j] = ok ? a : (bf16)0; rB[j] = ok ? bb : (bf16)0; rC[j] = ok ? cc : (bf16)0; }
        rdt = P[(size_t)(ch * 64 + lane) * NP + C_SS_DT + h];
    };
    load_raw(ch_lo);
    float phis = 0.f;
    for (int ch = ch_lo; ch < ch_hi; ++ch) {
        float phis_now = phis;
        {
            float tv[16];
#pragma unroll
            for (int i = 0; i < 16; ++i) { tv[i] = siluf_(wC[0] * RAWG(rC, i) + wC[1] * RAWG(rC, i + 1) + wC[2] * RAWG(rC, i + 2) + wC[3] * RAWG(rC, i + 3) + bC);
                CM[(16 * w4 + i) * LS2 + 64 * hh + lane] = cvt_bf16(tv[i]); }
            asm volatile("" ::: "memory");
#pragma unroll
            for (int i = 0; i < 16; ++i) { tv[i] = siluf_(wB[0] * RAWG(rB, i) + wB[1] * RAWG(rB, i + 1) + wB[2] * RAWG(rB, i + 2) + wB[3] * RAWG(rB, i + 3) + bB);
                BM[(16 * w4 + i) * LS2 + 64 * hh + lane] = cvt_bf16(tv[i]); }
            ssd_pack16(BT + (64 * hh + lane) * LS + 16 * w4, tv);
            asm volatile("" ::: "memory");
            const float dt = softplusf_(bf2f(rdt) + dtb); float cs = dt * Aneg;
#pragma unroll
            for (int o = 1; o < 64; o <<= 1) { const float u = __shfl_up(cs, o); if (lane >= o) cs += u; }
            const float c63 = __shfl(cs, 63);
            const float wsc = __expf(c63 - cs);
            phis += c63;
            if (w4 == 0) { CUM[lane] = cs; ECUM[lane] = __expf(cs); }
            float xw[16];
#pragma unroll
            for (int i = 0; i < 16; ++i) { const int t = 16 * w4 + i;
                const float xs = siluf_(wx[0] * RAWG(rx, i) + wx[1] * RAWG(rx, i + 1) + wx[2] * RAWG(rx, i + 2) + wx[3] * RAWG(rx, i + 3) + bx);
                XR[t * LS + lane] = cvt_bf16(xs); tv[i] = xs * __shfl(dt, t); xw[i] = tv[i] * __shfl(wsc, t); }
            ssd_pack16(XVT + lane * LS + 16 * w4, tv);
            ssd_pack16(XVWT + lane * LS + 16 * w4, xw);
#pragma unroll
            for (int a = 0; a < 2; ++a)
#pragma unroll
                for (int nv = 0; nv < 4; ++nv) st4(ZT, LS2, 16 * nv + r, 16 * (2 * w4 + a) + 4 * q, zs[a][nv]);
        }
        WG_BAR();
        if (ch + 1 < ch_hi) load_raw(ch + 1);
        f32x4 yv[4];
        {
            const int m = w4;
            f32x4 Pt[4];
#pragma unroll
            for (int n = 0; n < 4; ++n) Pt[n] = zero4();
            bf16x8 ac[4];
#pragma unroll
            for (int k = 0; k < 4; ++k) ac[k] = ld_frag(CM, LS2, 16 * m + r, 32 * k, q);
            const float cumt = CUM[16 * m + r];
#pragma unroll
            for (int n = 0; n < 4; ++n) if (n <= m) {
#pragma unroll
                for (int k = 0; k < 4; ++k) Pt[n] = MFMA16(ld_frag(BM, LS2, 16 * n + r, 32 * k, q), ac[k], Pt[n]);
                const f32x4 cs = *(const LAS f32x4*)(CUM + 16 * n + 4 * q);
#pragma unroll
                for (int i = 0; i < 4; ++i) { const bool keep = (n < m) || (4 * q + i <= r); Pt[n][i] = keep ? Pt[n][i] * __expf(cumt - cs[i]) : 0.f; }
            }
            f32x4 O[4];
            const float ect = ECUM[16 * m + r];
#pragma unroll
            for (int nv = 0; nv < 4; ++nv) O[nv] = zero4();
#pragma unroll
            for (int k = 0; k < 4; ++k)
#pragma unroll
                for (int nv = 0; nv < 4; ++nv) O[nv] = MFMA16(ld_frag(ZT, LS2, 16 * nv + r, 32 * k, q), ac[k], O[nv]);
#pragma unroll
            for (int nv = 0; nv < 4; ++nv) O[nv] = O[nv] * ect;
#pragma unroll
            for (int k = 0; k < 2; ++k) if (2 * k <= m) { const bf16x8 pf = pack_frag(Pt[2 * k], Pt[2 * k + 1]);
#pragma unroll
                for (int nv = 0; nv < 4; ++nv) O[nv] = MFMA16(ld_frag_perm(XVT, LS, 16 * nv + r, 32 * k, q), pf, O[nv]); }
            const int t = ch * 64 + 16 * m + r;
            float ss = 0.f;
#pragma unroll
            for (int nv = 0; nv < 4; ++nv) { const int p0 = 16 * nv + 4 * q;
                const v2u xr = *(const LAS v2u*)(XR + (16 * m + r) * LS + p0);
                const v2u zr = *(const v2u*)(P + (size_t)t * NP + C_Z + 512 + h * 64 + p0);
                const float x0 = __builtin_bit_cast(float, xr.x << 16), x1 = __builtin_bit_cast(float, xr.x & 0xffff0000u), x2 = __builtin_bit_cast(float, xr.y << 16), x3 = __builtin_bit_cast(float, xr.y & 0xffff0000u);
                const float z0 = __builtin_bit_cast(float, zr.x << 16), z1 = __builtin_bit_cast(float, zr.x & 0xffff0000u), z2 = __builtin_bit_cast(float, zr.y << 16), z3 = __builtin_bit_cast(float, zr.y & 0xffff0000u);
                yv[nv][0] = (O[nv][0] + x0 * dsk) * siluf_(z0); yv[nv][1] = (O[nv][1] + x1 * dsk) * siluf_(z1);
                yv[nv][2] = (O[nv][2] + x2 * dsk) * siluf_(z2); yv[nv][3] = (O[nv][3] + x3 * dsk) * siluf_(z3);
                ss += (yv[nv][0] * yv[nv][0] + yv[nv][1] * yv[nv][1]) + (yv[nv][2] * yv[nv][2] + yv[nv][3] * yv[nv][3]); }
            ss += __shfl_xor(ss, 16); ss += __shfl_xor(ss, 32);
            if (q == 0) SS[hh * 64 + 16 * m + r] = ss;
            if (seg == 2) {
                unsigned char* cb = cbuf_h + ((size_t)(ch - CSPLIT) * 2 + hh) * 8448;
#pragma unroll
                for (int nv = 0; nv < 4; ++nv) { const int p0 = 16 * nv + 4 * q;
                    const v2u xr = *(const LAS v2u*)(XR + (16 * m + r) * LS + p0);
                    const float x0 = __builtin_bit_cast(float, xr.x << 16), x1 = __builtin_bit_cast(float, xr.x & 0xffff0000u), x2 = __builtin_bit_cast(float, xr.y << 16), x3 = __builtin_bit_cast(float, xr.y & 0xffff0000u);
                    v2u o; o.x = pk_bf16(O[nv][0] + x0 * dsk, O[nv][1] + x1 * dsk); o.y = pk_bf16(O[nv][2] + x2 * dsk, O[nv][3] + x3 * dsk);
                    *(v2u*)(cb + ((16 * m + r) * 64 + p0) * 2) = o; }
                if (q == 0) ((float*)(cb + 8192))[16 * m + r] = __expf(CUM[16 * m + r] + phis_now);
                { unsigned char* cc = cbuf_c + (size_t)(ch - CSPLIT) * 16384;
#pragma unroll
                  for (int j = 0; j < 2; ++j) { const int u = tid + 512 * j, row = u >> 4, part = u & 15;
                      *(v4u*)(cc + row * 256 + part * 16) = *(const LAS v4u*)((const LAS unsigned char*)CM + row * (LS2 * 2) + part * 16); } }
            }
            const float el = ECUM[63];
#pragma unroll
            for (int a = 0; a < 2; ++a) { bf16x8 ab[2];
#pragma unroll
                for (int k = 0; k < 2; ++k) ab[k] = ld_frag(BT, LS, 16 * (2 * w4 + a) + r, 32 * k, q);
#pragma unroll
                for (int nv = 0; nv < 4; ++nv) { zs[a][nv] = zs[a][nv] * el;
#pragma unroll
                    for (int k = 0; k < 2; ++k) zs[a][nv] = MFMA16(ab[k], ld_frag(XVWT, LS, 16 * nv + r, 32 * k, q), zs[a][nv]); } }
        }
        WG_BAR();
        if (seg != 2) {
            const int m = w4, t = ch * 64 + 16 * m + r;
            const float tot = SS[16 * m + r] + SS[64 + 16 * m + r];
            const float rs = rsqrtf(tot * (1.f / 128.f) + 1e-6f);
#pragma unroll
            for (int nv = 0; nv < 4; ++nv) { const f32x4 gg = *(const f32x4*)(gnp + 16 * nv); v2u o; o.x = pk_bf16(yv[nv][0] * rs * gg[0], yv[nv][1] * rs * gg[1]); o.y = pk_bf16(yv[nv][2] * rs * gg[2], yv[nv][3] * rs * gg[3]);
                *(v2u*)(Yb + (size_t)t * DM + 512 + h * 64 + 16 * nv + 4 * q) = o; }
        }
    }
    if (seg == 1) { bf16* zb = (bf16*)(sbuf + hh * 16384);
#pragma unroll
        for (int a = 0; a < 2; ++a)
#pragma unroll
            for (int nv = 0; nv < 4; ++nv) { v2u o; o.x = pk_bf16(zs[a][nv][0], zs[a][nv][1]); o.y = pk_bf16(zs[a][nv][2], zs[a][nv][3]); *(v2u*)(zb + (16 * nv + r) * 128 + 16 * (2 * w4 + a) + 4 * q) = o; }
    }
}

__device__ __forceinline__ void rwkv_pre_block(const Inputs& in, const int layer, const bf16* __restrict__ PROJ, float* __restrict__ CUMo, float* __restrict__ CUMPo, float* __restrict__ AV, LAS float* ldsf, const int m0, const int tid) {
    LAS bf16* SWH = (LAS bf16*)ldsf; LAS bf16* SWL = SWH + 64 * LS; LAS bf16* SAH = SWL + 64 * LS;
    const float* mu = in.rwkv_mu + (size_t)layer * 896;
    { const int j = tid & 63, tg = tid >> 6; const float muw = mu[768 + j], mua = mu[832 + j];
#pragma unroll
      for (int tt = 0; tt < 8; ++tt) { const int t = tg * 8 + tt, m = m0 + t; const bool first = ((m & (SEQ - 1)) == 0);
          const float xw = bf2f(PROJ[(size_t)m * NP + C_RW_WD + j]), xa = bf2f(PROJ[(size_t)m * NP + C_RW_AD + j]);
          const float pw = first ? 0.f : bf2f(PROJ[(size_t)(m - 1) * NP + C_RW_WD + j]), pa = first ? 0.f : bf2f(PROJ[(size_t)(m - 1) * NP + C_RW_AD + j]);
          const float sw = tanhf(xw + (pw - xw) * muw), sa = xa + (pa - xa) * mua;
          const unsigned hw = f2bf(sw); const float hwf = __builtin_bit_cast(float, hw << 16);
          SWH[t * LS + j] = (bf16)hw; SWL[t * LS + j] = (bf16)f2bf(sw - hwf); SAH[t * LS + j] = (bf16)f2bf(sa); } }
    __syncthreads();
    { const int lane = tid & 63, w8 = __builtin_amdgcn_readfirstlane(tid >> 6), r = lane & 15, q = lane >> 4;
      const float* wup = in.rwkv_w_up + (size_t)layer * 64 * GW; const float* aup = in.rwkv_a_up + (size_t)layer * 64 * GW;
#pragma unroll
      for (int nn = 0; nn < 2; ++nn) {
          const int c = 32 * w8 + 16 * nn + r;
          bf16x8 bwh[2], bwl[2], bah[2];
#pragma unroll
          for (int kk = 0; kk < 2; ++kk) { union { unsigned u[4]; bf16x8 v; } xh, xl, xa;
#pragma unroll
              for (int p = 0; p < 4; ++p) { const int j0 = 32 * kk + 8 * q + 2 * p;
                  const float w0 = wup[(size_t)j0 * GW + c], w1 = wup[(size_t)(j0 + 1) * GW + c], a0 = aup[(size_t)j0 * GW + c], a1 = aup[(size_t)(j0 + 1) * GW + c];
                  const unsigned h0 = f2bf(w0), h1 = f2bf(w1);
                  xh.u[p] = h0 | (h1 << 16);
                  xl.u[p] = f2bf(w0 - __builtin_bit_cast(float, h0 << 16)) | (f2bf(w1 - __builtin_bit_cast(float, h1 << 16)) << 16);
                  xa.u[p] = f2bf(a0) | (f2bf(a1) << 16); }
              bwh[kk] = xh.v; bwl[kk] = xl.v; bah[kk] = xa.v; }
          const float w0c = in.rwkv_w0[layer * GW + c], a0c = in.rwkv_a0[layer * GW + c];
          f32x4 lwv[4];
#pragma unroll
          for (int m = 0; m < 4; ++m) { f32x4 wl = zero4(), al = zero4();
#pragma unroll
              for (int kk = 0; kk < 2; ++kk) { const bf16x8 ah = ld_frag(SWH, LS, 16 * m + r, 32 * kk, q), alo = ld_frag(SWL, LS, 16 * m + r, 32 * kk, q), aa = ld_frag(SAH, LS, 16 * m + r, 32 * kk, q);
                  wl = MFMA16(ah, bwh[kk], wl); wl = MFMA16(alo, bwh[kk], wl); wl = MFMA16(ah, bwl[kk], wl);
                  al = MFMA16(aa, bah[kk], al); }
#pragma unroll
              for (int i = 0; i < 4; ++i) { const float w = -softplusf_(-(wl[i] + w0c)) - 0.5f; lwv[m][i] = -__expf(w);
                  AV[(size_t)(m0 + 16 * m + 4 * q + i) * GW + c] = sigmoidf_(al[i] + a0c); } }
          float base = 0.f;
#pragma unroll
          for (int m = 0; m < 4; ++m) { const float s = (lwv[m][0] + lwv[m][1]) + (lwv[m][2] + lwv[m][3]);
              const float s0 = __shfl(s, r), s1 = __shfl(s, 16 + r), s2 = __shfl(s, 32 + r), s3 = __shfl(s, 48 + r);
              float run = base + (q > 0 ? s0 : 0.f) + (q > 1 ? s1 : 0.f) + (q > 2 ? s2 : 0.f);
#pragma unroll
              for (int i = 0; i < 4; ++i) { run += lwv[m][i]; CUMo[(size_t)(m0 + 16 * m + 4 * q + i) * GW + c] = run; }
              base += (s0 + s1) + (s2 + s3); }
      }
    }
    __syncthreads();
}

__device__ __forceinline__ void mixopt_rwkv(const Inputs& in, const int layer, const bf16* __restrict__ PROJ, const float* __restrict__ CUMg, const float* __restrict__ CUMPg, const float* __restrict__ AV, bf16* __restrict__ Yg,
                                            LAS unsigned char* L, const int b, const int h, const int tid) {
    const int lane0 = tid & 63, wave = __builtin_amdgcn_readfirstlane(tid >> 6), w4 = wave & 3;
    const bool act = wave < 4;
    LAS bf16* AT = (LAS bf16*)L; LAS bf16* RT = (LAS bf16*)(L + 9216); LAS bf16* BL = (LAS bf16*)(L + 18432); LAS bf16* KL = (LAS bf16*)(L + 27648);
    LAS bf16* BTT = (LAS bf16*)(L + 36864); LAS bf16* KTT = (LAS bf16*)(L + 46080); LAS bf16* VT = (LAS bf16*)(L + 55296); LAS bf16* ZT = (LAS bf16*)(L + 64512);
    LAS bf16* AMT = (LAS bf16*)(L + 73728); LAS bf16* RHST = (LAS bf16*)(L + 82944); LAS float* AD = (LAS float*)(L + 92160); LAS bf16* DT = (LAS bf16*)(L + 96256);
    LAS float* QTOT = (LAS float*)(L + 98304); LAS float* ELAST = (LAS float*)(L + 99328); LAS float* BON = (LAS float*)(L + 99584);
    LAS bf16* SAT = AT;
    const bf16* P = PROJ + (size_t)b * SEQ * NP; bf16* Yb = Yg + (size_t)b * SEQ * DM;
    const float* CUMb = CUMg + (size_t)b * SEQ * GW; const float* CUMPb = CUMPg + (size_t)b * SEQ * GW; const float* AVb = AV + (size_t)b * SEQ * GW;
    const float* mu = in.rwkv_mu + (size_t)layer * 896 + h * 64;
    f32x4 zs[4];
#pragma unroll
    for (int n = 0; n < 4; ++n) zs[n] = zero4();
    LAS unsigned char* RAWT = L + 73728; LAS float* CMT = (LAS float*)(L + 99840); LAS float* AVT = (LAS float*)(L + 116480);
    v4u st[16];
    auto stage_load = [&](int ch, int ht) {
#pragma unroll
        for (int i = 0; i < 7; ++i) { const int u = ht + 256 * i; const int row = u / 24, rem = u - row * 24, seg = rem >> 3, part = rem & 7; const int t = ch * 64 - 1 + row;
            st[i] = (u < 1560 && t >= 0) ? *(const v4u*)(P + (size_t)t * NP + C_RW_R + seg * 256 + h * 64 + part * 8) : (v4u){0u, 0u, 0u, 0u}; }
#pragma unroll
        for (int i = 0; i < 5; ++i) { const int u = ht + 256 * i; const int row = u >> 4, part = u & 15; const int t = ch * 64 - 1 + row;
            st[7 + i] = (u < 1040 && t >= 0) ? *(const v4u*)(CUMb + (size_t)t * GW + h * 64 + part * 4) : (v4u){0u, 0u, 0u, 0u}; }
#pragma unroll
        for (int i = 0; i < 4; ++i) { const int u = ht + 256 * i; const int row = u >> 4, part = u & 15; const int t = ch * 64 + row;
            st[12 + i] = *(const v4u*)(AVb + (size_t)t * GW + h * 64 + part * 4); }
    };
    auto stage_store = [&](int ht) {
#pragma unroll
        for (int i = 0; i < 7; ++i) { const int u = ht + 256 * i; const int row = u / 24, rem = u - row * 24; if (u < 1560) *(LAS v4u*)(RAWT + row * 384 + rem * 16) = st[i]; }
#pragma unroll
        for (int i = 0; i < 5; ++i) { const int u = ht + 256 * i; if (u < 1040) *(LAS v4u*)((LAS unsigned char*)CMT + u * 16) = st[7 + i]; }
#pragma unroll
        for (int i = 0; i < 4; ++i) { const int u = ht + 256 * i; *(LAS v4u*)((LAS unsigned char*)AVT + u * 16) = st[12 + i]; }
    };
    if (!act) { const int ht = opaque_i(tid - 256); stage_load(0, ht); stage_store(ht); }
    WG_BAR();
    for (int ch = 0; ch < SEQ / 64; ++ch) {
        if (act) { const int lane = opaque_i(lane0), r = lane & 15, q = lane >> 4;
            float rs[16], k2[16], kkv[16], tv[16];
            const float mu_r = mu[lane], mu_k = mu[256 + lane], mu_v = mu[512 + lane];
            const float kkc = in.rwkv_k_k[layer * GW + h * 64 + lane], kac = in.rwkv_k_a[layer * GW + h * 64 + lane], rkc = in.rwkv_r_k[layer * GW + h * 64 + lane];
            { const LAS bf16* rw = (const LAS bf16*)RAWT + (16 * w4) * 192 + lane;
              float pr = bf2f(rw[0]), pk = bf2f(rw[64]), pv = bf2f(rw[128]);
#pragma unroll
              for (int i = 0; i < 16; ++i) { const float xr = bf2f(rw[(i + 1) * 192]), xk = bf2f(rw[(i + 1) * 192 + 64]), xv = bf2f(rw[(i + 1) * 192 + 128]);
                  const float av = AVT[(16 * w4 + i) * 64 + lane];
                  rs[i] = xr + (pr - xr) * mu_r; const float ks = xk + (pk - xk) * mu_k; tv[i] = xv + (pv - xv) * mu_v;
                  kkv[i] = ks * kkc; k2[i] = ks * (1.f + (av - 1.f) * kac); pr = xr; pk = xk; pv = xv; } }
            ssd_pack16(VT + lane * LS + 16 * w4, tv);
            { float sq[16];
#pragma unroll
              for (int i = 0; i < 16; ++i) sq[i] = kkv[i] * kkv[i];
              const float sred = tr_reduce16(sq, lane);
#pragma unroll
              for (int i = 0; i < 16; ++i) kkv[i] *= rsqrtf(rdlane(sred, 4 * i) + 1e-6f);
#pragma unroll
              for (int i = 0; i < 16; ++i) sq[i] = rs[i] * k2[i] * rkc;
              const float bred = tr_reduce16(sq, lane);
              if ((lane & 3) == 0) BON[16 * w4 + (lane >> 2)] = bred; }
#pragma unroll
            for (int i = 0; i < 16; ++i) { const float cum = CMT[(16 * w4 + i + 1) * 64 + lane]; const int t = 16 * w4 + i;
                const float en = __expf(-cum); const float cump = (i == 0 && w4 == 0) ? 0.f : CMT[(16 * w4 + i) * 64 + lane];
                AT[t * LS + lane] = cvt_bf16(-kkv[i] * __expf(cump));
                RT[t * LS + lane] = cvt_bf16(rs[i] * __expf(cum));
                kkv[i] = kkv[i] * AVT[(16 * w4 + i) * 64 + lane] * en; k2[i] = k2[i] * en;
                BL[t * LS + lane] = cvt_bf16(kkv[i]); KL[t * LS + lane] = cvt_bf16(k2[i]); }
            ssd_pack16(BTT + lane * LS + 16 * w4, kkv);
            ssd_pack16(KTT + lane * LS + 16 * w4, k2);
            if (w4 == 3) ELAST[lane] = __expf(CMT[64 * 64 + lane]);
#pragma unroll
            for (int n = 0; n < 4; ++n) st4(ZT, LS, 16 * n + r, 16 * w4 + 4 * q, zs[n]);
        }
        WG_BAR();
        if (!act && ch + 1 < SEQ / 64) stage_load(ch + 1, opaque_i(tid - 256));
        const int m = w4;
        if (act) { const int lane = opaque_i(lane0), r = lane & 15, q = lane >> 4;
            f32x4 Aak[4];
            bf16x8 aa[2];
#pragma unroll
            for (int k = 0; k < 2; ++k) aa[k] = ld_frag(AT, LS, 16 * m + r, 32 * k, q);
#pragma unroll
            for (int n = 0; n < 4; ++n) { Aak[n] = zero4(); if (n <= m) {
                f32x4 ab = zero4();
#pragma unroll
                for (int k = 0; k < 2; ++k) { const bf16x8 fb = ld_frag(BL, LS, 16 * n + r, 32 * k, q), fk = ld_frag(KL, LS, 16 * n + r, 32 * k, q);
                    ab = MFMA16(aa[k], fb, ab);
                    Aak[n] = MFMA16(fk, aa[k], Aak[n]); }
                f32x4 av;
#pragma unroll
                for (int i = 0; i < 4; ++i) { const bool keep = (n < m) || (r < 4 * q + i); av[i] = keep ? -ab[i] : 0.f; }
                st4(AMT, LS, 16 * n + r, 16 * m + 4 * q, av);
                if (n == m) {
#pragma unroll
                    for (int i = 0; i < 4; ++i) AD[m * 256 + (4 * q + i) * 16 + r] = av[i];
#pragma unroll
                    for (int i = 0; i < 4; ++i) { const bool strict = (4 * q + i < r); Aak[n][i] = strict ? Aak[n][i] : 0.f; } }
            } }
            const bf16x8 p0 = pack_frag(Aak[0], Aak[1]), p1 = pack_frag(Aak[2], Aak[3]);
#pragma unroll
            for (int nv = 0; nv < 4; ++nv) { f32x4 rh = zero4();
#pragma unroll
                for (int k = 0; k < 2; ++k) rh = MFMA16(aa[k], ld_frag(ZT, LS, 16 * nv + r, 32 * k, q), rh);
                rh = MFMA16(p0, ld_frag_perm(VT, LS, 16 * nv + r, 0, q), rh);
                if (m >= 2) rh = MFMA16(p1, ld_frag_perm(VT, LS, 16 * nv + r, 32, q), rh);
                st4(RHST, LS, 16 * nv + r, 16 * m + 4 * q, rh); }
        }
        WG_BAR();
        if (act) { const int lane = opaque_i(lane0), r = lane & 15, q = lane >> 4;
            diag_inverse(AD, DT, lane);
            asm volatile("s_waitcnt lgkmcnt(0)" ::: "memory");
            f32x4 Tm[4];
            tri_inverse_row(AMT, DT, m, r, q, Tm);
            const bf16x8 t0 = pack_frag(Tm[0], Tm[1]), t1 = pack_frag(Tm[2], Tm[3]);
#pragma unroll
            for (int nv = 0; nv < 4; ++nv) { f32x4 sa = zero4();
                sa = MFMA16(t0, ld_frag_perm(RHST, LS, 16 * nv + r, 0, q), sa);
                if (m >= 2) sa = MFMA16(t1, ld_frag_perm(RHST, LS, 16 * nv + r, 32, q), sa);
                st4(SAT, LS, 16 * nv + r, 16 * m + 4 * q, sa); }
        }
        WG_BAR();
        if (!act && ch + 1 < SEQ / 64) stage_store(opaque_i(tid - 256));
        if (act) { const int lane = opaque_i(lane0), r = lane & 15, q = lane >> 4;
            f32x4 O[4];
            bf16x8 ar[2];
#pragma unroll
            for (int k = 0; k < 2; ++k) ar[k] = ld_frag(RT, LS, 16 * m + r, 32 * k, q);
            f32x4 Arb[4], Ark[4];
#pragma unroll
            for (int n = 0; n < 4; ++n) { Arb[n] = zero4(); Ark[n] = zero4(); if (n <= m) {
#pragma unroll
                for (int k = 0; k < 2; ++k) { Arb[n] = MFMA16(ld_frag(BL, LS, 16 * n + r, 32 * k, q), ar[k], Arb[n]); Ark[n] = MFMA16(ld_frag(KL, LS, 16 * n + r, 32 * k, q), ar[k], Ark[n]); }
                if (n == m) {
#pragma unroll
                    for (int i = 0; i < 4; ++i) { const bool incl = (4 * q + i <= r); Arb[n][i] = incl ? Arb[n][i] : 0.f; Ark[n][i] = incl ? Ark[n][i] : 0.f; } } } }
            const bf16x8 b0 = pack_frag(Arb[0], Arb[1]), b1 = pack_frag(Arb[2], Arb[3]), k0 = pack_frag(Ark[0], Ark[1]), k1 = pack_frag(Ark[2], Ark[3]);
            float s1 = 0.f;
#pragma unroll
            for (int nv = 0; nv < 4; ++nv) { O[nv] = zero4();
#pragma unroll
                for (int k = 0; k < 2; ++k) O[nv] = MFMA16(ld_frag(ZT, LS, 16 * nv + r, 32 * k, q), ar[k], O[nv]);
                O[nv] = MFMA16(ld_frag_perm(SAT, LS, 16 * nv + r, 0, q), b0, O[nv]);
                O[nv] = MFMA16(ld_frag_perm(VT, LS, 16 * nv + r, 0, q), k0, O[nv]);
                if (m >= 2) { O[nv] = MFMA16(ld_frag_perm(SAT, LS, 16 * nv + r, 32, q), b1, O[nv]); O[nv] = MFMA16(ld_frag_perm(VT, LS, 16 * nv + r, 32, q), k1, O[nv]); }
                s1 += (O[nv][0] + O[nv][1]) + (O[nv][2] + O[nv][3]); }
            s1 += __shfl_xor(s1, 16); s1 += __shfl_xor(s1, 32);
            const float mean = s1 * (1.f / 64.f); float s2 = 0.f;
#pragma unroll
            for (int nv = 0; nv < 4; ++nv) { O[nv] = O[nv] - mean; s2 += (O[nv][0] * O[nv][0] + O[nv][1] * O[nv][1]) + (O[nv][2] * O[nv][2] + O[nv][3] * O[nv][3]); }
            s2 += __shfl_xor(s2, 16); s2 += __shfl_xor(s2, 32);
            const float rstd = rsqrtf(s2 * (1.f / 64.f) + 64e-5f);
            const int t = ch * 64 + 16 * m + r; const float bon = BON[16 * m + r];
#pragma unroll
            for (int nv = 0; nv < 4; ++nv) { const int dv0 = 16 * nv + 4 * q, cc = h * 64 + dv0;
                const f32x4 lw4 = *(const f32x4*)(in.rwkv_ln_w + layer * GW + cc); const f32x4 lb4 = *(const f32x4*)(in.rwkv_ln_b + layer * GW + cc);
                const v2u zr = *(const v2u*)(P + (size_t)t * NP + C_Z + 768 + cc);
                const float z0 = __builtin_bit_cast(float, zr.x << 16), z1 = __builtin_bit_cast(float, zr.x & 0xffff0000u), z2 = __builtin_bit_cast(float, zr.y << 16), z3 = __builtin_bit_cast(float, zr.y & 0xffff0000u);
                const float v0 = bf2f(VT[(dv0 + 0) * LS + 16 * m + r]), v1 = bf2f(VT[(dv0 + 1) * LS + 16 * m + r]), v2 = bf2f(VT[(dv0 + 2) * LS + 16 * m + r]), v3 = bf2f(VT[(dv0 + 3) * LS + 16 * m + r]);
                v2u o; o.x = pk_bf16((O[nv][0] * rstd * lw4[0] + lb4[0] + bon * v0) * siluf_(z0), (O[nv][1] * rstd * lw4[1] + lb4[1] + bon * v1) * siluf_(z1));
                o.y = pk_bf16((O[nv][2] * rstd * lw4[2] + lb4[2] + bon * v2) * siluf_(z2), (O[nv][3] * rstd * lw4[3] + lb4[3] + bon * v3) * siluf_(z3));
                *(v2u*)(Yb + (size_t)t * DM + 768 + cc) = o; }
            const f32x4 el = *(const LAS f32x4*)(ELAST + 16 * w4 + 4 * q);
            bf16x8 ab2[2], ak2[2];
#pragma unroll
            for (int k = 0; k < 2; ++k) { ab2[k] = ld_frag(BTT, LS, 16 * w4 + r, 32 * k, q); ak2[k] = ld_frag(KTT, LS, 16 * w4 + r, 32 * k, q); }
#pragma unroll
            for (int n = 0; n < 4; ++n) {
#pragma unroll
                for (int k = 0; k < 2; ++k) { zs[n] = MFMA16(ab2[k], ld_frag(SAT, LS, 16 * n + r, 32 * k, q), zs[n]); zs[n] = MFMA16(ak2[k], ld_frag(VT, LS, 16 * n + r, 32 * k, q), zs[n]); }
                zs[n] = zs[n] * el; }
        }
        WG_BAR();
    }
}

__device__ __forceinline__ void mixopt_rwkv2(const Inputs& in, const int layer, const bf16* __restrict__ PROJ, const float* __restrict__ CUMg, const float* __restrict__ CUMPg, const float* __restrict__ AV, bf16* __restrict__ Yg,
                                            LAS unsigned char* L, const int b, const int h, const int tid, const int seg, bf16* __restrict__ sbuf, unsigned char* __restrict__ cbuf) {
    const int ch_lo = (seg == 2) ? CSPLIT : 0, ch_hi = (seg == 1) ? CSPLIT : SEQ / 64;
    const int lane0 = tid & 63, wave = __builtin_amdgcn_readfirstlane(tid >> 6), w4 = wave & 3;
    const bool act = wave < 4;
    LAS bf16* AT = (LAS bf16*)L; LAS bf16* RT = (LAS bf16*)(L + 9216); LAS bf16* BL = (LAS bf16*)(L + 18432); LAS bf16* KL = (LAS bf16*)(L + 27648);
    LAS bf16* BTT = (LAS bf16*)(L + 36864); LAS bf16* KTT = (LAS bf16*)(L + 46080); LAS bf16* VT = (LAS bf16*)(L + 55296); LAS bf16* ZT = (LAS bf16*)(L + 64512);
    LAS bf16* AMT = (LAS bf16*)(L + 73728); LAS bf16* RHST = (LAS bf16*)(L + 82944); LAS float* AD = (LAS float*)(L + 92160); LAS bf16* DT = (LAS bf16*)(L + 96256);
    LAS float* QTOT = (LAS float*)(L + 98304); LAS float* ELAST = (LAS float*)(L + 99328); LAS float* BON = (LAS float*)(L + 99584);
    LAS bf16* SAT = AT;
    const bf16* P = PROJ + (size_t)b * SEQ * NP; bf16* Yb = Yg + (size_t)b * SEQ * DM;
    const float* CUMb = CUMg + (size_t)b * SEQ * GW; const float* CUMPb = CUMPg + (size_t)b * SEQ * GW; const float* AVb = AV + (size_t)b * SEQ * GW;
    const float* mu = in.rwkv_mu + (size_t)layer * 896 + h * 64;
    f32x4 zs[4];
#pragma unroll
    for (int n = 0; n < 4; ++n) zs[n] = zero4();
    f32x4 ps[4];
    { const int lane_i = opaque_i(lane0), r0 = lane_i & 15, q0 = lane_i >> 4;
#pragma unroll
      for (int n = 0; n < 4; ++n)
#pragma unroll
          for (int i = 0; i < 4; ++i) ps[n][i] = (16 * w4 + 4 * q0 + i == 16 * n + r0) ? 1.f : 0.f; }
#define O zs
    LAS unsigned char* RAWT = L + 73728; LAS float* CMT = (LAS float*)(L + 99840); LAS float* AVT = (LAS float*)(L + 117248);
    LAS bf16* PT = (LAS bf16*)(L + 133632); LAS bf16* RHSHT = (LAS bf16*)(L + 142848); LAS bf16* SAHT = (LAS bf16*)(L + 152064);
    v4u st[9];
    auto stage_load_a = [&](int ch, int ht) {
#pragma unroll
        for (int i = 0; i < 5; ++i) { const int u = ht + 256 * i; const int row = u >> 4, part = u & 15; const int t = ch * 64 - 1 + row;
            st[i] = (u < 1040 && t >= 0) ? *(const v4u*)(CUMb + (size_t)t * GW + h * 64 + part * 4) : (v4u){0u, 0u, 0u, 0u}; }
#pragma unroll
        for (int i = 0; i < 4; ++i) { const int u = ht + 256 * i; const int row = u >> 4, part = u & 15; const int t = ch * 64 + row;
            st[5 + i] = *(const v4u*)(AVb + (size_t)t * GW + h * 64 + part * 4); }
    };
    auto stage_store_a = [&](int ht) {
#pragma unroll
        for (int i = 0; i < 5; ++i) { const int u = ht + 256 * i; if (u < 1040) *(LAS v4u*)((LAS unsigned char*)CMT + u * 16) = st[i]; }
#pragma unroll
        for (int i = 0; i < 4; ++i) { const int u = ht + 256 * i; *(LAS v4u*)((LAS unsigned char*)AVT + u * 16) = st[5 + i]; }
    };
    auto stage_dma_a = [&](int ch, int ht, int wv) {
#pragma unroll
        for (int i = 0; i < 5; ++i) if (i < 4 || wv == 0) { const int u = ht + 256 * i; const int uu = u < 1040 ? u : 1039; const int row = uu >> 4, part = uu & 15; const int t = ch * 64 - 1 + row;
            __builtin_amdgcn_global_load_lds((const GAS unsigned*)(CUMb + (size_t)t * GW + h * 64 + part * 4), (LAS unsigned*)((LAS unsigned char*)CMT + (64 * wv + 256 * i) * 16), 16, 0, 0); }
#pragma unroll
        for (int i = 0; i < 4; ++i) { const int u = ht + 256 * i; const int row = u >> 4, part = u & 15; const int t = ch * 64 + row;
            __builtin_amdgcn_global_load_lds((const GAS unsigned*)(AVb + (size_t)t * GW + h * 64 + part * 4), (LAS unsigned*)((LAS unsigned char*)AVT + (64 * wv + 256 * i) * 16), 16, 0, 0); }
    };
    auto stage_load_b = [&](int ch, int ht) {
#pragma unroll
        for (int i = 0; i < 7; ++i) { const int u = ht + 256 * i; const int row = u / 24, rem = u - row * 24, seg = rem >> 3, part = rem & 7; const int t = ch * 64 - 1 + row;
            st[i] = (u < 1560 && t >= 0) ? *(const v4u*)(P + (size_t)t * NP + C_RW_R + seg * 256 + h * 64 + part * 8) : (v4u){0u, 0u, 0u, 0u}; }
    };
    auto stage_store_b = [&](int ht) {
#pragma unroll
        for (int i = 0; i < 7; ++i) { const int u = ht + 256 * i; const int row = u / 24, rem = u - row * 24; if (u < 1560) *(LAS v4u*)(RAWT + row * 384 + rem * 16) = st[i]; }
    };
    auto stage_dma_b = [&](int ch, int ht, int wv) {
#pragma unroll
        for (int i = 0; i < 7; ++i) if (i < 6 || wv == 0) { const int u = ht + 256 * i; const int uu = u < 1560 ? u : 1559; const int row = uu / 24, rem = uu - row * 24, seg_ = rem >> 3, part = rem & 7; const int t = ch * 64 - 1 + row;
            __builtin_amdgcn_global_load_lds((const GAS unsigned*)(P + (size_t)t * NP + C_RW_R + seg_ * 256 + h * 64 + part * 8), (LAS unsigned*)(RAWT + (64 * wv + 256 * i) * 16), 16, 0, 0); }
    };
    if (!act) { const int ht = opaque_i(tid) - 256; stage_load_a(ch_lo, ht); stage_store_a(ht); stage_load_b(ch_lo, ht); stage_store_b(ht); }
    WG_BAR();
    for (int ch = ch_lo; ch < ch_hi; ++ch) {
        { const int lane = opaque_i(lane0), r = lane & 15, q = lane >> 4;
          const float mu_k = mu[256 + lane];
          const float kac = in.rwkv_k_a[layer * GW + h * 64 + lane];
          const LAS bf16* rw = (const LAS bf16*)RAWT + (16 * w4) * 192 + lane;
          float k2[16];
          if (act) {
            float kkv[16];
            const float kkc = in.rwkv_k_k[layer * GW + h * 64 + lane];
            { float pk = bf2f(rw[64]);
#pragma unroll
              for (int i = 0; i < 16; ++i) { const float xk = bf2f(rw[(i + 1) * 192 + 64]); const float av = AVT[(16 * w4 + i) * 64 + lane];
                  const float ks = xk + (pk - xk) * mu_k; kkv[i] = ks * kkc; k2[i] = ks * (1.f + (av - 1.f) * kac); pk = xk; } }
            { float sq[16];
#pragma unroll
              for (int i = 0; i < 16; ++i) sq[i] = kkv[i] * kkv[i];
              const float sred = tr_reduce16(sq, lane);
#pragma unroll
              for (int i = 0; i < 16; ++i) kkv[i] *= rsqrtf(rdlane(sred, 4 * i) + 1e-6f); }
#pragma unroll
            for (int i = 0; i < 16; ++i) { const float cum = CMT[(16 * w4 + i + 1) * 64 + lane]; const int t = 16 * w4 + i;
                const float en = __expf(-cum); const float cump = (i == 0 && w4 == 0) ? 0.f : CMT[(16 * w4 + i) * 64 + lane];
                AT[t * LS + lane] = cvt_bf16(-kkv[i] * __expf(cump));
                kkv[i] = kkv[i] * AVT[(16 * w4 + i) * 64 + lane] * en; k2[i] = k2[i] * en;
                BL[t * LS + lane] = cvt_bf16(kkv[i]); KL[t * LS + lane] = cvt_bf16(k2[i]); }
            ssd_pack16(BTT + lane * LS + 16 * w4, kkv);
            ssd_pack16(KTT + lane * LS + 16 * w4, k2);
            if (w4 == 3) ELAST[lane] = __expf(CMT[64 * 64 + lane]);
#pragma unroll
            for (int n = 0; n < 4; ++n) st4(ZT, LS, 16 * n + r, 16 * w4 + 4 * q, zs[n]);
            if (seg == 2) {
#pragma unroll
                for (int n = 0; n < 4; ++n) st4(PT, LS, 16 * n + r, 16 * w4 + 4 * q, ps[n]); }
          } else {
            float rs[16], tv[16];
            const float mu_r = mu[lane], mu_v = mu[512 + lane];
            const float rkc = in.rwkv_r_k[layer * GW + h * 64 + lane];
            { float pr = bf2f(rw[0]), pk = bf2f(rw[64]), pv = bf2f(rw[128]);
#pragma unroll
              for (int i = 0; i < 16; ++i) { const float xr = bf2f(rw[(i + 1) * 192]), xk = bf2f(rw[(i + 1) * 192 + 64]), xv = bf2f(rw[(i + 1) * 192 + 128]);
                  const float av = AVT[(16 * w4 + i) * 64 + lane];
                  rs[i] = xr + (pr - xr) * mu_r; const float ks = xk + (pk - xk) * mu_k; tv[i] = xv + (pv - xv) * mu_v;
                  k2[i] = ks * (1.f + (av - 1.f) * kac); pr = xr; pk = xk; pv = xv; } }
            ssd_pack16(VT + lane * LS + 16 * w4, tv);
            { float sq[16];
#pragma unroll
              for (int i = 0; i < 16; ++i) sq[i] = rs[i] * k2[i] * rkc;
              const float bred = tr_reduce16(sq, lane);
              if ((lane & 3) == 0) BON[16 * w4 + (lane >> 2)] = bred; }
#pragma unroll
            for (int i = 0; i < 16; ++i) RT[(16 * w4 + i) * LS + lane] = cvt_bf16(rs[i] * __expf(CMT[(16 * w4 + i + 1) * 64 + lane]));
          }
        }
        WG_BAR();
        if (!act && ch + 1 < ch_hi) stage_dma_a(ch + 1, opaque_i(tid) - 256, wave - 4);
        const int m = w4;
        f32x4 Arb[4], Ark[4];
        if (!act) { const int lane = opaque_i(lane0), r = lane & 15, q = lane >> 4;
            bf16x8 ar[2];
#pragma unroll
            for (int k = 0; k < 2; ++k) ar[k] = ld_frag(RT, LS, 16 * m + r, 32 * k, q);
#pragma unroll
            for (int n = 0; n < 4; ++n) { Arb[n] = zero4(); Ark[n] = zero4(); if (n <= m) {
#pragma unroll
                for (int k = 0; k < 2; ++k) { Arb[n] = MFMA16(ld_frag(BL, LS, 16 * n + r, 32 * k, q), ar[k], Arb[n]); Ark[n] = MFMA16(ld_frag(KL, LS, 16 * n + r, 32 * k, q), ar[k], Ark[n]); }
                if (n == m) {
#pragma unroll
                    for (int i = 0; i < 4; ++i) { const bool incl = (4 * q + i <= r); Arb[n][i] = incl ? Arb[n][i] : 0.f; Ark[n][i] = incl ? Ark[n][i] : 0.f; } } } }
        }
        if (act) { const int lane = opaque_i(lane0), r = lane & 15, q = lane >> 4;
            f32x4 Aak[4];
            bf16x8 aa[2];
#pragma unroll
            for (int k = 0; k < 2; ++k) aa[k] = ld_frag(AT, LS, 16 * m + r, 32 * k, q);
#pragma unroll
            for (int n = 0; n < 4; ++n) { Aak[n] = zero4(); if (n <= m) {
                f32x4 ab = zero4();
#pragma unroll
                for (int k = 0; k < 2; ++k) { const bf16x8 fb = ld_frag(BL, LS, 16 * n + r, 32 * k, q), fk = ld_frag(KL, LS, 16 * n + r, 32 * k, q);
                    ab = MFMA16(aa[k], fb, ab);
                    Aak[n] = MFMA16(fk, aa[k], Aak[n]); }
                f32x4 av;
#pragma unroll
                for (int i = 0; i < 4; ++i) { const bool keep = (n < m) || (r < 4 * q + i); av[i] = keep ? -ab[i] : 0.f; }
                st4(AMT, LS, 16 * n + r, 16 * m + 4 * q, av);
                if (n == m) {
#pragma unroll
                    for (int i = 0; i < 4; ++i) AD[m * 256 + (4 * q + i) * 16 + r] = av[i];
#pragma unroll
                    for (int i = 0; i < 4; ++i) { const bool strict = (4 * q + i < r); Aak[n][i] = strict ? Aak[n][i] : 0.f; } }
            } }
            const bf16x8 p0 = pack_frag(Aak[0], Aak[1]), p1 = pack_frag(Aak[2], Aak[3]);
#pragma unroll
            for (int nv = 0; nv < 4; ++nv) { f32x4 rh = zero4();
#pragma unroll
                for (int k = 0; k < 2; ++k) rh = MFMA16(aa[k], ld_frag(ZT, LS, 16 * nv + r, 32 * k, q), rh);
                rh = MFMA16(p0, ld_frag_perm(VT, LS, 16 * nv + r, 0, q), rh);
                if (m >= 2) rh = MFMA16(p1, ld_frag_perm(VT, LS, 16 * nv + r, 32, q), rh);
                st4(RHST, LS, 16 * nv + r, 16 * m + 4 * q, rh);
                if (seg == 2) { f32x4 rhh = zero4();
#pragma unroll
                    for (int k = 0; k < 2; ++k) rhh = MFMA16(aa[k], ld_frag(PT, LS, 16 * nv + r, 32 * k, q), rhh);
                    st4(RHSHT, LS, 16 * nv + r, 16 * m + 4 * q, rhh); } }
        }
        WG_BAR();
        if (!act) { const int lane = opaque_i(lane0), r = lane & 15, q = lane >> 4;
            bf16x8 ar[2];
#pragma unroll
            for (int k = 0; k < 2; ++k) ar[k] = ld_frag(RT, LS, 16 * m + r, 32 * k, q);
#pragma unroll
            for (int nv = 0; nv < 4; ++nv) { O[nv] = zero4();
#pragma unroll
                for (int k = 0; k < 2; ++k) O[nv] = MFMA16(ld_frag(ZT, LS, 16 * nv + r, 32 * k, q), ar[k], O[nv]);
                if (seg == 2) { ps[nv] = zero4();
#pragma unroll
                    for (int k = 0; k < 2; ++k) ps[nv] = MFMA16(ld_frag(PT, LS, 16 * nv + r, 32 * k, q), ar[k], ps[nv]); } }
        }
        if (act) { const int lane = opaque_i(lane0), r = lane & 15, q = lane >> 4;
            diag_inverse(AD, DT, lane);
            asm volatile("s_waitcnt lgkmcnt(0)" ::: "memory");
            f32x4 Tm[4];
            tri_inverse_row(AMT, DT, m, r, q, Tm);
            const bf16x8 t0 = pack_frag(Tm[0], Tm[1]), t1 = pack_frag(Tm[2], Tm[3]);
#pragma unroll
            for (int nv = 0; nv < 4; ++nv) { f32x4 sa = zero4();
                sa = MFMA16(t0, ld_frag_perm(RHST, LS, 16 * nv + r, 0, q), sa);
                if (m >= 2) sa = MFMA16(t1, ld_frag_perm(RHST, LS, 16 * nv + r, 32, q), sa);
                st4(SAT, LS, 16 * nv + r, 16 * m + 4 * q, sa);
                if (seg == 2) { f32x4 sh = zero4();
                    sh = MFMA16(t0, ld_frag_perm(RHSHT, LS, 16 * nv + r, 0, q), sh);
                    if (m >= 2) sh = MFMA16(t1, ld_frag_perm(RHSHT, LS, 16 * nv + r, 32, q), sh);
                    st4(SAHT, LS, 16 * nv + r, 16 * m + 4 * q, sh); } }
        }
        WG_BAR();
        if (!act) { const int lane = opaque_i(lane0), r = lane & 15, q = lane >> 4;
            if (ch + 1 < ch_hi) stage_dma_b(ch + 1, opaque_i(tid) - 256, wave - 4);
            const bf16x8 b0 = pack_frag(Arb[0], Arb[1]), b1 = pack_frag(Arb[2], Arb[3]), k0 = pack_frag(Ark[0], Ark[1]), k1 = pack_frag(Ark[2], Ark[3]);
            float s1 = 0.f;
#pragma unroll
            for (int nv = 0; nv < 4; ++nv) {
                O[nv] = MFMA16(ld_frag_perm(SAT, LS, 16 * nv + r, 0, q), b0, O[nv]);
                O[nv] = MFMA16(ld_frag_perm(VT, LS, 16 * nv + r, 0, q), k0, O[nv]);
                if (m >= 2) { O[nv] = MFMA16(ld_frag_perm(SAT, LS, 16 * nv + r, 32, q), b1, O[nv]); O[nv] = MFMA16(ld_frag_perm(VT, LS, 16 * nv + r, 32, q), k1, O[nv]); }
                s1 += (O[nv][0] + O[nv][1]) + (O[nv][2] + O[nv][3]); }
            if (seg == 2) { unsigned char* cb = cbuf + (size_t)(ch - CSPLIT) * 16640;
#pragma unroll
                for (int nv = 0; nv < 4; ++nv) {
                    ps[nv] = MFMA16(ld_frag_perm(SAHT, LS, 16 * nv + r, 0, q), b0, ps[nv]);
                    if (m >= 2) ps[nv] = MFMA16(ld_frag_perm(SAHT, LS, 16 * nv + r, 32, q), b1, ps[nv]);
                    v2u o; o.x = pk_bf16(O[nv][0], O[nv][1]); o.y = pk_bf16(O[nv][2], O[nv][3]); *(v2u*)(cb + ((16 * m + r) * 64 + 16 * nv + 4 * q) * 2) = o;
                    v2u g; g.x = pk_bf16(ps[nv][0], ps[nv][1]); g.y = pk_bf16(ps[nv][2], ps[nv][3]); *(v2u*)(cb + 8192 + ((16 * m + r) * 64 + 16 * nv + 4 * q) * 2) = g; }
                if (q == 0) ((float*)(cb + 16384))[16 * m + r] = BON[16 * m + r];
            } else {
            s1 += __shfl_xor(s1, 16); s1 += __shfl_xor(s1, 32);
            const float mean = s1 * (1.f / 64.f); float s2 = 0.f;
#pragma unroll
            for (int nv = 0; nv < 4; ++nv) { O[nv] = O[nv] - mean; s2 += (O[nv][0] * O[nv][0] + O[nv][1] * O[nv][1]) + (O[nv][2] * O[nv][2] + O[nv][3] * O[nv][3]); }
            s2 += __shfl_xor(s2, 16); s2 += __shfl_xor(s2, 32);
            const float rstd = rsqrtf(s2 * (1.f / 64.f) + 64e-5f);
            const int t = ch * 64 + 16 * m + r; const float bon = BON[16 * m + r];
#pragma unroll
            for (int nv = 0; nv < 4; ++nv) { const int dv0 = 16 * nv + 4 * q, cc = h * 64 + dv0;
                const f32x4 lw4 = *(const f32x4*)(in.rwkv_ln_w + layer * GW + cc); const f32x4 lb4 = *(const f32x4*)(in.rwkv_ln_b + layer * GW + cc);
                const v2u zr = *(const v2u*)(P + (size_t)t * NP + C_Z + 768 + cc);
                const float z0 = __builtin_bit_cast(float, zr.x << 16), z1 = __builtin_bit_cast(float, zr.x & 0xffff0000u), z2 = __builtin_bit_cast(float, zr.y << 16), z3 = __builtin_bit_cast(float, zr.y & 0xffff0000u);
                const float v0 = bf2f(VT[(dv0 + 0) * LS + 16 * m + r]), v1 = bf2f(VT[(dv0 + 1) * LS + 16 * m + r]), v2 = bf2f(VT[(dv0 + 2) * LS + 16 * m + r]), v3 = bf2f(VT[(dv0 + 3) * LS + 16 * m + r]);
                v2u o; o.x = pk_bf16((O[nv][0] * rstd * lw4[0] + lb4[0] + bon * v0) * siluf_(z0), (O[nv][1] * rstd * lw4[1] + lb4[1] + bon * v1) * siluf_(z1));
                o.y = pk_bf16((O[nv][2] * rstd * lw4[2] + lb4[2] + bon * v2) * siluf_(z2), (O[nv][3] * rstd * lw4[3] + lb4[3] + bon * v3) * siluf_(z3));
                *(v2u*)(Yb + (size_t)t * DM + 768 + cc) = o; }
            }
        }
        if (act) { const int lane = opaque_i(lane0), r = lane & 15, q = lane >> 4;
            const f32x4 el = *(const LAS f32x4*)(ELAST + 16 * w4 + 4 * q);
            bf16x8 ab2[2], ak2[2];
#pragma unroll
            for (int k = 0; k < 2; ++k) { ab2[k] = ld_frag(BTT, LS, 16 * w4 + r, 32 * k, q); ak2[k] = ld_frag(KTT, LS, 16 * w4 + r, 32 * k, q); }
#pragma unroll
            for (int n = 0; n < 4; ++n) {
#pragma unroll
                for (int k = 0; k < 2; ++k) { zs[n] = MFMA16(ab2[k], ld_frag(SAT, LS, 16 * n + r, 32 * k, q), zs[n]); zs[n] = MFMA16(ak2[k], ld_frag(VT, LS, 16 * n + r, 32 * k, q), zs[n]); }
                zs[n] = zs[n] * el; }
            if (seg == 2) {
#pragma unroll
                for (int n = 0; n < 4; ++n) {
#pragma unroll
                    for (int k = 0; k < 2; ++k) ps[n] = MFMA16(ab2[k], ld_frag(SAHT, LS, 16 * n + r, 32 * k, q), ps[n]);
                    ps[n] = ps[n] * el; } }
        }
        WG_BAR();
    }
    if (seg == 1 && act) { const int lane = opaque_i(lane0), r = lane & 15, q = lane >> 4;
#pragma unroll
        for (int n = 0; n < 4; ++n) { v2u o; o.x = pk_bf16(zs[n][0], zs[n][1]); o.y = pk_bf16(zs[n][2], zs[n][3]); *(v2u*)(sbuf + (16 * n + r) * 64 + 16 * w4 + 4 * q) = o; }
    }
}
#undef O

#ifndef MK_MASK
#define MK_MASK 31
#endif
#ifndef REP_MASK
#define REP_MASK 0
#endif

constexpr int NWAVES = 8;
constexpr size_t MiB = 1u << 20;
constexpr size_t WS_CTL = 0, CTL_ZERO_BYTES = 64 * 1024;
constexpr size_t WS_WIN = 1 * MiB;
constexpr size_t WS_WOUT = 18 * MiB;
constexpr size_t WS_U = 22 * MiB;
constexpr size_t WS_PROJ = 54 * MiB;
constexpr size_t WS_OUT = 190 * MiB;
constexpr size_t CB_HGRN = 16 * MiB, CB_GDN = 16 * MiB + 7680 * 1024, SB_BASE = 16 * MiB + 14848 * 1024  , CB_RWKV = 48 * MiB, CB_SSD = 48 * MiB + 7680 * 1024, CB_SSDC = 48 * MiB + 11776 * 1024;
constexpr int CW_BAR = 4096;
constexpr int LDSCTL_OFF = 162816, MISC_OFF = LDSCTL_OFF + 320, LDS_BYTES = 163840;

struct Args { Inputs in; float* out; unsigned char* ws; };
__device__ __forceinline__ int opaque_v(int v) { asm volatile("" : "+v"(v)); return v; }

__device__ __forceinline__ void wprep_load(const float* __restrict__ W, int N, int use_perm, int n0, int k0, int tid, LAS float* tile) {
    const int nn = tid & 31, kq = tid >> 5;
    const int oc = use_perm ? old_col(n0 + nn) : (n0 + nn);
#pragma unroll
    for (int i = 0; i < 8; ++i) { const int kk = kq + 8 * i; tile[kk * 33 + nn] = (oc >= 0) ? W[(size_t)(k0 + kk) * N + oc] : 0.f; }
}
__device__ __forceinline__ void wprep_store(bf16* __restrict__ WT, int K, int n0, int k0, int tid, const LAS float* tile) {
    const int n = tid >> 3, kc = (tid & 7) * 8;
    uint4 o;
    o.x = f2bf(tile[(kc + 0) * 33 + n]) | (f2bf(tile[(kc + 1) * 33 + n]) << 16);
    o.y = f2bf(tile[(kc + 2) * 33 + n]) | (f2bf(tile[(kc + 3) * 33 + n]) << 16);
    o.z = f2bf(tile[(kc + 4) * 33 + n]) | (f2bf(tile[(kc + 5) * 33 + n]) << 16);
    o.w = f2bf(tile[(kc + 6) * 33 + n]) | (f2bf(tile[(kc + 7) * 33 + n]) << 16);
    *(uint4*)(WT + (size_t)(n0 + n) * K + k0 + kc) = o;
}

__device__ __forceinline__ void rmsnorm_row_bf16(const float* __restrict__ hrow, const float* __restrict__ g, bf16* __restrict__ urow, int lane) {
    const float4* xr = (const float4*)hrow + lane; const float4* gr = (const float4*)g + lane;
    float4 v[4]; float s = 0.f;
#pragma unroll
    for (int j = 0; j < 4; ++j) { v[j] = xr[64 * j]; s += (v[j].x * v[j].x + v[j].y * v[j].y) + (v[j].z * v[j].z + v[j].w * v[j].w); }
    const float r = rsqrtf(wave_sum(s) * (1.f / DM) + 1e-6f);
    uint2* o8 = (uint2*)urow + lane;
#pragma unroll
    for (int j = 0; j < 4; ++j) { const float4 gg = gr[64 * j]; uint2 o;
        o.x = f2bf(v[j].x * r * gg.x) | (f2bf(v[j].y * r * gg.y) << 16); o.y = f2bf(v[j].z * r * gg.z) | (f2bf(v[j].w * r * gg.w) << 16); o8[64 * j] = o; }
}

__device__ __forceinline__ void post_row(const float* hrow, const float* __restrict__ orow_, const float* __restrict__ g, float* hnew, const float* __restrict__ g2, bf16* __restrict__ urow, int lane) {
    const float4* orow = (const float4*)orow_ + lane; const float4* hr = (const float4*)hrow + lane; const float4* gr = (const float4*)g + lane;
    float4 v[4]; float s = 0.f;
#pragma unroll
    for (int j = 0; j < 4; ++j) { v[j] = orow[64 * j]; s += (v[j].x * v[j].x + v[j].y * v[j].y) + (v[j].z * v[j].z + v[j].w * v[j].w); }
    const float r = rsqrtf(wave_sum(s) * (1.f / DM) + 1e-6f);
    float4* o = (float4*)hnew + lane; float s2 = 0.f;
#pragma unroll
    for (int j = 0; j < 4; ++j) { const float4 gg = gr[64 * j]; const float4 hh = hr[64 * j]; float4 w;
        w.x = hh.x + v[j].x * r * gg.x; w.y = hh.y + v[j].y * r * gg.y; w.z = hh.z + v[j].z * r * gg.z; w.w = hh.w + v[j].w * r * gg.w; o[64 * j] = w; v[j] = w;
        s2 += (w.x * w.x + w.y * w.y) + (w.z * w.z + w.w * w.w); }
    if (g2) {
        const float r2 = rsqrtf(wave_sum(s2) * (1.f / DM) + 1e-6f);
        const float4* g2r = (const float4*)g2 + lane; uint2* o8 = (uint2*)urow + lane;
#pragma unroll
        for (int j = 0; j < 4; ++j) { const float4 gg = g2r[64 * j]; uint2 q;
            q.x = f2bf(v[j].x * r2 * gg.x) | (f2bf(v[j].y * r2 * gg.y) << 16); q.y = f2bf(v[j].z * r2 * gg.z) | (f2bf(v[j].w * r2 * gg.w) << 16); o8[64 * j] = q; }
    }
}

#define CAS __attribute__((address_space(4)))
#define GRID_BAR() do { const CAS Args* apb = (const CAS Args*)__builtin_amdgcn_kernarg_segment_ptr(); asm volatile("" : "+s"(apb)); \
    XcdBarrier bq; bq.bar = (unsigned*)((gu32*)(apb->ws + WS_CTL) + CW_BAR); bq.x = xb_xcc_id(); bq.st = (volatile LAS unsigned*)(lds + MISC_OFF) + 8; \
    int wv_ = wave_k; asm volatile("" : "+s"(wv_)); xcd_barrier(bq, (wv_ << 6) | fresh_lane()); } while (0)
#define PHASE_LOCALS() \
    const CAS Args* ap = (const CAS Args*)__builtin_amdgcn_kernarg_segment_ptr(); asm volatile("" : "+s"(ap)); \
    Inputs in; in.x = ap->in.x; in.pre_norm_g = ap->in.pre_norm_g; in.w_in = ap->in.w_in; in.hgrn_lb = ap->in.hgrn_lb; in.hgrn_norm_g = ap->in.hgrn_norm_g; in.gdn_conv_w = ap->in.gdn_conv_w; in.gdn_a_log = ap->in.gdn_a_log; in.gdn_dt_bias = ap->in.gdn_dt_bias; in.gdn_norm_g = ap->in.gdn_norm_g; in.ssm_conv_w = ap->in.ssm_conv_w; in.ssm_conv_b = ap->in.ssm_conv_b; in.ssm_a_log = ap->in.ssm_a_log; in.ssm_dt_bias = ap->in.ssm_dt_bias; in.ssm_d = ap->in.ssm_d; in.ssm_norm_g = ap->in.ssm_norm_g; in.rwkv_mu = ap->in.rwkv_mu; in.rwkv_w0 = ap->in.rwkv_w0; in.rwkv_w_up = ap->in.rwkv_w_up; in.rwkv_a0 = ap->in.rwkv_a0; in.rwkv_a_up = ap->in.rwkv_a_up; in.rwkv_k_k = ap->in.rwkv_k_k; in.rwkv_k_a = ap->in.rwkv_k_a; in.rwkv_r_k = ap->in.rwkv_r_k; in.rwkv_ln_w = ap->in.rwkv_ln_w; in.rwkv_ln_b = ap->in.rwkv_ln_b; in.w_out = ap->in.w_out; in.post_norm_g = ap->in.post_norm_g; \
    unsigned char* ws = ap->ws; float* hout = ap->out; \
    int bx = blockIdx.x; asm volatile("" : "+s"(bx)); int G = gridDim.x; asm volatile("" : "+s"(G)); \
    const int lane = fresh_lane(); int wave = wave_k; asm volatile("" : "+s"(wave)); const int tid = (wave << 6) | lane; \
    bf16* Win = (bf16*)(ws + WS_WIN); bf16* Wout = (bf16*)(ws + WS_WOUT); bf16* U = (bf16*)(ws + WS_U); bf16* PROJ = (bf16*)(ws + WS_PROJ); float* OUT = (float*)(ws + WS_OUT); \
    (void)Win; (void)Wout; (void)U; (void)PROJ; (void)OUT; (void)hout; (void)bx; (void)G; (void)lane; (void)wave;

#define WPREP_ITEMS(LAYER, FIRST_WAVE, NUM_WAVES) do { \
        LAS float* scr = (LAS float*)(lds + wave * 8448); \
        constexpr int NB_IN = NP / 32, NB_OUT = DM / 32, IT_IN = NB_IN * (DM / 64), IT_OUT = NB_OUT * (DM / 64); \
        for (int it = (FIRST_WAVE); it < IT_IN + IT_OUT; it += (NUM_WAVES)) { \
            int rr = it; const int lw_ = (LAYER); \
            const float* W; bf16* WT; int N, perm, n0, k0; \
            if (rr < IT_IN) { W = in.w_in + (size_t)lw_ * DM * IN_COLS; N = IN_COLS; perm = 1; WT = Win + (size_t)lw_ * NP * DM; n0 = (rr % NB_IN) * 32; k0 = (rr / NB_IN) * 64; } \
            else { rr -= IT_IN; W = in.w_out + (size_t)lw_ * DM * DM; N = DM; perm = 0; WT = Wout + (size_t)lw_ * DM * DM; n0 = (rr % NB_OUT) * 32; k0 = (rr / NB_OUT) * 64; } \
            const int nl = lane & 31, oc = perm ? old_col(n0 + nl) : (n0 + nl); \
            const float* src = W + (size_t)(k0 + (lane >> 5)) * N + (oc >= 0 ? oc : 0); \
            _Pragma("unroll 8") \
            for (int i = 0; i < 32; ++i) { const float v = src[(size_t)(2 * i) * N]; scr[(2 * i + (lane >> 5)) * 33 + nl] = (oc >= 0) ? v : 0.f; } \
            LDS_WAIT(); asm volatile("" ::: "memory"); \
            const int cq = lane & 7; \
            _Pragma("unroll") \
            for (int j = 0; j < 4; ++j) { const int n = (lane >> 3) + 8 * j; const LAS float* s = scr + (8 * cq) * 33 + n; \
                v4u o; o.x = pk2(s[0 * 33], s[1 * 33]); o.y = pk2(s[2 * 33], s[3 * 33]); o.z = pk2(s[4 * 33], s[5 * 33]); o.w = pk2(s[6 * 33], s[7 * 33]); \
                *(v4u*)(WT + (size_t)(n0 + n) * DM + k0 + 8 * cq) = o; } \
            LDS_WAIT(); asm volatile("" ::: "memory"); \
        } } while (0)
__global__ void __launch_bounds__(NWAVES * 64, 2) mk_fwd(Args args) {
    extern __shared__ __attribute__((aligned(16))) unsigned char lds_raw[];
    LAS unsigned char* lds = (LAS unsigned char*)lds_raw;
    volatile LAS unsigned* MISC = (volatile LAS unsigned*)(lds + MISC_OFF);
    const int wave_k = __builtin_amdgcn_readfirstlane((int)threadIdx.x >> 6);
    for (int u = threadIdx.x; u < (LDS_BYTES - LDSCTL_OFF) / 4; u += NWAVES * 64) ((LAS unsigned*)(lds + LDSCTL_OFF))[u] = 0u;
    __syncthreads();
    (void)xcd_barrier_post((unsigned*)((gu32*)(args.ws + WS_CTL) + CW_BAR), MISC + 8, (int)threadIdx.x);

    for (int rep0 = 0; rep0 < ((REP_MASK & 256) ? 2 : 1); ++rep0) {
        PHASE_LOCALS();
        WPREP_ITEMS(0, bx * NWAVES + wave, G * NWAVES);
        for (int m = bx * NWAVES + wave; m < MTOK; m += G * NWAVES) rmsnorm_row_bf16(in.x + (size_t)m * DM, in.pre_norm_g, U + (size_t)m * DM, lane);
    }
    GRID_BAR();

#pragma unroll
    for (int l = 0; l < NLAYER; ++l) {
        { PHASE_LOCALS();
          pg8::Gemm g; g.A = U; g.Bt = Win + (size_t)l * NP * DM; g.M = MTOK; g.N = NP; g.K = DM;
          pg8::StaticOrder S; S.init(MTOK, NP, G, bx); S.wave_id = wave;
          pg8::EpiBf16<0> E; E.O = PROJ; E.ldc = NP; E.bias = nullptr; E.split_cols = 0; E.split_stride = 0;
          for (int rep = 0; rep < ((REP_MASK & 32) ? 2 : 1); ++rep) pg8::gemm_phase<pg8::EpiBf16<0>, pg8::StaticOrder, false>(lds, g, S, E, nullptr); }
        GRID_BAR();
        { PHASE_LOCALS();
          float* CUMW = OUT; float* CUMPW = OUT + (size_t)MTOK * GW; float* AVW = OUT + (size_t)2 * MTOK * GW;
          for (int rep = 0; rep < ((REP_MASK & 16) ? 2 : 1); ++rep) for (int blk = bx; blk < MTOK / 64; blk += G) { const int tid_l = opaque_v(tid); rwkv_pre_block(in, l, PROJ, CUMW, CUMPW, AVW, (LAS float*)lds, blk * 64, tid_l); } }
        GRID_BAR();
        { PHASE_LOCALS();
          const float* CUMW = OUT; const float* CUMPW = OUT + (size_t)MTOK * GW; const float* AVW = OUT + (size_t)2 * MTOK * GW;
          unsigned char* OB = (unsigned char*)OUT;
          if (bx < 64) { const int bh = bx >> 1, half = bx & 1;
              mixopt_hgrn<1>(in, l, PROJ, U, lds, bh >> 2, bh & 3, (wave << 6) | fresh_lane(), 1 + half, (bf16*)(OB + SB_BASE) + (size_t)(0 * 32 + bh) * 4096, (bf16*)(OB + CB_HGRN) + (size_t)bh * NSEG2 * 8192); }
          else if (bx < 128) { const int bh = (bx - 64) >> 1, half = (bx - 64) & 1;
              mixopt_gdn2(in, l, PROJ, U, lds, bh >> 2, bh & 3, (wave << 6) | fresh_lane(), 1 + half, (bf16*)(OB + SB_BASE) + (size_t)(1 * 32 + bh) * 4096, (bf16*)(OB + CB_GDN) + (size_t)bh * NSEG2 * 8192); }
          else if (bx < 160) { const int bg = (bx - 128) >> 1, half = (bx - 128) & 1;
              mixopt_ssd(in, l, PROJ, U, lds, bg >> 1, bg & 1, (wave << 6) | fresh_lane(), 1 + half, OB + SB_BASE + 96 * 8192 + (size_t)bg * 32768,
                         OB + CB_SSD + (size_t)bg * NSEG2 * 2 * 8448, OB + CB_SSDC + (size_t)bg * NSEG2 * 16384); }
          else if (bx < 224) { const int bh = (bx - 160) >> 1, half = (bx - 160) & 1;
              mixopt_rwkv2(in, l, PROJ, CUMW, CUMPW, AVW, U, lds, bh >> 2, bh & 3, (wave << 6) | fresh_lane(), 1 + half, (bf16*)(OB + SB_BASE) + (size_t)(2 * 32 + bh) * 4096, OB + CB_RWKV + (size_t)bh * NSEG2 * 16640); }
          else if (l + 1 < NLAYER) WPREP_ITEMS(l + 1, (bx - 224) * NWAVES + wave, (G - 224) * NWAVES); }
        GRID_BAR();
        { PHASE_LOCALS();
          const unsigned char* OB = (const unsigned char*)OUT;
          const int hh = wave >> 2, m = wave & 3;
          for (int it = bx; it < 16 * NSEG2; it += G) { const int b = it / (2 * NSEG2), rem = it - b * 2 * NSEG2, hp = rem / NSEG2, cc = rem - hp * NSEG2, h = 2 * hp + hh, bh = b * 4 + h;
              corr_item_rms(in.hgrn_norm_g + l * HD, PROJ + (size_t)b * SEQ * NP, U + (size_t)b * SEQ * DM, C_Z + 0 + h * 64, 0 + h * 64,
                            (const bf16*)(OB + SB_BASE) + (size_t)(0 * 32 + bh) * 4096, (const bf16*)(OB + CB_HGRN) + ((size_t)bh * NSEG2 + cc) * 8192, CSPLIT + cc, m, lane); }
          for (int it = bx; it < 16 * NSEG2; it += G) { const int b = it / (2 * NSEG2), rem = it - b * 2 * NSEG2, hp = rem / NSEG2, cc = rem - hp * NSEG2, h = 2 * hp + hh, bh = b * 4 + h;
              corr_item_rms(in.gdn_norm_g + l * HD, PROJ + (size_t)b * SEQ * NP, U + (size_t)b * SEQ * DM, C_Z + 256 + h * 64, 256 + h * 64,
                            (const bf16*)(OB + SB_BASE) + (size_t)(1 * 32 + bh) * 4096, (const bf16*)(OB + CB_GDN) + ((size_t)bh * NSEG2 + cc) * 8192, CSPLIT + cc, m, lane); }
          for (int it = bx; it < 16 * NSEG2; it += G) { const int b = it / (2 * NSEG2), rem = it - b * 2 * NSEG2, hp = rem / NSEG2, cc = rem - hp * NSEG2, h = 2 * hp + hh, bh = b * 4 + h;
              corr_item_rwkv(in, l, PROJ + (size_t)b * SEQ * NP, U + (size_t)b * SEQ * DM, h, (const bf16*)(OB + SB_BASE) + (size_t)(2 * 32 + bh) * 4096, OB + CB_RWKV + ((size_t)bh * NSEG2 + cc) * 16640, CSPLIT + cc, m, lane); }
          for (int it = bx; it < 16 * NSEG2; it += G) { const int bg = it / NSEG2, cc = it - bg * NSEG2, b = bg >> 1, g = bg & 1, h = 2 * g + hh;
              corr_item_ssd(in.ssm_norm_g + l * GW + h * 64, PROJ + (size_t)b * SEQ * NP, U + (size_t)b * SEQ * DM, h, hh,
                            (const bf16*)(OB + SB_BASE + 96 * 8192 + (size_t)bg * 32768 + hh * 16384), OB + CB_SSD + (((size_t)bg * NSEG2 + cc) * 2 + hh) * 8448,
                            (const bf16*)(OB + CB_SSDC + ((size_t)bg * NSEG2 + cc) * 16384), CSPLIT + cc, m, lane, (LAS float*)lds); }
        }
        GRID_BAR();
        { PHASE_LOCALS();
          pg8::Gemm g; g.A = U; g.Bt = Wout + (size_t)l * DM * DM; g.M = MTOK; g.N = DM; g.K = DM;
          pg8::StaticOrder S; S.init(MTOK, DM, G, bx); S.wave_id = wave;
          pg8::EpiF32 E; E.C = OUT; E.ldc = DM; E.bias = nullptr;
          for (int rep = 0; rep < ((REP_MASK & 64) ? 2 : 1); ++rep) pg8::gemm_phase<pg8::EpiF32, pg8::StaticOrder, false>(lds, g, S, E, nullptr); }
        GRID_BAR();
        { PHASE_LOCALS();
          const float* hin = (l == 0) ? in.x : hout;
          for (int m = bx * NWAVES + wave; m < MTOK; m += G * NWAVES)
            post_row(hin + (size_t)m * DM, OUT + (size_t)m * DM, in.post_norm_g + (size_t)l * DM, hout + (size_t)m * DM,
                     (l + 1 < NLAYER) ? in.pre_norm_g + (size_t)(l + 1) * DM : nullptr, U + (size_t)m * DM, lane); }
        if (l + 1 < NLAYER) GRID_BAR();
    }
}

extern "C" void kernel_launch(void* const* d_in, const int* in_sizes, int n_in, void* d_out, int out_size, void* d_ws, size_t ws_size, hipStream_t stream) {
    static int grid = 0;
    if (grid == 0) {
        int dev = 0, cus = 0, per_cu = 0;
        if (hipGetDevice(&dev) != hipSuccess || hipDeviceGetAttribute(&cus, hipDeviceAttributeMultiprocessorCount, dev) != hipSuccess) { fprintf(stderr, "kernel_launch: device query failed\n"); grid = -1; return; }
        if (hipFuncSetAttribute((const void*)mk_fwd, hipFuncAttributeMaxDynamicSharedMemorySize, LDS_BYTES) != hipSuccess) { fprintf(stderr, "kernel_launch: hipFuncSetAttribute failed\n"); grid = -1; return; }
        if (hipOccupancyMaxActiveBlocksPerMultiprocessor(&per_cu, (const void*)mk_fwd, NWAVES * 64, LDS_BYTES) != hipSuccess || per_cu < 1)
            fprintf(stderr, "kernel_launch: note: occupancy query reports %d workgroups per CU\n", per_cu);
        (void)hipGetLastError();
        grid = cus;
    }
    if (grid < 0) return;
    if (hipMemsetAsync((char*)d_ws + WS_CTL, 0, CTL_ZERO_BYTES, stream) != hipSuccess) { fprintf(stderr, "kernel_launch: memset failed\n"); return; }
    Args a{};
    { const float** ip = (const float**)&a.in; for (int i = 0; i < 27; ++i) ip[i] = (const float*)d_in[i]; }
    a.out = (float*)d_out; a.ws = (unsigned char*)d_ws;
    hipLaunchKernelGGL(mk_fwd, dim3(grid), dim3(NWAVES * 64), LDS_BYTES, stream, a);
}
```

```cpp
#include <hip/hip_runtime.h>
#include <cstdio>
#include <cstdint>
#define REP_MASK 0
#define HWCVT 3
#define HWSITES 0
namespace pg8 {
#define PG8_LAS __attribute__((address_space(3)))
typedef unsigned short bf16_t;
typedef short bf16x8 __attribute__((ext_vector_type(8)));
typedef float f32x4 __attribute__((ext_vector_type(4)));
typedef unsigned u32x4 __attribute__((ext_vector_type(4)));
constexpr int BM = 256, BK = 64, HALF = 128, HTB = HALF * BK * 2  , STAGE_BYTES = 8 * HTB, NXCD = 8, WGM = 8;

__host__ __device__ __forceinline__ int lds_byte(int r, int c) { const int st = (r >> 4) * 2 + (c >> 5), rr = r & 15, cc = c & 31, ob = rr * 64 + cc * 2; return st * 1024 + (ob ^ (((ob >> 9) & 1) << 5)); }
__host__ __device__ __forceinline__ void stage_rc(int b, int& R, int& C) { const int st = b / 1024, sb = b % 1024, swz = sb ^ (((sb >> 9) & 1) << 5); R = (st >> 1) * 16 + swz / 64; C = (st & 1) * 32 + (swz % 64) / 2; }
__host__ __device__ __forceinline__ int perm32(int rho) { const int n = rho >> 4, i = rho & 15; return 8 * (i >> 2) + 4 * n + (i & 3); }

struct Unit { int pm, pn; };
struct Gemm { const bf16_t* A; const bf16_t* Bt; int M, N, K; };

struct StaticOrder {
    int nM, nN, nwg, G, c, wave_id;
    __host__ __device__ void init(int M, int N, int G_, int c_) { nM = M / BM; nN = N / BM; nwg = nM * nN; G = G_; c = c_; }
    __host__ __device__ bool next(int i, Unit& u) const {
        const long L = (long)i * G + c; if (L >= nwg) return false;
        int wgid = (int)L; { const int q = nwg / NXCD, r = nwg % NXCD, xcd = wgid % NXCD, off = wgid / NXCD; wgid = (xcd < r ? xcd * (q + 1) : r * (q + 1) + (xcd - r) * q) + off; }
        const int nig = WGM * nN, gid = wgid / nig, fm = gid * WGM, gsz = (nM - fm) < WGM ? (nM - fm) : WGM;
        u.pm = fm + ((wgid % nig) % gsz); u.pn = (wgid % nig) / gsz; return true;
    }
    __device__ __forceinline__ void a_ready(const Unit&) const {}
    __device__ __forceinline__ void done(const Unit&) const {}
};
__device__ __forceinline__ unsigned cvt_pk_bf16(float lo, float hi) { unsigned r; asm volatile("v_cvt_pk_bf16_f32 %0, %1, %2" : "=v"(r) : "v"(lo), "v"(hi)); return r; }
typedef float f32x2 __attribute__((ext_vector_type(2)));
__device__ __forceinline__ f32x2 gelu_pk(f32x2 v) {
    const f32x2 av = __builtin_elementwise_abs(v), d = av * 0.2316418882f + 1.0f;
    f32x2 t; t.x = __builtin_amdgcn_rcpf(d.x); t.y = __builtin_amdgcn_rcpf(d.y);
    f32x2 q = t * 0.5307027145f + (-0.7265760135f); q = q * t + 0.7107068705f; q = q * t + (-0.142248368f); q = q * t + 0.127414796f; q = q * t;
    const f32x2 s = (v * v) * (-0.72134752044f);
    f32x2 e; e.x = __builtin_amdgcn_exp2f(s.x); e.y = __builtin_amdgcn_exp2f(s.y);
    const f32x2 m = v * (q * e), r = v - m;
    f32x2 o; o.x = v.x < 0.f ? m.x : r.x; o.y = v.y < 0.f ? m.y : r.y; return o;
}

struct EpiF32 {
    static constexpr bool PERM = false, AFTER_DRAIN = false;
    float* C; int ldc; const float* bias;
    __device__ __forceinline__ void operator()(const f32x4 (&acc)[2][2][4][2], const Unit& u, int wr, int wc, int fr, int fq) const {
        const int row0 = u.pm * BM + wr * 64 + fr, col0 = u.pn * BM + wc * 32 + 4 * fq;
        f32x4 bv[2][2];
#pragma unroll
        for (int bj = 0; bj < 2; ++bj)
#pragma unroll
            for (int n = 0; n < 2; ++n) bv[bj][n] = bias ? *(const f32x4*)(bias + col0 + bj * HALF + n * 16) : (f32x4){0.f, 0.f, 0.f, 0.f};
#pragma unroll
        for (int ai = 0; ai < 2; ++ai)
#pragma unroll
            for (int m = 0; m < 4; ++m) { float* rowp = C + (size_t)(row0 + ai * HALF + m * 16) * ldc + col0;
#pragma unroll
                for (int bj = 0; bj < 2; ++bj)
#pragma unroll
                    for (int n = 0; n < 2; ++n) *(f32x4*)(rowp + bj * HALF + n * 16) = acc[ai][bj][m][n] + bv[bj][n]; }
    }
};
template <int ACT  > struct EpiBf16 {
    static constexpr bool PERM = true, AFTER_DRAIN = false;
    bf16_t* O; int ldc; const float* bias; int split_cols; size_t split_stride;
    __device__ __forceinline__ void operator()(const f32x4 (&acc)[2][2][4][2], const Unit& u, int wr, int wc, int fr, int fq) const {
        const int row0 = u.pm * BM + wr * 64 + fr; int colt = u.pn * BM; bf16_t* base = O;
        if (split_cols) { const int t = colt / split_cols; base += (size_t)t * split_stride; colt -= t * split_cols; }
        const int col0 = colt + wc * 32 + 8 * fq, bcol0 = u.pn * BM + wc * 32 + 8 * fq;
        f32x4 bv[2][2];
#pragma unroll
        for (int bj = 0; bj < 2; ++bj)
#pragma unroll
            for (int n = 0; n < 2; ++n) bv[bj][n] = bias ? *(const f32x4*)(bias + bcol0 + bj * HALF + 4 * n) : (f32x4){0.f, 0.f, 0.f, 0.f};
#pragma unroll
        for (int ai = 0; ai < 2; ++ai)
#pragma unroll
            for (int m = 0; m < 4; ++m) { bf16_t* rowp = base + (size_t)(row0 + ai * HALF + m * 16) * ldc + col0;
#pragma unroll
                for (int bj = 0; bj < 2; ++bj) { f32x4 v0 = acc[ai][bj][m][0] + bv[bj][0], v1 = acc[ai][bj][m][1] + bv[bj][1];
                    if (ACT == 1) { f32x2 a = gelu_pk((f32x2){v0[0], v0[1]}), b = gelu_pk((f32x2){v0[2], v0[3]}), c = gelu_pk((f32x2){v1[0], v1[1]}), d = gelu_pk((f32x2){v1[2], v1[3]});
                        v0 = (f32x4){a.x, a.y, b.x, b.y}; v1 = (f32x4){c.x, c.y, d.x, d.y}; }
                    if (ACT == 2) {
#pragma unroll
                        for (int j = 0; j < 4; ++j) { v0[j] = 0.5f * v0[j] * (1.0f + erff(v0[j] * 0.70710678f)); v1[j] = 0.5f * v1[j] * (1.0f + erff(v1[j] * 0.70710678f)); } }
                    u32x4 w; w.x = cvt_pk_bf16(v0[0], v0[1]); w.y = cvt_pk_bf16(v0[2], v0[3]); w.z = cvt_pk_bf16(v1[0], v1[1]); w.w = cvt_pk_bf16(v1[2], v1[3]);
                    *(u32x4*)(rowp + bj * HALF) = w; } }
    }
};
__device__ __forceinline__ int fresh_lane_pg8() { unsigned m_ = ~0u; asm volatile("" : "+s"(m_)); return (int)__builtin_amdgcn_mbcnt_hi(m_, __builtin_amdgcn_mbcnt_lo(m_, 0u)); }
template <class Epi, class Sched, bool STAMP = false>
__device__ __forceinline__ void gemm_phase(PG8_LAS unsigned char* lds, const Gemm g, const Sched& S, const Epi& E, unsigned long long* stamps) {
    int tid_op_ = (S.wave_id << 6) | fresh_lane_pg8(); const int tid = tid_op_, wid = __builtin_amdgcn_readfirstlane(tid >> 6), lane = tid & 63, wr = wid >> 2, wc = wid & 3, fr = lane & 15, fq = lane >> 4;
    const int K = g.K, nt = K / BK;
    int ts_lo = 0, ts_hi = 0, nts = 0; const unsigned long long rt_entry = STAMP ? (unsigned long long)wall_clock64() : 0ull;
#define PG8_STAMP() do { if (STAMP && wid == 0 && nts < 64) { const unsigned long long _c = (unsigned long long)clock64(); \
        ts_lo = (lane == nts) ? (int)(unsigned)_c : ts_lo; ts_hi = (lane == nts) ? (int)(unsigned)(_c >> 32) : ts_hi; ++nts; } } while (0)
    PG8_STAMP();
    unsigned voffA[2], voffB[2];
#pragma unroll
    for (int i = 0; i < 2; ++i) { int R, C; stage_rc(tid * 16 + i * 8192, R, C); const int Rb = Epi::PERM ? ((R & ~31) + perm32(R & 31)) : R;
        voffA[i] = (unsigned)(R * K + C) * 2u; voffB[i] = (unsigned)(Rb * K + C) * 2u; }
    const size_t kstep = (size_t)(BK * 2);
    const size_t hstep = (size_t)HALF * K * 2;
    const size_t tstep = 2 * hstep;
    const unsigned ldsw = (unsigned)wid * 1024u;
    const int aoff = lds_byte(wr * 64 + fr, fq * 8), boff = lds_byte(wc * 32 + fr, fq * 8);
#define PG8_SA(b, h) (((b) * 2 + (h)) * HTB)
#define PG8_SB(b, h) ((4 + (b) * 2 + (h)) * HTB)
#define PG8_STAGE(bufoff, gbase, voff) do { _Pragma("unroll") for (int _i = 0; _i < 2; ++_i) \
        __builtin_amdgcn_global_load_lds((const unsigned*)((const char*)(gbase) + (voff)[_i]), (PG8_LAS unsigned*)(lds + (bufoff) + ldsw + _i * 8192), 16, 0, 0); } while (0)
#define PG8_LDA(dst, b, h) do { _Pragma("unroll") for (int m = 0; m < 4; ++m) _Pragma("unroll") for (int k = 0; k < 2; ++k) dst[m][k] = *(const PG8_LAS bf16x8*)(lds + PG8_SA(b, h) + aoff + m * 2048 + k * 1024); } while (0)
#define PG8_LDB(dst, b, h) do { _Pragma("unroll") for (int n = 0; n < 2; ++n) _Pragma("unroll") for (int k = 0; k < 2; ++k) dst[n][k] = *(const PG8_LAS bf16x8*)(lds + PG8_SB(b, h) + boff + n * 2048 + k * 1024); } while (0)
#define PG8_MMA(ai, bj, At, Bt) do { __builtin_amdgcn_s_setprio(1); _Pragma("unroll") for (int m = 0; m < 4; ++m) _Pragma("unroll") for (int n = 0; n < 2; ++n) _Pragma("unroll") for (int k = 0; k < 2; ++k) \
        acc[ai][bj][m][n] = __builtin_amdgcn_mfma_f32_16x16x32_bf16(Bt[n][k], At[m][k], acc[ai][bj][m][n], 0, 0, 0); __builtin_amdgcn_s_setprio(0); } while (0)
#define PG8_WAIT_V(n) asm volatile("s_waitcnt vmcnt(" #n ")" ::: "memory")
#define PG8_WAIT_L(n) asm volatile("s_waitcnt lgkmcnt(" #n ")" ::: "memory")
#define PG8_BAR __builtin_amdgcn_s_barrier()
#define PG8_SCHED __builtin_amdgcn_sched_barrier(0)
    Unit cur, nxt; int ui = 0;
    if (!S.next(0, cur)) return;
    f32x4 acc[2][2][4][2];
#pragma unroll
    for (int a = 0; a < 2; ++a)
#pragma unroll
        for (int b = 0; b < 2; ++b)
#pragma unroll
            for (int m = 0; m < 4; ++m)
#pragma unroll
                for (int n = 0; n < 2; ++n) acc[a][b][m][n] = (f32x4){0.f, 0.f, 0.f, 0.f};
    bf16x8 At[4][2], B0[2][2], B1[2][2];
    const char* cA = (const char*)g.A + (size_t)cur.pm * tstep; const char* cB = (const char*)g.Bt + (size_t)cur.pn * tstep;
    S.a_ready(cur);
    PG8_STAGE(PG8_SB(0, 0), cB, voffB); PG8_STAGE(PG8_SA(0, 0), cA, voffA); PG8_STAGE(PG8_SB(0, 1), cB + hstep, voffB); PG8_STAGE(PG8_SA(0, 1), cA + hstep, voffA);
    if (wr == 1) PG8_BAR;
    PG8_WAIT_V(4); PG8_BAR;
    PG8_STAGE(PG8_SB(1, 0), cB + kstep, voffB); PG8_STAGE(PG8_SA(1, 0), cA + kstep, voffA); PG8_STAGE(PG8_SB(1, 1), cB + hstep + kstep, voffB);
    PG8_WAIT_V(6); PG8_BAR;
    PG8_STAMP();
    for (;;) {
        const bool has_next = S.next(ui + 1, nxt);
        const char* nA = has_next ? (const char*)g.A + (size_t)nxt.pm * tstep : cA; const char* nB = has_next ? (const char*)g.Bt + (size_t)nxt.pn * tstep : cB;
        for (int t = 0; t < nt; t += 2) {
            const bool last = (t == nt - 2);
            const char* a1 = cA + (size_t)(t + 1) * kstep;
            const char* a2 = last ? nA : cA + (size_t)(t + 2) * kstep; const char* b2 = last ? nB : cB + (size_t)(t + 2) * kstep;
            const char* a3 = a2 + kstep; const char* b3 = b2 + kstep;
            if (last && has_next) S.a_ready(nxt);
            PG8_LDB(B0, 0, 0); PG8_SCHED; PG8_LDA(At, 0, 0); PG8_STAGE(PG8_SA(1, 1), a1 + hstep, voffA);
            PG8_WAIT_L(8); PG8_BAR; PG8_WAIT_L(0); PG8_MMA(0, 0, At, B0); PG8_BAR; PG8_SCHED;
            PG8_LDB(B1, 0, 1); PG8_STAGE(PG8_SB(0, 0), b2, voffB);
            PG8_BAR; PG8_WAIT_L(0); PG8_MMA(0, 1, At, B1); PG8_BAR;
            PG8_LDA(At, 0, 1); PG8_STAGE(PG8_SA(0, 0), a2, voffA);
            PG8_BAR; PG8_WAIT_L(0); PG8_MMA(1, 0, At, B0); PG8_BAR; PG8_SCHED;
            PG8_STAGE(PG8_SB(0, 1), b2 + hstep, voffB);
            PG8_WAIT_V(6); PG8_BAR; PG8_MMA(1, 1, At, B1); PG8_BAR;
            PG8_LDB(B0, 1, 0); PG8_SCHED; PG8_LDA(At, 1, 0); PG8_STAGE(PG8_SA(0, 1), a2 + hstep, voffA);
            PG8_WAIT_L(8); PG8_BAR; PG8_WAIT_L(0); PG8_MMA(0, 0, At, B0); PG8_BAR; PG8_SCHED;
            PG8_LDB(B1, 1, 1); PG8_STAGE(PG8_SB(1, 0), b3, voffB);
            PG8_BAR; PG8_WAIT_L(0); PG8_MMA(0, 1, At, B1); PG8_BAR;
            PG8_LDA(At, 1, 1); PG8_STAGE(PG8_SA(1, 0), a3, voffA);
            PG8_BAR; PG8_WAIT_L(0); PG8_MMA(1, 0, At, B0); PG8_BAR; PG8_SCHED;
            PG8_STAGE(PG8_SB(1, 1), b3 + hstep, voffB);
            PG8_WAIT_V(6); PG8_BAR; PG8_MMA(1, 1, At, B1); PG8_BAR;
        }
        PG8_STAMP();
        if constexpr (!Epi::AFTER_DRAIN) { E(acc, cur, wr, wc, fr, fq); S.done(cur); }
        PG8_STAMP();
        if (!has_next) break;
#pragma unroll
        for (int a = 0; a < 2; ++a)
#pragma unroll
            for (int b = 0; b < 2; ++b)
#pragma unroll
                for (int m = 0; m < 4; ++m)
#pragma unroll
                    for (int n = 0; n < 2; ++n) acc[a][b][m][n] = (f32x4){0.f, 0.f, 0.f, 0.f};
        cur = nxt; cA = nA; cB = nB; ++ui;
    }
    PG8_WAIT_V(0);
    if (wr == 0) PG8_BAR;
    PG8_BAR;
    if constexpr (Epi::AFTER_DRAIN) { E.fused(acc, cur, wr, wc, fr, fq, lds, wid, lane); S.done(cur); }
    PG8_STAMP();
    if (STAMP && wid == 0) { stamps[lane] = lane < nts ? (((unsigned long long)(unsigned)ts_hi << 32) | (unsigned)ts_lo) : 0ull;
        if (lane == 62) stamps[62] = rt_entry; if (lane == 63) stamps[63] = (unsigned long long)wall_clock64(); }
#undef PG8_STAMP
#undef PG8_SA
#undef PG8_SB
#undef PG8_STAGE
#undef PG8_LDA
#undef PG8_LDB
#undef PG8_MMA
#undef PG8_WAIT_V
#undef PG8_WAIT_L
#undef PG8_BAR
#undef PG8_SCHED
}
}
#define GAS __attribute__((address_space(1)))
#define LAS __attribute__((address_space(3)))
typedef unsigned short bf16;
typedef unsigned v4u __attribute__((ext_vector_type(4)));
typedef float f32x4 __attribute__((ext_vector_type(4)));
typedef short bf16x8 __attribute__((ext_vector_type(8)));
typedef GAS unsigned gu32;
typedef GAS unsigned long long gu64;
__device__ __forceinline__ int fresh_lane() { unsigned m_ = ~0u; asm volatile("" : "+s"(m_)); return (int)__builtin_amdgcn_mbcnt_hi(m_, __builtin_amdgcn_mbcnt_lo(m_, 0u)); }
#define RLX_AGENT __ATOMIC_RELAXED, __HIP_MEMORY_SCOPE_AGENT
#define LDS_WAIT() asm volatile("s_waitcnt lgkmcnt(0)" ::: "memory")
#define VM_WAIT() asm volatile("s_waitcnt vmcnt(0)" ::: "memory")
__device__ __forceinline__ unsigned long long rt() { return __builtin_amdgcn_s_memrealtime(); }
__device__ __forceinline__ unsigned f2bf(float f) { unsigned u = __builtin_bit_cast(unsigned, f); return (u + 0x7fffu + ((u >> 16) & 1u)) >> 16; }
__device__ __forceinline__ unsigned pk2(float lo, float hi) { return f2bf(lo) | (f2bf(hi) << 16); }
#define XB_TMO      128
#define XB_XCNT(j)  (256  + 64 * (j))
#define XB_XSUB(j)  (1280 + 64 * (j))
#define XB_XGEN(j)  (2304 + 64 * (j))
#define XB_TOP      3328
#define XB_TOPGEN   3392
#define XCD_BAR_WORDS 3456
#define XB_SPIN_CAP (1u << 22)

__device__ __forceinline__ unsigned xb_ld(unsigned* p)              { return __hip_atomic_load(p, __ATOMIC_RELAXED, __HIP_MEMORY_SCOPE_AGENT); }
__device__ __forceinline__ unsigned xb_add(unsigned* p, unsigned v) { return __hip_atomic_fetch_add(p, v, __ATOMIC_RELAXED, __HIP_MEMORY_SCOPE_AGENT); }
__device__ __forceinline__ unsigned xb_xcc_id() { return (unsigned)__builtin_amdgcn_s_getreg((3 << 11) | 20) & 0xFu; }
#define XB_SPIN(cond, bar) do { unsigned _sp = 0; while (cond) { __builtin_amdgcn_s_sleep(1); \
    if ((++_sp & 255u) == 0u) { if (xb_ld(&(bar)[XB_TMO])) break; if (_sp > XB_SPIN_CAP) { atomicAdd(&(bar)[XB_TMO], 1u); break; } } } } while (0)

struct XcdBarrier {
    unsigned* bar; unsigned x;
    volatile LAS unsigned* st;
};

__device__ __forceinline__ XcdBarrier xcd_barrier_post(unsigned* bar, volatile LAS unsigned* st, const int tid_) {
    XcdBarrier b; b.bar = bar; b.x = xb_xcc_id(); b.st = st;
    if (tid_ == 0) (void)xb_add(&bar[XB_XCNT(b.x)], 1u);
    return b;
}
__device__ __forceinline__ void xcd_barrier_complete(unsigned* bar, unsigned x, unsigned& nloc, unsigned& nx) {
    const unsigned G = gridDim.x * gridDim.y * gridDim.z;
    unsigned sum, cnt, mine, sp = 0u;
    for (;;) {
        sum = 0u; cnt = 0u; mine = 0u;
#pragma unroll
        for (unsigned j = 0; j < 16; ++j) { const unsigned c = xb_ld(&bar[XB_XCNT(j)]); sum += c; cnt += (c > 0u) ? 1u : 0u; mine = (j == x) ? c : mine; }
        if (sum == G) break;
        __builtin_amdgcn_s_sleep(1);
        if ((++sp & 255u) == 0u) { if (xb_ld(&bar[XB_TMO])) break; if (sp > XB_SPIN_CAP) { atomicAdd(&bar[XB_TMO], 1u); break; } }
    }
    nloc = mine > 0u ? mine : 1u; nx = cnt > 0u ? cnt : 1u;
}

__device__ __forceinline__ void xcd_barrier(const XcdBarrier& b, const int tid_) {
    asm volatile("s_waitcnt vmcnt(0)" ::: "memory");
    __syncthreads();
    if (tid_ == 0) {
        unsigned* bar = b.bar;
        __builtin_amdgcn_s_waitcnt(0);
        unsigned nloc = b.st[0], nx = b.st[1];
        if (nloc == 0u) { xcd_barrier_complete(bar, b.x, nloc, nx); b.st[0] = nloc; b.st[1] = nx; }
        const unsigned old = xb_add(&bar[XB_XSUB(b.x)], 1u);
        const unsigned gen = old / nloc;
        if (old + 1u == (gen + 1u) * nloc) {
            __builtin_amdgcn_fence(__ATOMIC_RELEASE, "agent");
            asm volatile("s_waitcnt vmcnt(0)" ::: "memory");
            const unsigned og = xb_add(&bar[XB_TOP], 1u);
            const unsigned tg = og / nx;
            if (og + 1u == (tg + 1u) * nx) xb_add(&bar[XB_TOPGEN], 1u);
            else XB_SPIN(xb_ld(&bar[XB_TOPGEN]) == tg, bar);
            __builtin_amdgcn_fence(__ATOMIC_ACQUIRE, "agent");
            xb_add(&bar[XB_XGEN(b.x)], 1u);
            asm volatile("s_waitcnt vmcnt(0)" ::: "memory");
        } else {
            XB_SPIN(xb_ld(&bar[XB_XGEN(b.x)]) == gen, bar);
            __builtin_amdgcn_fence(__ATOMIC_ACQUIRE, "agent");
            asm volatile("s_waitcnt vmcnt(0)" ::: "memory");
        }
    }
    __syncthreads();
}

constexpr int BATCH = 8, SEQ = 2048, DM = 1024, MTOK = BATCH * SEQ, NLAYER = 2;
constexpr int GW = 256, HD = 64, NHEAD = 4;
constexpr int IN_COLS = 4236, NP = 4352;
constexpr int C_HG_Q = 0, C_HG_F = 256, C_HG_I = 512;
constexpr int C_GD_Q = 768, C_GD_K = 1024, C_GD_V = 1280;
constexpr int C_SS_X = 1536, C_SS_B = 1792, C_SS_C = 2048;
constexpr int C_RW_R = 2304, C_RW_K = 2560, C_RW_V = 2816;
constexpr int C_Z = 3072;
constexpr int C_GD_BETA = 4096, C_GD_DEC = 4100, C_SS_DT = 4104, C_RW_WD = 4112, C_RW_AD = 4176;

__host__ __device__ __forceinline__ int old_col(int n) {
    if (n < 1536) return n;
    if (n < 2304) return 1544 + (n - 1536);
    if (n < 3072) return 2316 + (n - 2304);
    if (n < 4096) return 3212 + (n - 3072);
    if (n < 4104) return 1536 + (n - 4096);
    if (n < 4108) return 2312 + (n - 4104);
    if (n < 4112) return -1;
    if (n < 4240) return 3084 + (n - 4112);
    return -1;
}
__device__ __forceinline__ float bf2f(bf16 b) { return __builtin_bit_cast(float, ((unsigned)b) << 16); }
__device__ __forceinline__ float wave_sum(float v) {
#pragma unroll
    for (int o = 1; o < 64; o <<= 1) v += __shfl_xor(v, o);
    return v;
}
__device__ __forceinline__ float sigmoidf_(float x) { return __builtin_amdgcn_rcpf(1.f + __expf(-x)); }
__device__ __forceinline__ float siluf_(float x) { return x * __builtin_amdgcn_rcpf(1.f + __expf(-x)); }
__device__ __forceinline__ float softplusf_(float x) { return x > 20.f ? x : log1pf(__expf(x)); }

struct Inputs {
    const float* x; const float* pre_norm_g; const float* w_in; const float* hgrn_lb; const float* hgrn_norm_g;
    const float* gdn_conv_w; const float* gdn_a_log; const float* gdn_dt_bias; const float* gdn_norm_g;
    const float* ssm_conv_w; const float* ssm_conv_b; const float* ssm_a_log; const float* ssm_dt_bias; const float* ssm_d; const float* ssm_norm_g;
    const float* rwkv_mu; const float* rwkv_w0; const float* rwkv_w_up; const float* rwkv_a0; const float* rwkv_a_up; const float* rwkv_k_k; const float* rwkv_k_a;
    const float* rwkv_r_k; const float* rwkv_ln_w; const float* rwkv_ln_b; const float* w_out; const float* post_norm_g;
};


typedef short bf16x4 __attribute__((ext_vector_type(4)));
typedef unsigned v2u __attribute__((ext_vector_type(2)));
#define MFMA16(a, b, c) __builtin_amdgcn_mfma_f32_16x16x32_bf16((a), (b), (c), 0, 0, 0)
constexpr int LS = 72;
constexpr int MAT_B = 64 * LS * 2;
constexpr int LS2 = 136;
constexpr int HEAD_LDS = 73728;

typedef float f32x2_ __attribute__((ext_vector_type(2)));
typedef __bf16 bf2_ __attribute__((ext_vector_type(2)));
#ifndef HWCVT
#define HWCVT 0
#endif
__device__ __forceinline__ unsigned pk_hw(float lo, float hi) { const f32x2_ v_ = {lo, hi}; const bf2_ r_ = __builtin_convertvector(v_, bf2_); return __builtin_bit_cast(unsigned, r_); }
__device__ __forceinline__ unsigned pk_sw(float lo, float hi) { return f2bf(lo) | (f2bf(hi) << 16); }
__device__ __forceinline__ unsigned pk_bf16(float lo, float hi) { return (HWCVT & 1) ? pk_hw(lo, hi) : pk_sw(lo, hi); }
__device__ __forceinline__ bf16 cvt_bf16(float x) { return (HWCVT & 2) ? (bf16)(pk_hw(x, x) & 0xffffu) : (bf16)f2bf(x); }
__device__ __forceinline__ bf16x8 ld_frag(const LAS bf16* base, int stride, int row, int kofs, int q) {
    return *(const LAS bf16x8*)(base + row * stride + kofs + 8 * q);
}
__device__ __forceinline__ bf16x8 ld_frag_perm(const LAS bf16* base, int stride, int row, int kofs, int q) {
    const bf16x4 lo = *(const LAS bf16x4*)(base + row * stride + kofs + 4 * q);
    const bf16x4 hi = *(const LAS bf16x4*)(base + row * stride + kofs + 16 + 4 * q);
    bf16x8 v; v[0] = lo[0]; v[1] = lo[1]; v[2] = lo[2]; v[3] = lo[3]; v[4] = hi[0]; v[5] = hi[1]; v[6] = hi[2]; v[7] = hi[3]; return v;
}
__device__ __forceinline__ bf16x8 pack_frag(const f32x4& a, const f32x4& b) {
    union { unsigned u[4]; bf16x8 v; } x;
    x.u[0] = pk_bf16(a[0], a[1]); x.u[1] = pk_bf16(a[2], a[3]); x.u[2] = pk_bf16(b[0], b[1]); x.u[3] = pk_bf16(b[2], b[3]); return x.v;
}
__device__ __forceinline__ void st4(LAS bf16* base, int stride, int row, int col, const f32x4& v) {
    v2u o; o.x = pk_bf16(v[0], v[1]); o.y = pk_bf16(v[2], v[3]); *(LAS v2u*)(base + row * stride + col) = o;
}
__device__ __forceinline__ f32x4 zero4() { return (f32x4){0.f, 0.f, 0.f, 0.f}; }
#define WG_BAR() __syncthreads()

__device__ __forceinline__ void ssd_pack16(LAS bf16* dst, const float* v) {
    v4u w0, w1;
    w0.x = pk_bf16(v[0], v[1]); w0.y = pk_bf16(v[2], v[3]); w0.z = pk_bf16(v[4], v[5]); w0.w = pk_bf16(v[6], v[7]);
    w1.x = pk_bf16(v[8], v[9]); w1.y = pk_bf16(v[10], v[11]); w1.z = pk_bf16(v[12], v[13]); w1.w = pk_bf16(v[14], v[15]);
    *(LAS v4u*)dst = w0; *(LAS v4u*)(dst + 8) = w1;
}
#define RAWF(arr, j) bf2f((arr)[(j) >> 1][(j) & 1])
__device__ __forceinline__ int opaque_i(int v) { asm volatile("" : "+v"(v)); return v; }
#define RAWG(arr, j) bf2f((arr)[(j)])

template <bool HW> __device__ __forceinline__ unsigned pkx(float lo, float hi) { if constexpr (HW) return pk_hw(lo, hi); else return pk_bf16(lo, hi); }
template <bool HW> __device__ __forceinline__ bf16x8 pack_frag_x(const f32x4& a, const f32x4& b) {
    union { unsigned u[4]; bf16x8 v; } x;
    x.u[0] = pkx<HW>(a[0], a[1]); x.u[1] = pkx<HW>(a[2], a[3]); x.u[2] = pkx<HW>(b[0], b[1]); x.u[3] = pkx<HW>(b[2], b[3]); return x.v; }
template <bool HW> __device__ __forceinline__ void st4_x(LAS bf16* base, int stride, int row, int col, const f32x4& v) {
    v2u o; o.x = pkx<HW>(v[0], v[1]); o.y = pkx<HW>(v[2], v[3]); *(LAS v2u*)(base + row * stride + col) = o; }
template <bool HW> __device__ __forceinline__ void pack16_x(LAS bf16* dst, const float* v) {
    v4u w0, w1;
    w0.x = pkx<HW>(v[0], v[1]); w0.y = pkx<HW>(v[2], v[3]); w0.z = pkx<HW>(v[4], v[5]); w0.w = pkx<HW>(v[6], v[7]);
    w1.x = pkx<HW>(v[8], v[9]); w1.y = pkx<HW>(v[10], v[11]); w1.z = pkx<HW>(v[12], v[13]); w1.w = pkx<HW>(v[14], v[15]);
    *(LAS v4u*)dst = w0; *(LAS v4u*)(dst + 8) = w1; }
#ifndef HWSITES
#define HWSITES 0
#endif
#define SITE(k) (((HWSITES) >> (k)) & 1)

constexpr int CSPLIT = 18, NSEG2 = SEQ / 64 - CSPLIT;
constexpr int CSPLIT_S = 16, NSEG2_S = SEQ / 64 - CSPLIT_S;

__device__ __forceinline__ void corr_item_rms(const float* __restrict__ gain, const bf16* __restrict__ P  , bf16* __restrict__ Yb  , const int zcol  , const int ycol,
                                              const bf16* __restrict__ ZT  , const bf16* __restrict__ CB  , const int ch, const int m, const int lane) {
    const int r = lane & 15, q = lane >> 4;
    const bf16* O0 = CB; const bf16* Gm = CB + 4096;
    bf16x8 ag[2];
#pragma unroll
    for (int k = 0; k < 2; ++k) ag[k] = *(const bf16x8*)(Gm + (16 * m + r) * 64 + 32 * k + 8 * q);
    f32x4 O[4]; float ss = 0.f;
#pragma unroll
    for (int nv = 0; nv < 4; ++nv) { const v2u o0 = *(const v2u*)(O0 + (16 * m + r) * 64 + 16 * nv + 4 * q);
        O[nv][0] = __builtin_bit_cast(float, o0.x << 16); O[nv][1] = __builtin_bit_cast(float, o0.x & 0xffff0000u); O[nv][2] = __builtin_bit_cast(float, o0.y << 16); O[nv][3] = __builtin_bit_cast(float, o0.y & 0xffff0000u);
#pragma unroll
        for (int k = 0; k < 2; ++k) O[nv] = MFMA16(*(const bf16x8*)(ZT + (16 * nv + r) * 64 + 32 * k + 8 * q), ag[k], O[nv]);
        ss += (O[nv][0] * O[nv][0] + O[nv][1] * O[nv][1]) + (O[nv][2] * O[nv][2] + O[nv][3] * O[nv][3]); }
    ss += __shfl_xor(ss, 16); ss += __shfl_xor(ss, 32);
    const float rs = rsqrtf(ss * (1.f / 64.f) + 1e-6f);
    const int t = ch * 64 + 16 * m + r;
#pragma unroll
    for (int nv = 0; nv < 4; ++nv) { const int dv0 = 16 * nv + 4 * q;
        const f32x4 gg = *(const f32x4*)(gain + dv0);
        const v2u zr = *(const v2u*)(P + (size_t)t * NP + zcol + dv0);
        const float z0 = __builtin_bit_cast(float, zr.x << 16), z1 = __builtin_bit_cast(float, zr.x & 0xffff0000u), z2 = __builtin_bit_cast(float, zr.y << 16), z3 = __builtin_bit_cast(float, zr.y & 0xffff0000u);
        v2u o; o.x = pk_bf16(O[nv][0] * rs * gg[0] * siluf_(z0), O[nv][1] * rs * gg[1] * siluf_(z1)); o.y = pk_bf16(O[nv][2] * rs * gg[2] * siluf_(z2), O[nv][3] * rs * gg[3] * siluf_(z3));
        *(v2u*)(Yb + (size_t)t * DM + ycol + dv0) = o; }
}

__device__ __forceinline__ void corr_item_ssd(const float* __restrict__ gain  , const bf16* __restrict__ P, bf16* __restrict__ Yb, const int h, const int hh,
                                              const bf16* __restrict__ ZT  , const unsigned char* __restrict__ CBh  , const bf16* __restrict__ Cg  ,
                                              const int ch, const int m, const int lane, LAS float* SSx) {
    const int r = lane & 15, q = lane >> 4;
    const bf16* O0 = (const bf16*)CBh; const float sc = ((const float*)(CBh + 8192))[16 * m + r];
    bf16x8 ac[4];
#pragma unroll
    for (int k = 0; k < 4; ++k) ac[k] = *(const bf16x8*)(Cg + (16 * m + r) * 128 + 32 * k + 8 * q);
    const int t = ch * 64 + 16 * m + r;
    f32x4 yv[4]; float ss = 0.f;
#pragma unroll
    for (int nv = 0; nv < 4; ++nv) { f32x4 os = zero4();
#pragma unroll
        for (int k = 0; k < 4; ++k) os = MFMA16(*(const bf16x8*)(ZT + (16 * nv + r) * 128 + 32 * k + 8 * q), ac[k], os);
        const v2u o0 = *(const v2u*)(O0 + (16 * m + r) * 64 + 16 * nv + 4 * q);
        const v2u zr = *(const v2u*)(P + (size_t)t * NP + C_Z + 512 + h * 64 + 16 * nv + 4 * q);
        const float z0 = __builtin_bit_cast(float, zr.x << 16), z1 = __builtin_bit_cast(float, zr.x & 0xffff0000u), z2 = __builtin_bit_cast(float, zr.y << 16), z3 = __builtin_bit_cast(float, zr.y & 0xffff0000u);
        yv[nv][0] = (__builtin_bit_cast(float, o0.x << 16) + sc * os[0]) * siluf_(z0); yv[nv][1] = (__builtin_bit_cast(float, o0.x & 0xffff0000u) + sc * os[1]) * siluf_(z1);
        yv[nv][2] = (__builtin_bit_cast(float, o0.y << 16) + sc * os[2]) * siluf_(z2); yv[nv][3] = (__builtin_bit_cast(float, o0.y & 0xffff0000u) + sc * os[3]) * siluf_(z3);
        ss += (yv[nv][0] * yv[nv][0] + yv[nv][1] * yv[nv][1]) + (yv[nv][2] * yv[nv][2] + yv[nv][3] * yv[nv][3]); }
    ss += __shfl_xor(ss, 16); ss += __shfl_xor(ss, 32);
    if (q == 0) SSx[hh * 64 + 16 * m + r] = ss;
    __syncthreads();
    const float tot = SSx[16 * m + r] + SSx[64 + 16 * m + r];
    const float rs = rsqrtf(tot * (1.f / 128.f) + 1e-6f);
#pragma unroll
    for (int nv = 0; nv < 4; ++nv) { const f32x4 gg = *(const f32x4*)(gain + 16 * nv + 4 * q); v2u o; o.x = pk_bf16(yv[nv][0] * rs * gg[0], yv[nv][1] * rs * gg[1]); o.y = pk_bf16(yv[nv][2] * rs * gg[2], yv[nv][3] * rs * gg[3]);
        *(v2u*)(Yb + (size_t)t * DM + 512 + h * 64 + 16 * nv + 4 * q) = o; }
    __syncthreads();
}

__device__ __forceinline__ void corr_item_rwkv(const Inputs& in, const int layer, const bf16* __restrict__ P, bf16* __restrict__ Yb, const int h, const bf16* __restrict__ ZT, const unsigned char* __restrict__ CB,
                                               const int ch, const int m, const int lane) {
    const int r = lane & 15, q = lane >> 4;
    const bf16* O0 = (const bf16*)CB; const bf16* Gm = (const bf16*)(CB + 8192); const float bon = ((const float*)(CB + 16384))[16 * m + r];
    bf16x8 ag[2];
#pragma unroll
    for (int k = 0; k < 2; ++k) ag[k] = *(const bf16x8*)(Gm + (16 * m + r) * 64 + 32 * k + 8 * q);
    f32x4 O[4]; float s1 = 0.f;
#pragma unroll
    for (int nv = 0; nv < 4; ++nv) { const v2u o0 = *(const v2u*)(O0 + (16 * m + r) * 64 + 16 * nv + 4 * q);
        O[nv][0] = __builtin_bit_cast(float, o0.x << 16); O[nv][1] = __builtin_bit_cast(float, o0.x & 0xffff0000u); O[nv][2] = __builtin_bit_cast(float, o0.y << 16); O[nv][3] = __builtin_bit_cast(float, o0.y & 0xffff0000u);
#pragma unroll
        for (int k = 0; k < 2; ++k) O[nv] = MFMA16(*(const bf16x8*)(ZT + (16 * nv + r) * 64 + 32 * k + 8 * q), ag[k], O[nv]);
        s1 += (O[nv][0] + O[nv][1]) + (O[nv][2] + O[nv][3]); }
    s1 += __shfl_xor(s1, 16); s1 += __shfl_xor(s1, 32);
    const float mean = s1 * (1.f / 64.f); float s2 = 0.f;
#pragma unroll
    for (int nv = 0; nv < 4; ++nv) { O[nv] = O[nv] - mean; s2 += (O[nv][0] * O[nv][0] + O[nv][1] * O[nv][1]) + (O[nv][2] * O[nv][2] + O[nv][3] * O[nv][3]); }
    s2 += __shfl_xor(s2, 16); s2 += __shfl_xor(s2, 32);
    const float rstd = rsqrtf(s2 * (1.f / 64.f) + 64e-5f);
    const int t = ch * 64 + 16 * m + r;
    const float* mu = in.rwkv_mu + (size_t)layer * 896 + 512 + h * 64;
#pragma unroll
    for (int nv = 0; nv < 4; ++nv) { const int dv0 = 16 * nv + 4 * q, cc = h * 64 + dv0;
        const f32x4 lw4 = *(const f32x4*)(in.rwkv_ln_w + layer * GW + cc); const f32x4 lb4 = *(const f32x4*)(in.rwkv_ln_b + layer * GW + cc); const f32x4 mu4 = *(const f32x4*)(mu + dv0);
        const v2u zr = *(const v2u*)(P + (size_t)t * NP + C_Z + 768 + cc);
        const v2u vx = *(const v2u*)(P + (size_t)t * NP + C_RW_V + cc); const v2u vp = *(const v2u*)(P + (size_t)(t - 1) * NP + C_RW_V + cc);
        const float z0 = __builtin_bit_cast(float, zr.x << 16), z1 = __builtin_bit_cast(float, zr.x & 0xffff0000u), z2 = __builtin_bit_cast(float, zr.y << 16), z3 = __builtin_bit_cast(float, zr.y & 0xffff0000u);
        const float x0 = __builtin_bit_cast(float, vx.x << 16), x1 = __builtin_bit_cast(float, vx.x & 0xffff0000u), x2 = __builtin_bit_cast(float, vx.y << 16), x3 = __builtin_bit_cast(float, vx.y & 0xffff0000u);
        const float p0 = __builtin_bit_cast(float, vp.x << 16), p1 = __builtin_bit_cast(float, vp.x & 0xffff0000u), p2 = __builtin_bit_cast(float, vp.y << 16), p3 = __builtin_bit_cast(float, vp.y & 0xffff0000u);
        const float v0 = x0 + (p0 - x0) * mu4[0], v1 = x1 + (p1 - x1) * mu4[1], v2 = x2 + (p2 - x2) * mu4[2], v3 = x3 + (p3 - x3) * mu4[3];
        v2u o; o.x = pk_bf16((O[nv][0] * rstd * lw4[0] + lb4[0] + bon * v0) * siluf_(z0), (O[nv][1] * rstd * lw4[1] + lb4[1] + bon * v1) * siluf_(z1));
        o.y = pk_bf16((O[nv][2] * rstd * lw4[2] + lb4[2] + bon * v2) * siluf_(z2), (O[nv][3] * rstd * lw4[3] + lb4[3] + bon * v3) * siluf_(z3));
        *(v2u*)(Yb + (size_t)t * DM + 768 + cc) = o; }
}

template <int NH> __device__ __forceinline__ void mixopt_hgrn(const Inputs& in, const int layer, const bf16* __restrict__ PROJ, bf16* __restrict__ Yg, LAS unsigned char* ldsw, const int b, const int hp, const int tid,
                                                              const int seg, bf16* __restrict__ sbuf, bf16* __restrict__ cbuf) {
    const int ch_lo = (seg == 2) ? CSPLIT : 0, ch_hi = (seg == 1) ? CSPLIT : SEQ / 64;
    const int lane = tid & 63, wave = __builtin_amdgcn_readfirstlane(tid >> 6), hh = wave >> 2, w4 = wave & 3, h = (NH == 2) ? hp * 2 + hh : hp, r = lane & 15, q = lane >> 4;
    const bool act = (NH == 2) || (hh == 0);
    LAS unsigned char* L = ldsw + hh * HEAD_LDS;
    LAS bf16* QT = (LAS bf16*)L; LAS bf16* KA = (LAS bf16*)(L + MAT_B); LAS bf16* KB = (LAS bf16*)(L + 2 * MAT_B); LAS bf16* R2 = (LAS bf16*)(L + 3 * MAT_B);
    LAS bf16* KDT = (LAS bf16*)(L + 4 * MAT_B); LAS bf16* VT = (LAS bf16*)(L + 5 * MAT_B); LAS bf16* ZT = (LAS bf16*)(L + 6 * MAT_B);
    LAS float* QTOT = (LAS float*)(L + 7 * MAT_B); LAS float* ELAST = QTOT + 256;
    const bf16* P = PROJ + (size_t)b * SEQ * NP; bf16* Yb = Yg + (size_t)b * SEQ * DM;
    const int c = h * 64 + lane;
    float lbv = 0.f;
    if (layer == 1) { const float x0 = in.hgrn_lb[c], x1 = in.hgrn_lb[GW + c]; const float mx = fmaxf(x0, x1); const float e0 = __expf(x0 - mx), e1 = __expf(x1 - mx); lbv = e1 / (e0 + e1); }
    f32x4 gn[4];
#pragma unroll
    for (int nv = 0; nv < 4; ++nv) gn[nv] = *(const f32x4*)(in.hgrn_norm_g + layer * HD + 16 * nv + 4 * q);
    f32x4 zs[4];
#pragma unroll
    for (int n = 0; n < 4; ++n) zs[n] = zero4();
    bf16 rq[16], rf[16], rv[16];
    if (act) { const bf16* p0 = P + (size_t)(ch_lo * 64 + 16 * w4) * NP;
#pragma unroll
      for (int i = 0; i < 16; ++i) { rq[i] = p0[(size_t)i * NP + C_HG_Q + c]; rf[i] = p0[(size_t)i * NP + C_HG_F + c]; rv[i] = p0[(size_t)i * NP + C_HG_I + c]; } }
    float phis = 0.f;
    for (int ch = ch_lo; ch < ch_hi; ++ch) {
        float qv[16], kv[16], cl[16], vv[16]; float run = 0.f;
        if (act) {
#pragma unroll
        for (int i = 0; i < 16; ++i) { const float x = bf2f(rq[i]); qv[i] = siluf_(x) * 0.125f; const float f = lbv + (1.f - lbv) * sigmoidf_(bf2f(rf[i])); kv[i] = 1.f - f; run += __logf(f); cl[i] = run; vv[i] = bf2f(rv[i]); }
        QTOT[w4 * 64 + lane] = run;
        if (ch + 1 < ch_hi) { const bf16* p0 = P + (size_t)((ch + 1) * 64 + 16 * w4) * NP;
#pragma unroll
            for (int i = 0; i < 16; ++i) { rq[i] = p0[(size_t)i * NP + C_HG_Q + c]; rf[i] = p0[(size_t)i * NP + C_HG_F + c]; rv[i] = p0[(size_t)i * NP + C_HG_I + c]; } }
        }
        WG_BAR();
        if (act) {
            const float o0 = QTOT[lane], o1 = QTOT[64 + lane], o2 = QTOT[128 + lane], o3 = QTOT[192 + lane];
            const float base = (w4 > 0 ? o0 : 0.f) + (w4 > 1 ? o1 : 0.f) + (w4 > 2 ? o2 : 0.f);
            const float c31 = o0 + o1, c63 = c31 + o2 + o3, cI = (w4 >= 2) ? c31 : 0.f;
            float kd[16];
#pragma unroll
            for (int i = 0; i < 16; ++i) { const float cum = cl[i] + base; const int t = 16 * w4 + i;
                QT[t * LS + lane] = cvt_bf16(qv[i] * __expf(cum - cI));
                KA[t * LS + lane] = cvt_bf16(kv[i] * __expf(fminf(cI - cum, 80.f)));
                if (w4 < 2) KB[t * LS + lane] = cvt_bf16(kv[i] * __expf(c31 - cum));
                R2[t * LS + lane] = cvt_bf16(qv[i] * __expf(cum));
                if (seg == 2) cbuf[(size_t)(ch - CSPLIT) * 8192 + 4096 + t * 64 + lane] = cvt_bf16(qv[i] * __expf(cum + phis));
                kd[i] = kv[i] * __expf(c63 - cum); }
            v4u w0, w1;
            w0.x = pk_bf16(kd[0], kd[1]); w0.y = pk_bf16(kd[2], kd[3]); w0.z = pk_bf16(kd[4], kd[5]); w0.w = pk_bf16(kd[6], kd[7]);
            w1.x = pk_bf16(kd[8], kd[9]); w1.y = pk_bf16(kd[10], kd[11]); w1.z = pk_bf16(kd[12], kd[13]); w1.w = pk_bf16(kd[14], kd[15]);
            *(LAS v4u*)(KDT + lane * LS + 16 * w4) = w0; *(LAS v4u*)(KDT + lane * LS + 16 * w4 + 8) = w1;
            w0.x = pk_bf16(vv[0], vv[1]); w0.y = pk_bf16(vv[2], vv[3]); w0.z = pk_bf16(vv[4], vv[5]); w0.w = pk_bf16(vv[6], vv[7]);
            w1.x = pk_bf16(vv[8], vv[9]); w1.y = pk_bf16(vv[10], vv[11]); w1.z = pk_bf16(vv[12], vv[13]); w1.w = pk_bf16(vv[14], vv[15]);
            *(LAS v4u*)(VT + lane * LS + 16 * w4) = w0; *(LAS v4u*)(VT + lane * LS + 16 * w4 + 8) = w1;
            if (w4 == 0) ELAST[lane] = __expf(c63);
            phis += c63;
#pragma unroll
            for (int n = 0; n < 4; ++n) st4(ZT, LS, 16 * n + r, 16 * w4 + 4 * q, zs[n]);
        }
        WG_BAR();
        if (act) {
            const int m = w4;
            f32x4 Pt[4];
#pragma unroll
            for (int n = 0; n < 4; ++n) Pt[n] = zero4();
            bf16x8 aq[2];
#pragma unroll
            for (int k = 0; k < 2; ++k) aq[k] = ld_frag(QT, LS, 16 * m + r, 32 * k, q);
#pragma unroll
            for (int n = 0; n < 4; ++n) if (n <= m) {
                const LAS bf16* Bs = ((n >> 1) == (m >> 1)) ? KA : KB;
#pragma unroll
                for (int k = 0; k < 2; ++k) Pt[n] = MFMA16(ld_frag(Bs, LS, 16 * n + r, 32 * k, q), aq[k], Pt[n]);
                if (n == m) {
#pragma unroll
                    for (int i = 0; i < 4; ++i) if (4 * q + i > r) Pt[n][i] = 0.f; }
            }
            f32x4 O[4];
#pragma unroll
            for (int nv = 0; nv < 4; ++nv) O[nv] = zero4();
#pragma unroll
            for (int k = 0; k < 2; ++k) if (2 * k <= m) { const bf16x8 pf = pack_frag(Pt[2 * k], Pt[2 * k + 1]);
#pragma unroll
                for (int nv = 0; nv < 4; ++nv) O[nv] = MFMA16(ld_frag_perm(VT, LS, 16 * nv + r, 32 * k, q), pf, O[nv]); }
#pragma unroll
            for (int k = 0; k < 2; ++k) { const bf16x8 ar = ld_frag(R2, LS, 16 * m + r, 32 * k, q);
#pragma unroll
                for (int nv = 0; nv < 4; ++nv) O[nv] = MFMA16(ld_frag(ZT, LS, 16 * nv + r, 32 * k, q), ar, O[nv]); }
            if (seg == 2) {
#pragma unroll
                for (int nv = 0; nv < 4; ++nv) { v2u o; o.x = pk_bf16(O[nv][0], O[nv][1]); o.y = pk_bf16(O[nv][2], O[nv][3]);
                    *(v2u*)(cbuf + (size_t)(ch - CSPLIT) * 8192 + (16 * m + r) * 64 + 16 * nv + 4 * q) = o; }
            } else {
            float ss = 0.f;
#pragma unroll
            for (int nv = 0; nv < 4; ++nv) ss += (O[nv][0] * O[nv][0] + O[nv][1] * O[nv][1]) + (O[nv][2] * O[nv][2] + O[nv][3] * O[nv][3]);
            ss += __shfl_xor(ss, 16); ss += __shfl_xor(ss, 32);
            const float rs = rsqrtf(ss * (1.f / 64.f) + 1e-6f);
            const int t = ch * 64 + 16 * m + r;
#pragma unroll
            for (int nv = 0; nv < 4; ++nv) { const int dv0 = h * 64 + 16 * nv + 4 * q;
                const v2u zr = *(const v2u*)(P + (size_t)t * NP + C_Z + 0 + dv0);
                const float z0 = __builtin_bit_cast(float, zr.x << 16), z1 = __builtin_bit_cast(float, zr.x & 0xffff0000u), z2 = __builtin_bit_cast(float, zr.y << 16), z3 = __builtin_bit_cast(float, zr.y & 0xffff0000u);
                v2u o; o.x = pk_bf16(O[nv][0] * rs * gn[nv][0] * siluf_(z0), O[nv][1] * rs * gn[nv][1] * siluf_(z1));
                o.y = pk_bf16(O[nv][2] * rs * gn[nv][2] * siluf_(z2), O[nv][3] * rs * gn[nv][3] * siluf_(z3));
                *(v2u*)(Yb + (size_t)t * DM + 0 + dv0) = o; }
            }
            const f32x4 el = *(const LAS f32x4*)(ELAST + 16 * w4 + 4 * q);
            bf16x8 ak[2];
#pragma unroll
            for (int k = 0; k < 2; ++k) ak[k] = ld_frag(KDT, LS, 16 * w4 + r, 32 * k, q);
#pragma unroll
            for (int n = 0; n < 4; ++n) { zs[n] = zs[n] * el;
#pragma unroll
                for (int k = 0; k < 2; ++k) zs[n] = MFMA16(ak[k], ld_frag(VT, LS, 16 * n + r, 32 * k, q), zs[n]); }
        }
        WG_BAR();
    }
    if (seg == 1 && act) {
#pragma unroll
        for (int n = 0; n < 4; ++n) { v2u o; o.x = pk_bf16(zs[n][0], zs[n][1]); o.y = pk_bf16(zs[n][2], zs[n][3]); *(v2u*)(sbuf + (16 * n + r) * 64 + 16 * w4 + 4 * q) = o; }
    }
}

__device__ __forceinline__ float tr_reduce16(const float* v, int lane) {
    float a[8], b[4], c[2], d;
    const bool b5 = lane & 32, b4 = lane & 16, b3 = lane & 8, b2 = lane & 4;
#pragma unroll
    for (int j = 0; j < 8; ++j) { const float snd = b5 ? v[j] : v[8 + j]; const float got = __shfl_xor(snd, 32); a[j] = (b5 ? v[8 + j] : v[j]) + got; }
#pragma unroll
    for (int j = 0; j < 4; ++j) { const float snd = b4 ? a[j] : a[4 + j]; const float got = __shfl_xor(snd, 16); b[j] = (b4 ? a[4 + j] : a[j]) + got; }
#pragma unroll
    for (int j = 0; j < 2; ++j) { const float snd = b3 ? b[j] : b[2 + j]; const float got = __shfl_xor(snd, 8); c[j] = (b3 ? b[2 + j] : b[j]) + got; }
    { const float snd = b2 ? c[0] : c[1]; const float got = __shfl_xor(snd, 4); d = (b2 ? c[1] : c[0]) + got; }
    d += __shfl_xor(d, 2); d += __shfl_xor(d, 1);
    return d;
}
__device__ __forceinline__ float rdlane(float x, int l) { return __builtin_bit_cast(float, __builtin_amdgcn_readlane(__builtin_bit_cast(int, x), l)); }

template <bool SW = false> __device__ __forceinline__ void diag_inverse(const LAS float* AD, LAS bf16* DT, int lane) {
    const int j = lane >> 4, c = lane & 15;
    const LAS float* A = AD + j * 256;
    float x[16];
#pragma unroll
    for (int i = 0; i < 16; ++i) {
        float s = (i == c) ? 1.f : 0.f;
#pragma unroll
        for (int k4 = 0; k4 < i; k4 += 4) { const f32x4 a = *(const LAS f32x4*)(A + i * 16 + k4);
#pragma unroll
            for (int kk = 0; kk < 4; ++kk) if (k4 + kk < i) s -= a[kk] * x[k4 + kk]; }
        x[i] = s;
    }
    v4u w0, w1;
    w0.x = pkx<SW>(x[0], x[1]); w0.y = pkx<SW>(x[2], x[3]); w0.z = pkx<SW>(x[4], x[5]); w0.w = pkx<SW>(x[6], x[7]);
    w1.x = pkx<SW>(x[8], x[9]); w1.y = pkx<SW>(x[10], x[11]); w1.z = pkx<SW>(x[12], x[13]); w1.w = pkx<SW>(x[14], x[15]);
    *(LAS v4u*)(DT + (j * 16 + c) * 16) = w0; *(LAS v4u*)(DT + (j * 16 + c) * 16 + 8) = w1;
}
__device__ __forceinline__ bf16x8 half_frag_lds(const LAS bf16* p) { const bf16x4 lo = *(const LAS bf16x4*)p; bf16x8 v; v[0] = lo[0]; v[1] = lo[1]; v[2] = lo[2]; v[3] = lo[3]; v[4] = 0; v[5] = 0; v[6] = 0; v[7] = 0; return v; }
__device__ __forceinline__ bf16x8 two_frag_lds(const LAS bf16* p0, const LAS bf16* p1) { const bf16x4 lo = *(const LAS bf16x4*)p0; const bf16x4 hi = *(const LAS bf16x4*)p1; bf16x8 v; v[0] = lo[0]; v[1] = lo[1]; v[2] = lo[2]; v[3] = lo[3]; v[4] = hi[0]; v[5] = hi[1]; v[6] = hi[2]; v[7] = hi[3]; return v; }
template <bool SW = false> __device__ __forceinline__ void tri_inverse_row(const LAS bf16* AMT, const LAS bf16* DT, int m, int r, int q, f32x4* Tm) {
    const f32x4 z4 = zero4();
    f32x4 dm;
#pragma unroll
    for (int i = 0; i < 4; ++i) dm[i] = bf2f(DT[(m * 16 + 4 * q + i) * 16 + r]);
#pragma unroll
    for (int n = 0; n < 4; ++n) Tm[n] = (n == m) ? dm : z4;
#pragma unroll
    for (int j = 2; j >= 0; --j) if (j < m) {
        f32x4 X = z4;
#pragma unroll
        for (int k = j + 1; k <= 3; k += 2) if (k <= m) {
            const LAS bf16* p0 = AMT + (16 * j + r) * LS + 16 * k + 4 * q;
            if (k + 1 <= 3) { const bf16x8 af = pack_frag_x<SW>(Tm[k], Tm[k + 1]); const bf16x8 bfr = two_frag_lds(p0, p0 + 16); X = MFMA16(bfr, af, X); }
            else { const bf16x8 af = pack_frag_x<SW>(Tm[k], z4); const bf16x8 bfr = half_frag_lds(p0); X = MFMA16(bfr, af, X); }
        }
        const bf16x8 xf = pack_frag_x<SW>(X, z4);
        const bf16x8 df = half_frag_lds(DT + (j * 16 + r) * 16 + 4 * q);
        const f32x4 Tj = MFMA16(df, xf, z4);
        Tm[j] = -Tj;
    }
}

__device__ __forceinline__ void mixopt_gdn(const Inputs& in, const int layer, const bf16* __restrict__ PROJ, bf16* __restrict__ Yg, LAS unsigned char* ldsw, const int b, const int hp, const int tid) {
    const int lane0 = tid & 63, wave = __builtin_amdgcn_readfirstlane(tid >> 6), hh = wave >> 2, w4 = wave & 3, h = hp * 2 + hh;
    LAS unsigned char* L = ldsw + hh * HEAD_LDS;
    LAS bf16* Qm = (LAS bf16*)L; LAS bf16* Km = (LAS bf16*)(L + 9216); LAS bf16* KT = (LAS bf16*)(L + 18432); LAS bf16* VT = (LAS bf16*)(L + 27648); LAS bf16* ZT = (LAS bf16*)(L + 36864);
    LAS bf16* AMT = (LAS bf16*)(L + 46080); LAS bf16* RHST = (LAS bf16*)(L + 55296); LAS float* AD = (LAS float*)(L + 64512); LAS bf16* DT = (LAS bf16*)(L + 68608);
    LAS float* CUM = (LAS float*)(L + 70656); LAS float* ECUM = CUM + 64; LAS float* BETA = CUM + 128; LAS float* WSC = CUM + 192;
    LAS bf16* VNWT = Km; LAS bf16* VNT = VT;
    const bf16* P = PROJ + (size_t)b * SEQ * NP; bf16* Yb = Yg + (size_t)b * SEQ * DM;
    const float* cw = in.gdn_conv_w + (size_t)layer * 4 * 768 + h * 64;
    const float Aneg = -__expf(in.gdn_a_log[layer * 4 + h]), dtb = in.gdn_dt_bias[layer * 4 + h];
    f32x4 zs[4];
#pragma unroll
    for (int n = 0; n < 4; ++n) zs[n] = zero4();
    typedef unsigned short us2 __attribute__((ext_vector_type(2)));
    bf16 rq[19], rk[19], rv[19]; bf16 rbt, rat;
    auto load_raw = [&](int ch, int lane) {
        const int c = h * 64 + lane;
        const int tb = ch * 64 + 16 * w4 - 3;
#pragma unroll
        for (int j = 0; j < 19; ++j) { const int t = tb + j; const bool ok = (t >= 0); const bf16* p0 = P + (size_t)(ok ? t : 0) * NP;
            const bf16 a = p0[C_GD_Q + c], bb = p0[C_GD_K + c], cc = p0[C_GD_V + c];
            rq[j] = ok ? a : (bf16)0; rk[j] = ok ? bb : (bf16)0; rv[j] = ok ? cc : (bf16)0; }
        rbt = P[(size_t)(ch * 64 + lane) * NP + C_GD_BETA + h]; rat = P[(size_t)(ch * 64 + lane) * NP + C_GD_DEC + h];
    };
    load_raw(0, lane0);
    for (int ch = 0; ch < SEQ / 64; ++ch) {
        const int lane = opaque_i(lane0), r = lane & 15, q = lane >> 4;
#ifndef GDN_REP
#define GDN_REP 0
#endif
        {
            float tv[16];
            float wq[4], wk[4], wv[4];
#pragma unroll
            for (int j = 0; j < 4; ++j) { wq[j] = cw[j * 768 + lane]; wk[j] = cw[j * 768 + 256 + lane]; wv[j] = cw[j * 768 + 512 + lane]; }
#pragma unroll
            for (int i = 0; i < 16; ++i) tv[i] = siluf_(wk[0] * RAWG(rk, i) + wk[1] * RAWG(rk, i + 1) + wk[2] * RAWG(rk, i + 2) + wk[3] * RAWG(rk, i + 3));
            { float sq[16];
#pragma unroll
              for (int i = 0; i < 16; ++i) sq[i] = tv[i] * tv[i];
              const float sred = tr_reduce16(sq, lane);
#pragma unroll
              for (int i = 0; i < 16; ++i) { tv[i] *= rsqrtf(rdlane(sred, 4 * i) + 1e-6f); Km[(16 * w4 + i) * LS + lane] = cvt_bf16(tv[i]); } }
            pack16_x<SITE(0)>(KT + lane * LS + 16 * w4, tv);
            asm volatile("" ::: "memory");
#pragma unroll
            for (int i = 0; i < 16; ++i) tv[i] = siluf_(wq[0] * RAWG(rq, i) + wq[1] * RAWG(rq, i + 1) + wq[2] * RAWG(rq, i + 2) + wq[3] * RAWG(rq, i + 3));
            { float sq[16];
#pragma unroll
              for (int i = 0; i < 16; ++i) sq[i] = tv[i] * tv[i];
              const float sred = tr_reduce16(sq, lane);
#pragma unroll
              for (int i = 0; i < 16; ++i) Qm[(16 * w4 + i) * LS + lane] = cvt_bf16(tv[i] * rsqrtf(rdlane(sred, 4 * i) + 1e-6f) * 0.125f); }
            asm volatile("" ::: "memory");
#pragma unroll
            for (int i = 0; i < 16; ++i) tv[i] = siluf_(wv[0] * RAWG(rv, i) + wv[1] * RAWG(rv, i + 1) + wv[2] * RAWG(rv, i + 2) + wv[3] * RAWG(rv, i + 3));
            pack16_x<SITE(0)>(VT + lane * LS + 16 * w4, tv);
            if (w4 == 0) {
                const float beta = sigmoidf_(bf2f(rbt)); float cs = Aneg * softplusf_(bf2f(rat) + dtb);
#pragma unroll
                for (int o = 1; o < 64; o <<= 1) { const float u = __shfl_up(cs, o); if (lane >= o) cs += u; }
                const float c63 = __shfl(cs, 63);
                CUM[lane] = cs; ECUM[lane] = __expf(cs); BETA[lane] = beta; WSC[lane] = __expf(c63 - cs);
            }
#pragma unroll
            for (int n = 0; n < 4; ++n) st4_x<SITE(1)>(ZT, LS, 16 * n + r, 16 * w4 + 4 * q, zs[n]);
        }
        WG_BAR();
        const int m = w4;
        f32x4 QK[4];
        { const int lane = opaque_i(lane0), r = lane & 15, q = lane >> 4;
        {
            bf16x8 ak[2], aq[2];
#pragma unroll
            for (int k = 0; k < 2; ++k) { ak[k] = ld_frag(Km, LS, 16 * m + r, 32 * k, q); aq[k] = ld_frag(Qm, LS, 16 * m + r, 32 * k, q); }
            const f32x4 cumt4 = *(const LAS f32x4*)(CUM + 16 * m + 4 * q);
            const f32x4 bet4 = *(const LAS f32x4*)(BETA + 16 * m + 4 * q);
            const f32x4 ecum4 = *(const LAS f32x4*)(ECUM + 16 * m + 4 * q);
            const float cumr = CUM[16 * m + r];
#pragma unroll
            for (int n = 0; n < 4; ++n) { QK[n] = zero4(); if (n <= m) {
                f32x4 kk = zero4();
#pragma unroll
                for (int k = 0; k < 2; ++k) { const bf16x8 bk = ld_frag(Km, LS, 16 * n + r, 32 * k, q);
                    kk = MFMA16(ak[k], bk, kk);
                    QK[n] = MFMA16(bk, aq[k], QK[n]); }
                const float cums = CUM[16 * n + r];
                f32x4 av;
#pragma unroll
                for (int i = 0; i < 4; ++i) { const bool keep = (n < m) || (r < 4 * q + i); av[i] = keep ? bet4[i] * kk[i] * __expf(cumt4[i] - cums) : 0.f; }
                st4_x<SITE(2)>(AMT, LS, 16 * n + r, 16 * m + 4 * q, av);
                if (n == m) {
#pragma unroll
                    for (int i = 0; i < 4; ++i) AD[m * 256 + (4 * q + i) * 16 + r] = av[i]; }
                const f32x4 cs4 = *(const LAS f32x4*)(CUM + 16 * n + 4 * q);
#pragma unroll
                for (int i = 0; i < 4; ++i) { const bool keep = (n < m) || (4 * q + i <= r); QK[n][i] = keep ? QK[n][i] * __expf(cumr - cs4[i]) : 0.f; }
            } }
#pragma unroll
            for (int nv = 0; nv < 4; ++nv) { f32x4 kz = zero4();
#pragma unroll
                for (int k = 0; k < 2; ++k) kz = MFMA16(ak[k], ld_frag(ZT, LS, 16 * nv + r, 32 * k, q), kz);
                const v2u vr = *(const LAS v2u*)(VT + (16 * nv + r) * LS + 16 * m + 4 * q);
                f32x4 rh;
                rh[0] = bet4[0] * (__builtin_bit_cast(float, vr.x << 16) - ecum4[0] * kz[0]); rh[1] = bet4[1] * (__builtin_bit_cast(float, vr.x & 0xffff0000u) - ecum4[1] * kz[1]);
                rh[2] = bet4[2] * (__builtin_bit_cast(float, vr.y << 16) - ecum4[2] * kz[2]); rh[3] = bet4[3] * (__builtin_bit_cast(float, vr.y & 0xffff0000u) - ecum4[3] * kz[3]);
                st4_x<SITE(2)>(RHST, LS, 16 * nv + r, 16 * m + 4 * q, rh); }
        }
        }
        WG_BAR();
        { const int lane = opaque_i(lane0), r = lane & 15, q = lane >> 4;
        if (ch + 1 < SEQ / 64) load_raw(ch + 1, lane);
        {
            diag_inverse<SITE(5)>(AD, DT, lane);
            asm volatile("s_waitcnt lgkmcnt(0)" ::: "memory");
            f32x4 Tm[4];
            tri_inverse_row<SITE(6)>(AMT, DT, m, r, q, Tm);
            const f32x4 w4v = *(const LAS f32x4*)(WSC + 16 * m + 4 * q);
            const bf16x8 t0 = pack_frag_x<SITE(3)>(Tm[0], Tm[1]), t1 = pack_frag_x<SITE(3)>(Tm[2], Tm[3]);
#pragma unroll
            for (int nv = 0; nv < 4; ++nv) { f32x4 vn = zero4();
                vn = MFMA16(t0, ld_frag_perm(RHST, LS, 16 * nv + r, 0, q), vn);
                if (m >= 2) vn = MFMA16(t1, ld_frag_perm(RHST, LS, 16 * nv + r, 32, q), vn);
                st4_x<SITE(3)>(VNT, LS, 16 * nv + r, 16 * m + 4 * q, vn);
                st4_x<SITE(3)>(VNWT, LS, 16 * nv + r, 16 * m + 4 * q, vn * w4v); }
        }
        }
        WG_BAR();
        { const int lane = opaque_i(lane0), r = lane & 15, q = lane >> 4; const float* gnp = in.gdn_norm_g + layer * HD + 4 * q;
        {
            f32x4 O[4];
            bf16x8 aq[2];
#pragma unroll
            for (int k = 0; k < 2; ++k) aq[k] = ld_frag(Qm, LS, 16 * m + r, 32 * k, q);
            const float ect = ECUM[16 * m + r];
            const bf16x8 p0 = pack_frag_x<SITE(4)>(QK[0], QK[1]), p1 = pack_frag_x<SITE(4)>(QK[2], QK[3]);
            float ss = 0.f;
#pragma unroll
            for (int nv = 0; nv < 4; ++nv) { O[nv] = zero4();
#pragma unroll
                for (int k = 0; k < 2; ++k) O[nv] = MFMA16(ld_frag(ZT, LS, 16 * nv + r, 32 * k, q), aq[k], O[nv]);
                O[nv] = O[nv] * ect;
                O[nv] = MFMA16(ld_frag_perm(VNT, LS, 16 * nv + r, 0, q), p0, O[nv]);
                if (m >= 2) O[nv] = MFMA16(ld_frag_perm(VNT, LS, 16 * nv + r, 32, q), p1, O[nv]);
                ss += (O[nv][0] * O[nv][0] + O[nv][1] * O[nv][1]) + (O[nv][2] * O[nv][2] + O[nv][3] * O[nv][3]); }
            ss += __shfl_xor(ss, 16); ss += __shfl_xor(ss, 32);
            const float rs = rsqrtf(ss * (1.f / 64.f) + 1e-6f);
            const int t = ch * 64 + 16 * m + r;
#pragma unroll
            for (int nv = 0; nv < 4; ++nv) { const int dv0 = h * 64 + 16 * nv + 4 * q;
                const f32x4 gg = *(const f32x4*)(gnp + 16 * nv);
                const v2u zr = *(const v2u*)(P + (size_t)t * NP + C_Z + 256 + dv0);
                const float z0 = __builtin_bit_cast(float, zr.x << 16), z1 = __builtin_bit_cast(float, zr.x & 0xffff0000u), z2 = __builtin_bit_cast(float, zr.y << 16), z3 = __builtin_bit_cast(float, zr.y & 0xffff0000u);
                v2u o; o.x = pkx<SITE(4)>(O[nv][0] * rs * gg[0] * siluf_(z0), O[nv][1] * rs * gg[1] * siluf_(z1)); o.y = pkx<SITE(4)>(O[nv][2] * rs * gg[2] * siluf_(z2), O[nv][3] * rs * gg[3] * siluf_(z3));
                *(v2u*)(Yb + (size_t)t * DM + 256 + dv0) = o; }
            const float last = ECUM[63];
            bf16x8 akt[2];
#pragma unroll
            for (int k = 0; k < 2; ++k) akt[k] = ld_frag(KT, LS, 16 * w4 + r, 32 * k, q);
#pragma unroll
            for (int n = 0; n < 4; ++n) { zs[n] = zs[n] * last;
#pragma unroll
                for (int k = 0; k < 2; ++k) zs[n] = MFMA16(akt[k], ld_frag(VNWT, LS, 16 * n + r, 32 * k, q), zs[n]); }
        }
        }
        WG_BAR();
    }
}

__device__ __forceinline__ void mixopt_gdn2(const Inputs& in, const int layer, const bf16* __restrict__ PROJ, bf16* __restrict__ Yg, LAS unsigned char* L, const int b, const int h, const int tid,
                                            const int seg, bf16* __restrict__ sbuf, bf16* __restrict__ cbuf) {
    const int ch_lo = (seg == 2) ? CSPLIT : 0, ch_hi = (seg == 1) ? CSPLIT : SEQ / 64;
    LAS bf16* PT = (LAS bf16*)(L + 80896); LAS bf16* RHSHT = (LAS bf16*)(L + 90112); LAS bf16* VNHT = (LAS bf16*)(L + 99328); LAS bf16* VNHWT = (LAS bf16*)(L + 108544);
    const int lane0 = tid & 63, wave = __builtin_amdgcn_readfirstlane(tid >> 6), grp = wave >> 2, w4 = wave & 3;
    LAS bf16* Qm = (LAS bf16*)L; LAS bf16* Km = (LAS bf16*)(L + 9216); LAS bf16* KT = (LAS bf16*)(L + 18432); LAS bf16* VT = (LAS bf16*)(L + 27648); LAS bf16* ZT = (LAS bf16*)(L + 36864);
    LAS bf16* AMT = (LAS bf16*)(L + 46080); LAS bf16* RHST = (LAS bf16*)(L + 55296); LAS bf16* QKM = (LAS bf16*)(L + 64512); LAS float* AD = (LAS float*)(L + 73728); LAS bf16* DT = (LAS bf16*)(L + 77824);
    LAS float* CUM = (LAS float*)(L + 79872); LAS float* ECUM = CUM + 64; LAS float* BETA = CUM + 128; LAS float* WSC = CUM + 192;
    LAS bf16* VNWT = Km; LAS bf16* VNT = VT;
    const bf16* P = PROJ + (size_t)b * SEQ * NP; bf16* Yb = Yg + (size_t)b * SEQ * DM;
    const float* cw = in.gdn_conv_w + (size_t)layer * 4 * 768 + h * 64;
    const float Aneg = -__expf(in.gdn_a_log[layer * 4 + h]), dtb = in.gdn_dt_bias[layer * 4 + h];
    f32x4 zs[4];
#pragma unroll
    for (int n = 0; n < 4; ++n) zs[n] = zero4();
    f32x4 ps[4];
    { const int lane_i = opaque_i(lane0), r0 = lane_i & 15, q0 = lane_i >> 4;
#pragma unroll
      for (int n = 0; n < 4; ++n)
#pragma unroll
          for (int i = 0; i < 4; ++i) ps[n][i] = (16 * w4 + 4 * q0 + i == 16 * n + r0) ? 1.f : 0.f; }
    bf16 ra[19], rb2[19]; bf16 rbt, rat;
    auto load_raw = [&](int ch, int lane) {
        const int c = h * 64 + lane;
        const int tb = ch * 64 + 16 * w4 - 3;
        if (grp == 0) {
#pragma unroll
            for (int j = 0; j < 19; ++j) { const int t = tb + j; const bool ok = (t >= 0); const bf16 a = P[(size_t)(ok ? t : 0) * NP + C_GD_K + c]; ra[j] = ok ? a : (bf16)0; }
            rbt = P[(size_t)(ch * 64 + lane) * NP + C_GD_BETA + h]; rat = P[(size_t)(ch * 64 + lane) * NP + C_GD_DEC + h];
        } else {
#pragma unroll
            for (int j = 0; j < 19; ++j) { const int t = tb + j; const bool ok = (t >= 0); const bf16* p0 = P + (size_t)(ok ? t : 0) * NP;
                const bf16 a = p0[C_GD_Q + c], bb = p0[C_GD_V + c]; ra[j] = ok ? a : (bf16)0; rb2[j] = ok ? bb : (bf16)0; }
        }
    };
    load_raw(ch_lo, lane0);
    for (int ch = ch_lo; ch < ch_hi; ++ch) {
        { const int lane = opaque_i(lane0), r = lane & 15, q = lane >> 4;
          float tv[16]; float w0[4];
          if (grp == 0) {
#pragma unroll
            for (int j = 0; j < 4; ++j) w0[j] = cw[j * 768 + 256 + lane];
#pragma unroll
            for (int i = 0; i < 16; ++i) tv[i] = siluf_(w0[0] * RAWG(ra, i) + w0[1] * RAWG(ra, i + 1) + w0[2] * RAWG(ra, i + 2) + w0[3] * RAWG(ra, i + 3));
            { float sq[16];
#pragma unroll
              for (int i = 0; i < 16; ++i) sq[i] = tv[i] * tv[i];
              const float sred = tr_reduce16(sq, lane);
#pragma unroll
              for (int i = 0; i < 16; ++i) { tv[i] *= rsqrtf(rdlane(sred, 4 * i) + 1e-6f); Km[(16 * w4 + i) * LS + lane] = cvt_bf16(tv[i]); } }
            ssd_pack16(KT + lane * LS + 16 * w4, tv);
            if (w4 == 0) {
                const float beta = sigmoidf_(bf2f(rbt)); float cs = Aneg * softplusf_(bf2f(rat) + dtb);
#pragma unroll
                for (int o = 1; o < 64; o <<= 1) { const float u = __shfl_up(cs, o); if (lane >= o) cs += u; }
                const float c63 = __shfl(cs, 63);
                CUM[lane] = cs; ECUM[lane] = __expf(cs); BETA[lane] = beta; WSC[lane] = __expf(c63 - cs);
            }
#pragma unroll
            for (int n = 0; n < 4; ++n) st4(ZT, LS, 16 * n + r, 16 * w4 + 4 * q, zs[n]);
            if (seg == 2) {
#pragma unroll
                for (int n = 0; n < 4; ++n) st4(PT, LS, 16 * n + r, 16 * w4 + 4 * q, ps[n]); }
          } else {
#pragma unroll
            for (int j = 0; j < 4; ++j) w0[j] = cw[j * 768 + lane];
#pragma unroll
            for (int i = 0; i < 16; ++i) tv[i] = siluf_(w0[0] * RAWG(ra, i) + w0[1] * RAWG(ra, i + 1) + w0[2] * RAWG(ra, i + 2) + w0[3] * RAWG(ra, i + 3));
            { float sq[16];
#pragma unroll
              for (int i = 0; i < 16; ++i) sq[i] = tv[i] * tv[i];
              const float sred = tr_reduce16(sq, lane);
#pragma unroll
              for (int i = 0; i < 16; ++i) Qm[(16 * w4 + i) * LS + lane] = cvt_bf16(tv[i] * rsqrtf(rdlane(sred, 4 * i) + 1e-6f) * 0.125f); }
            asm volatile("" ::: "memory");
#pragma unroll
            for (int j = 0; j < 4; ++j) w0[j] = cw[j * 768 + 512 + lane];
#pragma unroll
            for (int i = 0; i < 16; ++i) tv[i] = siluf_(w0[0] * RAWG(rb2, i) + w0[1] * RAWG(rb2, i + 1) + w0[2] * RAWG(rb2, i + 2) + w0[3] * RAWG(rb2, i + 3));
            ssd_pack16(VT + lane * LS + 16 * w4, tv);
          }
        }
        WG_BAR();
        const int m = w4;
        { const int lane = opaque_i(lane0), r = lane & 15, q = lane >> 4;
          if (ch + 1 < ch_hi) load_raw(ch + 1, lane);
          if (grp == 0) {
            bf16x8 ak[2];
#pragma unroll
            for (int k = 0; k < 2; ++k) ak[k] = ld_frag(Km, LS, 16 * m + r, 32 * k, q);
            const f32x4 cumt4 = *(const LAS f32x4*)(CUM + 16 * m + 4 * q);
            const f32x4 bet4 = *(const LAS f32x4*)(BETA + 16 * m + 4 * q);
            const f32x4 ecum4 = *(const LAS f32x4*)(ECUM + 16 * m + 4 * q);
#pragma unroll
            for (int n = 0; n < 4; ++n) if (n <= m) {
                f32x4 kk = zero4();
#pragma unroll
                for (int k = 0; k < 2; ++k) kk = MFMA16(ak[k], ld_frag(Km, LS, 16 * n + r, 32 * k, q), kk);
                const float cums = CUM[16 * n + r];
                f32x4 av;
#pragma unroll
                for (int i = 0; i < 4; ++i) { const bool keep = (n < m) || (r < 4 * q + i); av[i] = keep ? bet4[i] * kk[i] * __expf(cumt4[i] - cums) : 0.f; }
                st4(AMT, LS, 16 * n + r, 16 * m + 4 * q, av);
                if (n == m) {
#pragma unroll
                    for (int i = 0; i < 4; ++i) AD[m * 256 + (4 * q + i) * 16 + r] = av[i]; }
            }
#pragma unroll
            for (int nv = 0; nv < 4; ++nv) { f32x4 kz = zero4();
#pragma unroll
                for (int k = 0; k < 2; ++k) kz = MFMA16(ak[k], ld_frag(ZT, LS, 16 * nv + r, 32 * k, q), kz);
                const v2u vr = *(const LAS v2u*)(VT + (16 * nv + r) * LS + 16 * m + 4 * q);
                f32x4 rh;
                rh[0] = bet4[0] * (__builtin_bit_cast(float, vr.x << 16) - ecum4[0] * kz[0]); rh[1] = bet4[1] * (__builtin_bit_cast(float, vr.x & 0xffff0000u) - ecum4[1] * kz[1]);
                rh[2] = bet4[2] * (__builtin_bit_cast(float, vr.y << 16) - ecum4[2] * kz[2]); rh[3] = bet4[3] * (__builtin_bit_cast(float, vr.y & 0xffff0000u) - ecum4[3] * kz[3]);
                st4(RHST, LS, 16 * nv + r, 16 * m + 4 * q, rh);
                if (seg == 2) { f32x4 kp = zero4();
#pragma unroll
                    for (int k = 0; k < 2; ++k) kp = MFMA16(ak[k], ld_frag(PT, LS, 16 * nv + r, 32 * k, q), kp);
                    f32x4 rhh; rhh[0] = -bet4[0] * ecum4[0] * kp[0]; rhh[1] = -bet4[1] * ecum4[1] * kp[1]; rhh[2] = -bet4[2] * ecum4[2] * kp[2]; rhh[3] = -bet4[3] * ecum4[3] * kp[3];
                    st4(RHSHT, LS, 16 * nv + r, 16 * m + 4 * q, rhh); } }
          } else {
            bf16x8 aq[2];
#pragma unroll
            for (int k = 0; k < 2; ++k) aq[k] = ld_frag(Qm, LS, 16 * m + r, 32 * k, q);
            const float cumr = CUM[16 * m + r];
#pragma unroll
            for (int n = 0; n < 4; ++n) { f32x4 qk = zero4(); if (n <= m) {
#pragma unroll
                for (int k = 0; k < 2; ++k) qk = MFMA16(ld_frag(Km, LS, 16 * n + r, 32 * k, q), aq[k], qk);
                const f32x4 cs4 = *(const LAS f32x4*)(CUM + 16 * n + 4 * q);
#pragma unroll
                for (int i = 0; i < 4; ++i) { const bool keep = (n < m) || (4 * q + i <= r); qk[i] = keep ? qk[i] * __expf(cumr - cs4[i]) : 0.f; } }
                st4(QKM, LS, 16 * m + r, 16 * n + 4 * q, qk); }
          }
        }
        WG_BAR();
        f32x4 O[4];
        { const int lane = opaque_i(lane0), r = lane & 15, q = lane >> 4;
          if (grp == 0) {
            diag_inverse(AD, DT, lane);
            asm volatile("s_waitcnt lgkmcnt(0)" ::: "memory");
            f32x4 Tm[4];
            tri_inverse_row(AMT, DT, m, r, q, Tm);
            const f32x4 w4v = *(const LAS f32x4*)(WSC + 16 * m + 4 * q);
            const bf16x8 t0 = pack_frag(Tm[0], Tm[1]), t1 = pack_frag(Tm[2], Tm[3]);
#pragma unroll
            for (int nv = 0; nv < 4; ++nv) { f32x4 vn = zero4();
                vn = MFMA16(t0, ld_frag_perm(RHST, LS, 16 * nv + r, 0, q), vn);
                if (m >= 2) vn = MFMA16(t1, ld_frag_perm(RHST, LS, 16 * nv + r, 32, q), vn);
                st4(VNT, LS, 16 * nv + r, 16 * m + 4 * q, vn);
                st4(VNWT, LS, 16 * nv + r, 16 * m + 4 * q, vn * w4v);
                if (seg == 2) { f32x4 vh = zero4();
                    vh = MFMA16(t0, ld_frag_perm(RHSHT, LS, 16 * nv + r, 0, q), vh);
                    if (m >= 2) vh = MFMA16(t1, ld_frag_perm(RHSHT, LS, 16 * nv + r, 32, q), vh);
                    st4(VNHT, LS, 16 * nv + r, 16 * m + 4 * q, vh);
                    st4(VNHWT, LS, 16 * nv + r, 16 * m + 4 * q, vh * w4v); } }
          } else {
            bf16x8 aq[2];
#pragma unroll
            for (int k = 0; k < 2; ++k) aq[k] = ld_frag(Qm, LS, 16 * m + r, 32 * k, q);
            const float ect = ECUM[16 * m + r];
#pragma unroll
            for (int nv = 0; nv < 4; ++nv) { O[nv] = zero4();
#pragma unroll
                for (int k = 0; k < 2; ++k) O[nv] = MFMA16(ld_frag(ZT, LS, 16 * nv + r, 32 * k, q), aq[k], O[nv]);
                O[nv] = O[nv] * ect;
                if (seg == 2) { ps[nv] = zero4();
#pragma unroll
                    for (int k = 0; k < 2; ++k) ps[nv] = MFMA16(ld_frag(PT, LS, 16 * nv + r, 32 * k, q), aq[k], ps[nv]);
                    ps[nv] = ps[nv] * ect; } }
          }
        }
        WG_BAR();
        { const int lane = opaque_i(lane0), r = lane & 15, q = lane >> 4;
          if (grp == 0) {
            const float last = ECUM[63];
            bf16x8 akt[2];
#pragma unroll
            for (int k = 0; k < 2; ++k) akt[k] = ld_frag(KT, LS, 16 * w4 + r, 32 * k, q);
#pragma unroll
            for (int n = 0; n < 4; ++n) { zs[n] = zs[n] * last;
#pragma unroll
                for (int k = 0; k < 2; ++k) zs[n] = MFMA16(akt[k], ld_frag(VNWT, LS, 16 * n + r, 32 * k, q), zs[n]); }
            if (seg == 2) {
#pragma unroll
                for (int n = 0; n < 4; ++n) { ps[n] = ps[n] * last;
#pragma unroll
                    for (int k = 0; k < 2; ++k) ps[n] = MFMA16(akt[k], ld_frag(VNHWT, LS, 16 * n + r, 32 * k, q), ps[n]); } }
          } else {
            bf16x8 pq[2];
#pragma unroll
            for (int k = 0; k < 2; ++k) pq[k] = ld_frag(QKM, LS, 16 * m + r, 32 * k, q);
            float ss = 0.f;
#pragma unroll
            for (int nv = 0; nv < 4; ++nv) {
                O[nv] = MFMA16(ld_frag(VNT, LS, 16 * nv + r, 0, q), pq[0], O[nv]);
                if (m >= 2) O[nv] = MFMA16(ld_frag(VNT, LS, 16 * nv + r, 32, q), pq[1], O[nv]);
                ss += (O[nv][0] * O[nv][0] + O[nv][1] * O[nv][1]) + (O[nv][2] * O[nv][2] + O[nv][3] * O[nv][3]); }
            if (seg == 2) { bf16* cb = cbuf + (size_t)(ch - CSPLIT) * 8192;
#pragma unroll
                for (int nv = 0; nv < 4; ++nv) {
                    ps[nv] = MFMA16(ld_frag(VNHT, LS, 16 * nv + r, 0, q), pq[0], ps[nv]);
                    if (m >= 2) ps[nv] = MFMA16(ld_frag(VNHT, LS, 16 * nv + r, 32, q), pq[1], ps[nv]);
                    v2u o; o.x = pk_bf16(O[nv][0], O[nv][1]); o.y = pk_bf16(O[nv][2], O[nv][3]); *(v2u*)(cb + (16 * m + r) * 64 + 16 * nv + 4 * q) = o;
                    v2u g; g.x = pk_bf16(ps[nv][0], ps[nv][1]); g.y = pk_bf16(ps[nv][2], ps[nv][3]); *(v2u*)(cb + 4096 + (16 * m + r) * 64 + 16 * nv + 4 * q) = g; }
            } else {
            ss += __shfl_xor(ss, 16); ss += __shfl_xor(ss, 32);
            const float rs = rsqrtf(ss * (1.f / 64.f) + 1e-6f);
            const int t = ch * 64 + 16 * m + r;
            const float* gnp = in.gdn_norm_g + layer * HD + 4 * q;
#pragma unroll
            for (int nv = 0; nv < 4; ++nv) { const int dv0 = h * 64 + 16 * nv + 4 * q;
                const f32x4 gg = *(const f32x4*)(gnp + 16 * nv);
                const v2u zr = *(const v2u*)(P + (size_t)t * NP + C_Z + 256 + dv0);
                const float z0 = __builtin_bit_cast(float, zr.x << 16), z1 = __builtin_bit_cast(float, zr.x & 0xffff0000u), z2 = __builtin_bit_cast(float, zr.y << 16), z3 = __builtin_bit_cast(float, zr.y & 0xffff0000u);
                v2u o; o.x = pk_bf16(O[nv][0] * rs * gg[0] * siluf_(z0), O[nv][1] * rs * gg[1] * siluf_(z1)); o.y = pk_bf16(O[nv][2] * rs * gg[2] * siluf_(z2), O[nv][3] * rs * gg[3] * siluf_(z3));
                *(v2u*)(Yb + (size_t)t * DM + 256 + dv0) = o; }
            }
          }
        }
        WG_BAR();
    }
    if (seg == 1 && grp == 0) { const int lane = opaque_i(lane0), r = lane & 15, q = lane >> 4;
#pragma unroll
        for (int n = 0; n < 4; ++n) { v2u o; o.x = pk_bf16(zs[n][0], zs[n][1]); o.y = pk_bf16(zs[n][2], zs[n][3]); *(v2u*)(sbuf + (16 * n + r) * 64 + 16 * w4 + 4 * q) = o; }
    }
}

__device__ __forceinline__ void mixopt_ssd(const Inputs& in, const int layer, const bf16* __restrict__ PROJ, bf16* __restrict__ Yg, LAS unsigned char* ldsw, const int b, const int g, const int tid,
                                           const int seg, unsigned char* __restrict__ sbuf, unsigned char* __restrict__ cbuf_h, unsigned char* __restrict__ cbuf_c) {
    const int ch_lo = (seg == 2) ? CSPLIT_S : 0, ch_hi = (seg == 1) ? CSPLIT_S : SEQ / 64;
    const int lane = tid & 63, wave = __builtin_amdgcn_readfirstlane(tid >> 6), hh = wave >> 2, w4 = wave & 3, h = g * 2 + hh, r = lane & 15, q = lane >> 4;
    LAS bf16* CM = (LAS bf16*)ldsw; LAS bf16* BM = (LAS bf16*)(ldsw + 17408); LAS bf16* BT = (LAS bf16*)(ldsw + 34816);
    LAS unsigned char* L = ldsw + 53248 + hh * 45056;
    LAS bf16* XVT = (LAS bf16*)L; LAS bf16* XVWT = (LAS bf16*)(L + MAT_B); LAS bf16* XR = (LAS bf16*)(L + 2 * MAT_B); LAS bf16* ZT = (LAS bf16*)(L + 3 * MAT_B);
    LAS float* CUM = (LAS float*)(ldsw + 143360 + hh * 1024); LAS float* ECUM = CUM + 64;
    LAS float* SS = (LAS float*)(ldsw + 145408);
    const bf16* P = PROJ + (size_t)b * SEQ * NP; bf16* Yb = Yg + (size_t)b * SEQ * DM;
    const int cx = h * 64 + lane, cbc = g * 128 + 64 * hh + lane;
    const float* cw = in.ssm_conv_w + (size_t)layer * 4 * 768; const float* cb = in.ssm_conv_b + (size_t)layer * 768;
    float wx[4], wB[4], wC[4];
#pragma unroll
    for (int j = 0; j < 4; ++j) { wx[j] = cw[j * 768 + cx]; wB[j] = cw[j * 768 + 256 + cbc]; wC[j] = cw[j * 768 + 512 + cbc]; }
    const float bx = cb[cx], bB = cb[256 + cbc], bC = cb[512 + cbc];
    const float Aneg = -__expf(in.ssm_a_log[layer * 4 + h]), dtb = in.ssm_dt_bias[layer * 4 + h], dsk = in.ssm_d[layer * 4 + h];
    const float* gnp = in.ssm_norm_g + layer * GW + h * 64 + 4 * q;
    f32x4 zs[2][4];
#pragma unroll
    for (int a = 0; a < 2; ++a)
#pragma unroll
        for (int n = 0; n < 4; ++n) zs[a][n] = zero4();
    typedef unsigned short us2 __attribute__((ext_vector_type(2)));
    bf16 rx[19], rB[19], rC[19]; bf16 rdt;
    auto load_raw = [&](int ch) {
        const int tb = ch * 64 + 16 * w4 - 3;
#pragma unroll
        for (int j = 0; j < 19; ++j) { const int t = tb + j; const bool ok = (t >= 0); const bf16* p0 = P + (size_t)(ok ? t : 0) * NP;
            const bf16 a = p0[C_SS_X + cx], bb = p0[C_SS_B + cbc], cc = p0[C_SS_C + cbc];
            rx[j] = ok ? a : (bf16)0; rB[j] = ok ? bb : (bf16)0; rC[j] = ok ? cc : (bf16)0; }
        rdt = P[(size_t)(ch * 64 + lane) * NP + C_SS_DT + h];
    };
    load_raw(ch_lo);
    float phis = 0.f;
    for (int ch = ch_lo; ch < ch_hi; ++ch) {
        float phis_now = phis;
        {
            float tv[16];
#pragma unroll
            for (int i = 0; i < 16; ++i) { tv[i] = siluf_(wC[0] * RAWG(rC, i) + wC[1] * RAWG(rC, i + 1) + wC[2] * RAWG(rC, i + 2) + wC[3] * RAWG(rC, i + 3) + bC);
                CM[(16 * w4 + i) * LS2 + 64 * hh + lane] = cvt_bf16(tv[i]); }
            asm volatile("" ::: "memory");
#pragma unroll
            for (int i = 0; i < 16; ++i) { tv[i] = siluf_(wB[0] * RAWG(rB, i) + wB[1] * RAWG(rB, i + 1) + wB[2] * RAWG(rB, i + 2) + wB[3] * RAWG(rB, i + 3) + bB);
                BM[(16 * w4 + i) * LS2 + 64 * hh + lane] = cvt_bf16(tv[i]); }
            ssd_pack16(BT + (64 * hh + lane) * LS + 16 * w4, tv);
            asm volatile("" ::: "memory");
            const float dt = softplusf_(bf2f(rdt) + dtb); float cs = dt * Aneg;
#pragma unroll
            for (int o = 1; o < 64; o <<= 1) { const float u = __shfl_up(cs, o); if (lane >= o) cs += u; }
            const float c63 = __shfl(cs, 63);
            const float wsc = __expf(c63 - cs);
            phis += c63;
            if (w4 == 0) { CUM[lane] = cs; ECUM[lane] = __expf(cs); }
            float xw[16];
#pragma unroll
            for (int i = 0; i < 16; ++i) { const int t = 16 * w4 + i;
                const float xs = siluf_(wx[0] * RAWG(rx, i) + wx[1] * RAWG(rx, i + 1) + wx[2] * RAWG(rx, i + 2) + wx[3] * RAWG(rx, i + 3) + bx);
                XR[t * LS + lane] = cvt_bf16(xs); tv[i] = xs * __shfl(dt, t); xw[i] = tv[i] * __shfl(wsc, t); }
            ssd_pack16(XVT + lane * LS + 16 * w4, tv);
            ssd_pack16(XVWT + lane * LS + 16 * w4, xw);
#pragma unroll
            for (int a = 0; a < 2; ++a)
#pragma unroll
                for (int nv = 0; nv < 4; ++nv) st4(ZT, LS2, 16 * nv + r, 16 * (2 * w4 + a) + 4 * q, zs[a][nv]);
        }
        WG_BAR();
        if (ch + 1 < ch_hi) load_raw(ch + 1);
        f32x4 yv[4];
        {
            const int m = w4;
            f32x4 Pt[4];
#pragma unroll
            for (int n = 0; n < 4; ++n) Pt[n] = zero4();
            bf16x8 ac[4];
#pragma unroll
            for (int k = 0; k < 4; ++k) ac[k] = ld_frag(CM, LS2, 16 * m + r, 32 * k, q);
            const float cumt = CUM[16 * m + r];
#pragma unroll
            for (int n = 0; n < 4; ++n) if (n <= m) {
#pragma unroll
                for (int k = 0; k < 4; ++k) Pt[n] = MFMA16(ld_frag(BM, LS2, 16 * n + r, 32 * k, q), ac[k], Pt[n]);
                const f32x4 cs = *(const LAS f32x4*)(CUM + 16 * n + 4 * q);
#pragma unroll
                for (int i = 0; i < 4; ++i) { const bool keep = (n < m) || (4 * q + i <= r); Pt[n][i] = keep ? Pt[n][i] * __expf(cumt - cs[i]) : 0.f; }
            }
            f32x4 O[4];
            const float ect = ECUM[16 * m + r];
#pragma unroll
            for (int nv = 0; nv < 4; ++nv) O[nv] = zero4();
#pragma unroll
            for (int k = 0; k < 4; ++k)
#pragma unroll
                for (int nv = 0; nv < 4; ++nv) O[nv] = MFMA16(ld_frag(ZT, LS2, 16 * nv + r, 32 * k, q), ac[k], O[nv]);
#pragma unroll
            for (int nv = 0; nv < 4; ++nv) O[nv] = O[nv] * ect;
#pragma unroll
            for (int k = 0; k < 2; ++k) if (2 * k <= m) { const bf16x8 pf = pack_frag(Pt[2 * k], Pt[2 * k + 1]);
#pragma unroll
                for (int nv = 0; nv < 4; ++nv) O[nv] = MFMA16(ld_frag_perm(XVT, LS, 16 * nv + r, 32 * k, q), pf, O[nv]); }
            const int t = ch * 64 + 16 * m + r;
            float ss = 0.f;
#pragma unroll
            for (int nv = 0; nv < 4; ++nv) { const int p0 = 16 * nv + 4 * q;
                const v2u xr = *(const LAS v2u*)(XR + (16 * m + r) * LS + p0);
                const v2u zr = *(const v2u*)(P + (size_t)t * NP + C_Z + 512 + h * 64 + p0);
                const float x0 = __builtin_bit_cast(float, xr.x << 16), x1 = __builtin_bit_cast(float, xr.x & 0xffff0000u), x2 = __builtin_bit_cast(float, xr.y << 16), x3 = __builtin_bit_cast(float, xr.y & 0xffff0000u);
                const float z0 = __builtin_bit_cast(float, zr.x << 16), z1 = __builtin_bit_cast(float, zr.x & 0xffff0000u), z2 = __builtin_bit_cast(float, zr.y << 16), z3 = __builtin_bit_cast(float, zr.y & 0xffff0000u);
                yv[nv][0] = (O[nv][0] + x0 * dsk) * siluf_(z0); yv[nv][1] = (O[nv][1] + x1 * dsk) * siluf_(z1);
                yv[nv][2] = (O[nv][2] + x2 * dsk) * siluf_(z2); yv[nv][3] = (O[nv][3] + x3 * dsk) * siluf_(z3);
                ss += (yv[nv][0] * yv[nv][0] + yv[nv][1] * yv[nv][1]) + (yv[nv][2] * yv[nv][2] + yv[nv][3] * yv[nv][3]); }
            ss += __shfl_xor(ss, 16); ss += __shfl_xor(ss, 32);
            if (q == 0) SS[hh * 64 + 16 * m + r] = ss;
            if (seg == 2) {
                unsigned char* cb = cbuf_h + ((size_t)(ch - CSPLIT_S) * 2 + hh) * 8448;
#pragma unroll
                for (int nv = 0; nv < 4; ++nv) { const int p0 = 16 * nv + 4 * q;
                    const v2u xr = *(const LAS v2u*)(XR + (16 * m + r) * LS + p0);
                    const float x0 = __builtin_bit_cast(float, xr.x << 16), x1 = __builtin_bit_cast(float, xr.x & 0xffff0000u), x2 = __builtin_bit_cast(float, xr.y << 16), x3 = __builtin_bit_cast(float, xr.y & 0xffff0000u);
                    v2u o; o.x = pk_bf16(O[nv][0] + x0 * dsk, O[nv][1] + x1 * dsk); o.y = pk_bf16(O[nv][2] + x2 * dsk, O[nv][3] + x3 * dsk);
                    *(v2u*)(cb + ((16 * m + r) * 64 + p0) * 2) = o; }
                if (q == 0) ((float*)(cb + 8192))[16 * m + r] = __expf(CUM[16 * m + r] + phis_now);
                { unsigned char* cc = cbuf_c + (size_t)(ch - CSPLIT_S) * 16384;
#pragma unroll
                  for (int j = 0; j < 2; ++j) { const int u = tid + 512 * j, row = u >> 4, part = u & 15;
                      *(v4u*)(cc + row * 256 + part * 16) = *(const LAS v4u*)((const LAS unsigned char*)CM + row * (LS2 * 2) + part * 16); } }
            }
            const float el = ECUM[63];
#pragma unroll
            for (int a = 0; a < 2; ++a) { bf16x8 ab[2];
#pragma unroll
                for (int k = 0; k < 2; ++k) ab[k] = ld_frag(BT, LS, 16 * (2 * w4 + a) + r, 32 * k, q);
#pragma unroll
                for (int nv = 0; nv < 4; ++nv) { zs[a][nv] = zs[a][nv] * el;
#pragma unroll
                    for (int k = 0; k < 2; ++k) zs[a][nv] = MFMA16(ab[k], ld_frag(XVWT, LS, 16 * nv + r, 32 * k, q), zs[a][nv]); } }
        }
        WG_BAR();
        if (seg != 2) {
            const int m = w4, t = ch * 64 + 16 * m + r;
            const float tot = SS[16 * m + r] + SS[64 + 16 * m + r];
            const float rs = rsqrtf(tot * (1.f / 128.f) + 1e-6f);
#pragma unroll
            for (int nv = 0; nv < 4; ++nv) { const f32x4 gg = *(const f32x4*)(gnp + 16 * nv); v2u o; o.x = pk_bf16(yv[nv][0] * rs * gg[0], yv[nv][1] * rs * gg[1]); o.y = pk_bf16(yv[nv][2] * rs * gg[2], yv[nv][3] * rs * gg[3]);
                *(v2u*)(Yb + (size_t)t * DM + 512 + h * 64 + 16 * nv + 4 * q) = o; }
        }
    }
    if (seg == 1) { bf16* zb = (bf16*)(sbuf + hh * 16384);
#pragma unroll
        for (int a = 0; a < 2; ++a)
#pragma unroll
            for (int nv = 0; nv < 4; ++nv) { v2u o; o.x = pk_bf16(zs[a][nv][0], zs[a][nv][1]); o.y = pk_bf16(zs[a][nv][2], zs[a][nv][3]); *(v2u*)(zb + (16 * nv + r) * 128 + 16 * (2 * w4 + a) + 4 * q) = o; }
    }
}

__device__ __forceinline__ void rwkv_pre_block(const Inputs& in, const int layer, const bf16* __restrict__ PROJ, float* __restrict__ CUMo, float* __restrict__ CUMPo, float* __restrict__ AV, LAS float* ldsf, const int m0, const int tid) {
    LAS bf16* SWH = (LAS bf16*)ldsf; LAS bf16* SWL = SWH + 64 * LS; LAS bf16* SAH = SWL + 64 * LS;
    const float* mu = in.rwkv_mu + (size_t)layer * 896;
    { const int j = tid & 63, tg = tid >> 6; const float muw = mu[768 + j], mua = mu[832 + j];
#pragma unroll
      for (int tt = 0; tt < 8; ++tt) { const int t = tg * 8 + tt, m = m0 + t; const bool first = ((m & (SEQ - 1)) == 0);
          const float xw = bf2f(PROJ[(size_t)m * NP + C_RW_WD + j]), xa = bf2f(PROJ[(size_t)m * NP + C_RW_AD + j]);
          const float pw = first ? 0.f : bf2f(PROJ[(size_t)(m - 1) * NP + C_RW_WD + j]), pa = first ? 0.f : bf2f(PROJ[(size_t)(m - 1) * NP + C_RW_AD + j]);
          const float sw = tanhf(xw + (pw - xw) * muw), sa = xa + (pa - xa) * mua;
          const unsigned hw = f2bf(sw); const float hwf = __builtin_bit_cast(float, hw << 16);
          SWH[t * LS + j] = (bf16)hw; SWL[t * LS + j] = (bf16)f2bf(sw - hwf); SAH[t * LS + j] = (bf16)f2bf(sa); } }
    __syncthreads();
    { const int lane = tid & 63, w8 = __builtin_amdgcn_readfirstlane(tid >> 6), r = lane & 15, q = lane >> 4;
      const float* wup = in.rwkv_w_up + (size_t)layer * 64 * GW; const float* aup = in.rwkv_a_up + (size_t)layer * 64 * GW;
#pragma unroll
      for (int nn = 0; nn < 2; ++nn) {
          const int c = 32 * w8 + 16 * nn + r;
          bf16x8 bwh[2], bwl[2], bah[2];
#pragma unroll
          for (int kk = 0; kk < 2; ++kk) { union { unsigned u[4]; bf16x8 v; } xh, xl, xa;
#pragma unroll
              for (int p = 0; p < 4; ++p) { const int j0 = 32 * kk + 8 * q + 2 * p;
                  const float w0 = wup[(size_t)j0 * GW + c], w1 = wup[(size_t)(j0 + 1) * GW + c], a0 = aup[(size_t)j0 * GW + c], a1 = aup[(size_t)(j0 + 1) * GW + c];
                  const unsigned h0 = f2bf(w0), h1 = f2bf(w1);
                  xh.u[p] = h0 | (h1 << 16);
                  xl.u[p] = f2bf(w0 - __builtin_bit_cast(float, h0 << 16)) | (f2bf(w1 - __builtin_bit_cast(float, h1 << 16)) << 16);
                  xa.u[p] = f2bf(a0) | (f2bf(a1) << 16); }
              bwh[kk] = xh.v; bwl[kk] = xl.v; bah[kk] = xa.v; }
          const float w0c = in.rwkv_w0[layer * GW + c], a0c = in.rwkv_a0[layer * GW + c];
          f32x4 lwv[4];
#pragma unroll
          for (int m = 0; m < 4; ++m) { f32x4 wl = zero4(), al = zero4();
#pragma unroll
              for (int kk = 0; kk < 2; ++kk) { const bf16x8 ah = ld_frag(SWH, LS, 16 * m + r, 32 * kk, q), alo = ld_frag(SWL, LS, 16 * m + r, 32 * kk, q), aa = ld_frag(SAH, LS, 16 * m + r, 32 * kk, q);
                  wl = MFMA16(ah, bwh[kk], wl); wl = MFMA16(alo, bwh[kk], wl); wl = MFMA16(ah, bwl[kk], wl);
                  al = MFMA16(aa, bah[kk], al); }
#pragma unroll
              for (int i = 0; i < 4; ++i) { const float w = -softplusf_(-(wl[i] + w0c)) - 0.5f; lwv[m][i] = -__expf(w);
                  AV[(size_t)(m0 + 16 * m + 4 * q + i) * GW + c] = sigmoidf_(al[i] + a0c); } }
          float base = 0.f;
#pragma unroll
          for (int m = 0; m < 4; ++m) { const float s = (lwv[m][0] + lwv[m][1]) + (lwv[m][2] + lwv[m][3]);
              const float s0 = __shfl(s, r), s1 = __shfl(s, 16 + r), s2 = __shfl(s, 32 + r), s3 = __shfl(s, 48 + r);
              float run = base + (q > 0 ? s0 : 0.f) + (q > 1 ? s1 : 0.f) + (q > 2 ? s2 : 0.f);
#pragma unroll
              for (int i = 0; i < 4; ++i) { run += lwv[m][i]; CUMo[(size_t)(m0 + 16 * m + 4 * q + i) * GW + c] = run; }
              base += (s0 + s1) + (s2 + s3); }
      }
    }
    __syncthreads();
}

__device__ __forceinline__ void mixopt_rwkv(const Inputs& in, const int layer, const bf16* __restrict__ PROJ, const float* __restrict__ CUMg, const float* __restrict__ CUMPg, const float* __restrict__ AV, bf16* __restrict__ Yg,
                                            LAS unsigned char* L, const int b, const int h, const int tid) {
    const int lane0 = tid & 63, wave = __builtin_amdgcn_readfirstlane(tid >> 6), w4 = wave & 3;
    const bool act = wave < 4;
    LAS bf16* AT = (LAS bf16*)L; LAS bf16* RT = (LAS bf16*)(L + 9216); LAS bf16* BL = (LAS bf16*)(L + 18432); LAS bf16* KL = (LAS bf16*)(L + 27648);
    LAS bf16* BTT = (LAS bf16*)(L + 36864); LAS bf16* KTT = (LAS bf16*)(L + 46080); LAS bf16* VT = (LAS bf16*)(L + 55296); LAS bf16* ZT = (LAS bf16*)(L + 64512);
    LAS bf16* AMT = (LAS bf16*)(L + 73728); LAS bf16* RHST = (LAS bf16*)(L + 82944); LAS float* AD = (LAS float*)(L + 92160); LAS bf16* DT = (LAS bf16*)(L + 96256);
    LAS float* QTOT = (LAS float*)(L + 98304); LAS float* ELAST = (LAS float*)(L + 99328); LAS float* BON = (LAS float*)(L + 99584);
    LAS bf16* SAT = AT;
    const bf16* P = PROJ + (size_t)b * SEQ * NP; bf16* Yb = Yg + (size_t)b * SEQ * DM;
    const float* CUMb = CUMg + (size_t)b * SEQ * GW; const float* CUMPb = CUMPg + (size_t)b * SEQ * GW; const float* AVb = AV + (size_t)b * SEQ * GW;
    const float* mu = in.rwkv_mu + (size_t)layer * 896 + h * 64;
    f32x4 zs[4];
#pragma unroll
    for (int n = 0; n < 4; ++n) zs[n] = zero4();
    LAS unsigned char* RAWT = L + 73728; LAS float* CMT = (LAS float*)(L + 99840); LAS float* AVT = (LAS float*)(L + 116480);
    v4u st[16];
    auto stage_load = [&](int ch, int ht) {
#pragma unroll
        for (int i = 0; i < 7; ++i) { const int u = ht + 256 * i; const int row = u / 24, rem = u - row * 24, seg = rem >> 3, part = rem & 7; const int t = ch * 64 - 1 + row;
            st[i] = (u < 1560 && t >= 0) ? *(const v4u*)(P + (size_t)t * NP + C_RW_R + seg * 256 + h * 64 + part * 8) : (v4u){0u, 0u, 0u, 0u}; }
#pragma unroll
        for (int i = 0; i < 5; ++i) { const int u = ht + 256 * i; const int row = u >> 4, part = u & 15; const int t = ch * 64 - 1 + row;
            st[7 + i] = (u < 1040 && t >= 0) ? *(const v4u*)(CUMb + (size_t)t * GW + h * 64 + part * 4) : (v4u){0u, 0u, 0u, 0u}; }
#pragma unroll
        for (int i = 0; i < 4; ++i) { const int u = ht + 256 * i; const int row = u >> 4, part = u & 15; const int t = ch * 64 + row;
            st[12 + i] = *(const v4u*)(AVb + (size_t)t * GW + h * 64 + part * 4); }
    };
    auto stage_store = [&](int ht) {
#pragma unroll
        for (int i = 0; i < 7; ++i) { const int u = ht + 256 * i; const int row = u / 24, rem = u - row * 24; if (u < 1560) *(LAS v4u*)(RAWT + row * 384 + rem * 16) = st[i]; }
#pragma unroll
        for (int i = 0; i < 5; ++i) { const int u = ht + 256 * i; if (u < 1040) *(LAS v4u*)((LAS unsigned char*)CMT + u * 16) = st[7 + i]; }
#pragma unroll
        for (int i = 0; i < 4; ++i) { const int u = ht + 256 * i; *(LAS v4u*)((LAS unsigned char*)AVT + u * 16) = st[12 + i]; }
    };
    if (!act) { const int ht = opaque_i(tid - 256); stage_load(0, ht); stage_store(ht); }
    WG_BAR();
    for (int ch = 0; ch < SEQ / 64; ++ch) {
        if (act) { const int lane = opaque_i(lane0), r = lane & 15, q = lane >> 4;
            float rs[16], k2[16], kkv[16], tv[16];
            const float mu_r = mu[lane], mu_k = mu[256 + lane], mu_v = mu[512 + lane];
            const float kkc = in.rwkv_k_k[layer * GW + h * 64 + lane], kac = in.rwkv_k_a[layer * GW + h * 64 + lane], rkc = in.rwkv_r_k[layer * GW + h * 64 + lane];
            { const LAS bf16* rw = (const LAS bf16*)RAWT + (16 * w4) * 192 + lane;
              float pr = bf2f(rw[0]), pk = bf2f(rw[64]), pv = bf2f(rw[128]);
#pragma unroll
              for (int i = 0; i < 16; ++i) { const float xr = bf2f(rw[(i + 1) * 192]), xk = bf2f(rw[(i + 1) * 192 + 64]), xv = bf2f(rw[(i + 1) * 192 + 128]);
                  const float av = AVT[(16 * w4 + i) * 64 + lane];
                  rs[i] = xr + (pr - xr) * mu_r; const float ks = xk + (pk - xk) * mu_k; tv[i] = xv + (pv - xv) * mu_v;
                  kkv[i] = ks * kkc; k2[i] = ks * (1.f + (av - 1.f) * kac); pr = xr; pk = xk; pv = xv; } }
            ssd_pack16(VT + lane * LS + 16 * w4, tv);
            { float sq[16];
#pragma unroll
              for (int i = 0; i < 16; ++i) sq[i] = kkv[i] * kkv[i];
              const float sred = tr_reduce16(sq, lane);
#pragma unroll
              for (int i = 0; i < 16; ++i) kkv[i] *= rsqrtf(rdlane(sred, 4 * i) + 1e-6f);
#pragma unroll
              for (int i = 0; i < 16; ++i) sq[i] = rs[i] * k2[i] * rkc;
              const float bred = tr_reduce16(sq, lane);
              if ((lane & 3) == 0) BON[16 * w4 + (lane >> 2)] = bred; }
#pragma unroll
            for (int i = 0; i < 16; ++i) { const float cum = CMT[(16 * w4 + i + 1) * 64 + lane]; const int t = 16 * w4 + i;
                const float en = __expf(-cum); const float cump = (i == 0 && w4 == 0) ? 0.f : CMT[(16 * w4 + i) * 64 + lane];
                AT[t * LS + lane] = cvt_bf16(-kkv[i] * __expf(cump));
                RT[t * LS + lane] = cvt_bf16(rs[i] * __expf(cum));
                kkv[i] = kkv[i] * AVT[(16 * w4 + i) * 64 + lane] * en; k2[i] = k2[i] * en;
                BL[t * LS + lane] = cvt_bf16(kkv[i]); KL[t * LS + lane] = cvt_bf16(k2[i]); }
            ssd_pack16(BTT + lane * LS + 16 * w4, kkv);
            ssd_pack16(KTT + lane * LS + 16 * w4, k2);
            if (w4 == 3) ELAST[lane] = __expf(CMT[64 * 64 + lane]);
#pragma unroll
            for (int n = 0; n < 4; ++n) st4(ZT, LS, 16 * n + r, 16 * w4 + 4 * q, zs[n]);
        }
        WG_BAR();
        if (!act && ch + 1 < SEQ / 64) stage_load(ch + 1, opaque_i(tid - 256));
        const int m = w4;
        if (act) { const int lane = opaque_i(lane0), r = lane & 15, q = lane >> 4;
            f32x4 Aak[4];
            bf16x8 aa[2];
#pragma unroll
            for (int k = 0; k < 2; ++k) aa[k] = ld_frag(AT, LS, 16 * m + r, 32 * k, q);
#pragma unroll
            for (int n = 0; n < 4; ++n) { Aak[n] = zero4(); if (n <= m) {
                f32x4 ab = zero4();
#pragma unroll
                for (int k = 0; k < 2; ++k) { const bf16x8 fb = ld_frag(BL, LS, 16 * n + r, 32 * k, q), fk = ld_frag(KL, LS, 16 * n + r, 32 * k, q);
                    ab = MFMA16(aa[k], fb, ab);
                    Aak[n] = MFMA16(fk, aa[k], Aak[n]); }
                f32x4 av;
#pragma unroll
                for (int i = 0; i < 4; ++i) { const bool keep = (n < m) || (r < 4 * q + i); av[i] = keep ? -ab[i] : 0.f; }
                st4(AMT, LS, 16 * n + r, 16 * m + 4 * q, av);
                if (n == m) {
#pragma unroll
                    for (int i = 0; i < 4; ++i) AD[m * 256 + (4 * q + i) * 16 + r] = av[i];
#pragma unroll
                    for (int i = 0; i < 4; ++i) { const bool strict = (4 * q + i < r); Aak[n][i] = strict ? Aak[n][i] : 0.f; } }
            } }
            const bf16x8 p0 = pack_frag(Aak[0], Aak[1]), p1 = pack_frag(Aak[2], Aak[3]);
#pragma unroll
            for (int nv = 0; nv < 4; ++nv) { f32x4 rh = zero4();
#pragma unroll
                for (int k = 0; k < 2; ++k) rh = MFMA16(aa[k], ld_frag(ZT, LS, 16 * nv + r, 32 * k, q), rh);
                rh = MFMA16(p0, ld_frag_perm(VT, LS, 16 * nv + r, 0, q), rh);
                if (m >= 2) rh = MFMA16(p1, ld_frag_perm(VT, LS, 16 * nv + r, 32, q), rh);
                st4(RHST, LS, 16 * nv + r, 16 * m + 4 * q, rh); }
        }
        WG_BAR();
        if (act) { const int lane = opaque_i(lane0), r = lane & 15, q = lane >> 4;
            diag_inverse(AD, DT, lane);
            asm volatile("s_waitcnt lgkmcnt(0)" ::: "memory");
            f32x4 Tm[4];
            tri_inverse_row(AMT, DT, m, r, q, Tm);
            const bf16x8 t0 = pack_frag(Tm[0], Tm[1]), t1 = pack_frag(Tm[2], Tm[3]);
#pragma unroll
            for (int nv = 0; nv < 4; ++nv) { f32x4 sa = zero4();
                sa = MFMA16(t0, ld_frag_perm(RHST, LS, 16 * nv + r, 0, q), sa);
                if (m >= 2) sa = MFMA16(t1, ld_frag_perm(RHST, LS, 16 * nv + r, 32, q), sa);
                st4(SAT, LS, 16 * nv + r, 16 * m + 4 * q, sa); }
        }
        WG_BAR();
        if (!act && ch + 1 < SEQ / 64) stage_store(opaque_i(tid - 256));
        if (act) { const int lane = opaque_i(lane0), r = lane & 15, q = lane >> 4;
            f32x4 O[4];
            bf16x8 ar[2];
#pragma unroll
            for (int k = 0; k < 2; ++k) ar[k] = ld_frag(RT, LS, 16 * m + r, 32 * k, q);
            f32x4 Arb[4], Ark[4];
#pragma unroll
            for (int n = 0; n < 4; ++n) { Arb[n] = zero4(); Ark[n] = zero4(); if (n <= m) {
#pragma unroll
                for (int k = 0; k < 2; ++k) { Arb[n] = MFMA16(ld_frag(BL, LS, 16 * n + r, 32 * k, q), ar[k], Arb[n]); Ark[n] = MFMA16(ld_frag(KL, LS, 16 * n + r, 32 * k, q), ar[k], Ark[n]); }
                if (n == m) {
#pragma unroll
                    for (int i = 0; i < 4; ++i) { const bool incl = (4 * q + i <= r); Arb[n][i] = incl ? Arb[n][i] : 0.f; Ark[n][i] = incl ? Ark[n][i] : 0.f; } } } }
            const bf16x8 b0 = pack_frag(Arb[0], Arb[1]), b1 = pack_frag(Arb[2], Arb[3]), k0 = pack_frag(Ark[0], Ark[1]), k1 = pack_frag(Ark[2], Ark[3]);
            float s1 = 0.f;
#pragma unroll
            for (int nv = 0; nv < 4; ++nv) { O[nv] = zero4();
#pragma unroll
                for (int k = 0; k < 2; ++k) O[nv] = MFMA16(ld_frag(ZT, LS, 16 * nv + r, 32 * k, q), ar[k], O[nv]);
                O[nv] = MFMA16(ld_frag_perm(SAT, LS, 16 * nv + r, 0, q), b0, O[nv]);
                O[nv] = MFMA16(ld_frag_perm(VT, LS, 16 * nv + r, 0, q), k0, O[nv]);
                if (m >= 2) { O[nv] = MFMA16(ld_frag_perm(SAT, LS, 16 * nv + r, 32, q), b1, O[nv]); O[nv] = MFMA16(ld_frag_perm(VT, LS, 16 * nv + r, 32, q), k1, O[nv]); }
                s1 += (O[nv][0] + O[nv][1]) + (O[nv][2] + O[nv][3]); }
            s1 += __shfl_xor(s1, 16); s1 += __shfl_xor(s1, 32);
            const float mean = s1 * (1.f / 64.f); float s2 = 0.f;
#pragma unroll
            for (int nv = 0; nv < 4; ++nv) { O[nv] = O[nv] - mean; s2 += (O[nv][0] * O[nv][0] + O[nv][1] * O[nv][1]) + (O[nv][2] * O[nv][2] + O[nv][3] * O[nv][3]); }
            s2 += __shfl_xor(s2, 16); s2 += __shfl_xor(s2, 32);
            const float rstd = rsqrtf(s2 * (1.f / 64.f) + 64e-5f);
            const int t = ch * 64 + 16 * m + r; const float bon = BON[16 * m + r];
#pragma unroll
            for (int nv = 0; nv < 4; ++nv) { const int dv0 = 16 * nv + 4 * q, cc = h * 64 + dv0;
                const f32x4 lw4 = *(const f32x4*)(in.rwkv_ln_w + layer * GW + cc); const f32x4 lb4 = *(const f32x4*)(in.rwkv_ln_b + layer * GW + cc);
                const v2u zr = *(const v2u*)(P + (size_t)t * NP + C_Z + 768 + cc);
                const float z0 = __builtin_bit_cast(float, zr.x << 16), z1 = __builtin_bit_cast(float, zr.x & 0xffff0000u), z2 = __builtin_bit_cast(float, zr.y << 16), z3 = __builtin_bit_cast(float, zr.y & 0xffff0000u);
                const float v0 = bf2f(VT[(dv0 + 0) * LS + 16 * m + r]), v1 = bf2f(VT[(dv0 + 1) * LS + 16 * m + r]), v2 = bf2f(VT[(dv0 + 2) * LS + 16 * m + r]), v3 = bf2f(VT[(dv0 + 3) * LS + 16 * m + r]);
                v2u o; o.x = pk_bf16((O[nv][0] * rstd * lw4[0] + lb4[0] + bon * v0) * siluf_(z0), (O[nv][1] * rstd * lw4[1] + lb4[1] + bon * v1) * siluf_(z1));
                o.y = pk_bf16((O[nv][2] * rstd * lw4[2] + lb4[2] + bon * v2) * siluf_(z2), (O[nv][3] * rstd * lw4[3] + lb4[3] + bon * v3) * siluf_(z3));
                *(v2u*)(Yb + (size_t)t * DM + 768 + cc) = o; }
            const f32x4 el = *(const LAS f32x4*)(ELAST + 16 * w4 + 4 * q);
            bf16x8 ab2[2], ak2[2];
#pragma unroll
            for (int k = 0; k < 2; ++k) { ab2[k] = ld_frag(BTT, LS, 16 * w4 + r, 32 * k, q); ak2[k] = ld_frag(KTT, LS, 16 * w4 + r, 32 * k, q); }
#pragma unroll
            for (int n = 0; n < 4; ++n) {
#pragma unroll
                for (int k = 0; k < 2; ++k) { zs[n] = MFMA16(ab2[k], ld_frag(SAT, LS, 16 * n + r, 32 * k, q), zs[n]); zs[n] = MFMA16(ak2[k], ld_frag(VT, LS, 16 * n + r, 32 * k, q), zs[n]); }
                zs[n] = zs[n] * el; }
        }
        WG_BAR();
    }
}

__device__ __forceinline__ void mixopt_rwkv2(const Inputs& in, const int layer, const bf16* __restrict__ PROJ, const float* __restrict__ CUMg, const float* __restrict__ CUMPg, const float* __restrict__ AV, bf16* __restrict__ Yg,
                                            LAS unsigned char* L, const int b, const int h, const int tid, const int seg, bf16* __restrict__ sbuf, unsigned char* __restrict__ cbuf) {
    const int ch_lo = (seg == 2) ? CSPLIT : 0, ch_hi = (seg == 1) ? CSPLIT : SEQ / 64;
    const int lane0 = tid & 63, wave = __builtin_amdgcn_readfirstlane(tid >> 6), w4 = wave & 3;
    const bool act = wave < 4;
    LAS bf16* AT = (LAS bf16*)L; LAS bf16* RT = (LAS bf16*)(L + 9216); LAS bf16* BL = (LAS bf16*)(L + 18432); LAS bf16* KL = (LAS bf16*)(L + 27648);
    LAS bf16* BTT = (LAS bf16*)(L + 36864); LAS bf16* KTT = (LAS bf16*)(L + 46080); LAS bf16* VT = (LAS bf16*)(L + 55296); LAS bf16* ZT = (LAS bf16*)(L + 64512);
    LAS bf16* AMT = (LAS bf16*)(L + 73728); LAS bf16* RHST = (LAS bf16*)(L + 82944); LAS float* AD = (LAS float*)(L + 92160); LAS bf16* DT = (LAS bf16*)(L + 96256);
    LAS float* QTOT = (LAS float*)(L + 98304); LAS float* ELAST = (LAS float*)(L + 99328); LAS float* BON = (LAS float*)(L + 99584);
    LAS bf16* SAT = AT;
    const bf16* P = PROJ + (size_t)b * SEQ * NP; bf16* Yb = Yg + (size_t)b * SEQ * DM;
    const float* CUMb = CUMg + (size_t)b * SEQ * GW; const float* CUMPb = CUMPg + (size_t)b * SEQ * GW; const float* AVb = AV + (size_t)b * SEQ * GW;
    const float* mu = in.rwkv_mu + (size_t)layer * 896 + h * 64;
    f32x4 zs[4];
#pragma unroll
    for (int n = 0; n < 4; ++n) zs[n] = zero4();
    f32x4 ps[4];
    { const int lane_i = opaque_i(lane0), r0 = lane_i & 15, q0 = lane_i >> 4;
#pragma unroll
      for (int n = 0; n < 4; ++n)
#pragma unroll
          for (int i = 0; i < 4; ++i) ps[n][i] = (16 * w4 + 4 * q0 + i == 16 * n + r0) ? 1.f : 0.f; }
#define O zs
    LAS unsigned char* RAWT = L + 73728; LAS float* CMT = (LAS float*)(L + 99840); LAS float* AVT = (LAS float*)(L + 117248);
    LAS bf16* PT = (LAS bf16*)(L + 133632); LAS bf16* RHSHT = (LAS bf16*)(L + 142848); LAS bf16* SAHT = (LAS bf16*)(L + 152064);
    v4u st[9];
    auto stage_load_a = [&](int ch, int ht) {
#pragma unroll
        for (int i = 0; i < 5; ++i) { const int u = ht + 256 * i; const int row = u >> 4, part = u & 15; const int t = ch * 64 - 1 + row;
            st[i] = (u < 1040 && t >= 0) ? *(const v4u*)(CUMb + (size_t)t * GW + h * 64 + part * 4) : (v4u){0u, 0u, 0u, 0u}; }
#pragma unroll
        for (int i = 0; i < 4; ++i) { const int u = ht + 256 * i; const int row = u >> 4, part = u & 15; const int t = ch * 64 + row;
            st[5 + i] = *(const v4u*)(AVb + (size_t)t * GW + h * 64 + part * 4); }
    };
    auto stage_store_a = [&](int ht) {
#pragma unroll
        for (int i = 0; i < 5; ++i) { const int u = ht + 256 * i; if (u < 1040) *(LAS v4u*)((LAS unsigned char*)CMT + u * 16) = st[i]; }
#pragma unroll
        for (int i = 0; i < 4; ++i) { const int u = ht + 256 * i; *(LAS v4u*)((LAS unsigned char*)AVT + u * 16) = st[5 + i]; }
    };
    auto stage_dma_a = [&](int ch, int ht, int wv) {
#pragma unroll
        for (int i = 0; i < 5; ++i) if (i < 4 || wv == 0) { const int u = ht + 256 * i; const int uu = u < 1040 ? u : 1039; const int row = uu >> 4, part = uu & 15; const int t = ch * 64 - 1 + row;
            __builtin_amdgcn_global_load_lds((const GAS unsigned*)(CUMb + (size_t)t * GW + h * 64 + part * 4), (LAS unsigned*)((LAS unsigned char*)CMT + (64 * wv + 256 * i) * 16), 16, 0, 0); }
#pragma unroll
        for (int i = 0; i < 4; ++i) { const int u = ht + 256 * i; const int row = u >> 4, part = u & 15; const int t = ch * 64 + row;
            __builtin_amdgcn_global_load_lds((const GAS unsigned*)(AVb + (size_t)t * GW + h * 64 + part * 4), (LAS unsigned*)((LAS unsigned char*)AVT + (64 * wv + 256 * i) * 16), 16, 0, 0); }
    };
    auto stage_load_b = [&](int ch, int ht) {
#pragma unroll
        for (int i = 0; i < 7; ++i) { const int u = ht + 256 * i; const int row = u / 24, rem = u - row * 24, seg = rem >> 3, part = rem & 7; const int t = ch * 64 - 1 + row;
            st[i] = (u < 1560 && t >= 0) ? *(const v4u*)(P + (size_t)t * NP + C_RW_R + seg * 256 + h * 64 + part * 8) : (v4u){0u, 0u, 0u, 0u}; }
    };
    auto stage_store_b = [&](int ht) {
#pragma unroll
        for (int i = 0; i < 7; ++i) { const int u = ht + 256 * i; const int row = u / 24, rem = u - row * 24; if (u < 1560) *(LAS v4u*)(RAWT + row * 384 + rem * 16) = st[i]; }
    };
    auto stage_dma_b = [&](int ch, int ht, int wv) {
#pragma unroll
        for (int i = 0; i < 7; ++i) if (i < 6 || wv == 0) { const int u = ht + 256 * i; const int uu = u < 1560 ? u : 1559; const int row = uu / 24, rem = uu - row * 24, seg_ = rem >> 3, part = rem & 7; const int t = ch * 64 - 1 + row;
            __builtin_amdgcn_global_load_lds((const GAS unsigned*)(P + (size_t)t * NP + C_RW_R + seg_ * 256 + h * 64 + part * 8), (LAS unsigned*)(RAWT + (64 * wv + 256 * i) * 16), 16, 0, 0); }
    };
    if (!act) { const int ht = opaque_i(tid) - 256; stage_load_a(ch_lo, ht); stage_store_a(ht); stage_load_b(ch_lo, ht); stage_store_b(ht); }
    WG_BAR();
    for (int ch = ch_lo; ch < ch_hi; ++ch) {
        { const int lane = opaque_i(lane0), r = lane & 15, q = lane >> 4;
          const float mu_k = mu[256 + lane];
          const float kac = in.rwkv_k_a[layer * GW + h * 64 + lane];
          const LAS bf16* rw = (const LAS bf16*)RAWT + (16 * w4) * 192 + lane;
          float k2[16];
          if (act) {
            float kkv[16];
            const float kkc = in.rwkv_k_k[layer * GW + h * 64 + lane];
            { float pk = bf2f(rw[64]);
#pragma unroll
              for (int i = 0; i < 16; ++i) { const float xk = bf2f(rw[(i + 1) * 192 + 64]); const float av = AVT[(16 * w4 + i) * 64 + lane];
                  const float ks = xk + (pk - xk) * mu_k; kkv[i] = ks * kkc; k2[i] = ks * (1.f + (av - 1.f) * kac); pk = xk; } }
            { float sq[16];
#pragma unroll
              for (int i = 0; i < 16; ++i) sq[i] = kkv[i] * kkv[i];
              const float sred = tr_reduce16(sq, lane);
#pragma unroll
              for (int i = 0; i < 16; ++i) kkv[i] *= rsqrtf(rdlane(sred, 4 * i) + 1e-6f); }
#pragma unroll
            for (int i = 0; i < 16; ++i) { const float cum = CMT[(16 * w4 + i + 1) * 64 + lane]; const int t = 16 * w4 + i;
                const float en = __expf(-cum); const float cump = (i == 0 && w4 == 0) ? 0.f : CMT[(16 * w4 + i) * 64 + lane];
                AT[t * LS + lane] = cvt_bf16(-kkv[i] * __expf(cump));
                kkv[i] = kkv[i] * AVT[(16 * w4 + i) * 64 + lane] * en; k2[i] = k2[i] * en;
                BL[t * LS + lane] = cvt_bf16(kkv[i]); KL[t * LS + lane] = cvt_bf16(k2[i]); }
            ssd_pack16(BTT + lane * LS + 16 * w4, kkv);
            ssd_pack16(KTT + lane * LS + 16 * w4, k2);
            if (w4 == 3) ELAST[lane] = __expf(CMT[64 * 64 + lane]);
#pragma unroll
            for (int n = 0; n < 4; ++n) st4(ZT, LS, 16 * n + r, 16 * w4 + 4 * q, zs[n]);
            if (seg == 2) {
#pragma unroll
                for (int n = 0; n < 4; ++n) st4(PT, LS, 16 * n + r, 16 * w4 + 4 * q, ps[n]); }
          } else {
            float rs[16], tv[16];
            const float mu_r = mu[lane], mu_v = mu[512 + lane];
            const float rkc = in.rwkv_r_k[layer * GW + h * 64 + lane];
            { float pr = bf2f(rw[0]), pk = bf2f(rw[64]), pv = bf2f(rw[128]);
#pragma unroll
              for (int i = 0; i < 16; ++i) { const float xr = bf2f(rw[(i + 1) * 192]), xk = bf2f(rw[(i + 1) * 192 + 64]), xv = bf2f(rw[(i + 1) * 192 + 128]);
                  const float av = AVT[(16 * w4 + i) * 64 + lane];
                  rs[i] = xr + (pr - xr) * mu_r; const float ks = xk + (pk - xk) * mu_k; tv[i] = xv + (pv - xv) * mu_v;
                  k2[i] = ks * (1.f + (av - 1.f) * kac); pr = xr; pk = xk; pv = xv; } }
            ssd_pack16(VT + lane * LS + 16 * w4, tv);
            { float sq[16];
#pragma unroll
              for (int i = 0; i < 16; ++i) sq[i] = rs[i] * k2[i] * rkc;
              const float bred = tr_reduce16(sq, lane);
              if ((lane & 3) == 0) BON[16 * w4 + (lane >> 2)] = bred; }
#pragma unroll
            for (int i = 0; i < 16; ++i) RT[(16 * w4 + i) * LS + lane] = cvt_bf16(rs[i] * __expf(CMT[(16 * w4 + i + 1) * 64 + lane]));
          }
        }
        WG_BAR();
        if (!act && ch + 1 < ch_hi) stage_dma_a(ch + 1, opaque_i(tid) - 256, wave - 4);
        const int m = w4;
        f32x4 Arb[4], Ark[4];
        if (!act) { const int lane = opaque_i(lane0), r = lane & 15, q = lane >> 4;
            bf16x8 ar[2];
#pragma unroll
            for (int k = 0; k < 2; ++k) ar[k] = ld_frag(RT, LS, 16 * m + r, 32 * k, q);
#pragma unroll
            for (int n = 0; n < 4; ++n) { Arb[n] = zero4(); Ark[n] = zero4(); if (n <= m) {
#pragma unroll
                for (int k = 0; k < 2; ++k) { Arb[n] = MFMA16(ld_frag(BL, LS, 16 * n + r, 32 * k, q), ar[k], Arb[n]); Ark[n] = MFMA16(ld_frag(KL, LS, 16 * n + r, 32 * k, q), ar[k], Ark[n]); }
                if (n == m) {
#pragma unroll
                    for (int i = 0; i < 4; ++i) { const bool incl = (4 * q + i <= r); Arb[n][i] = incl ? Arb[n][i] : 0.f; Ark[n][i] = incl ? Ark[n][i] : 0.f; } } } }
        }
        if (act) { const int lane = opaque_i(lane0), r = lane & 15, q = lane >> 4;
            f32x4 Aak[4];
            bf16x8 aa[2];
#pragma unroll
            for (int k = 0; k < 2; ++k) aa[k] = ld_frag(AT, LS, 16 * m + r, 32 * k, q);
#pragma unroll
            for (int n = 0; n < 4; ++n) { Aak[n] = zero4(); if (n <= m) {
                f32x4 ab = zero4();
#pragma unroll
                for (int k = 0; k < 2; ++k) { const bf16x8 fb = ld_frag(BL, LS, 16 * n + r, 32 * k, q), fk = ld_frag(KL, LS, 16 * n + r, 32 * k, q);
                    ab = MFMA16(aa[k], fb, ab);
                    Aak[n] = MFMA16(fk, aa[k], Aak[n]); }
                f32x4 av;
#pragma unroll
                for (int i = 0; i < 4; ++i) { const bool keep = (n < m) || (r < 4 * q + i); av[i] = keep ? -ab[i] : 0.f; }
                st4(AMT, LS, 16 * n + r, 16 * m + 4 * q, av);
                if (n == m) {
#pragma unroll
                    for (int i = 0; i < 4; ++i) AD[m * 256 + (4 * q + i) * 16 + r] = av[i];
#pragma unroll
                    for (int i = 0; i < 4; ++i) { const bool strict = (4 * q + i < r); Aak[n][i] = strict ? Aak[n][i] : 0.f; } }
            } }
            const bf16x8 p0 = pack_frag(Aak[0], Aak[1]), p1 = pack_frag(Aak[2], Aak[3]);
#pragma unroll
            for (int nv = 0; nv < 4; ++nv) { f32x4 rh = zero4();
#pragma unroll
                for (int k = 0; k < 2; ++k) rh = MFMA16(aa[k], ld_frag(ZT, LS, 16 * nv + r, 32 * k, q), rh);
                rh = MFMA16(p0, ld_frag_perm(VT, LS, 16 * nv + r, 0, q), rh);
                if (m >= 2) rh = MFMA16(p1, ld_frag_perm(VT, LS, 16 * nv + r, 32, q), rh);
                st4(RHST, LS, 16 * nv + r, 16 * m + 4 * q, rh);
                if (seg == 2) { f32x4 rhh = zero4();
#pragma unroll
                    for (int k = 0; k < 2; ++k) rhh = MFMA16(aa[k], ld_frag(PT, LS, 16 * nv + r, 32 * k, q), rhh);
                    st4(RHSHT, LS, 16 * nv + r, 16 * m + 4 * q, rhh); } }
        }
        WG_BAR();
        if (!act) { const int lane = opaque_i(lane0), r = lane & 15, q = lane >> 4;
            bf16x8 ar[2];
#pragma unroll
            for (int k = 0; k < 2; ++k) ar[k] = ld_frag(RT, LS, 16 * m + r, 32 * k, q);
#pragma unroll
            for (int nv = 0; nv < 4; ++nv) { O[nv] = zero4();
#pragma unroll
                for (int k = 0; k < 2; ++k) O[nv] = MFMA16(ld_frag(ZT, LS, 16 * nv + r, 32 * k, q), ar[k], O[nv]);
                if (seg == 2) { ps[nv] = zero4();
#pragma unroll
                    for (int k = 0; k < 2; ++k) ps[nv] = MFMA16(ld_frag(PT, LS, 16 * nv + r, 32 * k, q), ar[k], ps[nv]); } }
        }
        if (act) { const int lane = opaque_i(lane0), r = lane & 15, q = lane >> 4;
            diag_inverse(AD, DT, lane);
            asm volatile("s_waitcnt lgkmcnt(0)" ::: "memory");
            f32x4 Tm[4];
            tri_inverse_row(AMT, DT, m, r, q, Tm);
            const bf16x8 t0 = pack_frag(Tm[0], Tm[1]), t1 = pack_frag(Tm[2], Tm[3]);
#pragma unroll
            for (int nv = 0; nv < 4; ++nv) { f32x4 sa = zero4();
                sa = MFMA16(t0, ld_frag_perm(RHST, LS, 16 * nv + r, 0, q), sa);
                if (m >= 2) sa = MFMA16(t1, ld_frag_perm(RHST, LS, 16 * nv + r, 32, q), sa);
                st4(SAT, LS, 16 * nv + r, 16 * m + 4 * q, sa);
                if (seg == 2) { f32x4 sh = zero4();
                    sh = MFMA16(t0, ld_frag_perm(RHSHT, LS, 16 * nv + r, 0, q), sh);
                    if (m >= 2) sh = MFMA16(t1, ld_frag_perm(RHSHT, LS, 16 * nv + r, 32, q), sh);
                    st4(SAHT, LS, 16 * nv + r, 16 * m + 4 * q, sh); } }
        }
        WG_BAR();
        if (!act) { const int lane = opaque_i(lane0), r = lane & 15, q = lane >> 4;
            if (ch + 1 < ch_hi) stage_dma_b(ch + 1, opaque_i(tid) - 256, wave - 4);
            const bf16x8 b0 = pack_frag(Arb[0], Arb[1]), b1 = pack_frag(Arb[2], Arb[3]), k0 = pack_frag(Ark[0], Ark[1]), k1 = pack_frag(Ark[2], Ark[3]);
            float s1 = 0.f;
#pragma unroll
            for (int nv = 0; nv < 4; ++nv) {
                O[nv] = MFMA16(ld_frag_perm(SAT, LS, 16 * nv + r, 0, q), b0, O[nv]);
                O[nv] = MFMA16(ld_frag_perm(VT, LS, 16 * nv + r, 0, q), k0, O[nv]);
                if (m >= 2) { O[nv] = MFMA16(ld_frag_perm(SAT, LS, 16 * nv + r, 32, q), b1, O[nv]); O[nv] = MFMA16(ld_frag_perm(VT, LS, 16 * nv + r, 32, q), k1, O[nv]); }
                s1 += (O[nv][0] + O[nv][1]) + (O[nv][2] + O[nv][3]); }
            if (seg == 2) { unsigned char* cb = cbuf + (size_t)(ch - CSPLIT) * 16640;
#pragma unroll
                for (int nv = 0; nv < 4; ++nv) {
                    ps[nv] = MFMA16(ld_frag_perm(SAHT, LS, 16 * nv + r, 0, q), b0, ps[nv]);
                    if (m >= 2) ps[nv] = MFMA16(ld_frag_perm(SAHT, LS, 16 * nv + r, 32, q), b1, ps[nv]);
                    v2u o; o.x = pk_bf16(O[nv][0], O[nv][1]); o.y = pk_bf16(O[nv][2], O[nv][3]); *(v2u*)(cb + ((16 * m + r) * 64 + 16 * nv + 4 * q) * 2) = o;
                    v2u g; g.x = pk_bf16(ps[nv][0], ps[nv][1]); g.y = pk_bf16(ps[nv][2], ps[nv][3]); *(v2u*)(cb + 8192 + ((16 * m + r) * 64 + 16 * nv + 4 * q) * 2) = g; }
                if (q == 0) ((float*)(cb + 16384))[16 * m + r] = BON[16 * m + r];
            } else {
            s1 += __shfl_xor(s1, 16); s1 += __shfl_xor(s1, 32);
            const float mean = s1 * (1.f / 64.f); float s2 = 0.f;
#pragma unroll
            for (int nv = 0; nv < 4; ++nv) { O[nv] = O[nv] - mean; s2 += (O[nv][0] * O[nv][0] + O[nv][1] * O[nv][1]) + (O[nv][2] * O[nv][2] + O[nv][3] * O[nv][3]); }
            s2 += __shfl_xor(s2, 16); s2 += __shfl_xor(s2, 32);
            const float rstd = rsqrtf(s2 * (1.f / 64.f) + 64e-5f);
            const int t = ch * 64 + 16 * m + r; const float bon = BON[16 * m + r];
#pragma unroll
            for (int nv = 0; nv < 4; ++nv) { const int dv0 = 16 * nv + 4 * q, cc = h * 64 + dv0;
                const f32x4 lw4 = *(const f32x4*)(in.rwkv_ln_w + layer * GW + cc); const f32x4 lb4 = *(const f32x4*)(in.rwkv_ln_b + layer * GW + cc);
                const v2u zr = *(const v2u*)(P + (size_t)t * NP + C_Z + 768 + cc);
                const float z0 = __builtin_bit_cast(float, zr.x << 16), z1 = __builtin_bit_cast(float, zr.x & 0xffff0000u), z2 = __builtin_bit_cast(float, zr.y << 16), z3 = __builtin_bit_cast(float, zr.y & 0xffff0000u);
                const float v0 = bf2f(VT[(dv0 + 0) * LS + 16 * m + r]), v1 = bf2f(VT[(dv0 + 1) * LS + 16 * m + r]), v2 = bf2f(VT[(dv0 + 2) * LS + 16 * m + r]), v3 = bf2f(VT[(dv0 + 3) * LS + 16 * m + r]);
                v2u o; o.x = pk_bf16((O[nv][0] * rstd * lw4[0] + lb4[0] + bon * v0) * siluf_(z0), (O[nv][1] * rstd * lw4[1] + lb4[1] + bon * v1) * siluf_(z1));
                o.y = pk_bf16((O[nv][2] * rstd * lw4[2] + lb4[2] + bon * v2) * siluf_(z2), (O[nv][3] * rstd * lw4[3] + lb4[3] + bon * v3) * siluf_(z3));
                *(v2u*)(Yb + (size_t)t * DM + 768 + cc) = o; }
            }
        }
        if (act) { const int lane = opaque_i(lane0), r = lane & 15, q = lane >> 4;
            const f32x4 el = *(const LAS f32x4*)(ELAST + 16 * w4 + 4 * q);
            bf16x8 ab2[2], ak2[2];
#pragma unroll
            for (int k = 0; k < 2; ++k) { ab2[k] = ld_frag(BTT, LS, 16 * w4 + r, 32 * k, q); ak2[k] = ld_frag(KTT, LS, 16 * w4 + r, 32 * k, q); }
#pragma unroll
            for (int n = 0; n < 4; ++n) {
#pragma unroll
                for (int k = 0; k < 2; ++k) { zs[n] = MFMA16(ab2[k], ld_frag(SAT, LS, 16 * n + r, 32 * k, q), zs[n]); zs[n] = MFMA16(ak2[k], ld_frag(VT, LS, 16 * n + r, 32 * k, q), zs[n]); }
                zs[n] = zs[n] * el; }
            if (seg == 2) {
#pragma unroll
                for (int n = 0; n < 4; ++n) {
#pragma unroll
                    for (int k = 0; k < 2; ++k) ps[n] = MFMA16(ab2[k], ld_frag(SAHT, LS, 16 * n + r, 32 * k, q), ps[n]);
                    ps[n] = ps[n] * el; } }
        }
        WG_BAR();
    }
    if (seg == 1 && act) { const int lane = opaque_i(lane0), r = lane & 15, q = lane >> 4;
#pragma unroll
        for (int n = 0; n < 4; ++n) { v2u o; o.x = pk_bf16(zs[n][0], zs[n][1]); o.y = pk_bf16(zs[n][2], zs[n][3]); *(v2u*)(sbuf + (16 * n + r) * 64 + 16 * w4 + 4 * q) = o; }
    }
}
#undef O

#ifndef MK_MASK
#define MK_MASK 31
#endif
#ifndef REP_MASK
#define REP_MASK 0
#endif

constexpr int NWAVES = 8;
constexpr size_t MiB = 1u << 20;
constexpr size_t WS_CTL = 0, CTL_ZERO_BYTES = 64 * 1024;
constexpr size_t WS_WIN = 1 * MiB;
constexpr size_t WS_WOUT = 18 * MiB;
constexpr size_t WS_U = 22 * MiB;
constexpr size_t WS_PROJ = 54 * MiB;
constexpr size_t WS_OUT = 190 * MiB;
constexpr size_t CB_HGRN = 16 * MiB, CB_GDN = 16 * MiB + 7680 * 1024, SB_BASE = 16 * MiB + 14848 * 1024  , CB_RWKV = 48 * MiB, CB_SSD = 48 * MiB + 7680 * 1024, CB_SSDC = 60 * MiB;
constexpr int CW_BAR = 4096;
constexpr int LDSCTL_OFF = 162816, MISC_OFF = LDSCTL_OFF + 320, LDS_BYTES = 163840;

struct Args { Inputs in; float* out; unsigned char* ws; };
__device__ __forceinline__ int opaque_v(int v) { asm volatile("" : "+v"(v)); return v; }

__device__ __forceinline__ void wprep_load(const float* __restrict__ W, int N, int use_perm, int n0, int k0, int tid, LAS float* tile) {
    const int nn = tid & 31, kq = tid >> 5;
    const int oc = use_perm ? old_col(n0 + nn) : (n0 + nn);
#pragma unroll
    for (int i = 0; i < 8; ++i) { const int kk = kq + 8 * i; tile[kk * 33 + nn] = (oc >= 0) ? W[(size_t)(k0 + kk) * N + oc] : 0.f; }
}
__device__ __forceinline__ void wprep_store(bf16* __restrict__ WT, int K, int n0, int k0, int tid, const LAS float* tile) {
    const int n = tid >> 3, kc = (tid & 7) * 8;
    uint4 o;
    o.x = f2bf(tile[(kc + 0) * 33 + n]) | (f2bf(tile[(kc + 1) * 33 + n]) << 16);
    o.y = f2bf(tile[(kc + 2) * 33 + n]) | (f2bf(tile[(kc + 3) * 33 + n]) << 16);
    o.z = f2bf(tile[(kc + 4) * 33 + n]) | (f2bf(tile[(kc + 5) * 33 + n]) << 16);
    o.w = f2bf(tile[(kc + 6) * 33 + n]) | (f2bf(tile[(kc + 7) * 33 + n]) << 16);
    *(uint4*)(WT + (size_t)(n0 + n) * K + k0 + kc) = o;
}

__device__ __forceinline__ void rmsnorm_row_bf16(const float* __restrict__ hrow, const float* __restrict__ g, bf16* __restrict__ urow, int lane) {
    const float4* xr = (const float4*)hrow + lane; const float4* gr = (const float4*)g + lane;
    float4 v[4]; float s = 0.f;
#pragma unroll
    for (int j = 0; j < 4; ++j) { v[j] = xr[64 * j]; s += (v[j].x * v[j].x + v[j].y * v[j].y) + (v[j].z * v[j].z + v[j].w * v[j].w); }
    const float r = rsqrtf(wave_sum(s) * (1.f / DM) + 1e-6f);
    uint2* o8 = (uint2*)urow + lane;
#pragma unroll
    for (int j = 0; j < 4; ++j) { const float4 gg = gr[64 * j]; uint2 o;
        o.x = f2bf(v[j].x * r * gg.x) | (f2bf(v[j].y * r * gg.y) << 16); o.y = f2bf(v[j].z * r * gg.z) | (f2bf(v[j].w * r * gg.w) << 16); o8[64 * j] = o; }
}

__device__ __forceinline__ void post_row(const float* hrow, const float* __restrict__ orow_, const float* __restrict__ g, float* hnew, const float* __restrict__ g2, bf16* __restrict__ urow, int lane) {
    const float4* orow = (const float4*)orow_ + lane; const float4* hr = (const float4*)hrow + lane; const float4* gr = (const float4*)g + lane;
    float4 v[4]; float s = 0.f;
#pragma unroll
    for (int j = 0; j < 4; ++j) { v[j] = orow[64 * j]; s += (v[j].x * v[j].x + v[j].y * v[j].y) + (v[j].z * v[j].z + v[j].w * v[j].w); }
    const float r = rsqrtf(wave_sum(s) * (1.f / DM) + 1e-6f);
    float4* o = (float4*)hnew + lane; float s2 = 0.f;
#pragma unroll
    for (int j = 0; j < 4; ++j) { const float4 gg = gr[64 * j]; const float4 hh = hr[64 * j]; float4 w;
        w.x = hh.x + v[j].x * r * gg.x; w.y = hh.y + v[j].y * r * gg.y; w.z = hh.z + v[j].z * r * gg.z; w.w = hh.w + v[j].w * r * gg.w; o[64 * j] = w; v[j] = w;
        s2 += (w.x * w.x + w.y * w.y) + (w.z * w.z + w.w * w.w); }
    if (g2) {
        const float r2 = rsqrtf(wave_sum(s2) * (1.f / DM) + 1e-6f);
        const float4* g2r = (const float4*)g2 + lane; uint2* o8 = (uint2*)urow + lane;
#pragma unroll
        for (int j = 0; j < 4; ++j) { const float4 gg = g2r[64 * j]; uint2 q;
            q.x = f2bf(v[j].x * r2 * gg.x) | (f2bf(v[j].y * r2 * gg.y) << 16); q.y = f2bf(v[j].z * r2 * gg.z) | (f2bf(v[j].w * r2 * gg.w) << 16); o8[64 * j] = q; }
    }
}

#define CAS __attribute__((address_space(4)))
#define GRID_BAR() do { const CAS Args* apb = (const CAS Args*)__builtin_amdgcn_kernarg_segment_ptr(); asm volatile("" : "+s"(apb)); \
    XcdBarrier bq; bq.bar = (unsigned*)((gu32*)(apb->ws + WS_CTL) + CW_BAR); bq.x = xb_xcc_id(); bq.st = (volatile LAS unsigned*)(lds + MISC_OFF) + 8; \
    int wv_ = wave_k; asm volatile("" : "+s"(wv_)); xcd_barrier(bq, (wv_ << 6) | fresh_lane()); } while (0)
#define PHASE_LOCALS() \
    const CAS Args* ap = (const CAS Args*)__builtin_amdgcn_kernarg_segment_ptr(); asm volatile("" : "+s"(ap)); \
    Inputs in; in.x = ap->in.x; in.pre_norm_g = ap->in.pre_norm_g; in.w_in = ap->in.w_in; in.hgrn_lb = ap->in.hgrn_lb; in.hgrn_norm_g = ap->in.hgrn_norm_g; in.gdn_conv_w = ap->in.gdn_conv_w; in.gdn_a_log = ap->in.gdn_a_log; in.gdn_dt_bias = ap->in.gdn_dt_bias; in.gdn_norm_g = ap->in.gdn_norm_g; in.ssm_conv_w = ap->in.ssm_conv_w; in.ssm_conv_b = ap->in.ssm_conv_b; in.ssm_a_log = ap->in.ssm_a_log; in.ssm_dt_bias = ap->in.ssm_dt_bias; in.ssm_d = ap->in.ssm_d; in.ssm_norm_g = ap->in.ssm_norm_g; in.rwkv_mu = ap->in.rwkv_mu; in.rwkv_w0 = ap->in.rwkv_w0; in.rwkv_w_up = ap->in.rwkv_w_up; in.rwkv_a0 = ap->in.rwkv_a0; in.rwkv_a_up = ap->in.rwkv_a_up; in.rwkv_k_k = ap->in.rwkv_k_k; in.rwkv_k_a = ap->in.rwkv_k_a; in.rwkv_r_k = ap->in.rwkv_r_k; in.rwkv_ln_w = ap->in.rwkv_ln_w; in.rwkv_ln_b = ap->in.rwkv_ln_b; in.w_out = ap->in.w_out; in.post_norm_g = ap->in.post_norm_g; \
    unsigned char* ws = ap->ws; float* hout = ap->out; \
    int bx = blockIdx.x; asm volatile("" : "+s"(bx)); int G = gridDim.x; asm volatile("" : "+s"(G)); \
    const int lane = fresh_lane(); int wave = wave_k; asm volatile("" : "+s"(wave)); const int tid = (wave << 6) | lane; \
    bf16* Win = (bf16*)(ws + WS_WIN); bf16* Wout = (bf16*)(ws + WS_WOUT); bf16* U = (bf16*)(ws + WS_U); bf16* PROJ = (bf16*)(ws + WS_PROJ); float* OUT = (float*)(ws + WS_OUT); \
    (void)Win; (void)Wout; (void)U; (void)PROJ; (void)OUT; (void)hout; (void)bx; (void)G; (void)lane; (void)wave;

#define WPREP_ITEMS(LAYER, FIRST_WAVE, NUM_WAVES) do { \
        LAS float* scr = (LAS float*)(lds + wave * 8448); \
        constexpr int NB_IN = NP / 32, NB_OUT = DM / 32, IT_IN = NB_IN * (DM / 64), IT_OUT = NB_OUT * (DM / 64); \
        for (int it = (FIRST_WAVE); it < IT_IN + IT_OUT; it += (NUM_WAVES)) { \
            int rr = it; const int lw_ = (LAYER); \
            const float* W; bf16* WT; int N, perm, n0, k0; \
            if (rr < IT_IN) { W = in.w_in + (size_t)lw_ * DM * IN_COLS; N = IN_COLS; perm = 1; WT = Win + (size_t)lw_ * NP * DM; n0 = (rr % NB_IN) * 32; k0 = (rr / NB_IN) * 64; } \
            else { rr -= IT_IN; W = in.w_out + (size_t)lw_ * DM * DM; N = DM; perm = 0; WT = Wout + (size_t)lw_ * DM * DM; n0 = (rr % NB_OUT) * 32; k0 = (rr / NB_OUT) * 64; } \
            const int nl = lane & 31, oc = perm ? old_col(n0 + nl) : (n0 + nl); \
            const float* src = W + (size_t)(k0 + (lane >> 5)) * N + (oc >= 0 ? oc : 0); \
            _Pragma("unroll 8") \
            for (int i = 0; i < 32; ++i) { const float v = src[(size_t)(2 * i) * N]; scr[(2 * i + (lane >> 5)) * 33 + nl] = (oc >= 0) ? v : 0.f; } \
            LDS_WAIT(); asm volatile("" ::: "memory"); \
            const int cq = lane & 7; \
            _Pragma("unroll") \
            for (int j = 0; j < 4; ++j) { const int n = (lane >> 3) + 8 * j; const LAS float* s = scr + (8 * cq) * 33 + n; \
                v4u o; o.x = pk2(s[0 * 33], s[1 * 33]); o.y = pk2(s[2 * 33], s[3 * 33]); o.z = pk2(s[4 * 33], s[5 * 33]); o.w = pk2(s[6 * 33], s[7 * 33]); \
                *(v4u*)(WT + (size_t)(n0 + n) * DM + k0 + 8 * cq) = o; } \
            LDS_WAIT(); asm volatile("" ::: "memory"); \
        } } while (0)
__global__ void __launch_bounds__(NWAVES * 64, 2) mk_fwd(Args args) {
    extern __shared__ __attribute__((aligned(16))) unsigned char lds_raw[];
    LAS unsigned char* lds = (LAS unsigned char*)lds_raw;
    volatile LAS unsigned* MISC = (volatile LAS unsigned*)(lds + MISC_OFF);
    const int wave_k = __builtin_amdgcn_readfirstlane((int)threadIdx.x >> 6);
    for (int u = threadIdx.x; u < (LDS_BYTES - LDSCTL_OFF) / 4; u += NWAVES * 64) ((LAS unsigned*)(lds + LDSCTL_OFF))[u] = 0u;
    __syncthreads();
    (void)xcd_barrier_post((unsigned*)((gu32*)(args.ws + WS_CTL) + CW_BAR), MISC + 8, (int)threadIdx.x);

    for (int rep0 = 0; rep0 < ((REP_MASK & 256) ? 2 : 1); ++rep0) {
        PHASE_LOCALS();
        WPREP_ITEMS(0, bx * NWAVES + wave, G * NWAVES);
        for (int m = bx * NWAVES + wave; m < MTOK; m += G * NWAVES) rmsnorm_row_bf16(in.x + (size_t)m * DM, in.pre_norm_g, U + (size_t)m * DM, lane);
    }
    GRID_BAR();

#pragma unroll
    for (int l = 0; l < NLAYER; ++l) {
        { PHASE_LOCALS();
          pg8::Gemm g; g.A = U; g.Bt = Win + (size_t)l * NP * DM; g.M = MTOK; g.N = NP; g.K = DM;
          pg8::StaticOrder S; S.init(MTOK, NP, G, bx); S.wave_id = wave;
          pg8::EpiBf16<0> E; E.O = PROJ; E.ldc = NP; E.bias = nullptr; E.split_cols = 0; E.split_stride = 0;
          for (int rep = 0; rep < ((REP_MASK & 32) ? 2 : 1); ++rep) pg8::gemm_phase<pg8::EpiBf16<0>, pg8::StaticOrder, false>(lds, g, S, E, nullptr); }
        GRID_BAR();
        { PHASE_LOCALS();
          float* CUMW = OUT; float* CUMPW = OUT + (size_t)MTOK * GW; float* AVW = OUT + (size_t)2 * MTOK * GW;
          for (int rep = 0; rep < ((REP_MASK & 16) ? 2 : 1); ++rep) for (int blk = bx; blk < MTOK / 64; blk += G) { const int tid_l = opaque_v(tid); rwkv_pre_block(in, l, PROJ, CUMW, CUMPW, AVW, (LAS float*)lds, blk * 64, tid_l); } }
        GRID_BAR();
        for (int repm = 0; repm < ((REP_MASK & 1) ? 2 : 1); ++repm) { PHASE_LOCALS();
          const float* CUMW = OUT; const float* CUMPW = OUT + (size_t)MTOK * GW; const float* AVW = OUT + (size_t)2 * MTOK * GW;
          unsigned char* OB = (unsigned char*)OUT;
          if (bx < 64) { const int bh = bx >> 1, half = bx & 1;
              mixopt_hgrn<1>(in, l, PROJ, U, lds, bh >> 2, bh & 3, (wave << 6) | fresh_lane(), 1 + half, (bf16*)(OB + SB_BASE) + (size_t)(0 * 32 + bh) * 4096, (bf16*)(OB + CB_HGRN) + (size_t)bh * NSEG2 * 8192); }
          else if (bx < 128) { const int bh = (bx - 64) >> 1, half = (bx - 64) & 1;
              mixopt_gdn2(in, l, PROJ, U, lds, bh >> 2, bh & 3, (wave << 6) | fresh_lane(), 1 + half, (bf16*)(OB + SB_BASE) + (size_t)(1 * 32 + bh) * 4096, (bf16*)(OB + CB_GDN) + (size_t)bh * NSEG2 * 8192); }
          else if (bx < 160) { const int bg = (bx - 128) >> 1, half = (bx - 128) & 1;
              mixopt_ssd(in, l, PROJ, U, lds, bg >> 1, bg & 1, (wave << 6) | fresh_lane(), 1 + half, OB + SB_BASE + 96 * 8192 + (size_t)bg * 32768,
                         OB + CB_SSD + (size_t)bg * NSEG2_S * 2 * 8448, OB + CB_SSDC + (size_t)bg * NSEG2_S * 16384); }
          else if (bx < 224) { const int bh = (bx - 160) >> 1, half = (bx - 160) & 1;
              mixopt_rwkv2(in, l, PROJ, CUMW, CUMPW, AVW, U, lds, bh >> 2, bh & 3, (wave << 6) | fresh_lane(), 1 + half, (bf16*)(OB + SB_BASE) + (size_t)(2 * 32 + bh) * 4096, OB + CB_RWKV + (size_t)bh * NSEG2 * 16640); }
          else if (l + 1 < NLAYER) WPREP_ITEMS(l + 1, (bx - 224) * NWAVES + wave, (G - 224) * NWAVES); }
        GRID_BAR();
        for (int repc = 0; repc < ((REP_MASK & 2) ? 2 : 1); ++repc) { PHASE_LOCALS();
          const unsigned char* OB = (const unsigned char*)OUT;
          const int hh = wave >> 2, m = wave & 3;
          for (int it = bx; it < 16 * NSEG2; it += G) { const int b = it / (2 * NSEG2), rem = it - b * 2 * NSEG2, hp = rem / NSEG2, cc = rem - hp * NSEG2, h = 2 * hp + hh, bh = b * 4 + h;
              corr_item_rms(in.hgrn_norm_g + l * HD, PROJ + (size_t)b * SEQ * NP, U + (size_t)b * SEQ * DM, C_Z + 0 + h * 64, 0 + h * 64,
                            (const bf16*)(OB + SB_BASE) + (size_t)(0 * 32 + bh) * 4096, (const bf16*)(OB + CB_HGRN) + ((size_t)bh * NSEG2 + cc) * 8192, CSPLIT + cc, m, lane); }
          for (int it = bx; it < 16 * NSEG2; it += G) { const int b = it / (2 * NSEG2), rem = it - b * 2 * NSEG2, hp = rem / NSEG2, cc = rem - hp * NSEG2, h = 2 * hp + hh, bh = b * 4 + h;
              corr_item_rms(in.gdn_norm_g + l * HD, PROJ + (size_t)b * SEQ * NP, U + (size_t)b * SEQ * DM, C_Z + 256 + h * 64, 256 + h * 64,
                            (const bf16*)(OB + SB_BASE) + (size_t)(1 * 32 + bh) * 4096, (const bf16*)(OB + CB_GDN) + ((size_t)bh * NSEG2 + cc) * 8192, CSPLIT + cc, m, lane); }
          for (int it = bx; it < 16 * NSEG2; it += G) { const int b = it / (2 * NSEG2), rem = it - b * 2 * NSEG2, hp = rem / NSEG2, cc = rem - hp * NSEG2, h = 2 * hp + hh, bh = b * 4 + h;
              corr_item_rwkv(in, l, PROJ + (size_t)b * SEQ * NP, U + (size_t)b * SEQ * DM, h, (const bf16*)(OB + SB_BASE) + (size_t)(2 * 32 + bh) * 4096, OB + CB_RWKV + ((size_t)bh * NSEG2 + cc) * 16640, CSPLIT + cc, m, lane); }
          for (int it = bx; it < 16 * NSEG2_S; it += G) { const int bg = it / NSEG2_S, cc = it - bg * NSEG2_S, b = bg >> 1, g = bg & 1, h = 2 * g + hh;
              corr_item_ssd(in.ssm_norm_g + l * GW + h * 64, PROJ + (size_t)b * SEQ * NP, U + (size_t)b * SEQ * DM, h, hh,
                            (const bf16*)(OB + SB_BASE + 96 * 8192 + (size_t)bg * 32768 + hh * 16384), OB + CB_SSD + (((size_t)bg * NSEG2_S + cc) * 2 + hh) * 8448,
                            (const bf16*)(OB + CB_SSDC + ((size_t)bg * NSEG2_S + cc) * 16384), CSPLIT_S + cc, m, lane, (LAS float*)lds); }
        }
        GRID_BAR();
        { PHASE_LOCALS();
          pg8::Gemm g; g.A = U; g.Bt = Wout + (size_t)l * DM * DM; g.M = MTOK; g.N = DM; g.K = DM;
          pg8::StaticOrder S; S.init(MTOK, DM, G, bx); S.wave_id = wave;
          pg8::EpiF32 E; E.C = OUT; E.ldc = DM; E.bias = nullptr;
          for (int rep = 0; rep < ((REP_MASK & 64) ? 2 : 1); ++rep) pg8::gemm_phase<pg8::EpiF32, pg8::StaticOrder, false>(lds, g, S, E, nullptr); }
        GRID_BAR();
        { PHASE_LOCALS();
          const float* hin = (l == 0) ? in.x : hout;
          for (int m = bx * NWAVES + wave; m < MTOK; m += G * NWAVES)
            post_row(hin + (size_t)m * DM, OUT + (size_t)m * DM, in.post_norm_g + (size_t)l * DM, hout + (size_t)m * DM,
                     (l + 1 < NLAYER) ? in.pre_norm_g + (size_t)(l + 1) * DM : nullptr, U + (size_t)m * DM, lane); }
        if (l + 1 < NLAYER) GRID_BAR();
    }
}

extern "C" void kernel_launch(void* const* d_in, const int* in_sizes, int n_in, void* d_out, int out_size, void* d_ws, size_t ws_size, hipStream_t stream) {
    static int grid = 0;
    if (grid == 0) {
        int dev = 0, cus = 0, per_cu = 0;
        if (hipGetDevice(&dev) != hipSuccess || hipDeviceGetAttribute(&cus, hipDeviceAttributeMultiprocessorCount, dev) != hipSuccess) { fprintf(stderr, "kernel_launch: device query failed\n"); grid = -1; return; }
        if (hipFuncSetAttribute((const void*)mk_fwd, hipFuncAttributeMaxDynamicSharedMemorySize, LDS_BYTES) != hipSuccess) { fprintf(stderr, "kernel_launch: hipFuncSetAttribute failed\n"); grid = -1; return; }
        if (hipOccupancyMaxActiveBlocksPerMultiprocessor(&per_cu, (const void*)mk_fwd, NWAVES * 64, LDS_BYTES) != hipSuccess || per_cu < 1)
            fprintf(stderr, "kernel_launch: note: occupancy query reports %d workgroups per CU\n", per_cu);
        (void)hipGetLastError();
        grid = cus;
    }
    if (grid < 0) return;
    if (hipMemsetAsync((char*)d_ws + WS_CTL, 0, CTL_ZERO_BYTES, stream) != hipSuccess) { fprintf(stderr, "kernel_launch: memset failed\n"); return; }
    Args a{};
    { const float** ip = (const float**)&a.in; for (int i = 0; i < 27; ++i) ip[i] = (const float*)d_in[i]; }
    a.out = (float*)d_out; a.ws = (unsigned char*)d_ws;
    hipLaunchKernelGGL(mk_fwd, dim3(grid), dim3(NWAVES * 64), LDS_BYTES, stream, a);
}
```
